# Optimizing an MI355X kernel written in HIP

```python
import math
import jax, jax.numpy as jnp
from jax import lax
import numpy as np

D_MODEL = 1024
BATCH = 8
SEQ = 4096
DEPTH = 1

NSA_HEADS = 8
NSA_HEAD_DIM = 64
NSA_KV_GROUPS = 2
NSA_WIDTH = NSA_HEADS * NSA_HEAD_DIM
NSA_KV_WIDTH = NSA_KV_GROUPS * NSA_HEAD_DIM
CMP_LEN = 32
CMP_STRIDE = 16
CMP_HIDDEN = 256
SLC_BLOCK = 64
SLC_TOPK = 16
WINDOW = 512
QUERY_BLOCK = 64
BIG = 1e9

SSD_HEADS = 8
SSD_HEAD_DIM = 64
SSD_WIDTH = SSD_HEADS * SSD_HEAD_DIM
SSD_GROUPS = 2
SSD_STATE = 128
SSD_CONV = 4
SSD_CHUNK = 128
DT_MIN = 0.001
DT_MAX = 0.1

MEM_LEN = 256
XA_HEADS = 4
XA_HEAD_DIM = 128
XA_WIDTH = XA_HEADS * XA_HEAD_DIM

MIX_WIDTH = NSA_WIDTH + SSD_WIDTH + XA_WIDTH
ROPE_THETA = 500000.0
ROPE_DIM = NSA_HEAD_DIM // 4
POS_OFFSET_MAX = 1024
EPS = 1e-6

kernel_name = "hymba_nsa_ssd_memory_layer"


def _in_proj_sizes():
    return [NSA_WIDTH,
            NSA_KV_WIDTH, NSA_KV_WIDTH,
            NSA_KV_WIDTH, NSA_KV_WIDTH,
            NSA_KV_WIDTH, NSA_KV_WIDTH,
            NSA_HEADS * 3,
            NSA_WIDTH,
            SSD_WIDTH,
            SSD_WIDTH + 2 * SSD_GROUPS * SSD_STATE,
            SSD_HEADS,
            XA_WIDTH,
            XA_WIDTH]


def _rmsnorm(x, g):
    xf = x.astype(jnp.float32)
    y = xf * lax.rsqrt(jnp.mean(xf * xf, axis=-1, keepdims=True) + EPS)
    return (y * g.astype(jnp.float32)).astype(x.dtype)


def _masked_softmax(s, mask):
    s = jnp.where(mask, s.astype(jnp.float32), -1e30)
    s = s - jnp.max(s, axis=-1, keepdims=True)
    p = jnp.exp(s) * mask
    return p / jnp.maximum(jnp.sum(p, axis=-1, keepdims=True), 1e-30)


def _rope_tables(pos):
    inv = ROPE_THETA ** (-jnp.arange(0, ROPE_DIM, 2, dtype=jnp.float32) / ROPE_DIM)
    ang = pos.astype(jnp.float32)[..., None] * inv
    return jnp.cos(ang), jnp.sin(ang)


def _apply_rope(x, cos, sin):
    half = ROPE_DIM // 2
    shp = cos.shape[:2] + (1,) * (x.ndim - 3) + (half,)
    c = cos.reshape(shp).astype(x.dtype)
    s = sin.reshape(shp).astype(x.dtype)
    x1, x2, rest = x[..., :half], x[..., half:ROPE_DIM], x[..., ROPE_DIM:]
    return jnp.concatenate([x1 * c - x2 * s, x2 * c + x1 * s, rest], axis=-1)


def _nsa_mixer(q, k_c, v_c, k_s, v_s, k_w, v_w, gate_logits, positions,
               pos_k, w1_k, w2_k, pos_v, w1_v, w2_v):
    B, S = q.shape[0], q.shape[1]
    G, E, Dh = NSA_KV_GROUPS, NSA_HEADS // NSA_KV_GROUPS, NSA_HEAD_DIM
    scale = Dh ** -0.5
    q = q.reshape(B, S, G, E, Dh)
    k_c, v_c, k_s, v_s, k_w, v_w = [a.reshape(B, S, G, Dh) for a in (k_c, v_c, k_s, v_s, k_w, v_w)]
    cos, sin = _rope_tables(positions)
    q = _apply_rope(q, cos, sin)
    k_s = _apply_rope(k_s, cos, sin)
    k_w = _apply_rope(k_w, cos, sin)
    t = jnp.arange(S)

    R = CMP_LEN // CMP_STRIDE
    n_cmp = S // CMP_STRIDE - (R - 1)

    def compress(a, pos_emb, w1, w2):
        chunks = a.reshape(B, S // CMP_STRIDE, CMP_STRIDE, G, Dh)
        blocks = jnp.concatenate([chunks[:, r:r + n_cmp] for r in range(R)], axis=2)
        blocks = blocks + pos_emb[:, None, :]
        flat = blocks.transpose(0, 1, 3, 2, 4).reshape(B, n_cmp, G, CMP_LEN * Dh)
        return jax.nn.silu(flat @ w1) @ w2

    kc = compress(k_c, pos_k, w1_k, w2_k)
    vc = compress(v_c, pos_v, w1_v, w2_v)
    cmp_end = jnp.arange(n_cmp) * CMP_STRIDE + CMP_LEN - 1
    cos_c, sin_c = _rope_tables(positions[:, cmp_end])
    kc = _apply_rope(kc, cos_c, sin_c)
    s_c = jnp.einsum('bsged,bngd->bgesn', q, kc) * scale
    p_c = _masked_softmax(s_c, cmp_end[None, :] <= t[:, None])
    o_c = jnp.einsum('bgesn,bngd->bsged', p_c.astype(vc.dtype), vc)

    n_slc = S // SLC_BLOCK
    topk = min(SLC_TOPK, n_slc)
    cmp_start = cmp_end - (CMP_LEN - 1)
    slc_start = jnp.arange(n_slc) * SLC_BLOCK
    overlap = ((cmp_start[:, None] < slc_start[None, :] + SLC_BLOCK)
               & (cmp_start[:, None] + CMP_LEN > slc_start[None, :])).astype(jnp.float32)
    imp = jnp.einsum('bgesn,nj->bgsj', p_c, overlap)
    cur = t // SLC_BLOCK
    j = jnp.arange(n_slc)
    forced = (j[None, :] == 0) | (j[None, :] == cur[:, None]) | (j[None, :] == cur[:, None] - 1)
    valid = j[None, :] <= cur[:, None]
    imp = jnp.where(forced, BIG, jnp.where(valid, imp, -BIG))
    _, sel = lax.top_k(imp, topk)

    k_blk = k_s.reshape(B, n_slc, SLC_BLOCK, G, Dh).transpose(0, 3, 1, 2, 4)
    v_blk = v_s.reshape(B, n_slc, SLC_BLOCK, G, Dh).transpose(0, 3, 1, 2, 4)
    k_pad = jnp.pad(k_w, ((0, 0), (WINDOW, 0), (0, 0), (0, 0)))
    v_pad = jnp.pad(v_w, ((0, 0), (WINDOW, 0), (0, 0), (0, 0)))
    b_ix = jnp.arange(B)[:, None, None, None]
    g_ix = jnp.arange(G)[None, :, None, None]
    in_blk = jnp.arange(SLC_BLOCK)
    span = WINDOW + QUERY_BLOCK
    w_off = jnp.arange(span)
    n_sel_keys = topk * SLC_BLOCK

    def query_block(i):
        s0 = i * QUERY_BLOCK
        tq = s0 + jnp.arange(QUERY_BLOCK)
        qb = lax.dynamic_slice_in_dim(q, s0, QUERY_BLOCK, axis=1)
        sb = lax.dynamic_slice_in_dim(sel, s0, QUERY_BLOCK, axis=2)
        ks = k_blk[b_ix, g_ix, sb].reshape(B, G, QUERY_BLOCK, n_sel_keys, Dh)
        vs = v_blk[b_ix, g_ix, sb].reshape(B, G, QUERY_BLOCK, n_sel_keys, Dh)
        kpos = (sb[..., None] * SLC_BLOCK + in_blk).reshape(B, G, QUERY_BLOCK, n_sel_keys)
        ps = _masked_softmax(jnp.einsum('bqged,bgqkd->bgeqk', qb, ks) * scale,
                             (kpos <= tq[:, None])[:, :, None])
        o_s = jnp.einsum('bgeqk,bgqkd->bqged', ps.astype(vs.dtype), vs)
        kw = lax.dynamic_slice_in_dim(k_pad, s0, span, axis=1)
        vw = lax.dynamic_slice_in_dim(v_pad, s0, span, axis=1)
        kpos_w = s0 - WINDOW + w_off
        mw = ((kpos_w[None, :] <= tq[:, None]) & (kpos_w[None, :] > tq[:, None] - WINDOW)
              & (kpos_w[None, :] >= 0))
        pw = _masked_softmax(jnp.einsum('bqged,bkgd->bgeqk', qb, kw) * scale, mw)
        o_w = jnp.einsum('bgeqk,bkgd->bqged', pw.astype(vw.dtype), vw)
        return o_s, o_w

    o_s, o_w = lax.map(query_block, jnp.arange(S // QUERY_BLOCK))
    o_s = jnp.moveaxis(o_s, 0, 1).reshape(B, S, G, E, Dh)
    o_w = jnp.moveaxis(o_w, 0, 1).reshape(B, S, G, E, Dh)

    gates = jax.nn.sigmoid(gate_logits.astype(jnp.float32)).astype(q.dtype).reshape(B, S, G, E, 3)
    o = gates[..., 0:1] * o_c + gates[..., 1:2] * o_s + gates[..., 2:3] * o_w
    return o.reshape(B, S, NSA_WIDTH)


def _ssd_mixer(z, xbc, dt, conv_w, conv_b, dt_bias, a_log, d_skip, g_norm):
    B, S = xbc.shape[0], xbc.shape[1]
    H, P, G, N, L = SSD_HEADS, SSD_HEAD_DIM, SSD_GROUPS, SSD_STATE, SSD_CHUNK
    E = H // G
    nc = S // L
    f32 = jnp.float32
    xp = jnp.pad(xbc, ((0, 0), (SSD_CONV - 1, 0), (0, 0)))
    acc = conv_b
    for k in range(SSD_CONV):
        acc = acc + xp[:, k:k + S] * conv_w[k]
    xbc = jax.nn.silu(acc)
    xs, bm, cm = jnp.split(xbc, [SSD_WIDTH, SSD_WIDTH + G * N], axis=-1)
    xs = xs.astype(f32).reshape(B, nc, L, G, E, P)
    bm = bm.astype(f32).reshape(B, nc, L, G, N)
    cm = cm.astype(f32).reshape(B, nc, L, G, N)
    dt = jax.nn.softplus(dt.astype(f32) + dt_bias.astype(f32)).reshape(B, nc, L, G, E)
    a = -jnp.exp(a_log.astype(f32)).reshape(G, E)
    a_cs = jnp.cumsum((dt * a).transpose(0, 1, 3, 4, 2), axis=-1)
    causal = jnp.tril(jnp.ones((L, L), dtype=bool))
    decay_in = jnp.exp(jnp.where(causal, a_cs[..., :, None] - a_cs[..., None, :], -jnp.inf))
    xdt = xs * dt[..., None]
    cb = jnp.einsum('bclgn,bcsgn->bcgls', cm, bm)
    y_diag = jnp.einsum('bcgels,bcsgep->bclgep', cb[:, :, :, None] * decay_in, xdt)
    decay_out = jnp.exp(a_cs[..., -1:] - a_cs)
    states = jnp.einsum('bclgn,bcgel,bclgep->bcgepn', bm, decay_out, xdt)
    chunk_decay = jnp.exp(a_cs[..., -1])

    def step(h, inp):
        st, dec = inp
        return h * dec[..., None, None] + st, h

    h0 = jnp.zeros((B, G, E, P, N), f32)
    _, prev = lax.scan(step, h0, (jnp.moveaxis(states, 1, 0), jnp.moveaxis(chunk_decay, 1, 0)))
    prev = jnp.moveaxis(prev, 0, 1)
    y_off = jnp.einsum('bclgn,bcgepn,bcgel->bclgep', cm, prev, jnp.exp(a_cs))
    y = y_diag + y_off + xs * d_skip.astype(f32).reshape(G, E, 1)
    y = y.reshape(B, S, SSD_WIDTH)
    return _rmsnorm(y * jax.nn.silu(z.astype(f32)), g_norm).astype(z.dtype)


def _memory_attention(q, mem, g_mem, w_mem_kv):
    B, S = q.shape[0], q.shape[1]
    M = mem.shape[1]
    q = q.reshape(B, S, XA_HEADS, XA_HEAD_DIM)
    kv = _rmsnorm(mem, g_mem) @ w_mem_kv
    k, v = jnp.split(kv, 2, axis=-1)
    k = k.reshape(B, M, XA_HEADS, XA_HEAD_DIM)
    v = v.reshape(B, M, XA_HEADS, XA_HEAD_DIM)
    s = jnp.einsum('bshd,bmhd->bhsm', q, k).astype(jnp.float32) * (XA_HEAD_DIM ** -0.5)
    p = jax.nn.softmax(s, axis=-1).astype(v.dtype)
    return jnp.einsum('bhsm,bmhd->bshd', p, v).reshape(B, S, XA_WIDTH)


def setup_inputs(seed: int = 0) -> dict:
    key = jax.random.key(seed)
    ks = jax.random.split(key, 24)
    f32 = jnp.float32

    def nrm(k, shape, scale):
        return jax.random.normal(k, shape, f32) * scale

    n_in = sum(_in_proj_sizes())
    conv_dim = SSD_WIDTH + 2 * SSD_GROUPS * SSD_STATE
    dt0 = jnp.exp(jax.random.uniform(ks[14], (DEPTH, SSD_HEADS), f32)
                  * (math.log(DT_MAX) - math.log(DT_MIN)) + math.log(DT_MIN))
    return {
        "x": nrm(ks[0], (BATCH, SEQ, D_MODEL), 1.0),
        "mem": nrm(ks[1], (BATCH, MEM_LEN, D_MODEL), 1.0),
        "positions": (jnp.arange(SEQ, dtype=jnp.int32)[None, :]
                      + jax.random.randint(ks[2], (BATCH, 1), 0, POS_OFFSET_MAX, dtype=jnp.int32)),
        "g_in": 1.0 + nrm(ks[3], (DEPTH, D_MODEL), 0.02),
        "w_in": nrm(ks[4], (DEPTH, D_MODEL, n_in), D_MODEL ** -0.5),
        "cmp_pos_k": nrm(ks[5], (DEPTH, CMP_LEN, NSA_HEAD_DIM), 0.02),
        "w_cmp1_k": nrm(ks[6], (DEPTH, CMP_LEN * NSA_HEAD_DIM, CMP_HIDDEN), (CMP_LEN * NSA_HEAD_DIM) ** -0.5),
        "w_cmp2_k": nrm(ks[7], (DEPTH, CMP_HIDDEN, NSA_HEAD_DIM), CMP_HIDDEN ** -0.5),
        "cmp_pos_v": nrm(ks[8], (DEPTH, CMP_LEN, NSA_HEAD_DIM), 0.02),
        "w_cmp1_v": nrm(ks[9], (DEPTH, CMP_LEN * NSA_HEAD_DIM, CMP_HIDDEN), (CMP_LEN * NSA_HEAD_DIM) ** -0.5),
        "w_cmp2_v": nrm(ks[10], (DEPTH, CMP_HIDDEN, NSA_HEAD_DIM), CMP_HIDDEN ** -0.5),
        "conv_w": nrm(ks[11], (DEPTH, SSD_CONV, conv_dim), SSD_CONV ** -0.5),
        "conv_b": nrm(ks[12], (DEPTH, conv_dim), 0.02),
        "dt_bias": dt0 + jnp.log(-jnp.expm1(-dt0)),
        "a_log": jnp.log(jax.random.uniform(ks[15], (DEPTH, SSD_HEADS), f32, 1.0, 16.0)),
        "d_skip": 1.0 + nrm(ks[16], (DEPTH, SSD_HEADS), 0.02),
        "g_ssd_norm": 1.0 + nrm(ks[17], (DEPTH, SSD_WIDTH), 0.02),
        "g_mem": 1.0 + nrm(ks[18], (DEPTH, D_MODEL), 0.02),
        "w_mem_kv": nrm(ks[19], (DEPTH, D_MODEL, 2 * XA_WIDTH), D_MODEL ** -0.5),
        "w_out": nrm(ks[20], (DEPTH, MIX_WIDTH, D_MODEL), MIX_WIDTH ** -0.5),
        "g_final": 1.0 + nrm(ks[21], (D_MODEL,), 0.02),
    }


def reference(x, mem, positions, g_in, w_in, cmp_pos_k, w_cmp1_k, w_cmp2_k, cmp_pos_v, w_cmp1_v,
              w_cmp2_v, conv_w, conv_b, dt_bias, a_log, d_skip, g_ssd_norm, g_mem, w_mem_kv, w_out,
              g_final):
    split_at = [int(v) for v in np.cumsum(_in_proj_sizes())[:-1]]
    h = x
    for l in range(DEPTH):
        xn = _rmsnorm(h, g_in[l])
        proj = xn @ w_in[l]
        (q_a, k_c, v_c, k_s, v_s, k_w, v_w, gate_logits, gate_a,
         z, xbc, dt, q_x, gate_x) = jnp.split(proj, split_at, axis=-1)
        o_a = _nsa_mixer(q_a, k_c, v_c, k_s, v_s, k_w, v_w, gate_logits, positions,
                         cmp_pos_k[l], w_cmp1_k[l], w_cmp2_k[l], cmp_pos_v[l], w_cmp1_v[l], w_cmp2_v[l])
        o_a = o_a * jax.nn.silu(gate_a)
        o_b = _ssd_mixer(z, xbc, dt, conv_w[l], conv_b[l], dt_bias[l], a_log[l], d_skip[l], g_ssd_norm[l])
        o_c = _memory_attention(q_x, mem, g_mem[l], w_mem_kv[l]) * jax.nn.silu(gate_x)
        h = h + jnp.concatenate([o_a, o_b, o_c], axis=-1) @ w_out[l]
    return _rmsnorm(h, g_final)
```

```cpp
#include <hip/hip_runtime.h>
#include <hip/hip_cooperative_groups.h>
#include <stdint.h>
#include <stdio.h>
namespace cg = cooperative_groups;

typedef unsigned short bf16_t;
typedef __attribute__((ext_vector_type(8))) short bf16x8;
typedef __attribute__((ext_vector_type(4))) short bf16x4;
typedef __attribute__((ext_vector_type(4))) float f32x4;

#define S_LEN 4096
#define T_TOK 32768
#define NIN 4384
#define NINP 4480
#define LOG2E 1.4426950408889634f

#define C_Q 0
#define C_KC 512
#define C_VC 640
#define C_KS 768
#define C_KW 1024
#define C_GL 1280
#define C_GA 1304
#define C_Z 1816
#define C_XBC 2328
#define C_DT 3352
#define C_QX 3360
#define C_GX 3872

#define SMEM_BYTES 73728
#ifndef REP0
#define REP0 1
#endif
#ifndef REP1
#define REP1 1
#endif
#ifndef REP2
#define REP2 1
#endif
#ifndef REP3
#define REP3 1
#endif
#ifndef REP5
#define REP5 1
#endif

struct Params {
  const float *x, *mem; const int* pos;
  const float *g_in, *w_in, *cpk, *w1k, *w2k, *cpv, *w1v, *w2v, *conv_w, *conv_b, *dt_bias, *a_log, *d_skip, *g_ssd, *g_mem, *w_kv, *w_out, *g_final;
  float* out;
  bf16_t *WinT, *WoutT, *WkvT, *W1kT, *W1vT, *W2kT, *W2vT, *XB, *MEMB, *PROJ, *VST, *VWT, *KMEM, *VMEMT, *KCMP, *VCMPT, *XT, *BC, *BT, *MIX, *KSC, *KWC;
  float *STATES, *CHDEC, *ACS, *DTV, *SS_SSD, *SS_OUT;
  unsigned* BAR;
  unsigned* MTCNT;
};

__device__ __forceinline__ bf16_t f2bf(float f) { uint32_t u = __float_as_uint(f); u += 0x7fffu + ((u >> 16) & 1u); return (bf16_t)(u >> 16); }
__device__ __forceinline__ float bf2f(bf16_t h) { return __uint_as_float(((uint32_t)h) << 16); }
__device__ __forceinline__ float bfs(short h) { return __uint_as_float(((uint32_t)(unsigned short)h) << 16); }
__device__ __forceinline__ float fexp2(float x) { return __builtin_amdgcn_exp2f(x); }
__device__ __forceinline__ float silu_f(float x) { return x * __builtin_amdgcn_rcpf(1.f + __builtin_amdgcn_exp2f(-1.4426950408889634f * x)); }
__device__ __forceinline__ float sigmoid_f(float x) { return __builtin_amdgcn_rcpf(1.f + __builtin_amdgcn_exp2f(-1.4426950408889634f * x)); }
__device__ __forceinline__ f32x4 mfma16(bf16x8 a, bf16x8 b, f32x4 c) { return __builtin_amdgcn_mfma_f32_16x16x32_bf16(a, b, c, 0, 0, 0); }
typedef __bf16 hbf2_t __attribute__((ext_vector_type(2)));
typedef float f2_t __attribute__((ext_vector_type(2)));
typedef uint32_t u32x2 __attribute__((ext_vector_type(2)));
typedef uint32_t u32x4 __attribute__((ext_vector_type(4)));
__device__ __forceinline__ uint32_t pk2(float a, float b) {
  f2_t v; v[0] = a; v[1] = b;
  hbf2_t r = __builtin_convertvector(v, hbf2_t);
  return __builtin_bit_cast(uint32_t, r);
}
__device__ __forceinline__ bf16x4 pack4(float a, float b, float c, float d) {
  u32x2 r; r[0] = pk2(a, b); r[1] = pk2(c, d); return __builtin_bit_cast(bf16x4, r);
}
__device__ __forceinline__ bf16x8 pack8(float a, float b, float c, float d, float e, float f, float g, float h) {
  u32x4 r; r[0] = pk2(a, b); r[1] = pk2(c, d); r[2] = pk2(e, f); r[3] = pk2(g, h); return __builtin_bit_cast(bf16x8, r);
}
__device__ __forceinline__ bf16x8 cat44(bf16x4 a, bf16x4 b) {
  u32x2 x = __builtin_bit_cast(u32x2, a), y = __builtin_bit_cast(u32x2, b);
  u32x4 r; r[0] = x[0]; r[1] = x[1]; r[2] = y[0]; r[3] = y[1]; return __builtin_bit_cast(bf16x8, r);
}
template <int NR, typename L, typename ST, typename C>
__device__ __forceinline__ void tile_pipeline(int n, L load, ST store, C compute) {
  if (n <= 0) return;
  bf16x8 ra[NR], rb[NR];
  const int last = n - 1;
  load(0, ra);
  load(min(1, last), rb);
  store(0, ra);
  load(min(2, last), ra);
  __syncthreads();
  for (int i = 0; i < n; i += 2) {
    compute(i, 0);
    store(1, rb);
    load(min(i + 3, last), rb);
    __syncthreads();
    if (i + 1 < n) compute(i + 1, 1);
    store(0, ra);
    load(min(i + 4, last), ra);
    __syncthreads();
  }
}
template <int NR, typename L, typename ST, typename C>
__device__ __forceinline__ void tile_pipeline1(int n, L load, ST store, C compute) {
  if (n <= 0) return;
  bf16x8 ra[NR];
  load(0, ra);
  store(0, ra);
  if (n > 1) load(1, ra);
  __syncthreads();
  for (int i = 0; i < n; i++) {
    compute(i, i & 1);
    if (i + 1 < n) { store((i + 1) & 1, ra); if (i + 2 < n) load(i + 2, ra); }
    __syncthreads();
  }
}
__device__ __forceinline__ void rope_cs(int pos, int j, float& cs, float& sn) {
  float inv = fexp2(-(float)j * (18.931568569324174f / 8.f));
  float a = (float)pos * inv;
  float n = rintf(a * 0.15915494309189535f);
  float r = fmaf(-n, 6.28125f, a);
  r = fmaf(-n, 1.9353071795864769e-3f, r);
  cs = __cosf(r); sn = __sinf(r);
}

__device__ __forceinline__ float rowmax4(float x) {
  unsigned xi = __float_as_uint(x);
  auto a = __builtin_amdgcn_permlane16_swap(xi, xi, false, false);
  float m = fmaxf(__uint_as_float(a[0]), __uint_as_float(a[1]));
  unsigned mi = __float_as_uint(m);
  auto b = __builtin_amdgcn_permlane32_swap(mi, mi, false, false);
  return fmaxf(__uint_as_float(b[0]), __uint_as_float(b[1]));
}
__device__ __forceinline__ float rowsum4(float x) {
  unsigned xi = __float_as_uint(x);
  auto a = __builtin_amdgcn_permlane16_swap(xi, xi, false, false);
  float m = __uint_as_float(a[0]) + __uint_as_float(a[1]);
  unsigned mi = __float_as_uint(m);
  auto b = __builtin_amdgcn_permlane32_swap(mi, mi, false, false);
  return __uint_as_float(b[0]) + __uint_as_float(b[1]);
}
__device__ __forceinline__ int get_tid() { int t = threadIdx.x; asm volatile("" : "+v"(t)); return t; }

__device__ void prep_rows(const float* __restrict__ x, bf16_t* __restrict__ xb, int nrows, int gw, int nw) {
  const int lane = threadIdx.x & 63;
  int row = gw;
  for (; row + 3 * nw < nrows; row += 4 * nw) {
    float4 v[4][4]; float ss[4];
#pragma unroll
    for (int r = 0; r < 4; r++) {
      const float4* p = (const float4*)(x + (size_t)(row + r * nw) * 1024);
#pragma unroll
      for (int i = 0; i < 4; i++) v[r][i] = p[lane + 64 * i];
    }
#pragma unroll
    for (int r = 0; r < 4; r++) {
      float s = 0.f;
#pragma unroll
      for (int i = 0; i < 4; i++) s += v[r][i].x * v[r][i].x + v[r][i].y * v[r][i].y + v[r][i].z * v[r][i].z + v[r][i].w * v[r][i].w;
#pragma unroll
      for (int o = 32; o >= 1; o >>= 1) s += __shfl_xor(s, o);
      ss[r] = rsqrtf(s * (1.f / 1024.f) + 1e-6f);
    }
#pragma unroll
    for (int r = 0; r < 4; r++)
#pragma unroll
      for (int i = 0; i < 4; i++)
        *(bf16x4*)(xb + (size_t)(row + r * nw) * 1024 + (lane + 64 * i) * 4) =
            pack4(v[r][i].x * ss[r], v[r][i].y * ss[r], v[r][i].z * ss[r], v[r][i].w * ss[r]);
  }
  for (; row < nrows; row += nw) {
    const float4* p = (const float4*)(x + (size_t)row * 1024);
    float4 v[4]; float ss = 0.f;
#pragma unroll
    for (int i = 0; i < 4; i++) { v[i] = p[lane + 64 * i]; ss += v[i].x * v[i].x + v[i].y * v[i].y + v[i].z * v[i].z + v[i].w * v[i].w; }
#pragma unroll
    for (int o = 32; o >= 1; o >>= 1) ss += __shfl_xor(ss, o);
    float r = rsqrtf(ss * (1.f / 1024.f) + 1e-6f);
#pragma unroll
    for (int i = 0; i < 4; i++) {
      bf16x4 o = pack4(v[i].x * r, v[i].y * r, v[i].z * r, v[i].w * r);
      *(bf16x4*)(xb + (size_t)row * 1024 + (lane + 64 * i) * 4) = o;
    }
  }
}

__device__ void prep_wT(const float* __restrict__ w, const float* __restrict__ g, int gk0, int gk1, bf16_t* __restrict__ wt,
                        int K, int N, int Npad, int gtid, int gthreads) {
  int total = Npad * (K / 8);
  for (int u = gtid; u < total; u += gthreads) {
    int n = u % Npad, k8 = u / Npad;
    bf16x8 o;
#pragma unroll
    for (int j = 0; j < 8; j++) {
      int k = k8 * 8 + j; float v = 0.f;
      if (n < N) { v = w[(size_t)k * N + n]; if (g != nullptr && k >= gk0 && k < gk1) v *= g[k - gk0]; }
      o[j] = (short)f2bf(v);
    }
    *(bf16x8*)(wt + (size_t)n * K + k8 * 8) = o;
  }
}

__device__ void phase_prep(const Params& p) {
  const int gtid = blockIdx.x * 256 + threadIdx.x, gthreads = gridDim.x * 256;
  const int gw = gtid >> 6, nw = gthreads >> 6;
  prep_rows(p.x, p.XB, T_TOK, gw, nw);
  prep_rows(p.mem, p.MEMB, 2048, gw, nw);
  prep_wT(p.w_in, p.g_in, 0, 1024, p.WinT, 1024, NIN, NINP, gtid, gthreads);
  prep_wT(p.w_out, p.g_ssd, 512, 1024, p.WoutT, 1536, 1024, 1024, gtid, gthreads);
  prep_wT(p.w_kv, p.g_mem, 0, 1024, p.WkvT, 1024, 1024, 1024, gtid, gthreads);
  prep_wT(p.w1k, nullptr, 0, 0, p.W1kT, 2048, 256, 256, gtid, gthreads);
  prep_wT(p.w1v, nullptr, 0, 0, p.W1vT, 2048, 256, 256, gtid, gthreads);
  prep_wT(p.w2k, nullptr, 0, 0, p.W2kT, 256, 64, 64, gtid, gthreads);
  prep_wT(p.w2v, nullptr, 0, 0, p.W2vT, 256, 64, 64, gtid, gthreads);
  for (int i = gtid; i < T_TOK; i += gthreads) p.SS_OUT[i] = 0.f;
  for (int i = gtid; i < 16 * 64; i += gthreads) {
    int bg = i >> 6, d = i & 63;
    p.KCMP[((size_t)bg * 256 + 255) * 64 + d] = 0;
    p.VCMPT[((size_t)bg * 64 + d) * 256 + 255] = 0;
  }
}

template <int MODE>
__device__ void gemm_tile(const Params& p, int mt, int nt, char* smem) {
  const int tid = get_tid(), lane = tid & 63, wave = tid >> 6, lr = lane & 15, lg = lane >> 4;
  const int wr = wave >> 1, wc = wave & 1;
  const int m0 = mt * 128, n0 = nt * 128;
  const bf16_t* A; const bf16_t* Bt; int K;
  if (MODE == 0) { A = p.XB; Bt = p.WinT; K = 1024; }
  else if (MODE == 1) { A = p.MEMB; Bt = p.WkvT; K = 1024; }
  else { A = p.MIX; Bt = p.WoutT; K = 1536; }
  bf16_t* As = (bf16_t*)smem;
  bf16_t* Bs = As + 2 * 9216;
  const int lrow = tid >> 3, kc = tid & 7;
  const bf16_t* ga = A + (size_t)(m0 + lrow) * K + kc * 8;
  const bf16_t* gb = Bt + (size_t)(n0 + lrow) * K + kc * 8;
  float rs[4] = {1.f, 1.f, 1.f, 1.f};
  if (MODE == 2) {
#pragma unroll
    for (int i = 0; i < 4; i++) {
      const float4* sp = (const float4*)(p.SS_SSD + (size_t)(m0 + lrow + 32 * i) * 8);
      float4 a = sp[0], b = sp[1];
      rs[i] = rsqrtf((a.x + a.y + a.z + a.w + b.x + b.y + b.z + b.w) * (1.f / 512.f) + 1e-6f);
    }
  }
  bool swap;
  if (MODE == 0) swap = !(nt == 7 || nt == 9);
  else if (MODE == 1) swap = (nt < 4);
  else swap = true;
  const bf16_t* F = swap ? (Bs + (64 * wc) * 72) : (As + (64 * wr) * 72);
  const bf16_t* G = swap ? (As + (64 * wr) * 72) : (Bs + (64 * wc) * 72);
  f32x4 acc[4][4];
#pragma unroll
  for (int i = 0; i < 4; i++)
#pragma unroll
    for (int j = 0; j < 4; j++) acc[i][j] = (f32x4){0.f, 0.f, 0.f, 0.f};
  bf16x8 ra0[4], rb0[4], ra1[4], rb1[4];
  const int nk = K / 64;
  auto load = [&](int kt, bf16x8 (&ra)[4], bf16x8 (&rb)[4]) {
#pragma unroll
    for (int i = 0; i < 4; i++) {
      ra[i] = *(const bf16x8*)(ga + (size_t)(32 * i) * K + kt * 64);
      rb[i] = *(const bf16x8*)(gb + (size_t)(32 * i) * K + kt * 64);
    }
  };
  auto store = [&](int buf, int kt, bf16x8 (&ra)[4], bf16x8 (&rb)[4]) {
    if (MODE == 2) {
      if (kt >= 8 && kt < 16) {
#pragma unroll
        for (int i = 0; i < 4; i++) {
          bf16x8 v = ra[i];
          ra[i] = pack8(bfs(v[0]) * rs[i], bfs(v[1]) * rs[i], bfs(v[2]) * rs[i], bfs(v[3]) * rs[i],
                        bfs(v[4]) * rs[i], bfs(v[5]) * rs[i], bfs(v[6]) * rs[i], bfs(v[7]) * rs[i]);
        }
      }
    }
#pragma unroll
    for (int i = 0; i < 4; i++) {
      *(bf16x8*)(As + buf * 9216 + (lrow + 32 * i) * 72 + kc * 8) = ra[i];
      *(bf16x8*)(Bs + buf * 9216 + (lrow + 32 * i) * 72 + kc * 8) = rb[i];
    }
  };
  auto compute = [&](int buf) {
    const int cb = buf * 9216;
#pragma unroll
    for (int ks = 0; ks < 2; ks++) {
      bf16x8 ff[4], gg[4];
#pragma unroll
      for (int i = 0; i < 4; i++) {
        ff[i] = *(const bf16x8*)(F + cb + (16 * i + lr) * 72 + ks * 32 + lg * 8);
        gg[i] = *(const bf16x8*)(G + cb + (16 * i + lr) * 72 + ks * 32 + lg * 8);
      }
#pragma unroll
      for (int i = 0; i < 4; i++)
#pragma unroll
        for (int j = 0; j < 4; j++) acc[i][j] = mfma16(ff[i], gg[j], acc[i][j]);
    }
  };
  const int lastk = nk - 1;
  load(0, ra0, rb0);
  load(1, ra1, rb1);
  store(0, 0, ra0, rb0);
  load(2, ra0, rb0);
  __syncthreads();
  for (int kt = 0; kt < nk; kt += 2) {
    compute(0);
    store(1, kt + 1, ra1, rb1);
    load(min(kt + 3, lastk), ra1, rb1);
    __syncthreads();
    compute(1);
    store(0, min(kt + 2, lastk), ra0, rb0);
    load(min(kt + 4, lastk), ra0, rb0);
    __syncthreads();
  }
  if (swap) {
    if (MODE == 0) {
      const bool rope = (nt < 4) || nt == 6 || nt == 8;
#pragma unroll
      for (int mi = 0; mi < 4; mi++) {
        const int m = m0 + 64 * wr + 16 * mi + lr;
        if (rope) {
          const int pos = p.pos[m];
          f32x4 v = acc[0][mi];
          f32x4 o;
#pragma unroll
          for (int i = 0; i < 4; i++) {
            float pr = __shfl_xor(v[i], 32);
            float cs, sn; rope_cs(pos, 4 * (lg & 1) + i, cs, sn);
            o[i] = (lg < 2) ? (v[i] * cs - pr * sn) : (v[i] * cs + pr * sn);
          }
          acc[0][mi] = o;
        }
        {
          bf16_t* stg = (bf16_t*)smem + ((wave & 1) ? 2 * 9216 : 0) + (wave >> 1) * 4608;
#pragma unroll
          for (int ni = 0; ni < 4; ni++) {
            f32x4 v = acc[ni][mi];
            *(bf16x4*)(stg + (16 * mi + lr) * 72 + 16 * ni + 4 * lg) = pack4(v[0], v[1], v[2], v[3]);
          }
        }
      }
      {
        const bf16_t* stg = (const bf16_t*)smem + ((wave & 1) ? 2 * 9216 : 0) + (wave >> 1) * 4608;
        const int rr = lane >> 3, ch = lane & 7;
        const int nb0 = n0 + 64 * wc + ch * 8;
#pragma unroll
        for (int it = 0; it < 8; it++) {
          const int row = it * 8 + rr;
          const int m = m0 + 64 * wr + row;
          bf16x8 v = *(const bf16x8*)(stg + row * 72 + ch * 8);
          if (nt == 6 || nt == 8) {
            bf16_t* kd = ((nt == 6) ? p.KSC : p.KWC) + (((size_t)(m >> 12) * 2 + wc) * S_LEN + (m & 4095)) * 64;
            *(bf16x8*)(kd + ch * 8) = v;
          } else if (nb0 < NIN) {
            *(bf16x8*)(p.PROJ + (size_t)m * NIN + nb0) = v;
          }
        }
      }
      __syncthreads();
    } else if (MODE == 1) {
#pragma unroll
      for (int mi = 0; mi < 4; mi++) {
        const int m = m0 + 64 * wr + 16 * mi + lr;
#pragma unroll
        for (int ni = 0; ni < 4; ni++) {
          const int n = n0 + 64 * wc + 16 * ni + 4 * lg;
          f32x4 v = acc[ni][mi];
          *(bf16x4*)(p.KMEM + (size_t)m * 512 + n) = pack4(v[0], v[1], v[2], v[3]);
        }
      }
    } else {
#pragma unroll
      for (int mi = 0; mi < 4; mi++) {
        const int m = m0 + 64 * wr + 16 * mi + lr;
        float ss = 0.f;
#pragma unroll
        for (int ni = 0; ni < 4; ni++) {
          const int n = n0 + 64 * wc + 16 * ni + 4 * lg;
          float4 xv = *(const float4*)(p.x + (size_t)m * 1024 + n);
          f32x4 v = acc[ni][mi];
          float4 h; h.x = xv.x + v[0]; h.y = xv.y + v[1]; h.z = xv.z + v[2]; h.w = xv.w + v[3];
          ss += h.x * h.x + h.y * h.y + h.z * h.z + h.w * h.w;
          *(float4*)(p.out + (size_t)m * 1024 + n) = h;
        }
        ss += __shfl_xor(ss, 16); ss += __shfl_xor(ss, 32);
        if (lg == 0) atomicAdd(p.SS_OUT + m, ss);
      }
    }
  } else {
#pragma unroll
    for (int mi = 0; mi < 4; mi++)
#pragma unroll
      for (int ni = 0; ni < 4; ni++) {
        f32x4 v = acc[mi][ni];
        bf16x4 o = pack4(v[0], v[1], v[2], v[3]);
        if (MODE == 0) {
          const int b = m0 >> 12, s = (m0 & 4095) + 64 * wr + 16 * mi + 4 * lg;
          const int d = 16 * ni + lr;
          bf16_t* dst = (nt == 7) ? p.VST : p.VWT;
          *(bf16x4*)(dst + ((size_t)(b * 2 + wc) * 64 + d) * S_LEN + s) = o;
        } else {
          const int b = m0 >> 8, s = (m0 & 255) + 64 * wr + 16 * mi + 4 * lg;
          const int col = n0 - 512 + 64 * wc + 16 * ni + lr;
          const int h = col >> 7, d = col & 127;
          *(bf16x4*)(p.VMEMT + ((size_t)(b * 4 + h) * 128 + d) * 256 + s) = o;
        }
      }
  }
}

template <int DQK, int DV, int MASK, typename MaskF>
__device__ __forceinline__ void attn_tile(const bf16_t* sK, const bf16_t* sVt, const bf16x8 (&qf)[2][DQK / 32], f32x4 (&o)[DV / 16][2],
                                          float (&m)[2], float (&l)[2], float c, bool qsel0, bool qsel1, MaskF valid) {
  constexpr int KST = DQK + 8;
  const int lane = get_tid() & 63, lr = lane & 15, lg = lane >> 4;
  f32x4 s[4][2];
#pragma unroll
  for (int kt = 0; kt < 4; kt++) { s[kt][0] = (f32x4){0.f, 0.f, 0.f, 0.f}; s[kt][1] = (f32x4){0.f, 0.f, 0.f, 0.f}; }
#pragma unroll
  for (int ks = 0; ks < DQK / 32; ks++)
#pragma unroll
    for (int kt = 0; kt < 4; kt++) {
      bf16x8 a = *(const bf16x8*)(sK + (16 * kt + lr) * KST + ks * 32 + lg * 8);
      s[kt][0] = mfma16(a, qf[0][ks], s[kt][0]);
      s[kt][1] = mfma16(a, qf[1][ks], s[kt][1]);
    }
#pragma unroll
  for (int qt = 0; qt < 2; qt++) {
    const bool qs = qt ? qsel1 : qsel0;
    float mx = -1e30f;
    if (MASK) {
#pragma unroll
      for (int kt = 0; kt < 4; kt++)
#pragma unroll
        for (int i = 0; i < 4; i++) {
          bool v = valid(16 * kt + 4 * lg + i, qt);
          float sv = v ? s[kt][qt][i] * c : -1e30f;
          s[kt][qt][i] = sv; mx = fmaxf(mx, sv);
        }
    } else {
#pragma unroll
      for (int kt = 0; kt < 4; kt++) mx = fmaxf(fmaxf(mx, fmaxf(s[kt][qt][0], s[kt][qt][1])), fmaxf(s[kt][qt][2], s[kt][qt][3]));
      mx = qs ? mx * c : -1e30f;
    }
    mx = rowmax4(mx);
    const float mn = fmaxf(m[qt], mx);
    const float alpha = fexp2(m[qt] - mn);
    m[qt] = mn;
    float me;
    if (MASK) me = (mn > -1e29f) ? mn : 1e30f; else me = qs ? mn : 1e30f;
    float rs = 0.f;
#pragma unroll
    for (int kt = 0; kt < 4; kt++)
#pragma unroll
      for (int i = 0; i < 4; i++) {
        float pv = MASK ? fexp2(s[kt][qt][i] - me) : fexp2(fmaf(s[kt][qt][i], c, -me));
        s[kt][qt][i] = pv; rs += pv;
      }
    rs = rowsum4(rs);
    l[qt] = l[qt] * alpha + rs;
#pragma unroll
    for (int dt = 0; dt < DV / 16; dt++) {
      o[dt][qt][0] *= alpha; o[dt][qt][1] *= alpha; o[dt][qt][2] *= alpha; o[dt][qt][3] *= alpha;
    }
  }
#pragma unroll
  for (int k2 = 0; k2 < 2; k2++) {
    bf16x8 pb[2];
#pragma unroll
    for (int qt = 0; qt < 2; qt++)
      pb[qt] = pack8(s[2 * k2][qt][0], s[2 * k2][qt][1], s[2 * k2][qt][2], s[2 * k2][qt][3],
                     s[2 * k2 + 1][qt][0], s[2 * k2 + 1][qt][1], s[2 * k2 + 1][qt][2], s[2 * k2 + 1][qt][3]);
#pragma unroll
    for (int dt = 0; dt < DV / 16; dt++) {
      const bf16_t* vp = sVt + (16 * dt + lr) * 72 + 32 * k2 + 4 * lg;
      bf16x8 a = cat44(*(const bf16x4*)vp, *(const bf16x4*)(vp + 16));
      o[dt][0] = mfma16(a, pb[0], o[dt][0]);
      o[dt][1] = mfma16(a, pb[1], o[dt][1]);
    }
  }
}

__device__ __forceinline__ int next_bit_below(unsigned long long m, int below) {
  unsigned long long mm = (below >= 64) ? m : (m & ((1ull << below) - 1ull));
  return mm ? (63 - __clzll((long long)mm)) : -1;
}

__device__ void nsa_item(const Params& p, int item, char* smem) {
  const int tid = get_tid(), lane = tid & 63, wave = tid >> 6, lr = lane & 15, lg = lane >> 4;
  const int bg = item & 15, qb = 127 - (item >> 4);
  const int b = bg >> 1, g = bg & 1;
  const int t0 = qb * 32, cur = t0 >> 6;
  const int hq = g * 4 + wave;
  float* sImp = (float*)(smem + 55296);
  unsigned long long* sSel = (unsigned long long*)(smem + 63616);
  const float c = 0.125f * LOG2E;
  const size_t tokbase = (size_t)b * S_LEN + t0;
  const int r0 = tid >> 3, cc = tid & 7;

  bf16x8 qf[2][2];
#pragma unroll
  for (int qt = 0; qt < 2; qt++) {
    const bf16_t* row = p.PROJ + (tokbase + 16 * qt + lr) * NIN;
#pragma unroll
    for (int ks = 0; ks < 2; ks++) qf[qt][ks] = *(const bf16x8*)(row + C_Q + hq * 64 + 32 * ks + 8 * lg);
  }
  auto emit = [&](f32x4 (&o)[4][2], float (&l)[2], int br) {
#pragma unroll
    for (int qt = 0; qt < 2; qt++) {
      const size_t tok = tokbase + 16 * qt + lr;
      const float gsc = sigmoid_f(bf2f(p.PROJ[tok * NIN + C_GL + hq * 3 + br])) / fmaxf(l[qt], 1e-30f);
#pragma unroll
      for (int dt = 0; dt < 4; dt++) {
        const int dbase = hq * 64 + 16 * dt + 4 * lg;
        bf16_t* dst = p.MIX + tok * 1536 + dbase;
        f32x4 r = o[dt][qt];
        r[0] *= gsc; r[1] *= gsc; r[2] *= gsc; r[3] *= gsc;
        if (br > 0) { bf16x4 pv = *(const bf16x4*)dst; r[0] += bfs(pv[0]); r[1] += bfs(pv[1]); r[2] += bfs(pv[2]); r[3] += bfs(pv[3]); }
        if (br == 2) {
          bf16x4 ga = *(const bf16x4*)(p.PROJ + tok * NIN + C_GA + dbase);
          r[0] *= silu_f(bfs(ga[0])); r[1] *= silu_f(bfs(ga[1])); r[2] *= silu_f(bfs(ga[2])); r[3] *= silu_f(bfs(ga[3]));
        }
        *(bf16x4*)dst = pack4(r[0], r[1], r[2], r[3]);
      }
    }
  };
  auto store_kv = [&](int buf, bf16x8 (&rg)[4]) {
    bf16_t* sK = (bf16_t*)(smem + buf * 27648);
    bf16_t* sVt = sK + 64 * 72;
    *(bf16x8*)(sK + r0 * 72 + cc * 8) = rg[0];
    *(bf16x8*)(sK + (r0 + 32) * 72 + cc * 8) = rg[1];
    *(bf16x8*)(sVt + r0 * 72 + cc * 8) = rg[2];
    *(bf16x8*)(sVt + (r0 + 32) * 72 + cc * 8) = rg[3];
  };

  {
    const int ntiles = (t0 >> 10) + 1;
    const bf16_t* kb = p.KCMP + (size_t)bg * 256 * 64;
    const bf16_t* vb = p.VCMPT + (size_t)bg * 64 * 256;
    for (int pass = 0; pass < 2; pass++) {
      f32x4 o[4][2]; float m[2] = {-1e30f, -1e30f}, l[2] = {0.f, 0.f};
#pragma unroll
      for (int dt = 0; dt < 4; dt++) { o[dt][0] = (f32x4){0.f, 0.f, 0.f, 0.f}; o[dt][1] = (f32x4){0.f, 0.f, 0.f, 0.f}; }
      int ldn = 0;
      tile_pipeline<4>(ntiles,
        [&](int i, bf16x8 (&rg)[4]) {
          rg[0] = *(const bf16x8*)(kb + (size_t)(64 * i + r0) * 64 + cc * 8);
          rg[1] = *(const bf16x8*)(kb + (size_t)(64 * i + r0 + 32) * 64 + cc * 8);
          if (pass == 0) {
            rg[2] = *(const bf16x8*)(vb + (size_t)r0 * 256 + 64 * i + cc * 8);
            rg[3] = *(const bf16x8*)(vb + (size_t)(r0 + 32) * 256 + 64 * i + cc * 8);
          }
        },
        [&](int buf, bf16x8 (&rg)[4]) {
          const int nt = ldn++;
          if (pass == 1) {
#pragma unroll
            for (int i2 = 0; i2 < 2; i2++) {
              const int j = r0 + 32 * i2;
              bf16x8 ov;
#pragma unroll
              for (int x = 0; x < 8; x++) { int n = 64 * nt + cc * 8 + x; ov[x] = (n >= 4 * j - 1 && n <= 4 * j + 3) ? (short)0x3F80 : (short)0; }
              rg[2 + i2] = ov;
            }
          }
          store_kv(buf, rg);
        },
        [&](int i, int buf) {
          const bf16_t* sK = (const bf16_t*)(smem + buf * 27648);
          attn_tile<64, 64, 1>(sK, sK + 64 * 72, qf, o, m, l, c, true, true,
                               [&](int key, int qt) { return 16 * (64 * i + key) + 31 <= t0 + 16 * qt + lr; });
        });
      if (pass == 0) {
        emit(o, l, 0);
      } else {
        float inv[2];
#pragma unroll
        for (int qt = 0; qt < 2; qt++) inv[qt] = 1.f / fmaxf(l[qt], 1e-30f);
        for (int e2 = 0; e2 < 4; e2++) {
          if (wave == e2) {
#pragma unroll
            for (int dt = 0; dt < 4; dt++)
#pragma unroll
              for (int qt = 0; qt < 2; qt++)
#pragma unroll
                for (int i = 0; i < 4; i++) {
                  int j = 16 * dt + 4 * lg + i, q = 16 * qt + lr;
                  float v = o[dt][qt][i] * inv[qt];
                  if (e2 == 0) sImp[q * 65 + j] = v; else sImp[q * 65 + j] += v;
                }
          }
          __syncthreads();
        }
      }
    }
  }
  for (int qq = 0; qq < 8; qq++) {
    const int q = wave * 8 + qq;
    const int j = lane;
    float v = sImp[q * 65 + j];
    bool valid = j <= cur;
    bool forced = (j == 0) || (j == cur) || (j == cur - 1);
    float val = forced ? 1e9f : (valid ? v : -1e9f);
    int rank = 0;
#pragma unroll 16
    for (int jj = 0; jj < 64; jj++) {
      float ov = __int_as_float(__builtin_amdgcn_readlane(__float_as_int(val), jj));
      rank += ((ov > val) || (ov == val && jj < j)) ? 1 : 0;
    }
    unsigned long long mask = __ballot((rank < 16) && valid);
    if (lane == 0) sSel[q] = mask;
  }
  __syncthreads();
  unsigned long long any = 0ull;
  for (int q = 0; q < 32; q++) any |= sSel[q];
  unsigned long long mk[2];
  mk[0] = sSel[lr]; mk[1] = sSel[16 + lr];

  {
    f32x4 o[4][2]; float m[2] = {-1e30f, -1e30f}, l[2] = {0.f, 0.f};
#pragma unroll
    for (int dt = 0; dt < 4; dt++) { o[dt][0] = (f32x4){0.f, 0.f, 0.f, 0.f}; o[dt][1] = (f32x4){0.f, 0.f, 0.f, 0.f}; }
    const bf16_t* kb = p.KSC + (size_t)bg * S_LEN * 64;
    const bf16_t* vb = p.VST + (size_t)bg * 64 * S_LEN;
    const int ntiles = __popcll(any);
    int jl = 64, jc = 64;
    tile_pipeline<4>(ntiles,
      [&](int, bf16x8 (&rg)[4]) {
        jl = (jl > 0) ? next_bit_below(any, jl) : -1;
        const int jj = jl < 0 ? 0 : jl;
        rg[0] = *(const bf16x8*)(kb + (size_t)(64 * jj + r0) * 64 + cc * 8);
        rg[1] = *(const bf16x8*)(kb + (size_t)(64 * jj + r0 + 32) * 64 + cc * 8);
        rg[2] = *(const bf16x8*)(vb + (size_t)r0 * S_LEN + 64 * jj + cc * 8);
        rg[3] = *(const bf16x8*)(vb + (size_t)(r0 + 32) * S_LEN + 64 * jj + cc * 8);
      },
      store_kv,
      [&](int, int buf) {
        jc = next_bit_below(any, jc);
        const int j = jc;
        const bf16_t* sK = (const bf16_t*)(smem + buf * 27648);
        if (j == cur) {
          attn_tile<64, 64, 1>(sK, sK + 64 * 72, qf, o, m, l, c, true, true,
                               [&](int key, int qt) { return 64 * j + key <= t0 + 16 * qt + lr; });
        } else {
          attn_tile<64, 64, 0>(sK, sK + 64 * 72, qf, o, m, l, c, ((mk[0] >> j) & 1ull) != 0ull, ((mk[1] >> j) & 1ull) != 0ull,
                               [&](int, int) { return true; });
        }
      });
    emit(o, l, 1);
  }
  {
    f32x4 o[4][2]; float m[2] = {-1e30f, -1e30f}, l[2] = {0.f, 0.f};
#pragma unroll
    for (int dt = 0; dt < 4; dt++) { o[dt][0] = (f32x4){0.f, 0.f, 0.f, 0.f}; o[dt][1] = (f32x4){0.f, 0.f, 0.f, 0.f}; }
    const int jlo = (cur - 8 > 0) ? (cur - 8) : 0;
    const bf16_t* kb = p.KWC + (size_t)bg * S_LEN * 64;
    const bf16_t* vb = p.VWT + (size_t)bg * 64 * S_LEN;
    tile_pipeline<4>(cur - jlo + 1,
      [&](int i, bf16x8 (&rg)[4]) {
        const int j = cur - i;
        rg[0] = *(const bf16x8*)(kb + (size_t)(64 * j + r0) * 64 + cc * 8);
        rg[1] = *(const bf16x8*)(kb + (size_t)(64 * j + r0 + 32) * 64 + cc * 8);
        rg[2] = *(const bf16x8*)(vb + (size_t)r0 * S_LEN + 64 * j + cc * 8);
        rg[3] = *(const bf16x8*)(vb + (size_t)(r0 + 32) * S_LEN + 64 * j + cc * 8);
      },
      store_kv,
      [&](int i, int buf) {
        const int j = cur - i;
        const bf16_t* sK = (const bf16_t*)(smem + buf * 27648);
        if (j == cur || j == cur - 8) {
          attn_tile<64, 64, 1>(sK, sK + 64 * 72, qf, o, m, l, c, true, true, [&](int key, int qt) {
            int tq = t0 + 16 * qt + lr, kp = 64 * j + key;
            return (kp <= tq) && (kp > tq - 512);
          });
        } else {
          attn_tile<64, 64, 0>(sK, sK + 64 * 72, qf, o, m, l, c, true, true, [&](int, int) { return true; });
        }
      });
    emit(o, l, 2);
  }
}

__device__ void memattn_item(const Params& p, int item, char* smem) {
  const int tid = get_tid(), lane = tid & 63, wave = tid >> 6, lr = lane & 15, lg = lane >> 4;
  const int b = item >> 7, h = (item >> 5) & 3, qb = item & 31;
  const int t0 = qb * 128 + wave * 32;
  const size_t tokbase = (size_t)b * S_LEN + t0;
  bf16x8 qf[2][4];
#pragma unroll
  for (int qt = 0; qt < 2; qt++)
#pragma unroll
    for (int ks = 0; ks < 4; ks++) qf[qt][ks] = *(const bf16x8*)(p.PROJ + (tokbase + 16 * qt + lr) * NIN + C_QX + h * 128 + 32 * ks + 8 * lg);
  f32x4 o[8][2]; float m[2] = {-1e30f, -1e30f}, l[2] = {0.f, 0.f};
#pragma unroll
  for (int dt = 0; dt < 8; dt++) { o[dt][0] = (f32x4){0.f, 0.f, 0.f, 0.f}; o[dt][1] = (f32x4){0.f, 0.f, 0.f, 0.f}; }
  const float c = 0.08838834764831845f * LOG2E;
  const bf16_t* kb = p.KMEM + (size_t)b * 256 * 512 + h * 128;
  const bf16_t* vb = p.VMEMT + (size_t)(b * 4 + h) * 128 * 256;
  tile_pipeline1<8>(4,
    [&](int kt, bf16x8 (&rg)[8]) {
#pragma unroll
      for (int i = 0; i < 4; i++) {
        int ch = tid + 256 * i;
        rg[i] = *(const bf16x8*)(kb + (size_t)(64 * kt + (ch >> 4)) * 512 + (ch & 15) * 8);
        rg[4 + i] = *(const bf16x8*)(vb + (size_t)(ch >> 3) * 256 + 64 * kt + (ch & 7) * 8);
      }
    },
    [&](int buf, bf16x8 (&rg)[8]) {
      bf16_t* sK = (bf16_t*)(smem + buf * 35840);
      bf16_t* sVt = sK + 64 * 136;
#pragma unroll
      for (int i = 0; i < 4; i++) {
        int ch = tid + 256 * i;
        *(bf16x8*)(sK + (ch >> 4) * 136 + (ch & 15) * 8) = rg[i];
        *(bf16x8*)(sVt + (ch >> 3) * 72 + (ch & 7) * 8) = rg[4 + i];
      }
    },
    [&](int, int buf) {
      const bf16_t* sK = (const bf16_t*)(smem + buf * 35840);
      attn_tile<128, 128, 0>(sK, sK + 64 * 136, qf, o, m, l, c, true, true, [&](int, int) { return true; });
    });
#pragma unroll
  for (int qt = 0; qt < 2; qt++) {
    const size_t tok = tokbase + 16 * qt + lr;
    const float inv = 1.f / fmaxf(l[qt], 1e-30f);
#pragma unroll
    for (int dt = 0; dt < 8; dt++) {
      const int dbase = h * 128 + 16 * dt + 4 * lg;
      bf16x4 ga = *(const bf16x4*)(p.PROJ + tok * NIN + C_GX + dbase);
      f32x4 r = o[dt][qt];
      *(bf16x4*)(p.MIX + tok * 1536 + 1024 + dbase) =
          pack4(r[0] * inv * silu_f(bfs(ga[0])), r[1] * inv * silu_f(bfs(ga[1])), r[2] * inv * silu_f(bfs(ga[2])), r[3] * inv * silu_f(bfs(ga[3])));
    }
  }
}

__device__ void compress_item(const Params& p, int item, char* smem) {
  const int tid = get_tid(), lane = tid & 63, wave = tid >> 6, lr = lane & 15, lg = lane >> 4;
  const int which = item >> 7, rho0 = (item & 127) * 32;
  const bf16_t* W1T = which ? p.W1vT : p.W1kT;
  const bf16_t* W2T = which ? p.W2vT : p.W2kT;
  const float* pe = which ? p.cpv : p.cpk;
  const int col0 = which ? C_VC : C_KC;
  bf16_t* sH = (bf16_t*)smem;
  const bf16_t* rowbase[2];
#pragma unroll
  for (int rt = 0; rt < 2; rt++) {
    int rho = rho0 + 16 * rt + lr; if (rho > 4079) rho = 4079;
    int b = rho / 510, rem = rho - b * 510, n = rem >> 1, g = rem & 1;
    rowbase[rt] = p.PROJ + ((size_t)b * S_LEN + 16 * n) * NIN + col0 + g * 64;
  }
  f32x4 acc[2][4];
#pragma unroll
  for (int i = 0; i < 2; i++)
#pragma unroll
    for (int j = 0; j < 4; j++) acc[i][j] = (f32x4){0.f, 0.f, 0.f, 0.f};
#pragma unroll 4
  for (int kstep = 0; kstep < 64; kstep++) {
    const int lin = kstep >> 1, d0 = (kstep & 1) * 32 + 8 * lg;
    float4 p0 = *(const float4*)(pe + lin * 64 + d0), p1 = *(const float4*)(pe + lin * 64 + d0 + 4);
    bf16x8 a[2];
#pragma unroll
    for (int rt = 0; rt < 2; rt++) {
      bf16x8 raw = *(const bf16x8*)(rowbase[rt] + (size_t)lin * NIN + d0);
      a[rt][0] = (short)f2bf(bfs(raw[0]) + p0.x); a[rt][1] = (short)f2bf(bfs(raw[1]) + p0.y);
      a[rt][2] = (short)f2bf(bfs(raw[2]) + p0.z); a[rt][3] = (short)f2bf(bfs(raw[3]) + p0.w);
      a[rt][4] = (short)f2bf(bfs(raw[4]) + p1.x); a[rt][5] = (short)f2bf(bfs(raw[5]) + p1.y);
      a[rt][6] = (short)f2bf(bfs(raw[6]) + p1.z); a[rt][7] = (short)f2bf(bfs(raw[7]) + p1.w);
    }
#pragma unroll
    for (int ct = 0; ct < 4; ct++) {
      bf16x8 bf = *(const bf16x8*)(W1T + (size_t)(64 * wave + 16 * ct + lr) * 2048 + kstep * 32 + 8 * lg);
      acc[0][ct] = mfma16(a[0], bf, acc[0][ct]);
      acc[1][ct] = mfma16(a[1], bf, acc[1][ct]);
    }
  }
  __syncthreads();
#pragma unroll
  for (int rt = 0; rt < 2; rt++)
#pragma unroll
    for (int ct = 0; ct < 4; ct++)
#pragma unroll
      for (int i = 0; i < 4; i++) sH[(16 * rt + 4 * lg + i) * 264 + 64 * wave + 16 * ct + lr] = f2bf(silu_f(acc[rt][ct][i]));
  __syncthreads();
  f32x4 acc2[2] = {(f32x4){0.f, 0.f, 0.f, 0.f}, (f32x4){0.f, 0.f, 0.f, 0.f}};
#pragma unroll
  for (int ks = 0; ks < 8; ks++) {
    bf16x8 bf = *(const bf16x8*)(W2T + (size_t)(16 * wave + lr) * 256 + 32 * ks + 8 * lg);
#pragma unroll
    for (int rt = 0; rt < 2; rt++) {
      bf16x8 a = *(const bf16x8*)(sH + (16 * rt + lr) * 264 + 32 * ks + 8 * lg);
      acc2[rt] = mfma16(a, bf, acc2[rt]);
    }
  }
  const int col = 16 * wave + lr;
#pragma unroll
  for (int rt = 0; rt < 2; rt++)
#pragma unroll
    for (int i = 0; i < 4; i++) {
      int rho = rho0 + 16 * rt + 4 * lg + i;
      bool ok = rho < 4080;
      int rc = ok ? rho : 4079;
      int b = rc / 510, rem = rc - b * 510, n = rem >> 1, g = rem & 1;
      float v = acc2[rt][i];
      float pr = __shfl_xor(v, 8);
      if (which == 0) {
        if (wave == 0) {
          int pos = p.pos[b * S_LEN + 16 * n + 31];
          float cs, sn; rope_cs(pos, lr & 7, cs, sn);
          v = (lr < 8) ? (v * cs - pr * sn) : (v * cs + pr * sn);
        }
        if (ok) p.KCMP[((size_t)(b * 2 + g) * 256 + n) * 64 + col] = f2bf(v);
      } else {
        if (ok) p.VCMPT[((size_t)(b * 2 + g) * 64 + col) * 256 + n] = f2bf(v);
      }
    }
}

__device__ void conv_units(const Params& p, int u) {
  const int cgp = u & 127, tg = u >> 7;
  const int tok0 = tg * 8, s0 = tok0 & 4095, ch0 = cgp * 8;
  const int b = tok0 >> 12;
  bf16x8 in[11];
#pragma unroll
  for (int r = 0; r < 11; r++) {
    int s = s0 - 3 + r;
    if (s >= 0) in[r] = *(const bf16x8*)(p.PROJ + (size_t)(tok0 - 3 + r) * NIN + C_XBC + ch0);
    else in[r] = (bf16x8){0, 0, 0, 0, 0, 0, 0, 0};
  }
  float4 wv[4][2];
#pragma unroll
  for (int k = 0; k < 4; k++) { wv[k][0] = *(const float4*)(p.conv_w + k * 1024 + ch0); wv[k][1] = *(const float4*)(p.conv_w + k * 1024 + ch0 + 4); }
  float4 bv0 = *(const float4*)(p.conv_b + ch0), bv1 = *(const float4*)(p.conv_b + ch0 + 4);
  float w[4][8], bias[8];
#pragma unroll
  for (int k = 0; k < 4; k++) { w[k][0] = wv[k][0].x; w[k][1] = wv[k][0].y; w[k][2] = wv[k][0].z; w[k][3] = wv[k][0].w; w[k][4] = wv[k][1].x; w[k][5] = wv[k][1].y; w[k][6] = wv[k][1].z; w[k][7] = wv[k][1].w; }
  bias[0] = bv0.x; bias[1] = bv0.y; bias[2] = bv0.z; bias[3] = bv0.w; bias[4] = bv1.x; bias[5] = bv1.y; bias[6] = bv1.z; bias[7] = bv1.w;
  if (ch0 >= 512) {
#pragma unroll
    for (int tt = 0; tt < 8; tt++) {
      bf16x8 o;
#pragma unroll
      for (int j = 0; j < 8; j++) {
        float a = bias[j];
#pragma unroll
        for (int k = 0; k < 4; k++) a += bfs(in[tt + k][j]) * w[k][j];
        o[j] = (short)f2bf(silu_f(a));
      }
      *(bf16x8*)(p.BC + (size_t)(tok0 + tt) * 512 + (ch0 - 512)) = o;
    }
  }
  if (ch0 < 768) {
#pragma unroll
    for (int j = 0; j < 8; j++) {
      bf16x8 o;
#pragma unroll
      for (int tt = 0; tt < 8; tt++) {
        float a = bias[j];
#pragma unroll
        for (int k = 0; k < 4; k++) a += bfs(in[tt + k][j]) * w[k][j];
        o[tt] = (short)f2bf(silu_f(a));
      }
      const int ch = ch0 + j;
      bf16_t* dst;
      if (ch0 < 512) dst = p.XT + ((size_t)(b * 8 + (ch >> 6)) * 64 + (ch & 63)) * S_LEN + s0;
      else dst = p.BT + ((size_t)(b * 2 + ((ch - 512) >> 7)) * 128 + ((ch - 512) & 127)) * S_LEN + s0;
      *(bf16x8*)dst = o;
    }
  }
}

__device__ void ssd_states_item(const Params& p, int item, char* smem) {
  const int tid = get_tid(), lane = tid & 63, wave = tid >> 6, lr = lane & 15, lg = lane >> 4;
  const int h = item & 7, c = (item >> 3) & 31, b = item >> 8;
  const int g = h >> 2;
  float* sAcs = (float*)smem;
  float* sW = sAcs + 128;
  float* sTot = sW + 128;
  const size_t tok0 = (size_t)b * S_LEN + c * 128;
  __syncthreads();
  float dt = 0.f, cs = 0.f;
  if (tid < 128) {
    float raw = bf2f(p.PROJ[(tok0 + tid) * NIN + C_DT + h]) + p.dt_bias[h];
    dt = fmaxf(raw, 0.f) + log1pf(__expf(-fabsf(raw)));
    float a = -__expf(p.a_log[h]);
    cs = dt * a;
#pragma unroll
    for (int o = 1; o < 64; o <<= 1) { float t = __shfl_up(cs, o); if (lane >= o) cs += t; }
    if (lane == 63) sTot[wave] = cs;
  }
  __syncthreads();
  if (tid < 128) {
    if (wave == 1) cs += sTot[0];
    sAcs[tid] = cs;
  }
  __syncthreads();
  if (tid < 128) {
    float last = sAcs[127];
    sW[tid] = dt * __expf(last - cs);
    const size_t o = ((size_t)(b * 32 + c) * 8 + h) * 128 + tid;
    p.ACS[o] = cs; p.DTV[o] = dt;
    if (tid == 0) p.CHDEC[(b * 32 + c) * 8 + h] = __expf(last);
  }
  __syncthreads();
  f32x4 acc[4][2];
#pragma unroll
  for (int i = 0; i < 4; i++) { acc[i][0] = (f32x4){0.f, 0.f, 0.f, 0.f}; acc[i][1] = (f32x4){0.f, 0.f, 0.f, 0.f}; }
  const bf16_t* xt = p.XT + (size_t)(b * 8 + h) * 64 * S_LEN + c * 128;
  const bf16_t* bt = p.BT + (size_t)(b * 2 + g) * 128 * S_LEN + c * 128;
#pragma unroll
  for (int ks = 0; ks < 4; ks++) {
    const int l0 = 32 * ks + 8 * lg;
    float4 w0 = *(const float4*)(sW + l0), w1 = *(const float4*)(sW + l0 + 4);
    bf16x8 bf0 = *(const bf16x8*)(bt + (size_t)(32 * wave + lr) * S_LEN + l0);
    bf16x8 bf1 = *(const bf16x8*)(bt + (size_t)(32 * wave + 16 + lr) * S_LEN + l0);
#pragma unroll
    for (int pt = 0; pt < 4; pt++) {
      bf16x8 raw = *(const bf16x8*)(xt + (size_t)(16 * pt + lr) * S_LEN + l0);
      bf16x8 a;
      a[0] = (short)f2bf(bfs(raw[0]) * w0.x); a[1] = (short)f2bf(bfs(raw[1]) * w0.y); a[2] = (short)f2bf(bfs(raw[2]) * w0.z); a[3] = (short)f2bf(bfs(raw[3]) * w0.w);
      a[4] = (short)f2bf(bfs(raw[4]) * w1.x); a[5] = (short)f2bf(bfs(raw[5]) * w1.y); a[6] = (short)f2bf(bfs(raw[6]) * w1.z); a[7] = (short)f2bf(bfs(raw[7]) * w1.w);
      acc[pt][0] = mfma16(a, bf0, acc[pt][0]);
      acc[pt][1] = mfma16(a, bf1, acc[pt][1]);
    }
  }
  float* st = p.STATES + ((size_t)(b * 32 + c) * 8 + h) * 8192;
#pragma unroll
  for (int pt = 0; pt < 4; pt++)
#pragma unroll
    for (int x = 0; x < 2; x++)
#pragma unroll
      for (int i = 0; i < 4; i++) st[(16 * pt + 4 * lg + i) * 128 + 32 * wave + 16 * x + lr] = acc[pt][x][i];
}

__device__ void scan_units(const Params& p, int q) {
  const int b = q >> 16, r = q & 65535, h = r >> 13;
  float hs = 0.f;
  for (int c0 = 0; c0 < 32; c0 += 16) {
    float s[16], d[16];
#pragma unroll
    for (int i = 0; i < 16; i++) { s[i] = p.STATES[(size_t)(b * 32 + c0 + i) * 65536 + r]; d[i] = p.CHDEC[(b * 32 + c0 + i) * 8 + h]; }
#pragma unroll
    for (int i = 0; i < 16; i++) { p.STATES[(size_t)(b * 32 + c0 + i) * 65536 + r] = hs; hs = hs * d[i] + s[i]; }
  }
}

__device__ void ssd_y_item(const Params& p, int item, char* smem) {
  const int tid = get_tid(), lane = tid & 63, wave = tid >> 6, lr = lane & 15, lg = lane >> 4;
  const int h = item & 7, c = (item >> 3) & 31, b = item >> 8;
  const int g = h >> 2;
  bf16_t* sB = (bf16_t*)smem;
  bf16_t* sXT = sB + 128 * 136;
  float* sAcs = (float*)(smem + (128 + 64) * 136 * 2);
  float* sDt = sAcs + 128;
  const size_t tok0 = (size_t)b * S_LEN + c * 128;
  const bf16_t* xt = p.XT + (size_t)(b * 8 + h) * 64 * S_LEN + c * 128;
  const int LT[2] = {wave, 7 - wave};
  __syncthreads();
  {
    bf16x8 tb[8], tx[4];
#pragma unroll
    for (int i = 0; i < 8; i++) { int ch = tid + 256 * i; tb[i] = *(const bf16x8*)(p.BC + (tok0 + (ch >> 4)) * 512 + g * 128 + (ch & 15) * 8); }
#pragma unroll
    for (int i = 0; i < 4; i++) { int ch = tid + 256 * i; tx[i] = *(const bf16x8*)(xt + (size_t)(ch >> 4) * S_LEN + (ch & 15) * 8); }
    if (tid < 128) {
      const size_t o = ((size_t)(b * 32 + c) * 8 + h) * 128 + tid;
      sAcs[tid] = p.ACS[o]; sDt[tid] = p.DTV[o];
    }
#pragma unroll
    for (int i = 0; i < 8; i++) { int ch = tid + 256 * i; *(bf16x8*)(sB + (ch >> 4) * 136 + (ch & 15) * 8) = tb[i]; }
#pragma unroll
    for (int i = 0; i < 4; i++) { int ch = tid + 256 * i; *(bf16x8*)(sXT + (ch >> 4) * 136 + (ch & 15) * 8) = tx[i]; }
  }
  bf16x8 cf[2][4];
  bf16x4 zpre[2][4];
#pragma unroll
  for (int li = 0; li < 2; li++) {
#pragma unroll
    for (int ks = 0; ks < 4; ks++)
      cf[li][ks] = *(const bf16x8*)(p.BC + (tok0 + 16 * LT[li] + lr) * 512 + 256 + g * 128 + 32 * ks + 8 * lg);
#pragma unroll
    for (int pt = 0; pt < 4; pt++)
      zpre[li][pt] = *(const bf16x4*)(p.PROJ + (tok0 + 16 * LT[li] + lr) * NIN + C_Z + h * 64 + 16 * pt + 4 * lg);
  }
  f32x4 acc[4][2];
#pragma unroll
  for (int i = 0; i < 4; i++) { acc[i][0] = (f32x4){0.f, 0.f, 0.f, 0.f}; acc[i][1] = (f32x4){0.f, 0.f, 0.f, 0.f}; }
  const float* prev = p.STATES + ((size_t)(b * 32 + c) * 8 + h) * 8192;
#pragma unroll
  for (int pt = 0; pt < 4; pt++)
#pragma unroll
    for (int ks = 0; ks < 4; ks++) {
      const float* pp = prev + (16 * pt + lr) * 128 + 32 * ks + 8 * lg;
      float4 v0 = *(const float4*)pp, v1 = *(const float4*)(pp + 4);
      bf16x8 a = pack8(v0.x, v0.y, v0.z, v0.w, v1.x, v1.y, v1.z, v1.w);
      acc[pt][0] = mfma16(a, cf[0][ks], acc[pt][0]);
      acc[pt][1] = mfma16(a, cf[1][ks], acc[pt][1]);
    }
  __syncthreads();
#pragma unroll
  for (int li = 0; li < 2; li++) {
    float e = __expf(sAcs[16 * LT[li] + lr]);
#pragma unroll
    for (int pt = 0; pt < 4; pt++) { acc[pt][li][0] *= e; acc[pt][li][1] *= e; acc[pt][li][2] *= e; acc[pt][li][3] *= e; }
  }
#pragma unroll
  for (int li = 0; li < 2; li++) {
    const int lt = LT[li];
    const int lpos = 16 * lt + lr;
    const float acl = sAcs[lpos];
    for (int sp = 0; sp <= (lt >> 1); sp++) {
      f32x4 cb[2] = {(f32x4){0.f, 0.f, 0.f, 0.f}, (f32x4){0.f, 0.f, 0.f, 0.f}};
#pragma unroll
      for (int x = 0; x < 2; x++)
#pragma unroll
        for (int ks = 0; ks < 4; ks++) {
          bf16x8 bfr = *(const bf16x8*)(sB + (32 * sp + 16 * x + lr) * 136 + 32 * ks + 8 * lg);
          cb[x] = mfma16(bfr, cf[li][ks], cb[x]);
        }
      float mv[8];
#pragma unroll
      for (int x = 0; x < 2; x++)
#pragma unroll
        for (int i = 0; i < 4; i++) {
          const int s = 32 * sp + 16 * x + 4 * lg + i;
          mv[4 * x + i] = (s <= lpos) ? cb[x][i] * __expf(acl - sAcs[s]) * sDt[s] : 0.f;
        }
      bf16x8 mb = pack8(mv[0], mv[1], mv[2], mv[3], mv[4], mv[5], mv[6], mv[7]);
#pragma unroll
      for (int pt = 0; pt < 4; pt++) {
        const bf16_t* xp = sXT + (16 * pt + lr) * 136 + 32 * sp + 4 * lg;
        bf16x8 a = cat44(*(const bf16x4*)xp, *(const bf16x4*)(xp + 16));
        acc[pt][li] = mfma16(a, mb, acc[pt][li]);
      }
    }
  }
  const float dsk = p.d_skip[h];
#pragma unroll
  for (int li = 0; li < 2; li++) {
    const int lpos = 16 * LT[li] + lr;
    const size_t tok = tok0 + lpos;
    float ss = 0.f;
#pragma unroll
    for (int pt = 0; pt < 4; pt++) {
      const int pb = 16 * pt + 4 * lg;
      bf16x4 zv = zpre[li][pt];
      float y[4];
#pragma unroll
      for (int i = 0; i < 4; i++) {
        float xv = bf2f(sXT[(pb + i) * 136 + lpos]);
        y[i] = (acc[pt][li][i] + dsk * xv) * silu_f(bfs(zv[i]));
        ss += y[i] * y[i];
      }
      *(bf16x4*)(p.MIX + tok * 1536 + 512 + h * 64 + pb) = pack4(y[0], y[1], y[2], y[3]);
    }
    ss += __shfl_xor(ss, 16); ss += __shfl_xor(ss, 32);
    if (lg == 0) p.SS_SSD[tok * 8 + h] = ss;
  }
}

__device__ void final_rows(const Params& p, int gw, int nw) {
  const int lane = threadIdx.x & 63;
  for (int row = gw; row < T_TOK; row += nw) {
    float r = rsqrtf(p.SS_OUT[row] * (1.f / 1024.f) + 1e-6f);
    float4* o = (float4*)(p.out + (size_t)row * 1024);
    const float4* gf = (const float4*)p.g_final;
#pragma unroll
    for (int i = 0; i < 4; i++) {
      float4 v = o[lane + 64 * i], gg = gf[lane + 64 * i];
      v.x *= r * gg.x; v.y *= r * gg.y; v.z *= r * gg.z; v.w *= r * gg.w;
      o[lane + 64 * i] = v;
    }
  }
}

__device__ __forceinline__ void grid_bar(unsigned* bar, unsigned k) {
  asm volatile("s_waitcnt vmcnt(0)" ::: "memory");
  __syncthreads();
  if (threadIdx.x == 0) {
    const unsigned nb = gridDim.x, r = blockIdx.x & 7u;
    const unsigned nsub = (nb - r + 7u) >> 3;
    const unsigned ngrp = nb < 8u ? nb : 8u;
    __builtin_amdgcn_fence(__ATOMIC_RELEASE, "agent");
    asm volatile("s_waitcnt vmcnt(0)" ::: "memory");
    const unsigned old = __hip_atomic_fetch_add(bar + 64 * r, 1u, __ATOMIC_RELAXED, __HIP_MEMORY_SCOPE_AGENT);
    if (old + 1u == k * nsub) {
      __builtin_amdgcn_fence(__ATOMIC_ACQ_REL, "agent");
      asm volatile("s_waitcnt vmcnt(0)" ::: "memory");
      __hip_atomic_fetch_add(bar + 64 * 8, 1u, __ATOMIC_RELAXED, __HIP_MEMORY_SCOPE_AGENT);
    }
    while (__hip_atomic_load(bar + 64 * 8, __ATOMIC_RELAXED, __HIP_MEMORY_SCOPE_AGENT) < k * ngrp) __builtin_amdgcn_s_sleep(1);
    __builtin_amdgcn_fence(__ATOMIC_ACQUIRE, "agent");
    asm volatile("s_waitcnt vmcnt(0)" ::: "memory");
  }
  __syncthreads();
}

__device__ __forceinline__ int next_item(unsigned* ctr, char* smem) {
  int* sh = (int*)(smem + SMEM_BYTES - 16);
  __syncthreads();
  if (threadIdx.x == 0) *sh = (int)__hip_atomic_fetch_add(ctr, 1u, __ATOMIC_RELAXED, __HIP_MEMORY_SCOPE_AGENT);
  __syncthreads();
  return *sh;
}

__global__ void __launch_bounds__(256, 2) hymba_fwd(Params p) {
  cg::grid_group grid = cg::this_grid();
  __shared__ __attribute__((aligned(16))) char smem[SMEM_BYTES];
  const int nb = gridDim.x, bid = blockIdx.x;
  unsigned bk = 0;

  if (p.out == nullptr) grid.sync();
  for (int rep = 0; rep < REP0; rep++) {
  phase_prep(p);
  grid_bar(p.BAR, ++bk);
  }
  for (int rep = 0; rep < REP1; rep++) {
  if ((nb & 7) == 0) {
    const int xcd = bid & 7, li = bid >> 3, nbx = nb >> 3;
    for (int e = li; e < 1120; e += nbx) {
      const int grp = e / 280, r = e - grp * 280;
      gemm_tile<0>(p, xcd * 32 + grp * 8 + (r & 7), r >> 3, smem);
    }
  } else {
    for (int it = bid; it < 256 * 35; it += nb) gemm_tile<0>(p, it / 35, it % 35, smem);
  }
  for (int j = bid; j < 128; j += nb) gemm_tile<1>(p, j >> 3, j & 7, smem);
  grid_bar(p.BAR, ++bk);
  }
  for (int rep = 0; rep < REP2; rep++) {
  for (int it = next_item(p.BAR + 64 * (9 + rep), smem); it < 256 + 1024 + 2048; it = next_item(p.BAR + 64 * (9 + rep), smem)) {
    if (it < 256) compress_item(p, it, smem);
    else if (it < 1280) memattn_item(p, it - 256, smem);
    else conv_units(p, (it - 1280) * 256 + get_tid());
  }
  grid_bar(p.BAR, ++bk);
  }
  for (int rep = 0; rep < REP3; rep++) {
  {
    const int xq = bid & 7;
    unsigned* ctr = p.BAR + 64 * (16 + xq + 8 * rep);
    for (int li = next_item(ctr, smem); li < 512; li = next_item(ctr, smem)) {
      if (li < 256) nsa_item(p, ((li >> 1) << 4) | (xq + 8 * (li & 1)), smem);
      else ssd_states_item(p, (li - 256) * 8 + xq, smem);
    }
  }
  grid_bar(p.BAR, ++bk);
  }
  for (int it = bid; it < 2048; it += nb) scan_units(p, it * 256 + get_tid());
  grid_bar(p.BAR, ++bk);
  for (int rep = 0; rep < REP5; rep++) {
  for (int it = bid; it < 2048; it += nb) ssd_y_item(p, it, smem);
  grid_bar(p.BAR, ++bk);
  }
  if ((nb & 7) == 0) {
    const int xcd = bid & 7, li = bid >> 3, nbx = nb >> 3;
    for (int e = li; e < 256; e += nbx) gemm_tile<2>(p, xcd * 32 + (e >> 3), e & 7, smem);
  } else {
    for (int it = bid; it < 256 * 8; it += nb) gemm_tile<2>(p, it >> 3, it & 7, smem);
  }
  grid_bar(p.BAR, ++bk);
  final_rows(p, (bid * 256 + threadIdx.x) >> 6, (nb * 256) >> 6);
}

extern "C" void kernel_launch(void* const* d_in, const int* in_sizes, int n_in, void* d_out, int out_size, void* d_ws, size_t ws_size,
                              hipStream_t stream) {
  static int grid_blocks = 0;
  if (!grid_blocks) {
    int dev = 0, cus = 0, per_cu = 0;
    hipGetDevice(&dev);
    hipDeviceGetAttribute(&cus, hipDeviceAttributeMultiprocessorCount, dev);
    hipOccupancyMaxActiveBlocksPerMultiprocessor(&per_cu, hymba_fwd, 256, 0);
    if (per_cu < 1) per_cu = 1;
    if (per_cu > 4) per_cu = 4;
    grid_blocks = cus * per_cu;
  }
  Params p{};
  p.x = (const float*)d_in[0]; p.mem = (const float*)d_in[1]; p.pos = (const int*)d_in[2];
  p.g_in = (const float*)d_in[3]; p.w_in = (const float*)d_in[4]; p.cpk = (const float*)d_in[5];
  p.w1k = (const float*)d_in[6]; p.w2k = (const float*)d_in[7]; p.cpv = (const float*)d_in[8];
  p.w1v = (const float*)d_in[9]; p.w2v = (const float*)d_in[10]; p.conv_w = (const float*)d_in[11];
  p.conv_b = (const float*)d_in[12]; p.dt_bias = (const float*)d_in[13]; p.a_log = (const float*)d_in[14];
  p.d_skip = (const float*)d_in[15]; p.g_ssd = (const float*)d_in[16]; p.g_mem = (const float*)d_in[17];
  p.w_kv = (const float*)d_in[18]; p.w_out = (const float*)d_in[19]; p.g_final = (const float*)d_in[20];
  p.out = (float*)d_out;
  char* w = (char*)d_ws; size_t off = 0;
  auto take = [&](size_t bytes) { char* r = w + off; off += (bytes + 255) & ~(size_t)255; return r; };
  p.WinT = (bf16_t*)take((size_t)NINP * 1024 * 2);
  p.WoutT = (bf16_t*)take((size_t)1024 * 1536 * 2);
  p.WkvT = (bf16_t*)take((size_t)1024 * 1024 * 2);
  p.W1kT = (bf16_t*)take((size_t)256 * 2048 * 2);
  p.W1vT = (bf16_t*)take((size_t)256 * 2048 * 2);
  p.W2kT = (bf16_t*)take((size_t)64 * 256 * 2);
  p.W2vT = (bf16_t*)take((size_t)64 * 256 * 2);
  p.MEMB = (bf16_t*)take((size_t)2048 * 1024 * 2);
  p.PROJ = (bf16_t*)take((size_t)T_TOK * NIN * 2);
  p.VST = (bf16_t*)take((size_t)16 * 64 * S_LEN * 2);
  p.VWT = (bf16_t*)take((size_t)16 * 64 * S_LEN * 2);
  p.KMEM = (bf16_t*)take((size_t)2048 * 512 * 2);
  p.VMEMT = (bf16_t*)take((size_t)32 * 128 * 256 * 2);
  p.KCMP = (bf16_t*)take((size_t)16 * 256 * 64 * 2);
  p.VCMPT = (bf16_t*)take((size_t)16 * 64 * 256 * 2);
  p.XT = (bf16_t*)take((size_t)64 * 64 * S_LEN * 2);
  p.BC = (bf16_t*)take((size_t)T_TOK * 512 * 2);
  p.BT = (bf16_t*)take((size_t)16 * 128 * S_LEN * 2);
  p.MIX = (bf16_t*)take((size_t)T_TOK * 1536 * 2);
  p.XB = p.MIX;
  p.CHDEC = (float*)take((size_t)8 * 32 * 8 * 4);
  p.ACS = (float*)take((size_t)8 * 32 * 8 * 128 * 4);
  p.DTV = (float*)take((size_t)8 * 32 * 8 * 128 * 4);
  p.SS_SSD = (float*)take((size_t)T_TOK * 8 * 4);
  p.SS_OUT = (float*)take((size_t)T_TOK * 4);
  p.BAR = (unsigned*)take((size_t)(64 * 32 + 256) * 4);
  p.MTCNT = p.BAR + 64 * 32;
  p.STATES = (float*)d_out;
  p.KSC = (bf16_t*)((char*)d_out + (size_t)80 * 1024 * 1024);
  p.KWC = p.KSC + (size_t)16 * S_LEN * 64;
  if (off > ws_size) { fprintf(stderr, "workspace too small: need %zu have %zu\n", off, ws_size); return; }
  hipMemsetAsync(p.BAR, 0, (64 * 32 + 256) * 4, stream);
  void* args[] = {&p};
  hipError_t e = hipLaunchCooperativeKernel((void*)hymba_fwd, dim3(grid_blocks), dim3(256), args, 0, stream);
  if (e != hipSuccess) fprintf(stderr, "cooperative launch failed: %s (grid %d)\n", hipGetErrorString(e), grid_blocks);
}
```

```cpp
#include <hip/hip_runtime.h>
#include <hip/hip_cooperative_groups.h>
#include <stdint.h>
#include <stdio.h>
namespace cg = cooperative_groups;

typedef unsigned short bf16_t;
typedef __attribute__((ext_vector_type(8))) short bf16x8;
typedef __attribute__((ext_vector_type(4))) short bf16x4;
typedef __attribute__((ext_vector_type(4))) float f32x4;

#define S_LEN 4096
#define T_TOK 32768
#define NIN 4384
#define NINP 4480
#define LOG2E 1.4426950408889634f

#define C_Q 0
#define C_KC 512
#define C_VC 640
#define C_KS 768
#define C_KW 1024
#define C_GL 1280
#define C_GA 1304
#define C_Z 1816
#define C_XBC 2328
#define C_DT 3352
#define C_QX 3360
#define C_GX 3872

#define SMEM_BYTES 73728
#ifndef REP0
#define REP0 1
#endif
#ifndef REP1
#define REP1 1
#endif
#ifndef REP2
#define REP2 1
#endif
#ifndef REP3
#define REP3 1
#endif
#ifndef REP5
#define REP5 1
#endif

struct Params {
  const float *x, *mem; const int* pos;
  const float *g_in, *w_in, *cpk, *w1k, *w2k, *cpv, *w1v, *w2v, *conv_w, *conv_b, *dt_bias, *a_log, *d_skip, *g_ssd, *g_mem, *w_kv, *w_out, *g_final;
  float* out;
  bf16_t *WinT, *WoutT, *WkvT, *W1kT, *W1vT, *W2kT, *W2vT, *XB, *MEMB, *PROJ, *VST, *VWT, *KMEM, *VMEMT, *KCMP, *VCMPT, *XT, *BC, *BT, *MIX, *KSC, *KWC;
  float *STATES, *CHDEC, *ACS, *DTV, *SS_SSD, *SS_OUT;
  unsigned* BAR;
  unsigned* MTCNT;
};

__device__ __forceinline__ bf16_t f2bf(float f) { uint32_t u = __float_as_uint(f); u += 0x7fffu + ((u >> 16) & 1u); return (bf16_t)(u >> 16); }
__device__ __forceinline__ float bf2f(bf16_t h) { return __uint_as_float(((uint32_t)h) << 16); }
__device__ __forceinline__ float bfs(short h) { return __uint_as_float(((uint32_t)(unsigned short)h) << 16); }
__device__ __forceinline__ float fexp2(float x) { return __builtin_amdgcn_exp2f(x); }
__device__ __forceinline__ float silu_f(float x) { return x * __builtin_amdgcn_rcpf(1.f + __builtin_amdgcn_exp2f(-1.4426950408889634f * x)); }
__device__ __forceinline__ float sigmoid_f(float x) { return __builtin_amdgcn_rcpf(1.f + __builtin_amdgcn_exp2f(-1.4426950408889634f * x)); }
__device__ __forceinline__ f32x4 mfma16(bf16x8 a, bf16x8 b, f32x4 c) { return __builtin_amdgcn_mfma_f32_16x16x32_bf16(a, b, c, 0, 0, 0); }
typedef __bf16 hbf2_t __attribute__((ext_vector_type(2)));
typedef float f2_t __attribute__((ext_vector_type(2)));
typedef uint32_t u32x2 __attribute__((ext_vector_type(2)));
typedef uint32_t u32x4 __attribute__((ext_vector_type(4)));
__device__ __forceinline__ uint32_t pk2(float a, float b) {
  f2_t v; v[0] = a; v[1] = b;
  hbf2_t r = __builtin_convertvector(v, hbf2_t);
  return __builtin_bit_cast(uint32_t, r);
}
__device__ __forceinline__ bf16x4 pack4(float a, float b, float c, float d) {
  u32x2 r; r[0] = pk2(a, b); r[1] = pk2(c, d); return __builtin_bit_cast(bf16x4, r);
}
__device__ __forceinline__ bf16x8 pack8(float a, float b, float c, float d, float e, float f, float g, float h) {
  u32x4 r; r[0] = pk2(a, b); r[1] = pk2(c, d); r[2] = pk2(e, f); r[3] = pk2(g, h); return __builtin_bit_cast(bf16x8, r);
}
__device__ __forceinline__ bf16x8 cat44(bf16x4 a, bf16x4 b) {
  u32x2 x = __builtin_bit_cast(u32x2, a), y = __builtin_bit_cast(u32x2, b);
  u32x4 r; r[0] = x[0]; r[1] = x[1]; r[2] = y[0]; r[3] = y[1]; return __builtin_bit_cast(bf16x8, r);
}
template <int NR, typename L, typename ST, typename C>
__device__ __forceinline__ void tile_pipeline(int n, L load, ST store, C compute) {
  if (n <= 0) return;
  bf16x8 ra[NR], rb[NR];
  const int last = n - 1;
  load(0, ra);
  load(min(1, last), rb);
  store(0, ra);
  load(min(2, last), ra);
  __syncthreads();
  for (int i = 0; i < n; i += 2) {
    compute(i, 0);
    store(1, rb);
    load(min(i + 3, last), rb);
    __syncthreads();
    if (i + 1 < n) compute(i + 1, 1);
    store(0, ra);
    load(min(i + 4, last), ra);
    __syncthreads();
  }
}
template <int NR, typename L, typename ST, typename C>
__device__ __forceinline__ void tile_pipeline1(int n, L load, ST store, C compute) {
  if (n <= 0) return;
  bf16x8 ra[NR];
  load(0, ra);
  store(0, ra);
  if (n > 1) load(1, ra);
  __syncthreads();
  for (int i = 0; i < n; i++) {
    compute(i, i & 1);
    if (i + 1 < n) { store((i + 1) & 1, ra); if (i + 2 < n) load(i + 2, ra); }
    __syncthreads();
  }
}
__device__ __forceinline__ void rope_cs(int pos, int j, float& cs, float& sn) {
  float inv = fexp2(-(float)j * (18.931568569324174f / 8.f));
  float a = (float)pos * inv;
  float n = rintf(a * 0.15915494309189535f);
  float r = fmaf(-n, 6.28125f, a);
  r = fmaf(-n, 1.9353071795864769e-3f, r);
  cs = __cosf(r); sn = __sinf(r);
}

__device__ __forceinline__ float rowmax4(float x) {
  unsigned xi = __float_as_uint(x);
  auto a = __builtin_amdgcn_permlane16_swap(xi, xi, false, false);
  float m = fmaxf(__uint_as_float(a[0]), __uint_as_float(a[1]));
  unsigned mi = __float_as_uint(m);
  auto b = __builtin_amdgcn_permlane32_swap(mi, mi, false, false);
  return fmaxf(__uint_as_float(b[0]), __uint_as_float(b[1]));
}
__device__ __forceinline__ float rowsum4(float x) {
  unsigned xi = __float_as_uint(x);
  auto a = __builtin_amdgcn_permlane16_swap(xi, xi, false, false);
  float m = __uint_as_float(a[0]) + __uint_as_float(a[1]);
  unsigned mi = __float_as_uint(m);
  auto b = __builtin_amdgcn_permlane32_swap(mi, mi, false, false);
  return __uint_as_float(b[0]) + __uint_as_float(b[1]);
}
__device__ __forceinline__ int get_tid() { int t = threadIdx.x; asm volatile("" : "+v"(t)); return t; }

__device__ void prep_rows(const float* __restrict__ x, bf16_t* __restrict__ xb, int nrows, int gw, int nw) {
  const int lane = threadIdx.x & 63;
  int row = gw;
  for (; row + 3 * nw < nrows; row += 4 * nw) {
    float4 v[4][4]; float ss[4];
#pragma unroll
    for (int r = 0; r < 4; r++) {
      const float4* p = (const float4*)(x + (size_t)(row + r * nw) * 1024);
#pragma unroll
      for (int i = 0; i < 4; i++) v[r][i] = p[lane + 64 * i];
    }
#pragma unroll
    for (int r = 0; r < 4; r++) {
      float s = 0.f;
#pragma unroll
      for (int i = 0; i < 4; i++) s += v[r][i].x * v[r][i].x + v[r][i].y * v[r][i].y + v[r][i].z * v[r][i].z + v[r][i].w * v[r][i].w;
#pragma unroll
      for (int o = 32; o >= 1; o >>= 1) s += __shfl_xor(s, o);
      ss[r] = rsqrtf(s * (1.f / 1024.f) + 1e-6f);
    }
#pragma unroll
    for (int r = 0; r < 4; r++)
#pragma unroll
      for (int i = 0; i < 4; i++)
        *(bf16x4*)(xb + (size_t)(row + r * nw) * 1024 + (lane + 64 * i) * 4) =
            pack4(v[r][i].x * ss[r], v[r][i].y * ss[r], v[r][i].z * ss[r], v[r][i].w * ss[r]);
  }
  for (; row < nrows; row += nw) {
    const float4* p = (const float4*)(x + (size_t)row * 1024);
    float4 v[4]; float ss = 0.f;
#pragma unroll
    for (int i = 0; i < 4; i++) { v[i] = p[lane + 64 * i]; ss += v[i].x * v[i].x + v[i].y * v[i].y + v[i].z * v[i].z + v[i].w * v[i].w; }
#pragma unroll
    for (int o = 32; o >= 1; o >>= 1) ss += __shfl_xor(ss, o);
    float r = rsqrtf(ss * (1.f / 1024.f) + 1e-6f);
#pragma unroll
    for (int i = 0; i < 4; i++) {
      bf16x4 o = pack4(v[i].x * r, v[i].y * r, v[i].z * r, v[i].w * r);
      *(bf16x4*)(xb + (size_t)row * 1024 + (lane + 64 * i) * 4) = o;
    }
  }
}

__device__ void prep_wT(const float* __restrict__ w, const float* __restrict__ g, int gk0, int gk1, bf16_t* __restrict__ wt,
                        int K, int N, int Npad, int gtid, int gthreads) {
  const int ln = gtid & 63, gwv = gtid >> 6, nwv = gthreads >> 6;
  const int kblocks = K >> 6;
  const int total = (Npad >> 3) * kblocks;
  for (int uw = gwv; uw < total; uw += nwv) {
    const int kb = uw % kblocks, nbk = uw / kblocks;
    const int n = nbk * 8 + (ln >> 3), k8 = kb * 8 + (ln & 7);
    bf16x8 o;
#pragma unroll
    for (int j = 0; j < 8; j++) {
      int k = k8 * 8 + j; float v = 0.f;
      if (n < N) { v = w[(size_t)k * N + n]; if (g != nullptr && k >= gk0 && k < gk1) v *= g[k - gk0]; }
      o[j] = (short)f2bf(v);
    }
    *(bf16x8*)(wt + (size_t)n * K + k8 * 8) = o;
  }
}

__device__ void phase_prep(const Params& p) {
  const int gtid = blockIdx.x * 256 + threadIdx.x, gthreads = gridDim.x * 256;
  const int gw = gtid >> 6, nw = gthreads >> 6;
  prep_rows(p.x, p.XB, T_TOK, gw, nw);
  prep_rows(p.mem, p.MEMB, 2048, gw, nw);
  prep_wT(p.w_in, p.g_in, 0, 1024, p.WinT, 1024, NIN, NINP, gtid, gthreads);
  prep_wT(p.w_out, p.g_ssd, 512, 1024, p.WoutT, 1536, 1024, 1024, gtid, gthreads);
  prep_wT(p.w_kv, p.g_mem, 0, 1024, p.WkvT, 1024, 1024, 1024, gtid, gthreads);
  prep_wT(p.w1k, nullptr, 0, 0, p.W1kT, 2048, 256, 256, gtid, gthreads);
  prep_wT(p.w1v, nullptr, 0, 0, p.W1vT, 2048, 256, 256, gtid, gthreads);
  prep_wT(p.w2k, nullptr, 0, 0, p.W2kT, 256, 64, 64, gtid, gthreads);
  prep_wT(p.w2v, nullptr, 0, 0, p.W2vT, 256, 64, 64, gtid, gthreads);
  for (int i = gtid; i < T_TOK; i += gthreads) p.SS_OUT[i] = 0.f;
  for (int i = gtid; i < 16 * 64; i += gthreads) {
    int bg = i >> 6, d = i & 63;
    p.KCMP[((size_t)bg * 256 + 255) * 64 + d] = 0;
    p.VCMPT[((size_t)bg * 64 + d) * 256 + 255] = 0;
  }
}

template <int MODE>
__device__ void gemm_tile(const Params& p, int mt, int nt, char* smem) {
  const int tid = get_tid(), lane = tid & 63, wave = tid >> 6, lr = lane & 15, lg = lane >> 4;
  const int wr = wave >> 1, wc = wave & 1;
  const int m0 = mt * 128, n0 = nt * 128;
  const bf16_t* A; const bf16_t* Bt; int K;
  if (MODE == 0) { A = p.XB; Bt = p.WinT; K = 1024; }
  else if (MODE == 1) { A = p.MEMB; Bt = p.WkvT; K = 1024; }
  else { A = p.MIX; Bt = p.WoutT; K = 1536; }
  bf16_t* As = (bf16_t*)smem;
  bf16_t* Bs = As + 2 * 9216;
  const int lrow = tid >> 3, kc = tid & 7;
  const bf16_t* ga = A + (size_t)(m0 + lrow) * K + kc * 8;
  const bf16_t* gb = Bt + (size_t)(n0 + lrow) * K + kc * 8;
  float rs[4] = {1.f, 1.f, 1.f, 1.f};
  if (MODE == 2) {
#pragma unroll
    for (int i = 0; i < 4; i++) {
      const float4* sp = (const float4*)(p.SS_SSD + (size_t)(m0 + lrow + 32 * i) * 8);
      float4 a = sp[0], b = sp[1];
      rs[i] = rsqrtf((a.x + a.y + a.z + a.w + b.x + b.y + b.z + b.w) * (1.f / 512.f) + 1e-6f);
    }
  }
  bool swap;
  if (MODE == 0) swap = !(nt == 7 || nt == 9);
  else if (MODE == 1) swap = (nt < 4);
  else swap = true;
  const bf16_t* F = swap ? (Bs + (64 * wc) * 72) : (As + (64 * wr) * 72);
  const bf16_t* G = swap ? (As + (64 * wr) * 72) : (Bs + (64 * wc) * 72);
  f32x4 acc[4][4];
#pragma unroll
  for (int i = 0; i < 4; i++)
#pragma unroll
    for (int j = 0; j < 4; j++) acc[i][j] = (f32x4){0.f, 0.f, 0.f, 0.f};
  bf16x8 ra0[4], rb0[4], ra1[4], rb1[4];
  const int nk = K / 64;
  auto load = [&](int kt, bf16x8 (&ra)[4], bf16x8 (&rb)[4]) {
#pragma unroll
    for (int i = 0; i < 4; i++) {
      ra[i] = *(const bf16x8*)(ga + (size_t)(32 * i) * K + kt * 64);
      rb[i] = *(const bf16x8*)(gb + (size_t)(32 * i) * K + kt * 64);
    }
  };
  auto store = [&](int buf, int kt, bf16x8 (&ra)[4], bf16x8 (&rb)[4]) {
    if (MODE == 2) {
      if (kt >= 8 && kt < 16) {
#pragma unroll
        for (int i = 0; i < 4; i++) {
          bf16x8 v = ra[i];
          ra[i] = pack8(bfs(v[0]) * rs[i], bfs(v[1]) * rs[i], bfs(v[2]) * rs[i], bfs(v[3]) * rs[i],
                        bfs(v[4]) * rs[i], bfs(v[5]) * rs[i], bfs(v[6]) * rs[i], bfs(v[7]) * rs[i]);
        }
      }
    }
#pragma unroll
    for (int i = 0; i < 4; i++) {
      *(bf16x8*)(As + buf * 9216 + (lrow + 32 * i) * 72 + kc * 8) = ra[i];
      *(bf16x8*)(Bs + buf * 9216 + (lrow + 32 * i) * 72 + kc * 8) = rb[i];
    }
  };
  auto compute = [&](int buf) {
    const int cb = buf * 9216;
#pragma unroll
    for (int ks = 0; ks < 2; ks++) {
      bf16x8 ff[4], gg[4];
#pragma unroll
      for (int i = 0; i < 4; i++) {
        ff[i] = *(const bf16x8*)(F + cb + (16 * i + lr) * 72 + ks * 32 + lg * 8);
        gg[i] = *(const bf16x8*)(G + cb + (16 * i + lr) * 72 + ks * 32 + lg * 8);
      }
#pragma unroll
      for (int i = 0; i < 4; i++)
#pragma unroll
        for (int j = 0; j < 4; j++) acc[i][j] = mfma16(ff[i], gg[j], acc[i][j]);
    }
  };
  const int lastk = nk - 1;
  load(0, ra0, rb0);
  load(1, ra1, rb1);
  store(0, 0, ra0, rb0);
  load(2, ra0, rb0);
  __syncthreads();
  for (int kt = 0; kt < nk; kt += 2) {
    compute(0);
    store(1, kt + 1, ra1, rb1);
    load(min(kt + 3, lastk), ra1, rb1);
    __syncthreads();
    compute(1);
    store(0, min(kt + 2, lastk), ra0, rb0);
    load(min(kt + 4, lastk), ra0, rb0);
    __syncthreads();
  }
  if (swap) {
    if (MODE == 0) {
      const bool rope = (nt < 4) || nt == 6 || nt == 8;
#pragma unroll
      for (int mi = 0; mi < 4; mi++) {
        const int m = m0 + 64 * wr + 16 * mi + lr;
        if (rope) {
          const int pos = p.pos[m];
          f32x4 v = acc[0][mi];
          f32x4 o;
#pragma unroll
          for (int i = 0; i < 4; i++) {
            float pr = __shfl_xor(v[i], 32);
            float cs, sn; rope_cs(pos, 4 * (lg & 1) + i, cs, sn);
            o[i] = (lg < 2) ? (v[i] * cs - pr * sn) : (v[i] * cs + pr * sn);
          }
          acc[0][mi] = o;
        }
        {
          bf16_t* stg = (bf16_t*)smem + ((wave & 1) ? 2 * 9216 : 0) + (wave >> 1) * 4608;
#pragma unroll
          for (int ni = 0; ni < 4; ni++) {
            f32x4 v = acc[ni][mi];
            *(bf16x4*)(stg + (16 * mi + lr) * 72 + 16 * ni + 4 * lg) = pack4(v[0], v[1], v[2], v[3]);
          }
        }
      }
      {
        const bf16_t* stg = (const bf16_t*)smem + ((wave & 1) ? 2 * 9216 : 0) + (wave >> 1) * 4608;
        const int rr = lane >> 3, ch = lane & 7;
        const int nb0 = n0 + 64 * wc + ch * 8;
#pragma unroll
        for (int it = 0; it < 8; it++) {
          const int row = it * 8 + rr;
          const int m = m0 + 64 * wr + row;
          bf16x8 v = *(const bf16x8*)(stg + row * 72 + ch * 8);
          if (nt == 6 || nt == 8) {
            bf16_t* kd = ((nt == 6) ? p.KSC : p.KWC) + (((size_t)(m >> 12) * 2 + wc) * S_LEN + (m & 4095)) * 64;
            *(bf16x8*)(kd + ch * 8) = v;
          } else if (nb0 < NIN) {
            *(bf16x8*)(p.PROJ + (size_t)m * NIN + nb0) = v;
          }
        }
      }
      __syncthreads();
    } else if (MODE == 1) {
#pragma unroll
      for (int mi = 0; mi < 4; mi++) {
        const int m = m0 + 64 * wr + 16 * mi + lr;
#pragma unroll
        for (int ni = 0; ni < 4; ni++) {
          const int n = n0 + 64 * wc + 16 * ni + 4 * lg;
          f32x4 v = acc[ni][mi];
          *(bf16x4*)(p.KMEM + (size_t)m * 512 + n) = pack4(v[0], v[1], v[2], v[3]);
        }
      }
    } else {
#pragma unroll
      for (int mi = 0; mi < 4; mi++) {
        const int m = m0 + 64 * wr + 16 * mi + lr;
        float ss = 0.f;
#pragma unroll
        for (int ni = 0; ni < 4; ni++) {
          const int n = n0 + 64 * wc + 16 * ni + 4 * lg;
          float4 xv = *(const float4*)(p.x + (size_t)m * 1024 + n);
          f32x4 v = acc[ni][mi];
          float4 h; h.x = xv.x + v[0]; h.y = xv.y + v[1]; h.z = xv.z + v[2]; h.w = xv.w + v[3];
          ss += h.x * h.x + h.y * h.y + h.z * h.z + h.w * h.w;
          *(float4*)(p.out + (size_t)m * 1024 + n) = h;
        }
        ss += __shfl_xor(ss, 16); ss += __shfl_xor(ss, 32);
        if (lg == 0) atomicAdd(p.SS_OUT + m, ss);
      }
    }
  } else {
#pragma unroll
    for (int mi = 0; mi < 4; mi++)
#pragma unroll
      for (int ni = 0; ni < 4; ni++) {
        f32x4 v = acc[mi][ni];
        bf16x4 o = pack4(v[0], v[1], v[2], v[3]);
        if (MODE == 0) {
          const int b = m0 >> 12, s = (m0 & 4095) + 64 * wr + 16 * mi + 4 * lg;
          const int d = 16 * ni + lr;
          bf16_t* dst = (nt == 7) ? p.VST : p.VWT;
          *(bf16x4*)(dst + ((size_t)(b * 2 + wc) * 64 + d) * S_LEN + s) = o;
        } else {
          const int b = m0 >> 8, s = (m0 & 255) + 64 * wr + 16 * mi + 4 * lg;
          const int col = n0 - 512 + 64 * wc + 16 * ni + lr;
          const int h = col >> 7, d = col & 127;
          *(bf16x4*)(p.VMEMT + ((size_t)(b * 4 + h) * 128 + d) * 256 + s) = o;
        }
      }
  }
}

template <int DQK, int DV, int MASK, typename MaskF>
__device__ __forceinline__ void attn_tile(const bf16_t* sK, const bf16_t* sVt, const bf16x8 (&qf)[2][DQK / 32], f32x4 (&o)[DV / 16][2],
                                          float (&m)[2], float (&l)[2], float c, bool qsel0, bool qsel1, MaskF valid) {
  constexpr int KST = DQK + 8;
  const int lane = get_tid() & 63, lr = lane & 15, lg = lane >> 4;
  f32x4 s[4][2];
#pragma unroll
  for (int kt = 0; kt < 4; kt++) { s[kt][0] = (f32x4){0.f, 0.f, 0.f, 0.f}; s[kt][1] = (f32x4){0.f, 0.f, 0.f, 0.f}; }
#pragma unroll
  for (int ks = 0; ks < DQK / 32; ks++)
#pragma unroll
    for (int kt = 0; kt < 4; kt++) {
      bf16x8 a = *(const bf16x8*)(sK + (16 * kt + lr) * KST + ks * 32 + lg * 8);
      s[kt][0] = mfma16(a, qf[0][ks], s[kt][0]);
      s[kt][1] = mfma16(a, qf[1][ks], s[kt][1]);
    }
#pragma unroll
  for (int qt = 0; qt < 2; qt++) {
    const bool qs = qt ? qsel1 : qsel0;
    float mx = -1e30f;
    if (MASK) {
#pragma unroll
      for (int kt = 0; kt < 4; kt++)
#pragma unroll
        for (int i = 0; i < 4; i++) {
          bool v = valid(16 * kt + 4 * lg + i, qt);
          float sv = v ? s[kt][qt][i] * c : -1e30f;
          s[kt][qt][i] = sv; mx = fmaxf(mx, sv);
        }
    } else {
#pragma unroll
      for (int kt = 0; kt < 4; kt++) mx = fmaxf(fmaxf(mx, fmaxf(s[kt][qt][0], s[kt][qt][1])), fmaxf(s[kt][qt][2], s[kt][qt][3]));
      mx = qs ? mx * c : -1e30f;
    }
    mx = rowmax4(mx);
    const float mn = fmaxf(m[qt], mx);
    const float alpha = fexp2(m[qt] - mn);
    m[qt] = mn;
    float me;
    if (MASK) me = (mn > -1e29f) ? mn : 1e30f; else me = qs ? mn : 1e30f;
    float rs = 0.f;
#pragma unroll
    for (int kt = 0; kt < 4; kt++)
#pragma unroll
      for (int i = 0; i < 4; i++) {
        float pv = MASK ? fexp2(s[kt][qt][i] - me) : fexp2(fmaf(s[kt][qt][i], c, -me));
        s[kt][qt][i] = pv; rs += pv;
      }
    rs = rowsum4(rs);
    l[qt] = l[qt] * alpha + rs;
#pragma unroll
    for (int dt = 0; dt < DV / 16; dt++) {
      o[dt][qt][0] *= alpha; o[dt][qt][1] *= alpha; o[dt][qt][2] *= alpha; o[dt][qt][3] *= alpha;
    }
  }
#pragma unroll
  for (int k2 = 0; k2 < 2; k2++) {
    bf16x8 pb[2];
#pragma unroll
    for (int qt = 0; qt < 2; qt++)
      pb[qt] = pack8(s[2 * k2][qt][0], s[2 * k2][qt][1], s[2 * k2][qt][2], s[2 * k2][qt][3],
                     s[2 * k2 + 1][qt][0], s[2 * k2 + 1][qt][1], s[2 * k2 + 1][qt][2], s[2 * k2 + 1][qt][3]);
#pragma unroll
    for (int dt = 0; dt < DV / 16; dt++) {
      const bf16_t* vp = sVt + (16 * dt + lr) * 72 + 32 * k2 + 4 * lg;
      bf16x8 a = cat44(*(const bf16x4*)vp, *(const bf16x4*)(vp + 16));
      o[dt][0] = mfma16(a, pb[0], o[dt][0]);
      o[dt][1] = mfma16(a, pb[1], o[dt][1]);
    }
  }
}

__device__ __forceinline__ int next_bit_below(unsigned long long m, int below) {
  unsigned long long mm = (below >= 64) ? m : (m & ((1ull << below) - 1ull));
  return mm ? (63 - __clzll((long long)mm)) : -1;
}

__device__ void nsa_item(const Params& p, int item, char* smem) {
  const int tid = get_tid(), lane = tid & 63, wave = tid >> 6, lr = lane & 15, lg = lane >> 4;
  const int bg = item & 15, qb = 127 - (item >> 4);
  const int b = bg >> 1, g = bg & 1;
  const int t0 = qb * 32, cur = t0 >> 6;
  const int hq = g * 4 + wave;
  float* sImp = (float*)(smem + 55296);
  unsigned long long* sSel = (unsigned long long*)(smem + 63616);
  const float c = 0.125f * LOG2E;
  const size_t tokbase = (size_t)b * S_LEN + t0;
  const int r0 = tid >> 3, cc = tid & 7;

  bf16x8 qf[2][2];
#pragma unroll
  for (int qt = 0; qt < 2; qt++) {
    const bf16_t* row = p.PROJ + (tokbase + 16 * qt + lr) * NIN;
#pragma unroll
    for (int ks = 0; ks < 2; ks++) qf[qt][ks] = *(const bf16x8*)(row + C_Q + hq * 64 + 32 * ks + 8 * lg);
  }
  auto emit = [&](f32x4 (&o)[4][2], float (&l)[2], int br) {
#pragma unroll
    for (int qt = 0; qt < 2; qt++) {
      const size_t tok = tokbase + 16 * qt + lr;
      const float gsc = sigmoid_f(bf2f(p.PROJ[tok * NIN + C_GL + hq * 3 + br])) / fmaxf(l[qt], 1e-30f);
#pragma unroll
      for (int dt = 0; dt < 4; dt++) {
        const int dbase = hq * 64 + 16 * dt + 4 * lg;
        bf16_t* dst = p.MIX + tok * 1536 + dbase;
        f32x4 r = o[dt][qt];
        r[0] *= gsc; r[1] *= gsc; r[2] *= gsc; r[3] *= gsc;
        if (br > 0) { bf16x4 pv = *(const bf16x4*)dst; r[0] += bfs(pv[0]); r[1] += bfs(pv[1]); r[2] += bfs(pv[2]); r[3] += bfs(pv[3]); }
        if (br == 2) {
          bf16x4 ga = *(const bf16x4*)(p.PROJ + tok * NIN + C_GA + dbase);
          r[0] *= silu_f(bfs(ga[0])); r[1] *= silu_f(bfs(ga[1])); r[2] *= silu_f(bfs(ga[2])); r[3] *= silu_f(bfs(ga[3]));
        }
        *(bf16x4*)dst = pack4(r[0], r[1], r[2], r[3]);
      }
    }
  };
  auto store_kv = [&](int buf, bf16x8 (&rg)[4]) {
    bf16_t* sK = (bf16_t*)(smem + buf * 27648);
    bf16_t* sVt = sK + 64 * 72;
    *(bf16x8*)(sK + r0 * 72 + cc * 8) = rg[0];
    *(bf16x8*)(sK + (r0 + 32) * 72 + cc * 8) = rg[1];
    *(bf16x8*)(sVt + r0 * 72 + cc * 8) = rg[2];
    *(bf16x8*)(sVt + (r0 + 32) * 72 + cc * 8) = rg[3];
  };

  {
    const int ntiles = (t0 >> 10) + 1;
    const bf16_t* kb = p.KCMP + (size_t)bg * 256 * 64;
    const bf16_t* vb = p.VCMPT + (size_t)bg * 64 * 256;
    for (int pass = 0; pass < 2; pass++) {
      f32x4 o[4][2]; float m[2] = {-1e30f, -1e30f}, l[2] = {0.f, 0.f};
#pragma unroll
      for (int dt = 0; dt < 4; dt++) { o[dt][0] = (f32x4){0.f, 0.f, 0.f, 0.f}; o[dt][1] = (f32x4){0.f, 0.f, 0.f, 0.f}; }
      int ldn = 0;
      tile_pipeline<4>(ntiles,
        [&](int i, bf16x8 (&rg)[4]) {
          rg[0] = *(const bf16x8*)(kb + (size_t)(64 * i + r0) * 64 + cc * 8);
          rg[1] = *(const bf16x8*)(kb + (size_t)(64 * i + r0 + 32) * 64 + cc * 8);
          if (pass == 0) {
            rg[2] = *(const bf16x8*)(vb + (size_t)r0 * 256 + 64 * i + cc * 8);
            rg[3] = *(const bf16x8*)(vb + (size_t)(r0 + 32) * 256 + 64 * i + cc * 8);
          }
        },
        [&](int buf, bf16x8 (&rg)[4]) {
          const int nt = ldn++;
          if (pass == 1) {
#pragma unroll
            for (int i2 = 0; i2 < 2; i2++) {
              const int j = r0 + 32 * i2;
              bf16x8 ov;
#pragma unroll
              for (int x = 0; x < 8; x++) { int n = 64 * nt + cc * 8 + x; ov[x] = (n >= 4 * j - 1 && n <= 4 * j + 3) ? (short)0x3F80 : (short)0; }
              rg[2 + i2] = ov;
            }
          }
          store_kv(buf, rg);
        },
        [&](int i, int buf) {
          const bf16_t* sK = (const bf16_t*)(smem + buf * 27648);
          attn_tile<64, 64, 1>(sK, sK + 64 * 72, qf, o, m, l, c, true, true,
                               [&](int key, int qt) { return 16 * (64 * i + key) + 31 <= t0 + 16 * qt + lr; });
        });
      if (pass == 0) {
        emit(o, l, 0);
      } else {
        float inv[2];
#pragma unroll
        for (int qt = 0; qt < 2; qt++) inv[qt] = 1.f / fmaxf(l[qt], 1e-30f);
        for (int e2 = 0; e2 < 4; e2++) {
          if (wave == e2) {
#pragma unroll
            for (int dt = 0; dt < 4; dt++)
#pragma unroll
              for (int qt = 0; qt < 2; qt++)
#pragma unroll
                for (int i = 0; i < 4; i++) {
                  int j = 16 * dt + 4 * lg + i, q = 16 * qt + lr;
                  float v = o[dt][qt][i] * inv[qt];
                  if (e2 == 0) sImp[q * 65 + j] = v; else sImp[q * 65 + j] += v;
                }
          }
          __syncthreads();
        }
      }
    }
  }
  for (int qq = 0; qq < 8; qq++) {
    const int q = wave * 8 + qq;
    const int j = lane;
    float v = sImp[q * 65 + j];
    bool valid = j <= cur;
    bool forced = (j == 0) || (j == cur) || (j == cur - 1);
    float val = forced ? 1e9f : (valid ? v : -1e9f);
    int rank = 0;
#pragma unroll 16
    for (int jj = 0; jj < 64; jj++) {
      float ov = __int_as_float(__builtin_amdgcn_readlane(__float_as_int(val), jj));
      rank += ((ov > val) || (ov == val && jj < j)) ? 1 : 0;
    }
    unsigned long long mask = __ballot((rank < 16) && valid);
    if (lane == 0) sSel[q] = mask;
  }
  __syncthreads();
  unsigned long long any = 0ull;
  for (int q = 0; q < 32; q++) any |= sSel[q];
  unsigned long long mk[2];
  mk[0] = sSel[lr]; mk[1] = sSel[16 + lr];

  {
    f32x4 o[4][2]; float m[2] = {-1e30f, -1e30f}, l[2] = {0.f, 0.f};
#pragma unroll
    for (int dt = 0; dt < 4; dt++) { o[dt][0] = (f32x4){0.f, 0.f, 0.f, 0.f}; o[dt][1] = (f32x4){0.f, 0.f, 0.f, 0.f}; }
    const bf16_t* kb = p.KSC + (size_t)bg * S_LEN * 64;
    const bf16_t* vb = p.VST + (size_t)bg * 64 * S_LEN;
    const int ntiles = __popcll(any);
    int jl = 64, jc = 64;
    tile_pipeline<4>(ntiles,
      [&](int, bf16x8 (&rg)[4]) {
        jl = (jl > 0) ? next_bit_below(any, jl) : -1;
        const int jj = jl < 0 ? 0 : jl;
        rg[0] = *(const bf16x8*)(kb + (size_t)(64 * jj + r0) * 64 + cc * 8);
        rg[1] = *(const bf16x8*)(kb + (size_t)(64 * jj + r0 + 32) * 64 + cc * 8);
        rg[2] = *(const bf16x8*)(vb + (size_t)r0 * S_LEN + 64 * jj + cc * 8);
        rg[3] = *(const bf16x8*)(vb + (size_t)(r0 + 32) * S_LEN + 64 * jj + cc * 8);
      },
      store_kv,
      [&](int, int buf) {
        jc = next_bit_below(any, jc);
        const int j = jc;
        const bf16_t* sK = (const bf16_t*)(smem + buf * 27648);
        if (j == cur) {
          attn_tile<64, 64, 1>(sK, sK + 64 * 72, qf, o, m, l, c, true, true,
                               [&](int key, int qt) { return 64 * j + key <= t0 + 16 * qt + lr; });
        } else {
          attn_tile<64, 64, 0>(sK, sK + 64 * 72, qf, o, m, l, c, ((mk[0] >> j) & 1ull) != 0ull, ((mk[1] >> j) & 1ull) != 0ull,
                               [&](int, int) { return true; });
        }
      });
    emit(o, l, 1);
  }
  {
    f32x4 o[4][2]; float m[2] = {-1e30f, -1e30f}, l[2] = {0.f, 0.f};
#pragma unroll
    for (int dt = 0; dt < 4; dt++) { o[dt][0] = (f32x4){0.f, 0.f, 0.f, 0.f}; o[dt][1] = (f32x4){0.f, 0.f, 0.f, 0.f}; }
    const int jlo = (cur - 8 > 0) ? (cur - 8) : 0;
    const bf16_t* kb = p.KWC + (size_t)bg * S_LEN * 64;
    const bf16_t* vb = p.VWT + (size_t)bg * 64 * S_LEN;
    tile_pipeline<4>(cur - jlo + 1,
      [&](int i, bf16x8 (&rg)[4]) {
        const int j = cur - i;
        rg[0] = *(const bf16x8*)(kb + (size_t)(64 * j + r0) * 64 + cc * 8);
        rg[1] = *(const bf16x8*)(kb + (size_t)(64 * j + r0 + 32) * 64 + cc * 8);
        rg[2] = *(const bf16x8*)(vb + (size_t)r0 * S_LEN + 64 * j + cc * 8);
        rg[3] = *(const bf16x8*)(vb + (size_t)(r0 + 32) * S_LEN + 64 * j + cc * 8);
      },
      store_kv,
      [&](int i, int buf) {
        const int j = cur - i;
        const bf16_t* sK = (const bf16_t*)(smem + buf * 27648);
        if (j == cur || j == cur - 8) {
          attn_tile<64, 64, 1>(sK, sK + 64 * 72, qf, o, m, l, c, true, true, [&](int key, int qt) {
            int tq = t0 + 16 * qt + lr, kp = 64 * j + key;
            return (kp <= tq) && (kp > tq - 512);
          });
        } else {
          attn_tile<64, 64, 0>(sK, sK + 64 * 72, qf, o, m, l, c, true, true, [&](int, int) { return true; });
        }
      });
    emit(o, l, 2);
  }
}

__device__ void memattn_item(const Params& p, int item, char* smem) {
  const int tid = get_tid(), lane = tid & 63, wave = tid >> 6, lr = lane & 15, lg = lane >> 4;
  const int b = item >> 7, h = (item >> 5) & 3, qb = item & 31;
  const int t0 = qb * 128 + wave * 32;
  const size_t tokbase = (size_t)b * S_LEN + t0;
  bf16x8 qf[2][4];
#pragma unroll
  for (int qt = 0; qt < 2; qt++)
#pragma unroll
    for (int ks = 0; ks < 4; ks++) qf[qt][ks] = *(const bf16x8*)(p.PROJ + (tokbase + 16 * qt + lr) * NIN + C_QX + h * 128 + 32 * ks + 8 * lg);
  f32x4 o[8][2]; float m[2] = {-1e30f, -1e30f}, l[2] = {0.f, 0.f};
#pragma unroll
  for (int dt = 0; dt < 8; dt++) { o[dt][0] = (f32x4){0.f, 0.f, 0.f, 0.f}; o[dt][1] = (f32x4){0.f, 0.f, 0.f, 0.f}; }
  const float c = 0.08838834764831845f * LOG2E;
  const bf16_t* kb = p.KMEM + (size_t)b * 256 * 512 + h * 128;
  const bf16_t* vb = p.VMEMT + (size_t)(b * 4 + h) * 128 * 256;
  tile_pipeline1<8>(4,
    [&](int kt, bf16x8 (&rg)[8]) {
#pragma unroll
      for (int i = 0; i < 4; i++) {
        int ch = tid + 256 * i;
        rg[i] = *(const bf16x8*)(kb + (size_t)(64 * kt + (ch >> 4)) * 512 + (ch & 15) * 8);
        rg[4 + i] = *(const bf16x8*)(vb + (size_t)(ch >> 3) * 256 + 64 * kt + (ch & 7) * 8);
      }
    },
    [&](int buf, bf16x8 (&rg)[8]) {
      bf16_t* sK = (bf16_t*)(smem + buf * 35840);
      bf16_t* sVt = sK + 64 * 136;
#pragma unroll
      for (int i = 0; i < 4; i++) {
        int ch = tid + 256 * i;
        *(bf16x8*)(sK + (ch >> 4) * 136 + (ch & 15) * 8) = rg[i];
        *(bf16x8*)(sVt + (ch >> 3) * 72 + (ch & 7) * 8) = rg[4 + i];
      }
    },
    [&](int, int buf) {
      const bf16_t* sK = (const bf16_t*)(smem + buf * 35840);
      attn_tile<128, 128, 0>(sK, sK + 64 * 136, qf, o, m, l, c, true, true, [&](int, int) { return true; });
    });
#pragma unroll
  for (int qt = 0; qt < 2; qt++) {
    const size_t tok = tokbase + 16 * qt + lr;
    const float inv = 1.f / fmaxf(l[qt], 1e-30f);
#pragma unroll
    for (int dt = 0; dt < 8; dt++) {
      const int dbase = h * 128 + 16 * dt + 4 * lg;
      bf16x4 ga = *(const bf16x4*)(p.PROJ + tok * NIN + C_GX + dbase);
      f32x4 r = o[dt][qt];
      *(bf16x4*)(p.MIX + tok * 1536 + 1024 + dbase) =
          pack4(r[0] * inv * silu_f(bfs(ga[0])), r[1] * inv * silu_f(bfs(ga[1])), r[2] * inv * silu_f(bfs(ga[2])), r[3] * inv * silu_f(bfs(ga[3])));
    }
  }
}

__device__ void compress_item(const Params& p, int item, char* smem) {
  const int tid = get_tid(), lane = tid & 63, wave = tid >> 6, lr = lane & 15, lg = lane >> 4;
  const int which = item >> 7, rho0 = (item & 127) * 32;
  const bf16_t* W1T = which ? p.W1vT : p.W1kT;
  const bf16_t* W2T = which ? p.W2vT : p.W2kT;
  const float* pe = which ? p.cpv : p.cpk;
  const int col0 = which ? C_VC : C_KC;
  bf16_t* sH = (bf16_t*)smem;
  const bf16_t* rowbase[2];
#pragma unroll
  for (int rt = 0; rt < 2; rt++) {
    int rho = rho0 + 16 * rt + lr; if (rho > 4079) rho = 4079;
    int b = rho / 510, rem = rho - b * 510, n = rem >> 1, g = rem & 1;
    rowbase[rt] = p.PROJ + ((size_t)b * S_LEN + 16 * n) * NIN + col0 + g * 64;
  }
  f32x4 acc[2][4];
#pragma unroll
  for (int i = 0; i < 2; i++)
#pragma unroll
    for (int j = 0; j < 4; j++) acc[i][j] = (f32x4){0.f, 0.f, 0.f, 0.f};
#pragma unroll 4
  for (int kstep = 0; kstep < 64; kstep++) {
    const int lin = kstep >> 1, d0 = (kstep & 1) * 32 + 8 * lg;
    float4 p0 = *(const float4*)(pe + lin * 64 + d0), p1 = *(const float4*)(pe + lin * 64 + d0 + 4);
    bf16x8 a[2];
#pragma unroll
    for (int rt = 0; rt < 2; rt++) {
      bf16x8 raw = *(const bf16x8*)(rowbase[rt] + (size_t)lin * NIN + d0);
      a[rt][0] = (short)f2bf(bfs(raw[0]) + p0.x); a[rt][1] = (short)f2bf(bfs(raw[1]) + p0.y);
      a[rt][2] = (short)f2bf(bfs(raw[2]) + p0.z); a[rt][3] = (short)f2bf(bfs(raw[3]) + p0.w);
      a[rt][4] = (short)f2bf(bfs(raw[4]) + p1.x); a[rt][5] = (short)f2bf(bfs(raw[5]) + p1.y);
      a[rt][6] = (short)f2bf(bfs(raw[6]) + p1.z); a[rt][7] = (short)f2bf(bfs(raw[7]) + p1.w);
    }
#pragma unroll
    for (int ct = 0; ct < 4; ct++) {
      bf16x8 bf = *(const bf16x8*)(W1T + (size_t)(64 * wave + 16 * ct + lr) * 2048 + kstep * 32 + 8 * lg);
      acc[0][ct] = mfma16(a[0], bf, acc[0][ct]);
      acc[1][ct] = mfma16(a[1], bf, acc[1][ct]);
    }
  }
  __syncthreads();
#pragma unroll
  for (int rt = 0; rt < 2; rt++)
#pragma unroll
    for (int ct = 0; ct < 4; ct++)
#pragma unroll
      for (int i = 0; i < 4; i++) sH[(16 * rt + 4 * lg + i) * 264 + 64 * wave + 16 * ct + lr] = f2bf(silu_f(acc[rt][ct][i]));
  __syncthreads();
  f32x4 acc2[2] = {(f32x4){0.f, 0.f, 0.f, 0.f}, (f32x4){0.f, 0.f, 0.f, 0.f}};
#pragma unroll
  for (int ks = 0; ks < 8; ks++) {
    bf16x8 bf = *(const bf16x8*)(W2T + (size_t)(16 * wave + lr) * 256 + 32 * ks + 8 * lg);
#pragma unroll
    for (int rt = 0; rt < 2; rt++) {
      bf16x8 a = *(const bf16x8*)(sH + (16 * rt + lr) * 264 + 32 * ks + 8 * lg);
      acc2[rt] = mfma16(a, bf, acc2[rt]);
    }
  }
  const int col = 16 * wave + lr;
#pragma unroll
  for (int rt = 0; rt < 2; rt++)
#pragma unroll
    for (int i = 0; i < 4; i++) {
      int rho = rho0 + 16 * rt + 4 * lg + i;
      bool ok = rho < 4080;
      int rc = ok ? rho : 4079;
      int b = rc / 510, rem = rc - b * 510, n = rem >> 1, g = rem & 1;
      float v = acc2[rt][i];
      float pr = __shfl_xor(v, 8);
      if (which == 0) {
        if (wave == 0) {
          int pos = p.pos[b * S_LEN + 16 * n + 31];
          float cs, sn; rope_cs(pos, lr & 7, cs, sn);
          v = (lr < 8) ? (v * cs - pr * sn) : (v * cs + pr * sn);
        }
        if (ok) p.KCMP[((size_t)(b * 2 + g) * 256 + n) * 64 + col] = f2bf(v);
      } else {
        if (ok) p.VCMPT[((size_t)(b * 2 + g) * 64 + col) * 256 + n] = f2bf(v);
      }
    }
}

__device__ void conv_units(const Params& p, int u) {
  const int it = u >> 8, wvi = (u >> 6) & 3, ln = u & 63;
  const int cgp = ((it & 3) * 4 + wvi) * 8 + (ln >> 3), tg = (it >> 2) * 8 + (ln & 7);
  const int tok0 = tg * 8, s0 = tok0 & 4095, ch0 = cgp * 8;
  const int b = tok0 >> 12;
  bf16x8 in[11];
#pragma unroll
  for (int r = 0; r < 11; r++) {
    int s = s0 - 3 + r;
    if (s >= 0) in[r] = *(const bf16x8*)(p.PROJ + (size_t)(tok0 - 3 + r) * NIN + C_XBC + ch0);
    else in[r] = (bf16x8){0, 0, 0, 0, 0, 0, 0, 0};
  }
  float4 wv[4][2];
#pragma unroll
  for (int k = 0; k < 4; k++) { wv[k][0] = *(const float4*)(p.conv_w + k * 1024 + ch0); wv[k][1] = *(const float4*)(p.conv_w + k * 1024 + ch0 + 4); }
  float4 bv0 = *(const float4*)(p.conv_b + ch0), bv1 = *(const float4*)(p.conv_b + ch0 + 4);
  float w[4][8], bias[8];
#pragma unroll
  for (int k = 0; k < 4; k++) { w[k][0] = wv[k][0].x; w[k][1] = wv[k][0].y; w[k][2] = wv[k][0].z; w[k][3] = wv[k][0].w; w[k][4] = wv[k][1].x; w[k][5] = wv[k][1].y; w[k][6] = wv[k][1].z; w[k][7] = wv[k][1].w; }
  bias[0] = bv0.x; bias[1] = bv0.y; bias[2] = bv0.z; bias[3] = bv0.w; bias[4] = bv1.x; bias[5] = bv1.y; bias[6] = bv1.z; bias[7] = bv1.w;
  if (ch0 >= 512) {
#pragma unroll
    for (int tt = 0; tt < 8; tt++) {
      bf16x8 o;
#pragma unroll
      for (int j = 0; j < 8; j++) {
        float a = bias[j];
#pragma unroll
        for (int k = 0; k < 4; k++) a += bfs(in[tt + k][j]) * w[k][j];
        o[j] = (short)f2bf(silu_f(a));
      }
      *(bf16x8*)(p.BC + (size_t)(tok0 + tt) * 512 + (ch0 - 512)) = o;
    }
  }
  if (ch0 < 768) {
#pragma unroll
    for (int j = 0; j < 8; j++) {
      bf16x8 o;
#pragma unroll
      for (int tt = 0; tt < 8; tt++) {
        float a = bias[j];
#pragma unroll
        for (int k = 0; k < 4; k++) a += bfs(in[tt + k][j]) * w[k][j];
        o[tt] = (short)f2bf(silu_f(a));
      }
      const int ch = ch0 + j;
      bf16_t* dst;
      if (ch0 < 512) dst = p.XT + ((size_t)(b * 8 + (ch >> 6)) * 64 + (ch & 63)) * S_LEN + s0;
      else dst = p.BT + ((size_t)(b * 2 + ((ch - 512) >> 7)) * 128 + ((ch - 512) & 127)) * S_LEN + s0;
      *(bf16x8*)dst = o;
    }
  }
}

__device__ void ssd_states_item(const Params& p, int item, char* smem) {
  const int tid = get_tid(), lane = tid & 63, wave = tid >> 6, lr = lane & 15, lg = lane >> 4;
  const int h = item & 7, c = (item >> 3) & 31, b = item >> 8;
  const int g = h >> 2;
  float* sAcs = (float*)smem;
  float* sW = sAcs + 128;
  float* sTot = sW + 128;
  const size_t tok0 = (size_t)b * S_LEN + c * 128;
  __syncthreads();
  float dt = 0.f, cs = 0.f;
  if (tid < 128) {
    float raw = bf2f(p.PROJ[(tok0 + tid) * NIN + C_DT + h]) + p.dt_bias[h];
    dt = fmaxf(raw, 0.f) + log1pf(__expf(-fabsf(raw)));
    float a = -__expf(p.a_log[h]);
    cs = dt * a;
#pragma unroll
    for (int o = 1; o < 64; o <<= 1) { float t = __shfl_up(cs, o); if (lane >= o) cs += t; }
    if (lane == 63) sTot[wave] = cs;
  }
  __syncthreads();
  if (tid < 128) {
    if (wave == 1) cs += sTot[0];
    sAcs[tid] = cs;
  }
  __syncthreads();
  if (tid < 128) {
    float last = sAcs[127];
    sW[tid] = dt * __expf(last - cs);
    const size_t o = ((size_t)(b * 32 + c) * 8 + h) * 128 + tid;
    p.ACS[o] = cs; p.DTV[o] = dt;
    if (tid == 0) p.CHDEC[(b * 32 + c) * 8 + h] = __expf(last);
  }
  __syncthreads();
  f32x4 acc[4][2];
#pragma unroll
  for (int i = 0; i < 4; i++) { acc[i][0] = (f32x4){0.f, 0.f, 0.f, 0.f}; acc[i][1] = (f32x4){0.f, 0.f, 0.f, 0.f}; }
  const bf16_t* xt = p.XT + (size_t)(b * 8 + h) * 64 * S_LEN + c * 128;
  const bf16_t* bt = p.BT + (size_t)(b * 2 + g) * 128 * S_LEN + c * 128;
#pragma unroll
  for (int ks = 0; ks < 4; ks++) {
    const int l0 = 32 * ks + 8 * lg;
    float4 w0 = *(const float4*)(sW + l0), w1 = *(const float4*)(sW + l0 + 4);
    bf16x8 bf0 = *(const bf16x8*)(bt + (size_t)(32 * wave + lr) * S_LEN + l0);
    bf16x8 bf1 = *(const bf16x8*)(bt + (size_t)(32 * wave + 16 + lr) * S_LEN + l0);
#pragma unroll
    for (int pt = 0; pt < 4; pt++) {
      bf16x8 raw = *(const bf16x8*)(xt + (size_t)(16 * pt + lr) * S_LEN + l0);
      bf16x8 a;
      a[0] = (short)f2bf(bfs(raw[0]) * w0.x); a[1] = (short)f2bf(bfs(raw[1]) * w0.y); a[2] = (short)f2bf(bfs(raw[2]) * w0.z); a[3] = (short)f2bf(bfs(raw[3]) * w0.w);
      a[4] = (short)f2bf(bfs(raw[4]) * w1.x); a[5] = (short)f2bf(bfs(raw[5]) * w1.y); a[6] = (short)f2bf(bfs(raw[6]) * w1.z); a[7] = (short)f2bf(bfs(raw[7]) * w1.w);
      acc[pt][0] = mfma16(a, bf0, acc[pt][0]);
      acc[pt][1] = mfma16(a, bf1, acc[pt][1]);
    }
  }
  float* st = p.STATES + ((size_t)(b * 32 + c) * 8 + h) * 8192;
#pragma unroll
  for (int pt = 0; pt < 4; pt++)
#pragma unroll
    for (int x = 0; x < 2; x++)
#pragma unroll
      for (int i = 0; i < 4; i++) st[(16 * pt + 4 * lg + i) * 128 + 32 * wave + 16 * x + lr] = acc[pt][x][i];
}

__device__ void scan_units(const Params& p, int q) {
  const int b = q >> 16, r = q & 65535, h = r >> 13;
  float hs = 0.f;
  for (int c0 = 0; c0 < 32; c0 += 16) {
    float s[16], d[16];
#pragma unroll
    for (int i = 0; i < 16; i++) { s[i] = p.STATES[(size_t)(b * 32 + c0 + i) * 65536 + r]; d[i] = p.CHDEC[(b * 32 + c0 + i) * 8 + h]; }
#pragma unroll
    for (int i = 0; i < 16; i++) { p.STATES[(size_t)(b * 32 + c0 + i) * 65536 + r] = hs; hs = hs * d[i] + s[i]; }
  }
}

__device__ void ssd_y_item(const Params& p, int item, char* smem) {
  const int tid = get_tid(), lane = tid & 63, wave = tid >> 6, lr = lane & 15, lg = lane >> 4;
  const int h = item & 7, c = (item >> 3) & 31, b = item >> 8;
  const int g = h >> 2;
  bf16_t* sB = (bf16_t*)smem;
  bf16_t* sXT = sB + 128 * 136;
  float* sAcs = (float*)(smem + (128 + 64) * 136 * 2);
  float* sDt = sAcs + 128;
  const size_t tok0 = (size_t)b * S_LEN + c * 128;
  const bf16_t* xt = p.XT + (size_t)(b * 8 + h) * 64 * S_LEN + c * 128;
  const int LT[2] = {wave, 7 - wave};
  __syncthreads();
  {
    bf16x8 tb[8], tx[4];
#pragma unroll
    for (int i = 0; i < 8; i++) { int ch = tid + 256 * i; tb[i] = *(const bf16x8*)(p.BC + (tok0 + (ch >> 4)) * 512 + g * 128 + (ch & 15) * 8); }
#pragma unroll
    for (int i = 0; i < 4; i++) { int ch = tid + 256 * i; tx[i] = *(const bf16x8*)(xt + (size_t)(ch >> 4) * S_LEN + (ch & 15) * 8); }
    if (tid < 128) {
      const size_t o = ((size_t)(b * 32 + c) * 8 + h) * 128 + tid;
      sAcs[tid] = p.ACS[o]; sDt[tid] = p.DTV[o];
    }
#pragma unroll
    for (int i = 0; i < 8; i++) { int ch = tid + 256 * i; *(bf16x8*)(sB + (ch >> 4) * 136 + (ch & 15) * 8) = tb[i]; }
#pragma unroll
    for (int i = 0; i < 4; i++) { int ch = tid + 256 * i; *(bf16x8*)(sXT + (ch >> 4) * 136 + (ch & 15) * 8) = tx[i]; }
  }
  bf16x8 cf[2][4];
  bf16x4 zpre[2][4];
#pragma unroll
  for (int li = 0; li < 2; li++) {
#pragma unroll
    for (int ks = 0; ks < 4; ks++)
      cf[li][ks] = *(const bf16x8*)(p.BC + (tok0 + 16 * LT[li] + lr) * 512 + 256 + g * 128 + 32 * ks + 8 * lg);
#pragma unroll
    for (int pt = 0; pt < 4; pt++)
      zpre[li][pt] = *(const bf16x4*)(p.PROJ + (tok0 + 16 * LT[li] + lr) * NIN + C_Z + h * 64 + 16 * pt + 4 * lg);
  }
  f32x4 acc[4][2];
#pragma unroll
  for (int i = 0; i < 4; i++) { acc[i][0] = (f32x4){0.f, 0.f, 0.f, 0.f}; acc[i][1] = (f32x4){0.f, 0.f, 0.f, 0.f}; }
  const float* prev = p.STATES + ((size_t)(b * 32 + c) * 8 + h) * 8192;
#pragma unroll
  for (int pt = 0; pt < 4; pt++)
#pragma unroll
    for (int ks = 0; ks < 4; ks++) {
      const float* pp = prev + (16 * pt + lr) * 128 + 32 * ks + 8 * lg;
      float4 v0 = *(const float4*)pp, v1 = *(const float4*)(pp + 4);
      bf16x8 a = pack8(v0.x, v0.y, v0.z, v0.w, v1.x, v1.y, v1.z, v1.w);
      acc[pt][0] = mfma16(a, cf[0][ks], acc[pt][0]);
      acc[pt][1] = mfma16(a, cf[1][ks], acc[pt][1]);
    }
  __syncthreads();
#pragma unroll
  for (int li = 0; li < 2; li++) {
    float e = __expf(sAcs[16 * LT[li] + lr]);
#pragma unroll
    for (int pt = 0; pt < 4; pt++) { acc[pt][li][0] *= e; acc[pt][li][1] *= e; acc[pt][li][2] *= e; acc[pt][li][3] *= e; }
  }
#pragma unroll
  for (int li = 0; li < 2; li++) {
    const int lt = LT[li];
    const int lpos = 16 * lt + lr;
    const float acl = sAcs[lpos];
    for (int sp = 0; sp <= (lt >> 1); sp++) {
      f32x4 cb[2] = {(f32x4){0.f, 0.f, 0.f, 0.f}, (f32x4){0.f, 0.f, 0.f, 0.f}};
#pragma unroll
      for (int x = 0; x < 2; x++)
#pragma unroll
        for (int ks = 0; ks < 4; ks++) {
          bf16x8 bfr = *(const bf16x8*)(sB + (32 * sp + 16 * x + lr) * 136 + 32 * ks + 8 * lg);
          cb[x] = mfma16(bfr, cf[li][ks], cb[x]);
        }
      float mv[8];
#pragma unroll
      for (int x = 0; x < 2; x++)
#pragma unroll
        for (int i = 0; i < 4; i++) {
          const int s = 32 * sp + 16 * x + 4 * lg + i;
          mv[4 * x + i] = (s <= lpos) ? cb[x][i] * __expf(acl - sAcs[s]) * sDt[s] : 0.f;
        }
      bf16x8 mb = pack8(mv[0], mv[1], mv[2], mv[3], mv[4], mv[5], mv[6], mv[7]);
#pragma unroll
      for (int pt = 0; pt < 4; pt++) {
        const bf16_t* xp = sXT + (16 * pt + lr) * 136 + 32 * sp + 4 * lg;
        bf16x8 a = cat44(*(const bf16x4*)xp, *(const bf16x4*)(xp + 16));
        acc[pt][li] = mfma16(a, mb, acc[pt][li]);
      }
    }
  }
  const float dsk = p.d_skip[h];
#pragma unroll
  for (int li = 0; li < 2; li++) {
    const int lpos = 16 * LT[li] + lr;
    const size_t tok = tok0 + lpos;
    float ss = 0.f;
#pragma unroll
    for (int pt = 0; pt < 4; pt++) {
      const int pb = 16 * pt + 4 * lg;
      bf16x4 zv = zpre[li][pt];
      float y[4];
#pragma unroll
      for (int i = 0; i < 4; i++) {
        float xv = bf2f(sXT[(pb + i) * 136 + lpos]);
        y[i] = (acc[pt][li][i] + dsk * xv) * silu_f(bfs(zv[i]));
        ss += y[i] * y[i];
      }
      *(bf16x4*)(p.MIX + tok * 1536 + 512 + h * 64 + pb) = pack4(y[0], y[1], y[2], y[3]);
    }
    ss += __shfl_xor(ss, 16); ss += __shfl_xor(ss, 32);
    if (lg == 0) p.SS_SSD[tok * 8 + h] = ss;
  }
}

__device__ void final_rows(const Params& p, int gw, int nw) {
  const int lane = threadIdx.x & 63;
  for (int row = gw; row < T_TOK; row += nw) {
    float r = rsqrtf(p.SS_OUT[row] * (1.f / 1024.f) + 1e-6f);
    float4* o = (float4*)(p.out + (size_t)row * 1024);
    const float4* gf = (const float4*)p.g_final;
#pragma unroll
    for (int i = 0; i < 4; i++) {
      float4 v = o[lane + 64 * i], gg = gf[lane + 64 * i];
      v.x *= r * gg.x; v.y *= r * gg.y; v.z *= r * gg.z; v.w *= r * gg.w;
      o[lane + 64 * i] = v;
    }
  }
}

__device__ __forceinline__ void grid_bar(unsigned* bar, unsigned k) {
  asm volatile("s_waitcnt vmcnt(0)" ::: "memory");
  __syncthreads();
  if (threadIdx.x == 0) {
    const unsigned nb = gridDim.x, r = blockIdx.x & 7u;
    const unsigned nsub = (nb - r + 7u) >> 3;
    const unsigned ngrp = nb < 8u ? nb : 8u;
    __builtin_amdgcn_fence(__ATOMIC_RELEASE, "agent");
    asm volatile("s_waitcnt vmcnt(0)" ::: "memory");
    const unsigned old = __hip_atomic_fetch_add(bar + 64 * r, 1u, __ATOMIC_RELAXED, __HIP_MEMORY_SCOPE_AGENT);
    if (old + 1u == k * nsub) {
      __builtin_amdgcn_fence(__ATOMIC_ACQ_REL, "agent");
      asm volatile("s_waitcnt vmcnt(0)" ::: "memory");
      __hip_atomic_fetch_add(bar + 64 * 8, 1u, __ATOMIC_RELAXED, __HIP_MEMORY_SCOPE_AGENT);
    }
    while (__hip_atomic_load(bar + 64 * 8, __ATOMIC_RELAXED, __HIP_MEMORY_SCOPE_AGENT) < k * ngrp) __builtin_amdgcn_s_sleep(1);
    __builtin_amdgcn_fence(__ATOMIC_ACQUIRE, "agent");
    asm volatile("s_waitcnt vmcnt(0)" ::: "memory");
  }
  __syncthreads();
}

__device__ __forceinline__ int next_item(unsigned* ctr, char* smem) {
  int* sh = (int*)(smem + SMEM_BYTES - 16);
  __syncthreads();
  if (threadIdx.x == 0) *sh = (int)__hip_atomic_fetch_add(ctr, 1u, __ATOMIC_RELAXED, __HIP_MEMORY_SCOPE_AGENT);
  __syncthreads();
  return *sh;
}

__global__ void __launch_bounds__(256, 2) hymba_fwd(Params p) {
  cg::grid_group grid = cg::this_grid();
  __shared__ __attribute__((aligned(16))) char smem[SMEM_BYTES];
  const int nb = gridDim.x, bid = blockIdx.x;
  unsigned bk = 0;

  if (p.out == nullptr) grid.sync();
  for (int rep = 0; rep < REP0; rep++) {
  phase_prep(p);
  grid_bar(p.BAR, ++bk);
  }
  for (int rep = 0; rep < REP1; rep++) {
  if ((nb & 7) == 0) {
    const int xcd = bid & 7, li = bid >> 3, nbx = nb >> 3;
    for (int e = li; e < 1120; e += nbx) {
      const int grp = e / 280, r = e - grp * 280;
      gemm_tile<0>(p, xcd * 32 + grp * 8 + (r & 7), r >> 3, smem);
    }
  } else {
    for (int it = bid; it < 256 * 35; it += nb) gemm_tile<0>(p, it / 35, it % 35, smem);
  }
  for (int j = bid; j < 128; j += nb) gemm_tile<1>(p, j >> 3, j & 7, smem);
  grid_bar(p.BAR, ++bk);
  }
  for (int rep = 0; rep < REP2; rep++) {
  for (int it = next_item(p.BAR + 64 * (9 + rep), smem); it < 256 + 1024 + 2048; it = next_item(p.BAR + 64 * (9 + rep), smem)) {
    if (it < 256) compress_item(p, it, smem);
    else if (it < 1280) memattn_item(p, it - 256, smem);
    else conv_units(p, (it - 1280) * 256 + get_tid());
  }
  grid_bar(p.BAR, ++bk);
  }
  for (int rep = 0; rep < REP3; rep++) {
  {
    const int xq = bid & 7;
    unsigned* ctr = p.BAR + 64 * (16 + xq + 8 * rep);
    for (int li = next_item(ctr, smem); li < 512; li = next_item(ctr, smem)) {
      if (li < 256) nsa_item(p, ((li >> 1) << 4) | (xq + 8 * (li & 1)), smem);
      else ssd_states_item(p, (li - 256) * 8 + xq, smem);
    }
  }
  grid_bar(p.BAR, ++bk);
  }
  for (int it = bid; it < 2048; it += nb) scan_units(p, it * 256 + get_tid());
  grid_bar(p.BAR, ++bk);
  for (int rep = 0; rep < REP5; rep++) {
  for (int it = bid; it < 2048; it += nb) ssd_y_item(p, it, smem);
  grid_bar(p.BAR, ++bk);
  }
  if ((nb & 7) == 0) {
    const int xcd = bid & 7, li = bid >> 3, nbx = nb >> 3;
    for (int e = li; e < 256; e += nbx) gemm_tile<2>(p, xcd * 32 + (e >> 3), e & 7, smem);
  } else {
    for (int it = bid; it < 256 * 8; it += nb) gemm_tile<2>(p, it >> 3, it & 7, smem);
  }
  grid_bar(p.BAR, ++bk);
  final_rows(p, (bid * 256 + threadIdx.x) >> 6, (nb * 256) >> 6);
}

extern "C" void kernel_launch(void* const* d_in, const int* in_sizes, int n_in, void* d_out, int out_size, void* d_ws, size_t ws_size,
                              hipStream_t stream) {
  static int grid_blocks = 0;
  if (!grid_blocks) {
    int dev = 0, cus = 0, per_cu = 0;
    hipGetDevice(&dev);
    hipDeviceGetAttribute(&cus, hipDeviceAttributeMultiprocessorCount, dev);
    hipOccupancyMaxActiveBlocksPerMultiprocessor(&per_cu, hymba_fwd, 256, 0);
    if (per_cu < 1) per_cu = 1;
    if (per_cu > 4) per_cu = 4;
    grid_blocks = cus * per_cu;
  }
  Params p{};
  p.x = (const float*)d_in[0]; p.mem = (const float*)d_in[1]; p.pos = (const int*)d_in[2];
  p.g_in = (const float*)d_in[3]; p.w_in = (const float*)d_in[4]; p.cpk = (const float*)d_in[5];
  p.w1k = (const float*)d_in[6]; p.w2k = (const float*)d_in[7]; p.cpv = (const float*)d_in[8];
  p.w1v = (const float*)d_in[9]; p.w2v = (const float*)d_in[10]; p.conv_w = (const float*)d_in[11];
  p.conv_b = (const float*)d_in[12]; p.dt_bias = (const float*)d_in[13]; p.a_log = (const float*)d_in[14];
  p.d_skip = (const float*)d_in[15]; p.g_ssd = (const float*)d_in[16]; p.g_mem = (const float*)d_in[17];
  p.w_kv = (const float*)d_in[18]; p.w_out = (const float*)d_in[19]; p.g_final = (const float*)d_in[20];
  p.out = (float*)d_out;
  char* w = (char*)d_ws; size_t off = 0;
  auto take = [&](size_t bytes) { char* r = w + off; off += (bytes + 255) & ~(size_t)255; return r; };
  p.WinT = (bf16_t*)take((size_t)NINP * 1024 * 2);
  p.WoutT = (bf16_t*)take((size_t)1024 * 1536 * 2);
  p.WkvT = (bf16_t*)take((size_t)1024 * 1024 * 2);
  p.W1kT = (bf16_t*)take((size_t)256 * 2048 * 2);
  p.W1vT = (bf16_t*)take((size_t)256 * 2048 * 2);
  p.W2kT = (bf16_t*)take((size_t)64 * 256 * 2);
  p.W2vT = (bf16_t*)take((size_t)64 * 256 * 2);
  p.MEMB = (bf16_t*)take((size_t)2048 * 1024 * 2);
  p.PROJ = (bf16_t*)take((size_t)T_TOK * NIN * 2);
  p.VST = (bf16_t*)take((size_t)16 * 64 * S_LEN * 2);
  p.VWT = (bf16_t*)take((size_t)16 * 64 * S_LEN * 2);
  p.KMEM = (bf16_t*)take((size_t)2048 * 512 * 2);
  p.VMEMT = (bf16_t*)take((size_t)32 * 128 * 256 * 2);
  p.KCMP = (bf16_t*)take((size_t)16 * 256 * 64 * 2);
  p.VCMPT = (bf16_t*)take((size_t)16 * 64 * 256 * 2);
  p.XT = (bf16_t*)take((size_t)64 * 64 * S_LEN * 2);
  p.BC = (bf16_t*)take((size_t)T_TOK * 512 * 2);
  p.BT = (bf16_t*)take((size_t)16 * 128 * S_LEN * 2);
  p.MIX = (bf16_t*)take((size_t)T_TOK * 1536 * 2);
  p.XB = p.MIX;
  p.CHDEC = (float*)take((size_t)8 * 32 * 8 * 4);
  p.ACS = (float*)take((size_t)8 * 32 * 8 * 128 * 4);
  p.DTV = (float*)take((size_t)8 * 32 * 8 * 128 * 4);
  p.SS_SSD = (float*)take((size_t)T_TOK * 8 * 4);
  p.SS_OUT = (float*)take((size_t)T_TOK * 4);
  p.BAR = (unsigned*)take((size_t)(64 * 32 + 256) * 4);
  p.MTCNT = p.BAR + 64 * 32;
  p.STATES = (float*)d_out;
  p.KSC = (bf16_t*)((char*)d_out + (size_t)80 * 1024 * 1024);
  p.KWC = p.KSC + (size_t)16 * S_LEN * 64;
  if (off > ws_size) { fprintf(stderr, "workspace too small: need %zu have %zu\n", off, ws_size); return; }
  hipMemsetAsync(p.BAR, 0, (64 * 32 + 256) * 4, stream);
  void* args[] = {&p};
  hipError_t e = hipLaunchCooperativeKernel((void*)hymba_fwd, dim3(grid_blocks), dim3(256), args, 0, stream);
  if (e != hipSuccess) fprintf(stderr, "cooperative launch failed: %s (grid %d)\n", hipGetErrorString(e), grid_blocks);
}
```

```cpp
#include <hip/hip_runtime.h>
#include <hip/hip_cooperative_groups.h>
#include <stdint.h>
#include <stdio.h>
namespace cg = cooperative_groups;

typedef unsigned short bf16_t;
typedef __attribute__((ext_vector_type(8))) short bf16x8;
typedef __attribute__((ext_vector_type(4))) short bf16x4;
typedef __attribute__((ext_vector_type(4))) float f32x4;

#define S_LEN 4096
#define T_TOK 32768
#define NIN 4384
#define NINP 4480
#define LOG2E 1.4426950408889634f

#define C_Q 0
#define C_KC 512
#define C_VC 640
#define C_KS 768
#define C_KW 1024
#define C_GL 1280
#define C_GA 1304
#define C_Z 1816
#define C_XBC 2328
#define C_DT 3352
#define C_QX 3360
#define C_GX 3872

#define SMEM_BYTES 73728
#ifndef REP0
#define REP0 1
#endif
#ifndef REP1
#define REP1 1
#endif
#ifndef REP2
#define REP2 1
#endif
#ifndef REP3
#define REP3 1
#endif
#ifndef REP5
#define REP5 1
#endif

struct Params {
  const float *x, *mem; const int* pos;
  const float *g_in, *w_in, *cpk, *w1k, *w2k, *cpv, *w1v, *w2v, *conv_w, *conv_b, *dt_bias, *a_log, *d_skip, *g_ssd, *g_mem, *w_kv, *w_out, *g_final;
  float* out;
  bf16_t *WinT, *WoutT, *WkvT, *W1kT, *W1vT, *W2kT, *W2vT, *XB, *MEMB, *PROJ, *VST, *VWT, *KMEM, *VMEMT, *KCMP, *VCMPT, *XT, *BC, *BT, *MIX, *KSC, *KWC;
  float *STATES, *CHDEC, *ACS, *DTV, *SS_SSD, *SS_OUT;
  unsigned* BAR;
  unsigned* MTCNT;
};

__device__ __forceinline__ bf16_t f2bf(float f) { uint32_t u = __float_as_uint(f); u += 0x7fffu + ((u >> 16) & 1u); return (bf16_t)(u >> 16); }
__device__ __forceinline__ float bf2f(bf16_t h) { return __uint_as_float(((uint32_t)h) << 16); }
__device__ __forceinline__ float bfs(short h) { return __uint_as_float(((uint32_t)(unsigned short)h) << 16); }
__device__ __forceinline__ float fexp2(float x) { return __builtin_amdgcn_exp2f(x); }
__device__ __forceinline__ float silu_f(float x) { return x * __builtin_amdgcn_rcpf(1.f + __builtin_amdgcn_exp2f(-1.4426950408889634f * x)); }
__device__ __forceinline__ float sigmoid_f(float x) { return __builtin_amdgcn_rcpf(1.f + __builtin_amdgcn_exp2f(-1.4426950408889634f * x)); }
__device__ __forceinline__ f32x4 mfma16(bf16x8 a, bf16x8 b, f32x4 c) { return __builtin_amdgcn_mfma_f32_16x16x32_bf16(a, b, c, 0, 0, 0); }
typedef __bf16 hbf2_t __attribute__((ext_vector_type(2)));
typedef float f2_t __attribute__((ext_vector_type(2)));
typedef uint32_t u32x2 __attribute__((ext_vector_type(2)));
typedef uint32_t u32x4 __attribute__((ext_vector_type(4)));
__device__ __forceinline__ uint32_t pk2(float a, float b) {
  f2_t v; v[0] = a; v[1] = b;
  hbf2_t r = __builtin_convertvector(v, hbf2_t);
  return __builtin_bit_cast(uint32_t, r);
}
__device__ __forceinline__ bf16x4 pack4(float a, float b, float c, float d) {
  u32x2 r; r[0] = pk2(a, b); r[1] = pk2(c, d); return __builtin_bit_cast(bf16x4, r);
}
__device__ __forceinline__ bf16x8 pack8(float a, float b, float c, float d, float e, float f, float g, float h) {
  u32x4 r; r[0] = pk2(a, b); r[1] = pk2(c, d); r[2] = pk2(e, f); r[3] = pk2(g, h); return __builtin_bit_cast(bf16x8, r);
}
__device__ __forceinline__ bf16x8 cat44(bf16x4 a, bf16x4 b) {
  u32x2 x = __builtin_bit_cast(u32x2, a), y = __builtin_bit_cast(u32x2, b);
  u32x4 r; r[0] = x[0]; r[1] = x[1]; r[2] = y[0]; r[3] = y[1]; return __builtin_bit_cast(bf16x8, r);
}
template <int NR, typename L, typename ST, typename C>
__device__ __forceinline__ void tile_pipeline(int n, L load, ST store, C compute) {
  if (n <= 0) return;
  bf16x8 ra[NR], rb[NR];
  const int last = n - 1;
  load(0, ra);
  load(min(1, last), rb);
  store(0, ra);
  load(min(2, last), ra);
  __syncthreads();
  for (int i = 0; i < n; i += 2) {
    compute(i, 0);
    store(1, rb);
    load(min(i + 3, last), rb);
    __syncthreads();
    if (i + 1 < n) compute(i + 1, 1);
    store(0, ra);
    load(min(i + 4, last), ra);
    __syncthreads();
  }
}
template <int NR, typename L, typename ST, typename C>
__device__ __forceinline__ void tile_pipeline1(int n, L load, ST store, C compute) {
  if (n <= 0) return;
  bf16x8 ra[NR];
  load(0, ra);
  store(0, ra);
  if (n > 1) load(1, ra);
  __syncthreads();
  for (int i = 0; i < n; i++) {
    compute(i, i & 1);
    if (i + 1 < n) { store((i + 1) & 1, ra); if (i + 2 < n) load(i + 2, ra); }
    __syncthreads();
  }
}
__device__ __forceinline__ void rope_cs(int pos, int j, float& cs, float& sn) {
  float inv = fexp2(-(float)j * (18.931568569324174f / 8.f));
  float a = (float)pos * inv;
  float n = rintf(a * 0.15915494309189535f);
  float r = fmaf(-n, 6.28125f, a);
  r = fmaf(-n, 1.9353071795864769e-3f, r);
  cs = __cosf(r); sn = __sinf(r);
}

__device__ __forceinline__ float rowmax4(float x) {
  unsigned xi = __float_as_uint(x);
  auto a = __builtin_amdgcn_permlane16_swap(xi, xi, false, false);
  float m = fmaxf(__uint_as_float(a[0]), __uint_as_float(a[1]));
  unsigned mi = __float_as_uint(m);
  auto b = __builtin_amdgcn_permlane32_swap(mi, mi, false, false);
  return fmaxf(__uint_as_float(b[0]), __uint_as_float(b[1]));
}
__device__ __forceinline__ float rowsum4(float x) {
  unsigned xi = __float_as_uint(x);
  auto a = __builtin_amdgcn_permlane16_swap(xi, xi, false, false);
  float m = __uint_as_float(a[0]) + __uint_as_float(a[1]);
  unsigned mi = __float_as_uint(m);
  auto b = __builtin_amdgcn_permlane32_swap(mi, mi, false, false);
  return __uint_as_float(b[0]) + __uint_as_float(b[1]);
}
__device__ __forceinline__ int get_tid() { int t = threadIdx.x; asm volatile("" : "+v"(t)); return t; }

__device__ void prep_rows(const float* __restrict__ x, bf16_t* __restrict__ xb, int nrows, int gw, int nw) {
  const int lane = threadIdx.x & 63;
  int row = gw;
  for (; row + 3 * nw < nrows; row += 4 * nw) {
    float4 v[4][4]; float ss[4];
#pragma unroll
    for (int r = 0; r < 4; r++) {
      const float4* p = (const float4*)(x + (size_t)(row + r * nw) * 1024);
#pragma unroll
      for (int i = 0; i < 4; i++) v[r][i] = p[lane + 64 * i];
    }
#pragma unroll
    for (int r = 0; r < 4; r++) {
      float s = 0.f;
#pragma unroll
      for (int i = 0; i < 4; i++) s += v[r][i].x * v[r][i].x + v[r][i].y * v[r][i].y + v[r][i].z * v[r][i].z + v[r][i].w * v[r][i].w;
#pragma unroll
      for (int o = 32; o >= 1; o >>= 1) s += __shfl_xor(s, o);
      ss[r] = rsqrtf(s * (1.f / 1024.f) + 1e-6f);
    }
#pragma unroll
    for (int r = 0; r < 4; r++)
#pragma unroll
      for (int i = 0; i < 4; i++)
        *(bf16x4*)(xb + (size_t)(row + r * nw) * 1024 + (lane + 64 * i) * 4) =
            pack4(v[r][i].x * ss[r], v[r][i].y * ss[r], v[r][i].z * ss[r], v[r][i].w * ss[r]);
  }
  for (; row < nrows; row += nw) {
    const float4* p = (const float4*)(x + (size_t)row * 1024);
    float4 v[4]; float ss = 0.f;
#pragma unroll
    for (int i = 0; i < 4; i++) { v[i] = p[lane + 64 * i]; ss += v[i].x * v[i].x + v[i].y * v[i].y + v[i].z * v[i].z + v[i].w * v[i].w; }
#pragma unroll
    for (int o = 32; o >= 1; o >>= 1) ss += __shfl_xor(ss, o);
    float r = rsqrtf(ss * (1.f / 1024.f) + 1e-6f);
#pragma unroll
    for (int i = 0; i < 4; i++) {
      bf16x4 o = pack4(v[i].x * r, v[i].y * r, v[i].z * r, v[i].w * r);
      *(bf16x4*)(xb + (size_t)row * 1024 + (lane + 64 * i) * 4) = o;
    }
  }
}

__device__ void prep_wT(const float* __restrict__ w, const float* __restrict__ g, int gk0, int gk1, bf16_t* __restrict__ wt,
                        int K, int N, int Npad, int gtid, int gthreads) {
  const int ln = gtid & 63, gwv = gtid >> 6, nwv = gthreads >> 6;
  const int kblocks = K >> 6;
  const int total = (Npad >> 3) * kblocks;
  for (int uw = gwv; uw < total; uw += nwv) {
    const int kb = uw % kblocks, nbk = uw / kblocks;
    const int n = nbk * 8 + (ln >> 3), k8 = kb * 8 + (ln & 7);
    bf16x8 o;
#pragma unroll
    for (int j = 0; j < 8; j++) {
      int k = k8 * 8 + j; float v = 0.f;
      if (n < N) { v = w[(size_t)k * N + n]; if (g != nullptr && k >= gk0 && k < gk1) v *= g[k - gk0]; }
      o[j] = (short)f2bf(v);
    }
    *(bf16x8*)(wt + (size_t)n * K + k8 * 8) = o;
  }
}

__device__ void phase_prep(const Params& p) {
  const int gtid = blockIdx.x * 256 + threadIdx.x, gthreads = gridDim.x * 256;
  const int gw = gtid >> 6, nw = gthreads >> 6;
  prep_rows(p.x, p.XB, T_TOK, gw, nw);
  prep_rows(p.mem, p.MEMB, 2048, gw, nw);
  prep_wT(p.w_in, p.g_in, 0, 1024, p.WinT, 1024, NIN, NINP, gtid, gthreads);
  prep_wT(p.w_out, p.g_ssd, 512, 1024, p.WoutT, 1536, 1024, 1024, gtid, gthreads);
  prep_wT(p.w_kv, p.g_mem, 0, 1024, p.WkvT, 1024, 1024, 1024, gtid, gthreads);
  prep_wT(p.w1k, nullptr, 0, 0, p.W1kT, 2048, 256, 256, gtid, gthreads);
  prep_wT(p.w1v, nullptr, 0, 0, p.W1vT, 2048, 256, 256, gtid, gthreads);
  prep_wT(p.w2k, nullptr, 0, 0, p.W2kT, 256, 64, 64, gtid, gthreads);
  prep_wT(p.w2v, nullptr, 0, 0, p.W2vT, 256, 64, 64, gtid, gthreads);
  for (int i = gtid; i < T_TOK; i += gthreads) p.SS_OUT[i] = 0.f;
  for (int i = gtid; i < 16 * 64; i += gthreads) {
    int bg = i >> 6, d = i & 63;
    p.KCMP[((size_t)bg * 256 + 255) * 64 + d] = 0;
    p.VCMPT[((size_t)bg * 64 + d) * 256 + 255] = 0;
  }
}

template <int MODE>
__device__ void gemm_tile(const Params& p, int mt, int nt, char* smem) {
  const int tid = get_tid(), lane = tid & 63, wave = tid >> 6, lr = lane & 15, lg = lane >> 4;
  const int wr = wave >> 1, wc = wave & 1;
  const int m0 = mt * 128, n0 = nt * 128;
  const bf16_t* A; const bf16_t* Bt; int K;
  if (MODE == 0) { A = p.XB; Bt = p.WinT; K = 1024; }
  else if (MODE == 1) { A = p.MEMB; Bt = p.WkvT; K = 1024; }
  else { A = p.MIX; Bt = p.WoutT; K = 1536; }
  bf16_t* As = (bf16_t*)smem;
  bf16_t* Bs = As + 2 * 9216;
  const int lrow = tid >> 3, kc = tid & 7;
  const bf16_t* ga = A + (size_t)(m0 + lrow) * K + kc * 8;
  const bf16_t* gb = Bt + (size_t)(n0 + lrow) * K + kc * 8;
  float rs[4] = {1.f, 1.f, 1.f, 1.f};
  if (MODE == 2) {
#pragma unroll
    for (int i = 0; i < 4; i++) {
      const float4* sp = (const float4*)(p.SS_SSD + (size_t)(m0 + lrow + 32 * i) * 8);
      float4 a = sp[0], b = sp[1];
      rs[i] = rsqrtf((a.x + a.y + a.z + a.w + b.x + b.y + b.z + b.w) * (1.f / 512.f) + 1e-6f);
    }
  }
  bool swap;
  if (MODE == 0) swap = !(nt == 7 || nt == 9);
  else if (MODE == 1) swap = (nt < 4);
  else swap = true;
  const bf16_t* F = swap ? (Bs + (64 * wc) * 72) : (As + (64 * wr) * 72);
  const bf16_t* G = swap ? (As + (64 * wr) * 72) : (Bs + (64 * wc) * 72);
  f32x4 acc[4][4];
#pragma unroll
  for (int i = 0; i < 4; i++)
#pragma unroll
    for (int j = 0; j < 4; j++) acc[i][j] = (f32x4){0.f, 0.f, 0.f, 0.f};
  bf16x8 ra0[4], rb0[4], ra1[4], rb1[4];
  const int nk = K / 64;
  auto load = [&](int kt, bf16x8 (&ra)[4], bf16x8 (&rb)[4]) {
#pragma unroll
    for (int i = 0; i < 4; i++) {
      ra[i] = *(const bf16x8*)(ga + (size_t)(32 * i) * K + kt * 64);
      rb[i] = *(const bf16x8*)(gb + (size_t)(32 * i) * K + kt * 64);
    }
  };
  auto store = [&](int buf, int kt, bf16x8 (&ra)[4], bf16x8 (&rb)[4]) {
    if (MODE == 2) {
      if (kt >= 8 && kt < 16) {
#pragma unroll
        for (int i = 0; i < 4; i++) {
          bf16x8 v = ra[i];
          ra[i] = pack8(bfs(v[0]) * rs[i], bfs(v[1]) * rs[i], bfs(v[2]) * rs[i], bfs(v[3]) * rs[i],
                        bfs(v[4]) * rs[i], bfs(v[5]) * rs[i], bfs(v[6]) * rs[i], bfs(v[7]) * rs[i]);
        }
      }
    }
#pragma unroll
    for (int i = 0; i < 4; i++) {
      *(bf16x8*)(As + buf * 9216 + (lrow + 32 * i) * 72 + kc * 8) = ra[i];
      *(bf16x8*)(Bs + buf * 9216 + (lrow + 32 * i) * 72 + kc * 8) = rb[i];
    }
  };
  auto compute = [&](int buf) {
    const int cb = buf * 9216;
#pragma unroll
    for (int ks = 0; ks < 2; ks++) {
      bf16x8 ff[4], gg[4];
#pragma unroll
      for (int i = 0; i < 4; i++) {
        ff[i] = *(const bf16x8*)(F + cb + (16 * i + lr) * 72 + ks * 32 + lg * 8);
        gg[i] = *(const bf16x8*)(G + cb + (16 * i + lr) * 72 + ks * 32 + lg * 8);
      }
#pragma unroll
      for (int i = 0; i < 4; i++)
#pragma unroll
        for (int j = 0; j < 4; j++) acc[i][j] = mfma16(ff[i], gg[j], acc[i][j]);
    }
  };
  const int lastk = nk - 1;
  load(0, ra0, rb0);
  load(1, ra1, rb1);
  store(0, 0, ra0, rb0);
  load(2, ra0, rb0);
  __syncthreads();
  for (int kt = 0; kt < nk; kt += 2) {
    compute(0);
    store(1, kt + 1, ra1, rb1);
    load(min(kt + 3, lastk), ra1, rb1);
    __syncthreads();
    compute(1);
    store(0, min(kt + 2, lastk), ra0, rb0);
    load(min(kt + 4, lastk), ra0, rb0);
    __syncthreads();
  }
  if (swap) {
    if (MODE == 0) {
      const bool rope = (nt < 4) || nt == 6 || nt == 8;
#pragma unroll
      for (int mi = 0; mi < 4; mi++) {
        const int m = m0 + 64 * wr + 16 * mi + lr;
        if (rope) {
          const int pos = p.pos[m];
          f32x4 v = acc[0][mi];
          f32x4 o;
#pragma unroll
          for (int i = 0; i < 4; i++) {
            float pr = __shfl_xor(v[i], 32);
            float cs, sn; rope_cs(pos, 4 * (lg & 1) + i, cs, sn);
            o[i] = (lg < 2) ? (v[i] * cs - pr * sn) : (v[i] * cs + pr * sn);
          }
          acc[0][mi] = o;
        }
        {
          bf16_t* stg = (bf16_t*)smem + ((wave & 1) ? 2 * 9216 : 0) + (wave >> 1) * 4608;
#pragma unroll
          for (int ni = 0; ni < 4; ni++) {
            f32x4 v = acc[ni][mi];
            *(bf16x4*)(stg + (16 * mi + lr) * 72 + 16 * ni + 4 * lg) = pack4(v[0], v[1], v[2], v[3]);
          }
        }
      }
      {
        const bf16_t* stg = (const bf16_t*)smem + ((wave & 1) ? 2 * 9216 : 0) + (wave >> 1) * 4608;
        const int rr = lane >> 3, ch = lane & 7;
        const int nb0 = n0 + 64 * wc + ch * 8;
#pragma unroll
        for (int it = 0; it < 8; it++) {
          const int row = it * 8 + rr;
          const int m = m0 + 64 * wr + row;
          bf16x8 v = *(const bf16x8*)(stg + row * 72 + ch * 8);
          if (nt == 6 || nt == 8) {
            bf16_t* kd = ((nt == 6) ? p.KSC : p.KWC) + (((size_t)(m >> 12) * 2 + wc) * S_LEN + (m & 4095)) * 64;
            *(bf16x8*)(kd + ch * 8) = v;
          } else if (nb0 < NIN) {
            *(bf16x8*)(p.PROJ + (size_t)m * NIN + nb0) = v;
          }
        }
      }
      __syncthreads();
    } else if (MODE == 1) {
#pragma unroll
      for (int mi = 0; mi < 4; mi++) {
        const int m = m0 + 64 * wr + 16 * mi + lr;
#pragma unroll
        for (int ni = 0; ni < 4; ni++) {
          const int n = n0 + 64 * wc + 16 * ni + 4 * lg;
          f32x4 v = acc[ni][mi];
          *(bf16x4*)(p.KMEM + (size_t)m * 512 + n) = pack4(v[0], v[1], v[2], v[3]);
        }
      }
    } else {
#pragma unroll
      for (int mi = 0; mi < 4; mi++) {
        const int m = m0 + 64 * wr + 16 * mi + lr;
        float ss = 0.f;
#pragma unroll
        for (int ni = 0; ni < 4; ni++) {
          const int n = n0 + 64 * wc + 16 * ni + 4 * lg;
          float4 xv = *(const float4*)(p.x + (size_t)m * 1024 + n);
          f32x4 v = acc[ni][mi];
          float4 h; h.x = xv.x + v[0]; h.y = xv.y + v[1]; h.z = xv.z + v[2]; h.w = xv.w + v[3];
          ss += h.x * h.x + h.y * h.y + h.z * h.z + h.w * h.w;
          *(float4*)(p.out + (size_t)m * 1024 + n) = h;
        }
        ss += __shfl_xor(ss, 16); ss += __shfl_xor(ss, 32);
        if (lg == 0) atomicAdd(p.SS_OUT + m, ss);
      }
    }
  } else {
#pragma unroll
    for (int mi = 0; mi < 4; mi++)
#pragma unroll
      for (int ni = 0; ni < 4; ni++) {
        f32x4 v = acc[mi][ni];
        bf16x4 o = pack4(v[0], v[1], v[2], v[3]);
        if (MODE == 0) {
          const int b = m0 >> 12, s = (m0 & 4095) + 64 * wr + 16 * mi + 4 * lg;
          const int d = 16 * ni + lr;
          bf16_t* dst = (nt == 7) ? p.VST : p.VWT;
          *(bf16x4*)(dst + ((size_t)(b * 2 + wc) * 64 + d) * S_LEN + s) = o;
        } else {
          const int b = m0 >> 8, s = (m0 & 255) + 64 * wr + 16 * mi + 4 * lg;
          const int col = n0 - 512 + 64 * wc + 16 * ni + lr;
          const int h = col >> 7, d = col & 127;
          *(bf16x4*)(p.VMEMT + ((size_t)(b * 4 + h) * 128 + d) * 256 + s) = o;
        }
      }
  }
}

template <int DQK, int DV, int MASK, typename MaskF>
__device__ __forceinline__ void attn_tile(const bf16_t* sK, const bf16_t* sVt, const bf16x8 (&qf)[2][DQK / 32], f32x4 (&o)[DV / 16][2],
                                          float (&m)[2], float (&l)[2], float c, bool qsel0, bool qsel1, MaskF valid) {
  constexpr int KST = DQK + 8;
  const int lane = get_tid() & 63, lr = lane & 15, lg = lane >> 4;
  f32x4 s[4][2];
#pragma unroll
  for (int kt = 0; kt < 4; kt++) { s[kt][0] = (f32x4){0.f, 0.f, 0.f, 0.f}; s[kt][1] = (f32x4){0.f, 0.f, 0.f, 0.f}; }
#pragma unroll
  for (int ks = 0; ks < DQK / 32; ks++)
#pragma unroll
    for (int kt = 0; kt < 4; kt++) {
      bf16x8 a = *(const bf16x8*)(sK + (16 * kt + lr) * KST + ks * 32 + lg * 8);
      s[kt][0] = mfma16(a, qf[0][ks], s[kt][0]);
      s[kt][1] = mfma16(a, qf[1][ks], s[kt][1]);
    }
#pragma unroll
  for (int qt = 0; qt < 2; qt++) {
    const bool qs = qt ? qsel1 : qsel0;
    float mx = -1e30f;
    if (MASK) {
#pragma unroll
      for (int kt = 0; kt < 4; kt++)
#pragma unroll
        for (int i = 0; i < 4; i++) {
          bool v = valid(16 * kt + 4 * lg + i, qt);
          float sv = v ? s[kt][qt][i] * c : -1e30f;
          s[kt][qt][i] = sv; mx = fmaxf(mx, sv);
        }
    } else {
#pragma unroll
      for (int kt = 0; kt < 4; kt++) mx = fmaxf(fmaxf(mx, fmaxf(s[kt][qt][0], s[kt][qt][1])), fmaxf(s[kt][qt][2], s[kt][qt][3]));
      mx = qs ? mx * c : -1e30f;
    }
    mx = rowmax4(mx);
    const float mn = fmaxf(m[qt], mx);
    const float alpha = fexp2(m[qt] - mn);
    m[qt] = mn;
    float me;
    if (MASK) me = (mn > -1e29f) ? mn : 1e30f; else me = qs ? mn : 1e30f;
    float rs = 0.f;
#pragma unroll
    for (int kt = 0; kt < 4; kt++)
#pragma unroll
      for (int i = 0; i < 4; i++) {
        float pv = MASK ? fexp2(s[kt][qt][i] - me) : fexp2(fmaf(s[kt][qt][i], c, -me));
        s[kt][qt][i] = pv; rs += pv;
      }
    rs = rowsum4(rs);
    l[qt] = l[qt] * alpha + rs;
#pragma unroll
    for (int dt = 0; dt < DV / 16; dt++) {
      o[dt][qt][0] *= alpha; o[dt][qt][1] *= alpha; o[dt][qt][2] *= alpha; o[dt][qt][3] *= alpha;
    }
  }
#pragma unroll
  for (int k2 = 0; k2 < 2; k2++) {
    bf16x8 pb[2];
#pragma unroll
    for (int qt = 0; qt < 2; qt++)
      pb[qt] = pack8(s[2 * k2][qt][0], s[2 * k2][qt][1], s[2 * k2][qt][2], s[2 * k2][qt][3],
                     s[2 * k2 + 1][qt][0], s[2 * k2 + 1][qt][1], s[2 * k2 + 1][qt][2], s[2 * k2 + 1][qt][3]);
#pragma unroll
    for (int dt = 0; dt < DV / 16; dt++) {
      const bf16_t* vp = sVt + (16 * dt + lr) * 72 + 32 * k2 + 4 * lg;
      bf16x8 a = cat44(*(const bf16x4*)vp, *(const bf16x4*)(vp + 16));
      o[dt][0] = mfma16(a, pb[0], o[dt][0]);
      o[dt][1] = mfma16(a, pb[1], o[dt][1]);
    }
  }
}

__device__ __forceinline__ int next_bit_below(unsigned long long m, int below) {
  unsigned long long mm = (below >= 64) ? m : (m & ((1ull << below) - 1ull));
  return mm ? (63 - __clzll((long long)mm)) : -1;
}

__device__ void nsa_item(const Params& p, int item, char* smem) {
  const int tid = get_tid(), lane = tid & 63, wave = tid >> 6, lr = lane & 15, lg = lane >> 4;
  const int bg = item & 15, qb = 127 - (item >> 4);
  const int b = bg >> 1, g = bg & 1;
  const int t0 = qb * 32, cur = t0 >> 6;
  const int hq = g * 4 + wave;
  float* sImp = (float*)(smem + 55296);
  unsigned long long* sSel = (unsigned long long*)(smem + 63616);
  const float c = 0.125f * LOG2E;
  const size_t tokbase = (size_t)b * S_LEN + t0;
  const int r0 = tid >> 3, cc = tid & 7;

  bf16x8 qf[2][2];
#pragma unroll
  for (int qt = 0; qt < 2; qt++) {
    const bf16_t* row = p.PROJ + (tokbase + 16 * qt + lr) * NIN;
#pragma unroll
    for (int ks = 0; ks < 2; ks++) qf[qt][ks] = *(const bf16x8*)(row + C_Q + hq * 64 + 32 * ks + 8 * lg);
  }
  auto emit = [&](f32x4 (&o)[4][2], float (&l)[2], int br) {
#pragma unroll
    for (int qt = 0; qt < 2; qt++) {
      const size_t tok = tokbase + 16 * qt + lr;
      const float gsc = sigmoid_f(bf2f(p.PROJ[tok * NIN + C_GL + hq * 3 + br])) / fmaxf(l[qt], 1e-30f);
#pragma unroll
      for (int dt = 0; dt < 4; dt++) {
        const int dbase = hq * 64 + 16 * dt + 4 * lg;
        bf16_t* dst = p.MIX + tok * 1536 + dbase;
        f32x4 r = o[dt][qt];
        r[0] *= gsc; r[1] *= gsc; r[2] *= gsc; r[3] *= gsc;
        if (br > 0) { bf16x4 pv = *(const bf16x4*)dst; r[0] += bfs(pv[0]); r[1] += bfs(pv[1]); r[2] += bfs(pv[2]); r[3] += bfs(pv[3]); }
        if (br == 2) {
          bf16x4 ga = *(const bf16x4*)(p.PROJ + tok * NIN + C_GA + dbase);
          r[0] *= silu_f(bfs(ga[0])); r[1] *= silu_f(bfs(ga[1])); r[2] *= silu_f(bfs(ga[2])); r[3] *= silu_f(bfs(ga[3]));
        }
        *(bf16x4*)dst = pack4(r[0], r[1], r[2], r[3]);
      }
    }
  };
  auto store_kv = [&](int buf, bf16x8 (&rg)[4]) {
    bf16_t* sK = (bf16_t*)(smem + buf * 27648);
    bf16_t* sVt = sK + 64 * 72;
    *(bf16x8*)(sK + r0 * 72 + cc * 8) = rg[0];
    *(bf16x8*)(sK + (r0 + 32) * 72 + cc * 8) = rg[1];
    *(bf16x8*)(sVt + r0 * 72 + cc * 8) = rg[2];
    *(bf16x8*)(sVt + (r0 + 32) * 72 + cc * 8) = rg[3];
  };

  {
    const int ntiles = (t0 >> 10) + 1;
    const bf16_t* kb = p.KCMP + (size_t)bg * 256 * 64;
    const bf16_t* vb = p.VCMPT + (size_t)bg * 64 * 256;
    for (int pass = 0; pass < 2; pass++) {
      f32x4 o[4][2]; float m[2] = {-1e30f, -1e30f}, l[2] = {0.f, 0.f};
#pragma unroll
      for (int dt = 0; dt < 4; dt++) { o[dt][0] = (f32x4){0.f, 0.f, 0.f, 0.f}; o[dt][1] = (f32x4){0.f, 0.f, 0.f, 0.f}; }
      int ldn = 0;
      tile_pipeline<4>(ntiles,
        [&](int i, bf16x8 (&rg)[4]) {
          rg[0] = *(const bf16x8*)(kb + (size_t)(64 * i + r0) * 64 + cc * 8);
          rg[1] = *(const bf16x8*)(kb + (size_t)(64 * i + r0 + 32) * 64 + cc * 8);
          if (pass == 0) {
            rg[2] = *(const bf16x8*)(vb + (size_t)r0 * 256 + 64 * i + cc * 8);
            rg[3] = *(const bf16x8*)(vb + (size_t)(r0 + 32) * 256 + 64 * i + cc * 8);
          }
        },
        [&](int buf, bf16x8 (&rg)[4]) {
          const int nt = ldn++;
          if (pass == 1) {
#pragma unroll
            for (int i2 = 0; i2 < 2; i2++) {
              const int j = r0 + 32 * i2;
              bf16x8 ov;
#pragma unroll
              for (int x = 0; x < 8; x++) { int n = 64 * nt + cc * 8 + x; ov[x] = (n >= 4 * j - 1 && n <= 4 * j + 3) ? (short)0x3F80 : (short)0; }
              rg[2 + i2] = ov;
            }
          }
          store_kv(buf, rg);
        },
        [&](int i, int buf) {
          const bf16_t* sK = (const bf16_t*)(smem + buf * 27648);
          attn_tile<64, 64, 1>(sK, sK + 64 * 72, qf, o, m, l, c, true, true,
                               [&](int key, int qt) { return 16 * (64 * i + key) + 31 <= t0 + 16 * qt + lr; });
        });
      if (pass == 0) {
        emit(o, l, 0);
      } else {
        float inv[2];
#pragma unroll
        for (int qt = 0; qt < 2; qt++) inv[qt] = 1.f / fmaxf(l[qt], 1e-30f);
        for (int e2 = 0; e2 < 4; e2++) {
          if (wave == e2) {
#pragma unroll
            for (int dt = 0; dt < 4; dt++)
#pragma unroll
              for (int qt = 0; qt < 2; qt++)
#pragma unroll
                for (int i = 0; i < 4; i++) {
                  int j = 16 * dt + 4 * lg + i, q = 16 * qt + lr;
                  float v = o[dt][qt][i] * inv[qt];
                  if (e2 == 0) sImp[q * 65 + j] = v; else sImp[q * 65 + j] += v;
                }
          }
          __syncthreads();
        }
      }
    }
  }
  for (int qq = 0; qq < 8; qq++) {
    const int q = wave * 8 + qq;
    const int j = lane;
    float v = sImp[q * 65 + j];
    bool valid = j <= cur;
    bool forced = (j == 0) || (j == cur) || (j == cur - 1);
    float val = forced ? 1e9f : (valid ? v : -1e9f);
    int rank = 0;
#pragma unroll 16
    for (int jj = 0; jj < 64; jj++) {
      float ov = __int_as_float(__builtin_amdgcn_readlane(__float_as_int(val), jj));
      rank += ((ov > val) || (ov == val && jj < j)) ? 1 : 0;
    }
    unsigned long long mask = __ballot((rank < 16) && valid);
    if (lane == 0) sSel[q] = mask;
  }
  __syncthreads();
  unsigned long long any = 0ull;
  for (int q = 0; q < 32; q++) any |= sSel[q];
  unsigned long long mk[2];
  mk[0] = sSel[lr]; mk[1] = sSel[16 + lr];

  {
    f32x4 o[4][2]; float m[2] = {-1e30f, -1e30f}, l[2] = {0.f, 0.f};
#pragma unroll
    for (int dt = 0; dt < 4; dt++) { o[dt][0] = (f32x4){0.f, 0.f, 0.f, 0.f}; o[dt][1] = (f32x4){0.f, 0.f, 0.f, 0.f}; }
    const bf16_t* kb = p.KSC + (size_t)bg * S_LEN * 64;
    const bf16_t* vb = p.VST + (size_t)bg * 64 * S_LEN;
    const int ntiles = __popcll(any);
    int jl = 64, jc = 64;
    tile_pipeline<4>(ntiles,
      [&](int, bf16x8 (&rg)[4]) {
        jl = (jl > 0) ? next_bit_below(any, jl) : -1;
        const int jj = jl < 0 ? 0 : jl;
        rg[0] = *(const bf16x8*)(kb + (size_t)(64 * jj + r0) * 64 + cc * 8);
        rg[1] = *(const bf16x8*)(kb + (size_t)(64 * jj + r0 + 32) * 64 + cc * 8);
        rg[2] = *(const bf16x8*)(vb + (size_t)r0 * S_LEN + 64 * jj + cc * 8);
        rg[3] = *(const bf16x8*)(vb + (size_t)(r0 + 32) * S_LEN + 64 * jj + cc * 8);
      },
      store_kv,
      [&](int, int buf) {
        jc = next_bit_below(any, jc);
        const int j = jc;
        const bf16_t* sK = (const bf16_t*)(smem + buf * 27648);
        if (j == cur) {
          attn_tile<64, 64, 1>(sK, sK + 64 * 72, qf, o, m, l, c, true, true,
                               [&](int key, int qt) { return 64 * j + key <= t0 + 16 * qt + lr; });
        } else {
          attn_tile<64, 64, 0>(sK, sK + 64 * 72, qf, o, m, l, c, ((mk[0] >> j) & 1ull) != 0ull, ((mk[1] >> j) & 1ull) != 0ull,
                               [&](int, int) { return true; });
        }
      });
    emit(o, l, 1);
  }
  {
    f32x4 o[4][2]; float m[2] = {-1e30f, -1e30f}, l[2] = {0.f, 0.f};
#pragma unroll
    for (int dt = 0; dt < 4; dt++) { o[dt][0] = (f32x4){0.f, 0.f, 0.f, 0.f}; o[dt][1] = (f32x4){0.f, 0.f, 0.f, 0.f}; }
    const int jlo = (cur - 8 > 0) ? (cur - 8) : 0;
    const bf16_t* kb = p.KWC + (size_t)bg * S_LEN * 64;
    const bf16_t* vb = p.VWT + (size_t)bg * 64 * S_LEN;
    tile_pipeline<4>(cur - jlo + 1,
      [&](int i, bf16x8 (&rg)[4]) {
        const int j = cur - i;
        rg[0] = *(const bf16x8*)(kb + (size_t)(64 * j + r0) * 64 + cc * 8);
        rg[1] = *(const bf16x8*)(kb + (size_t)(64 * j + r0 + 32) * 64 + cc * 8);
        rg[2] = *(const bf16x8*)(vb + (size_t)r0 * S_LEN + 64 * j + cc * 8);
        rg[3] = *(const bf16x8*)(vb + (size_t)(r0 + 32) * S_LEN + 64 * j + cc * 8);
      },
      store_kv,
      [&](int i, int buf) {
        const int j = cur - i;
        const bf16_t* sK = (const bf16_t*)(smem + buf * 27648);
        if (j == cur || j == cur - 8) {
          attn_tile<64, 64, 1>(sK, sK + 64 * 72, qf, o, m, l, c, true, true, [&](int key, int qt) {
            int tq = t0 + 16 * qt + lr, kp = 64 * j + key;
            return (kp <= tq) && (kp > tq - 512);
          });
        } else {
          attn_tile<64, 64, 0>(sK, sK + 64 * 72, qf, o, m, l, c, true, true, [&](int, int) { return true; });
        }
      });
    emit(o, l, 2);
  }
}

__device__ void memattn_item(const Params& p, int item, char* smem) {
  const int tid = get_tid(), lane = tid & 63, wave = tid >> 6, lr = lane & 15, lg = lane >> 4;
  const int b = item >> 7, h = (item >> 5) & 3, qb = item & 31;
  const int t0 = qb * 128 + wave * 32;
  const size_t tokbase = (size_t)b * S_LEN + t0;
  bf16x8 qf[2][4];
#pragma unroll
  for (int qt = 0; qt < 2; qt++)
#pragma unroll
    for (int ks = 0; ks < 4; ks++) qf[qt][ks] = *(const bf16x8*)(p.PROJ + (tokbase + 16 * qt + lr) * NIN + C_QX + h * 128 + 32 * ks + 8 * lg);
  f32x4 o[8][2]; float m[2] = {-1e30f, -1e30f}, l[2] = {0.f, 0.f};
#pragma unroll
  for (int dt = 0; dt < 8; dt++) { o[dt][0] = (f32x4){0.f, 0.f, 0.f, 0.f}; o[dt][1] = (f32x4){0.f, 0.f, 0.f, 0.f}; }
  const float c = 0.08838834764831845f * LOG2E;
  const bf16_t* kb = p.KMEM + (size_t)b * 256 * 512 + h * 128;
  const bf16_t* vb = p.VMEMT + (size_t)(b * 4 + h) * 128 * 256;
  tile_pipeline1<8>(4,
    [&](int kt, bf16x8 (&rg)[8]) {
#pragma unroll
      for (int i = 0; i < 4; i++) {
        int ch = tid + 256 * i;
        rg[i] = *(const bf16x8*)(kb + (size_t)(64 * kt + (ch >> 4)) * 512 + (ch & 15) * 8);
        rg[4 + i] = *(const bf16x8*)(vb + (size_t)(ch >> 3) * 256 + 64 * kt + (ch & 7) * 8);
      }
    },
    [&](int buf, bf16x8 (&rg)[8]) {
      bf16_t* sK = (bf16_t*)(smem + buf * 35840);
      bf16_t* sVt = sK + 64 * 136;
#pragma unroll
      for (int i = 0; i < 4; i++) {
        int ch = tid + 256 * i;
        *(bf16x8*)(sK + (ch >> 4) * 136 + (ch & 15) * 8) = rg[i];
        *(bf16x8*)(sVt + (ch >> 3) * 72 + (ch & 7) * 8) = rg[4 + i];
      }
    },
    [&](int, int buf) {
      const bf16_t* sK = (const bf16_t*)(smem + buf * 35840);
      attn_tile<128, 128, 0>(sK, sK + 64 * 136, qf, o, m, l, c, true, true, [&](int, int) { return true; });
    });
#pragma unroll
  for (int qt = 0; qt < 2; qt++) {
    const size_t tok = tokbase + 16 * qt + lr;
    const float inv = 1.f / fmaxf(l[qt], 1e-30f);
#pragma unroll
    for (int dt = 0; dt < 8; dt++) {
      const int dbase = h * 128 + 16 * dt + 4 * lg;
      bf16x4 ga = *(const bf16x4*)(p.PROJ + tok * NIN + C_GX + dbase);
      f32x4 r = o[dt][qt];
      *(bf16x4*)(p.MIX + tok * 1536 + 1024 + dbase) =
          pack4(r[0] * inv * silu_f(bfs(ga[0])), r[1] * inv * silu_f(bfs(ga[1])), r[2] * inv * silu_f(bfs(ga[2])), r[3] * inv * silu_f(bfs(ga[3])));
    }
  }
}

__device__ void compress_item(const Params& p, int item, char* smem) {
  const int tid = get_tid(), lane = tid & 63, wave = tid >> 6, lr = lane & 15, lg = lane >> 4;
  const int which = item >> 7, rho0 = (item & 127) * 32;
  const bf16_t* W1T = which ? p.W1vT : p.W1kT;
  const bf16_t* W2T = which ? p.W2vT : p.W2kT;
  const float* pe = which ? p.cpv : p.cpk;
  const int col0 = which ? C_VC : C_KC;
  bf16_t* sA = (bf16_t*)smem;
  bf16_t* sW = sA + 32 * 72;
  bf16_t* sH = sW + 256 * 72;
  const int arow = tid >> 3, akc = tid & 7;
  const bf16_t* abase;
  {
    int rho = rho0 + arow; if (rho > 4079) rho = 4079;
    int b = rho / 510, rem = rho - b * 510, n = rem >> 1, g = rem & 1;
    abase = p.PROJ + ((size_t)b * S_LEN + 16 * n) * NIN + col0 + g * 64 + akc * 8;
  }
  const bf16_t* wbase = W1T + (size_t)arow * 2048 + akc * 8;
  f32x4 acc[2][4];
#pragma unroll
  for (int i = 0; i < 2; i++)
#pragma unroll
    for (int j = 0; j < 4; j++) acc[i][j] = (f32x4){0.f, 0.f, 0.f, 0.f};
  bf16x8 ra, rw[8];
  float4 rp0, rp1;
  auto load = [&](int kt) {
    ra = *(const bf16x8*)(abase + (size_t)kt * NIN);
    rp0 = *(const float4*)(pe + kt * 64 + akc * 8); rp1 = *(const float4*)(pe + kt * 64 + akc * 8 + 4);
#pragma unroll
    for (int i = 0; i < 8; i++) rw[i] = *(const bf16x8*)(wbase + (size_t)(32 * i) * 2048 + kt * 64);
  };
  load(0);
  for (int kt = 0; kt < 32; kt++) {
    __syncthreads();
    *(bf16x8*)(sA + arow * 72 + akc * 8) =
        pack8(bfs(ra[0]) + rp0.x, bfs(ra[1]) + rp0.y, bfs(ra[2]) + rp0.z, bfs(ra[3]) + rp0.w,
              bfs(ra[4]) + rp1.x, bfs(ra[5]) + rp1.y, bfs(ra[6]) + rp1.z, bfs(ra[7]) + rp1.w);
#pragma unroll
    for (int i = 0; i < 8; i++) *(bf16x8*)(sW + (arow + 32 * i) * 72 + akc * 8) = rw[i];
    __syncthreads();
    load(kt < 31 ? kt + 1 : 31);
#pragma unroll
    for (int ks = 0; ks < 2; ks++) {
      bf16x8 a0 = *(const bf16x8*)(sA + lr * 72 + ks * 32 + 8 * lg);
      bf16x8 a1 = *(const bf16x8*)(sA + (16 + lr) * 72 + ks * 32 + 8 * lg);
#pragma unroll
      for (int ct = 0; ct < 4; ct++) {
        bf16x8 bf = *(const bf16x8*)(sW + (64 * wave + 16 * ct + lr) * 72 + ks * 32 + 8 * lg);
        acc[0][ct] = mfma16(a0, bf, acc[0][ct]);
        acc[1][ct] = mfma16(a1, bf, acc[1][ct]);
      }
    }
  }
  __syncthreads();
#pragma unroll
  for (int rt = 0; rt < 2; rt++)
#pragma unroll
    for (int ct = 0; ct < 4; ct++)
#pragma unroll
      for (int i = 0; i < 4; i++) sH[(16 * rt + 4 * lg + i) * 264 + 64 * wave + 16 * ct + lr] = f2bf(silu_f(acc[rt][ct][i]));
  __syncthreads();
  f32x4 acc2[2] = {(f32x4){0.f, 0.f, 0.f, 0.f}, (f32x4){0.f, 0.f, 0.f, 0.f}};
#pragma unroll
  for (int ks = 0; ks < 8; ks++) {
    bf16x8 bf = *(const bf16x8*)(W2T + (size_t)(16 * wave + lr) * 256 + 32 * ks + 8 * lg);
#pragma unroll
    for (int rt = 0; rt < 2; rt++) {
      bf16x8 a = *(const bf16x8*)(sH + (16 * rt + lr) * 264 + 32 * ks + 8 * lg);
      acc2[rt] = mfma16(a, bf, acc2[rt]);
    }
  }
  const int col = 16 * wave + lr;
#pragma unroll
  for (int rt = 0; rt < 2; rt++)
#pragma unroll
    for (int i = 0; i < 4; i++) {
      int rho = rho0 + 16 * rt + 4 * lg + i;
      bool ok = rho < 4080;
      int rc = ok ? rho : 4079;
      int b = rc / 510, rem = rc - b * 510, n = rem >> 1, g = rem & 1;
      float v = acc2[rt][i];
      float pr = __shfl_xor(v, 8);
      if (which == 0) {
        if (wave == 0) {
          int pos = p.pos[b * S_LEN + 16 * n + 31];
          float cs, sn; rope_cs(pos, lr & 7, cs, sn);
          v = (lr < 8) ? (v * cs - pr * sn) : (v * cs + pr * sn);
        }
        if (ok) p.KCMP[((size_t)(b * 2 + g) * 256 + n) * 64 + col] = f2bf(v);
      } else {
        if (ok) p.VCMPT[((size_t)(b * 2 + g) * 64 + col) * 256 + n] = f2bf(v);
      }
    }
}

__device__ void conv_units(const Params& p, int u) {
  const int it = u >> 8, wvi = (u >> 6) & 3, ln = u & 63;
  const int cgp = ((it & 3) * 4 + wvi) * 8 + (ln >> 3), tg = (it >> 2) * 8 + (ln & 7);
  const int tok0 = tg * 8, s0 = tok0 & 4095, ch0 = cgp * 8;
  const int b = tok0 >> 12;
  bf16x8 in[11];
#pragma unroll
  for (int r = 0; r < 11; r++) {
    int s = s0 - 3 + r;
    if (s >= 0) in[r] = *(const bf16x8*)(p.PROJ + (size_t)(tok0 - 3 + r) * NIN + C_XBC + ch0);
    else in[r] = (bf16x8){0, 0, 0, 0, 0, 0, 0, 0};
  }
  float4 wv[4][2];
#pragma unroll
  for (int k = 0; k < 4; k++) { wv[k][0] = *(const float4*)(p.conv_w + k * 1024 + ch0); wv[k][1] = *(const float4*)(p.conv_w + k * 1024 + ch0 + 4); }
  float4 bv0 = *(const float4*)(p.conv_b + ch0), bv1 = *(const float4*)(p.conv_b + ch0 + 4);
  float w[4][8], bias[8];
#pragma unroll
  for (int k = 0; k < 4; k++) { w[k][0] = wv[k][0].x; w[k][1] = wv[k][0].y; w[k][2] = wv[k][0].z; w[k][3] = wv[k][0].w; w[k][4] = wv[k][1].x; w[k][5] = wv[k][1].y; w[k][6] = wv[k][1].z; w[k][7] = wv[k][1].w; }
  bias[0] = bv0.x; bias[1] = bv0.y; bias[2] = bv0.z; bias[3] = bv0.w; bias[4] = bv1.x; bias[5] = bv1.y; bias[6] = bv1.z; bias[7] = bv1.w;
  if (ch0 >= 512) {
#pragma unroll
    for (int tt = 0; tt < 8; tt++) {
      bf16x8 o;
#pragma unroll
      for (int j = 0; j < 8; j++) {
        float a = bias[j];
#pragma unroll
        for (int k = 0; k < 4; k++) a += bfs(in[tt + k][j]) * w[k][j];
        o[j] = (short)f2bf(silu_f(a));
      }
      *(bf16x8*)(p.BC + (size_t)(tok0 + tt) * 512 + (ch0 - 512)) = o;
    }
  }
  if (ch0 < 768) {
#pragma unroll
    for (int j = 0; j < 8; j++) {
      bf16x8 o;
#pragma unroll
      for (int tt = 0; tt < 8; tt++) {
        float a = bias[j];
#pragma unroll
        for (int k = 0; k < 4; k++) a += bfs(in[tt + k][j]) * w[k][j];
        o[tt] = (short)f2bf(silu_f(a));
      }
      const int ch = ch0 + j;
      bf16_t* dst;
      if (ch0 < 512) dst = p.XT + ((size_t)(b * 8 + (ch >> 6)) * 64 + (ch & 63)) * S_LEN + s0;
      else dst = p.BT + ((size_t)(b * 2 + ((ch - 512) >> 7)) * 128 + ((ch - 512) & 127)) * S_LEN + s0;
      *(bf16x8*)dst = o;
    }
  }
}

__device__ void ssd_states_item(const Params& p, int item, char* smem) {
  const int tid = get_tid(), lane = tid & 63, wave = tid >> 6, lr = lane & 15, lg = lane >> 4;
  const int h = item & 7, c = (item >> 3) & 31, b = item >> 8;
  const int g = h >> 2;
  float* sAcs = (float*)smem;
  float* sW = sAcs + 128;
  float* sTot = sW + 128;
  const size_t tok0 = (size_t)b * S_LEN + c * 128;
  __syncthreads();
  float dt = 0.f, cs = 0.f;
  if (tid < 128) {
    float raw = bf2f(p.PROJ[(tok0 + tid) * NIN + C_DT + h]) + p.dt_bias[h];
    dt = fmaxf(raw, 0.f) + log1pf(__expf(-fabsf(raw)));
    float a = -__expf(p.a_log[h]);
    cs = dt * a;
#pragma unroll
    for (int o = 1; o < 64; o <<= 1) { float t = __shfl_up(cs, o); if (lane >= o) cs += t; }
    if (lane == 63) sTot[wave] = cs;
  }
  __syncthreads();
  if (tid < 128) {
    if (wave == 1) cs += sTot[0];
    sAcs[tid] = cs;
  }
  __syncthreads();
  if (tid < 128) {
    float last = sAcs[127];
    sW[tid] = dt * __expf(last - cs);
    const size_t o = ((size_t)(b * 32 + c) * 8 + h) * 128 + tid;
    p.ACS[o] = cs; p.DTV[o] = dt;
    if (tid == 0) p.CHDEC[(b * 32 + c) * 8 + h] = __expf(last);
  }
  __syncthreads();
  f32x4 acc[4][2];
#pragma unroll
  for (int i = 0; i < 4; i++) { acc[i][0] = (f32x4){0.f, 0.f, 0.f, 0.f}; acc[i][1] = (f32x4){0.f, 0.f, 0.f, 0.f}; }
  const bf16_t* xt = p.XT + (size_t)(b * 8 + h) * 64 * S_LEN + c * 128;
  const bf16_t* bt = p.BT + (size_t)(b * 2 + g) * 128 * S_LEN + c * 128;
#pragma unroll
  for (int ks = 0; ks < 4; ks++) {
    const int l0 = 32 * ks + 8 * lg;
    float4 w0 = *(const float4*)(sW + l0), w1 = *(const float4*)(sW + l0 + 4);
    bf16x8 bf0 = *(const bf16x8*)(bt + (size_t)(32 * wave + lr) * S_LEN + l0);
    bf16x8 bf1 = *(const bf16x8*)(bt + (size_t)(32 * wave + 16 + lr) * S_LEN + l0);
#pragma unroll
    for (int pt = 0; pt < 4; pt++) {
      bf16x8 raw = *(const bf16x8*)(xt + (size_t)(16 * pt + lr) * S_LEN + l0);
      bf16x8 a;
      a[0] = (short)f2bf(bfs(raw[0]) * w0.x); a[1] = (short)f2bf(bfs(raw[1]) * w0.y); a[2] = (short)f2bf(bfs(raw[2]) * w0.z); a[3] = (short)f2bf(bfs(raw[3]) * w0.w);
      a[4] = (short)f2bf(bfs(raw[4]) * w1.x); a[5] = (short)f2bf(bfs(raw[5]) * w1.y); a[6] = (short)f2bf(bfs(raw[6]) * w1.z); a[7] = (short)f2bf(bfs(raw[7]) * w1.w);
      acc[pt][0] = mfma16(a, bf0, acc[pt][0]);
      acc[pt][1] = mfma16(a, bf1, acc[pt][1]);
    }
  }
  float* st = p.STATES + ((size_t)(b * 32 + c) * 8 + h) * 8192;
#pragma unroll
  for (int pt = 0; pt < 4; pt++)
#pragma unroll
    for (int x = 0; x < 2; x++)
#pragma unroll
      for (int i = 0; i < 4; i++) st[(16 * pt + 4 * lg + i) * 128 + 32 * wave + 16 * x + lr] = acc[pt][x][i];
}

__device__ void scan_units(const Params& p, int q) {
  const int b = q >> 16, r = q & 65535, h = r >> 13;
  float hs = 0.f;
  for (int c0 = 0; c0 < 32; c0 += 16) {
    float s[16], d[16];
#pragma unroll
    for (int i = 0; i < 16; i++) { s[i] = p.STATES[(size_t)(b * 32 + c0 + i) * 65536 + r]; d[i] = p.CHDEC[(b * 32 + c0 + i) * 8 + h]; }
#pragma unroll
    for (int i = 0; i < 16; i++) { p.STATES[(size_t)(b * 32 + c0 + i) * 65536 + r] = hs; hs = hs * d[i] + s[i]; }
  }
}

__device__ void ssd_y_item(const Params& p, int item, char* smem) {
  const int tid = get_tid(), lane = tid & 63, wave = tid >> 6, lr = lane & 15, lg = lane >> 4;
  const int h = item & 7, c = (item >> 3) & 31, b = item >> 8;
  const int g = h >> 2;
  bf16_t* sB = (bf16_t*)smem;
  bf16_t* sXT = sB + 128 * 136;
  float* sAcs = (float*)(smem + (128 + 64) * 136 * 2);
  float* sDt = sAcs + 128;
  const size_t tok0 = (size_t)b * S_LEN + c * 128;
  const bf16_t* xt = p.XT + (size_t)(b * 8 + h) * 64 * S_LEN + c * 128;
  const int LT[2] = {wave, 7 - wave};
  __syncthreads();
  {
    bf16x8 tb[8], tx[4];
#pragma unroll
    for (int i = 0; i < 8; i++) { int ch = tid + 256 * i; tb[i] = *(const bf16x8*)(p.BC + (tok0 + (ch >> 4)) * 512 + g * 128 + (ch & 15) * 8); }
#pragma unroll
    for (int i = 0; i < 4; i++) { int ch = tid + 256 * i; tx[i] = *(const bf16x8*)(xt + (size_t)(ch >> 4) * S_LEN + (ch & 15) * 8); }
    if (tid < 128) {
      const size_t o = ((size_t)(b * 32 + c) * 8 + h) * 128 + tid;
      sAcs[tid] = p.ACS[o]; sDt[tid] = p.DTV[o];
    }
#pragma unroll
    for (int i = 0; i < 8; i++) { int ch = tid + 256 * i; *(bf16x8*)(sB + (ch >> 4) * 136 + (ch & 15) * 8) = tb[i]; }
#pragma unroll
    for (int i = 0; i < 4; i++) { int ch = tid + 256 * i; *(bf16x8*)(sXT + (ch >> 4) * 136 + (ch & 15) * 8) = tx[i]; }
  }
  bf16x8 cf[2][4];
  bf16x4 zpre[2][4];
#pragma unroll
  for (int li = 0; li < 2; li++) {
#pragma unroll
    for (int ks = 0; ks < 4; ks++)
      cf[li][ks] = *(const bf16x8*)(p.BC + (tok0 + 16 * LT[li] + lr) * 512 + 256 + g * 128 + 32 * ks + 8 * lg);
#pragma unroll
    for (int pt = 0; pt < 4; pt++)
      zpre[li][pt] = *(const bf16x4*)(p.PROJ + (tok0 + 16 * LT[li] + lr) * NIN + C_Z + h * 64 + 16 * pt + 4 * lg);
  }
  f32x4 acc[4][2];
#pragma unroll
  for (int i = 0; i < 4; i++) { acc[i][0] = (f32x4){0.f, 0.f, 0.f, 0.f}; acc[i][1] = (f32x4){0.f, 0.f, 0.f, 0.f}; }
  const float* prev = p.STATES + ((size_t)(b * 32 + c) * 8 + h) * 8192;
#pragma unroll
  for (int pt = 0; pt < 4; pt++)
#pragma unroll
    for (int ks = 0; ks < 4; ks++) {
      const float* pp = prev + (16 * pt + lr) * 128 + 32 * ks + 8 * lg;
      float4 v0 = *(const float4*)pp, v1 = *(const float4*)(pp + 4);
      bf16x8 a = pack8(v0.x, v0.y, v0.z, v0.w, v1.x, v1.y, v1.z, v1.w);
      acc[pt][0] = mfma16(a, cf[0][ks], acc[pt][0]);
      acc[pt][1] = mfma16(a, cf[1][ks], acc[pt][1]);
    }
  __syncthreads();
#pragma unroll
  for (int li = 0; li < 2; li++) {
    float e = __expf(sAcs[16 * LT[li] + lr]);
#pragma unroll
    for (int pt = 0; pt < 4; pt++) { acc[pt][li][0] *= e; acc[pt][li][1] *= e; acc[pt][li][2] *= e; acc[pt][li][3] *= e; }
  }
#pragma unroll
  for (int li = 0; li < 2; li++) {
    const int lt = LT[li];
    const int lpos = 16 * lt + lr;
    const float acl = sAcs[lpos];
    for (int sp = 0; sp <= (lt >> 1); sp++) {
      f32x4 cb[2] = {(f32x4){0.f, 0.f, 0.f, 0.f}, (f32x4){0.f, 0.f, 0.f, 0.f}};
#pragma unroll
      for (int x = 0; x < 2; x++)
#pragma unroll
        for (int ks = 0; ks < 4; ks++) {
          bf16x8 bfr = *(const bf16x8*)(sB + (32 * sp + 16 * x + lr) * 136 + 32 * ks + 8 * lg);
          cb[x] = mfma16(bfr, cf[li][ks], cb[x]);
        }
      float mv[8];
#pragma unroll
      for (int x = 0; x < 2; x++)
#pragma unroll
        for (int i = 0; i < 4; i++) {
          const int s = 32 * sp + 16 * x + 4 * lg + i;
          mv[4 * x + i] = (s <= lpos) ? cb[x][i] * __expf(acl - sAcs[s]) * sDt[s] : 0.f;
        }
      bf16x8 mb = pack8(mv[0], mv[1], mv[2], mv[3], mv[4], mv[5], mv[6], mv[7]);
#pragma unroll
      for (int pt = 0; pt < 4; pt++) {
        const bf16_t* xp = sXT + (16 * pt + lr) * 136 + 32 * sp + 4 * lg;
        bf16x8 a = cat44(*(const bf16x4*)xp, *(const bf16x4*)(xp + 16));
        acc[pt][li] = mfma16(a, mb, acc[pt][li]);
      }
    }
  }
  const float dsk = p.d_skip[h];
#pragma unroll
  for (int li = 0; li < 2; li++) {
    const int lpos = 16 * LT[li] + lr;
    const size_t tok = tok0 + lpos;
    float ss = 0.f;
#pragma unroll
    for (int pt = 0; pt < 4; pt++) {
      const int pb = 16 * pt + 4 * lg;
      bf16x4 zv = zpre[li][pt];
      float y[4];
#pragma unroll
      for (int i = 0; i < 4; i++) {
        float xv = bf2f(sXT[(pb + i) * 136 + lpos]);
        y[i] = (acc[pt][li][i] + dsk * xv) * silu_f(bfs(zv[i]));
        ss += y[i] * y[i];
      }
      *(bf16x4*)(p.MIX + tok * 1536 + 512 + h * 64 + pb) = pack4(y[0], y[1], y[2], y[3]);
    }
    ss += __shfl_xor(ss, 16); ss += __shfl_xor(ss, 32);
    if (lg == 0) p.SS_SSD[tok * 8 + h] = ss;
  }
}

__device__ void final_rows(const Params& p, int gw, int nw) {
  const int lane = threadIdx.x & 63;
  for (int row = gw; row < T_TOK; row += nw) {
    float r = rsqrtf(p.SS_OUT[row] * (1.f / 1024.f) + 1e-6f);
    float4* o = (float4*)(p.out + (size_t)row * 1024);
    const float4* gf = (const float4*)p.g_final;
#pragma unroll
    for (int i = 0; i < 4; i++) {
      float4 v = o[lane + 64 * i], gg = gf[lane + 64 * i];
      v.x *= r * gg.x; v.y *= r * gg.y; v.z *= r * gg.z; v.w *= r * gg.w;
      o[lane + 64 * i] = v;
    }
  }
}

__device__ __forceinline__ void grid_bar(unsigned* bar, unsigned k) {
  asm volatile("s_waitcnt vmcnt(0)" ::: "memory");
  __syncthreads();
  if (threadIdx.x == 0) {
    const unsigned nb = gridDim.x, r = blockIdx.x & 7u;
    const unsigned nsub = (nb - r + 7u) >> 3;
    const unsigned ngrp = nb < 8u ? nb : 8u;
    __builtin_amdgcn_fence(__ATOMIC_RELEASE, "agent");
    asm volatile("s_waitcnt vmcnt(0)" ::: "memory");
    const unsigned old = __hip_atomic_fetch_add(bar + 64 * r, 1u, __ATOMIC_RELAXED, __HIP_MEMORY_SCOPE_AGENT);
    if (old + 1u == k * nsub) {
      __builtin_amdgcn_fence(__ATOMIC_ACQ_REL, "agent");
      asm volatile("s_waitcnt vmcnt(0)" ::: "memory");
      __hip_atomic_fetch_add(bar + 64 * 8, 1u, __ATOMIC_RELAXED, __HIP_MEMORY_SCOPE_AGENT);
    }
    while (__hip_atomic_load(bar + 64 * 8, __ATOMIC_RELAXED, __HIP_MEMORY_SCOPE_AGENT) < k * ngrp) __builtin_amdgcn_s_sleep(1);
    __builtin_amdgcn_fence(__ATOMIC_ACQUIRE, "agent");
    asm volatile("s_waitcnt vmcnt(0)" ::: "memory");
  }
  __syncthreads();
}

__device__ __forceinline__ int next_item(unsigned* ctr, char* smem) {
  int* sh = (int*)(smem + SMEM_BYTES - 16);
  __syncthreads();
  if (threadIdx.x == 0) *sh = (int)__hip_atomic_fetch_add(ctr, 1u, __ATOMIC_RELAXED, __HIP_MEMORY_SCOPE_AGENT);
  __syncthreads();
  return *sh;
}

__global__ void __launch_bounds__(256, 2) hymba_fwd(Params p) {
  cg::grid_group grid = cg::this_grid();
  __shared__ __attribute__((aligned(16))) char smem[SMEM_BYTES];
  const int nb = gridDim.x, bid = blockIdx.x;
  unsigned bk = 0;

  if (p.out == nullptr) grid.sync();
  for (int rep = 0; rep < REP0; rep++) {
  phase_prep(p);
  grid_bar(p.BAR, ++bk);
  }
  for (int rep = 0; rep < REP1; rep++) {
  if ((nb & 7) == 0) {
    const int xcd = bid & 7, li = bid >> 3, nbx = nb >> 3;
    for (int e = li; e < 1120; e += nbx) {
      const int grp = e / 280, r = e - grp * 280;
      gemm_tile<0>(p, xcd * 32 + grp * 8 + (r & 7), r >> 3, smem);
    }
  } else {
    for (int it = bid; it < 256 * 35; it += nb) gemm_tile<0>(p, it / 35, it % 35, smem);
  }
  for (int j = bid; j < 128; j += nb) gemm_tile<1>(p, j >> 3, j & 7, smem);
  grid_bar(p.BAR, ++bk);
  }
  for (int rep = 0; rep < REP2; rep++) {
  for (int it = next_item(p.BAR + 64 * (9 + rep), smem); it < 256 + 1024 + 2048; it = next_item(p.BAR + 64 * (9 + rep), smem)) {
    if (it < 256) compress_item(p, it, smem);
    else if (it < 1280) memattn_item(p, it - 256, smem);
    else conv_units(p, (it - 1280) * 256 + get_tid());
  }
  grid_bar(p.BAR, ++bk);
  }
  for (int rep = 0; rep < REP3; rep++) {
  {
    const int xq = bid & 7;
    unsigned* ctr = p.BAR + 64 * (16 + xq + 8 * rep);
    for (int li = next_item(ctr, smem); li < 512; li = next_item(ctr, smem)) {
      if (li < 256) nsa_item(p, ((li >> 1) << 4) | (xq + 8 * (li & 1)), smem);
      else ssd_states_item(p, (li - 256) * 8 + xq, smem);
    }
  }
  grid_bar(p.BAR, ++bk);
  }
  for (int it = bid; it < 2048; it += nb) scan_units(p, it * 256 + get_tid());
  grid_bar(p.BAR, ++bk);
  for (int rep = 0; rep < REP5; rep++) {
  for (int it = bid; it < 2048; it += nb) ssd_y_item(p, it, smem);
  grid_bar(p.BAR, ++bk);
  }
  if ((nb & 7) == 0) {
    const int xcd = bid & 7, li = bid >> 3, nbx = nb >> 3;
    for (int e = li; e < 256; e += nbx) gemm_tile<2>(p, xcd * 32 + (e >> 3), e & 7, smem);
  } else {
    for (int it = bid; it < 256 * 8; it += nb) gemm_tile<2>(p, it >> 3, it & 7, smem);
  }
  grid_bar(p.BAR, ++bk);
  final_rows(p, (bid * 256 + threadIdx.x) >> 6, (nb * 256) >> 6);
}

extern "C" void kernel_launch(void* const* d_in, const int* in_sizes, int n_in, void* d_out, int out_size, void* d_ws, size_t ws_size,
                              hipStream_t stream) {
  static int grid_blocks = 0;
  if (!grid_blocks) {
    int dev = 0, cus = 0, per_cu = 0;
    hipGetDevice(&dev);
    hipDeviceGetAttribute(&cus, hipDeviceAttributeMultiprocessorCount, dev);
    hipOccupancyMaxActiveBlocksPerMultiprocessor(&per_cu, hymba_fwd, 256, 0);
    if (per_cu < 1) per_cu = 1;
    if (per_cu > 4) per_cu = 4;
    grid_blocks = cus * per_cu;
  }
  Params p{};
  p.x = (const float*)d_in[0]; p.mem = (const float*)d_in[1]; p.pos = (const int*)d_in[2];
  p.g_in = (const float*)d_in[3]; p.w_in = (const float*)d_in[4]; p.cpk = (const float*)d_in[5];
  p.w1k = (const float*)d_in[6]; p.w2k = (const float*)d_in[7]; p.cpv = (const float*)d_in[8];
  p.w1v = (const float*)d_in[9]; p.w2v = (const float*)d_in[10]; p.conv_w = (const float*)d_in[11];
  p.conv_b = (const float*)d_in[12]; p.dt_bias = (const float*)d_in[13]; p.a_log = (const float*)d_in[14];
  p.d_skip = (const float*)d_in[15]; p.g_ssd = (const float*)d_in[16]; p.g_mem = (const float*)d_in[17];
  p.w_kv = (const float*)d_in[18]; p.w_out = (const float*)d_in[19]; p.g_final = (const float*)d_in[20];
  p.out = (float*)d_out;
  char* w = (char*)d_ws; size_t off = 0;
  auto take = [&](size_t bytes) { char* r = w + off; off += (bytes + 255) & ~(size_t)255; return r; };
  p.WinT = (bf16_t*)take((size_t)NINP * 1024 * 2);
  p.WoutT = (bf16_t*)take((size_t)1024 * 1536 * 2);
  p.WkvT = (bf16_t*)take((size_t)1024 * 1024 * 2);
  p.W1kT = (bf16_t*)take((size_t)256 * 2048 * 2);
  p.W1vT = (bf16_t*)take((size_t)256 * 2048 * 2);
  p.W2kT = (bf16_t*)take((size_t)64 * 256 * 2);
  p.W2vT = (bf16_t*)take((size_t)64 * 256 * 2);
  p.MEMB = (bf16_t*)take((size_t)2048 * 1024 * 2);
  p.PROJ = (bf16_t*)take((size_t)T_TOK * NIN * 2);
  p.VST = (bf16_t*)take((size_t)16 * 64 * S_LEN * 2);
  p.VWT = (bf16_t*)take((size_t)16 * 64 * S_LEN * 2);
  p.KMEM = (bf16_t*)take((size_t)2048 * 512 * 2);
  p.VMEMT = (bf16_t*)take((size_t)32 * 128 * 256 * 2);
  p.KCMP = (bf16_t*)take((size_t)16 * 256 * 64 * 2);
  p.VCMPT = (bf16_t*)take((size_t)16 * 64 * 256 * 2);
  p.XT = (bf16_t*)take((size_t)64 * 64 * S_LEN * 2);
  p.BC = (bf16_t*)take((size_t)T_TOK * 512 * 2);
  p.BT = (bf16_t*)take((size_t)16 * 128 * S_LEN * 2);
  p.MIX = (bf16_t*)take((size_t)T_TOK * 1536 * 2);
  p.XB = p.MIX;
  p.CHDEC = (float*)take((size_t)8 * 32 * 8 * 4);
  p.ACS = (float*)take((size_t)8 * 32 * 8 * 128 * 4);
  p.DTV = (float*)take((size_t)8 * 32 * 8 * 128 * 4);
  p.SS_SSD = (float*)take((size_t)T_TOK * 8 * 4);
  p.SS_OUT = (float*)take((size_t)T_TOK * 4);
  p.BAR = (unsigned*)take((size_t)(64 * 32 + 256) * 4);
  p.MTCNT = p.BAR + 64 * 32;
  p.STATES = (float*)d_out;
  p.KSC = (bf16_t*)((char*)d_out + (size_t)80 * 1024 * 1024);
  p.KWC = p.KSC + (size_t)16 * S_LEN * 64;
  if (off > ws_size) { fprintf(stderr, "workspace too small: need %zu have %zu\n", off, ws_size); return; }
  hipMemsetAsync(p.BAR, 0, (64 * 32 + 256) * 4, stream);
  void* args[] = {&p};
  hipError_t e = hipLaunchCooperativeKernel((void*)hymba_fwd, dim3(grid_blocks), dim3(256), args, 0, stream);
  if (e != hipSuccess) fprintf(stderr, "cooperative launch failed: %s (grid %d)\n", hipGetErrorString(e), grid_blocks);
}
```

```cpp
#include <hip/hip_runtime.h>
#include <hip/hip_cooperative_groups.h>
#include <stdint.h>
#include <stdio.h>
namespace cg = cooperative_groups;

typedef unsigned short bf16_t;
typedef __attribute__((ext_vector_type(8))) short bf16x8;
typedef __attribute__((ext_vector_type(4))) short bf16x4;
typedef __attribute__((ext_vector_type(4))) float f32x4;

#define S_LEN 4096
#define T_TOK 32768
#define NIN 4384
#define NINP 4480
#define LOG2E 1.4426950408889634f

#define C_Q 0
#define C_KC 512
#define C_VC 640
#define C_KS 768
#define C_KW 1024
#define C_GL 1280
#define C_GA 1304
#define C_Z 1816
#define C_XBC 2328
#define C_DT 3352
#define C_QX 3360
#define C_GX 3872

#define SMEM_BYTES 73728
#ifndef REP0
#define REP0 1
#endif
#ifndef REP1
#define REP1 1
#endif
#ifndef REP2
#define REP2 1
#endif
#ifndef REP3
#define REP3 1
#endif
#ifndef REP5
#define REP5 1
#endif

struct Params {
  const float *x, *mem; const int* pos;
  const float *g_in, *w_in, *cpk, *w1k, *w2k, *cpv, *w1v, *w2v, *conv_w, *conv_b, *dt_bias, *a_log, *d_skip, *g_ssd, *g_mem, *w_kv, *w_out, *g_final;
  float* out;
  bf16_t *WinT, *WoutT, *WkvT, *W1kT, *W1vT, *W2kT, *W2vT, *XB, *MEMB, *PROJ, *VST, *VWT, *KMEM, *VMEMT, *KCMP, *VCMPT, *XT, *BC, *BT, *MIX, *KSC, *KWC;
  float *STATES, *CHDEC, *ACS, *DTV, *SS_SSD, *SS_OUT;
  unsigned* BAR;
  unsigned* MTCNT;
};

__device__ __forceinline__ bf16_t f2bf(float f) { uint32_t u = __float_as_uint(f); u += 0x7fffu + ((u >> 16) & 1u); return (bf16_t)(u >> 16); }
__device__ __forceinline__ float bf2f(bf16_t h) { return __uint_as_float(((uint32_t)h) << 16); }
__device__ __forceinline__ float bfs(short h) { return __uint_as_float(((uint32_t)(unsigned short)h) << 16); }
__device__ __forceinline__ float fexp2(float x) { return __builtin_amdgcn_exp2f(x); }
__device__ __forceinline__ float silu_f(float x) { return x * __builtin_amdgcn_rcpf(1.f + __builtin_amdgcn_exp2f(-1.4426950408889634f * x)); }
__device__ __forceinline__ float sigmoid_f(float x) { return __builtin_amdgcn_rcpf(1.f + __builtin_amdgcn_exp2f(-1.4426950408889634f * x)); }
__device__ __forceinline__ f32x4 mfma16(bf16x8 a, bf16x8 b, f32x4 c) { return __builtin_amdgcn_mfma_f32_16x16x32_bf16(a, b, c, 0, 0, 0); }
typedef __bf16 hbf2_t __attribute__((ext_vector_type(2)));
typedef float f2_t __attribute__((ext_vector_type(2)));
typedef uint32_t u32x2 __attribute__((ext_vector_type(2)));
typedef uint32_t u32x4 __attribute__((ext_vector_type(4)));
__device__ __forceinline__ uint32_t pk2(float a, float b) {
  f2_t v; v[0] = a; v[1] = b;
  hbf2_t r = __builtin_convertvector(v, hbf2_t);
  return __builtin_bit_cast(uint32_t, r);
}
__device__ __forceinline__ bf16x4 pack4(float a, float b, float c, float d) {
  u32x2 r; r[0] = pk2(a, b); r[1] = pk2(c, d); return __builtin_bit_cast(bf16x4, r);
}
__device__ __forceinline__ bf16x8 pack8(float a, float b, float c, float d, float e, float f, float g, float h) {
  u32x4 r; r[0] = pk2(a, b); r[1] = pk2(c, d); r[2] = pk2(e, f); r[3] = pk2(g, h); return __builtin_bit_cast(bf16x8, r);
}
__device__ __forceinline__ bf16x8 cat44(bf16x4 a, bf16x4 b) {
  u32x2 x = __builtin_bit_cast(u32x2, a), y = __builtin_bit_cast(u32x2, b);
  u32x4 r; r[0] = x[0]; r[1] = x[1]; r[2] = y[0]; r[3] = y[1]; return __builtin_bit_cast(bf16x8, r);
}
template <int NR, typename L, typename ST, typename C>
__device__ __forceinline__ void tile_pipeline(int n, L load, ST store, C compute) {
  if (n <= 0) return;
  bf16x8 ra[NR], rb[NR];
  const int last = n - 1;
  load(0, ra);
  load(min(1, last), rb);
  store(0, ra);
  load(min(2, last), ra);
  __syncthreads();
  for (int i = 0; i < n; i += 2) {
    compute(i, 0);
    store(1, rb);
    load(min(i + 3, last), rb);
    __syncthreads();
    if (i + 1 < n) compute(i + 1, 1);
    store(0, ra);
    load(min(i + 4, last), ra);
    __syncthreads();
  }
}
template <int NR, typename L, typename ST, typename C>
__device__ __forceinline__ void tile_pipeline1(int n, L load, ST store, C compute) {
  if (n <= 0) return;
  bf16x8 ra[NR];
  load(0, ra);
  store(0, ra);
  if (n > 1) load(1, ra);
  __syncthreads();
  for (int i = 0; i < n; i++) {
    compute(i, i & 1);
    if (i + 1 < n) { store((i + 1) & 1, ra); if (i + 2 < n) load(i + 2, ra); }
    __syncthreads();
  }
}
__device__ __forceinline__ void rope_cs(int pos, int j, float& cs, float& sn) {
  float inv = fexp2(-(float)j * (18.931568569324174f / 8.f));
  float a = (float)pos * inv;
  float n = rintf(a * 0.15915494309189535f);
  float r = fmaf(-n, 6.28125f, a);
  r = fmaf(-n, 1.9353071795864769e-3f, r);
  cs = __cosf(r); sn = __sinf(r);
}

__device__ __forceinline__ float rowmax4(float x) {
  unsigned xi = __float_as_uint(x);
  auto a = __builtin_amdgcn_permlane16_swap(xi, xi, false, false);
  float m = fmaxf(__uint_as_float(a[0]), __uint_as_float(a[1]));
  unsigned mi = __float_as_uint(m);
  auto b = __builtin_amdgcn_permlane32_swap(mi, mi, false, false);
  return fmaxf(__uint_as_float(b[0]), __uint_as_float(b[1]));
}
__device__ __forceinline__ float rowsum4(float x) {
  unsigned xi = __float_as_uint(x);
  auto a = __builtin_amdgcn_permlane16_swap(xi, xi, false, false);
  float m = __uint_as_float(a[0]) + __uint_as_float(a[1]);
  unsigned mi = __float_as_uint(m);
  auto b = __builtin_amdgcn_permlane32_swap(mi, mi, false, false);
  return __uint_as_float(b[0]) + __uint_as_float(b[1]);
}
__device__ __forceinline__ int get_tid() { int t = threadIdx.x; asm volatile("" : "+v"(t)); return t; }

__device__ void prep_rows(const float* __restrict__ x, bf16_t* __restrict__ xb, int nrows, int gw, int nw) {
  const int lane = threadIdx.x & 63;
  int row = gw;
  for (; row + 3 * nw < nrows; row += 4 * nw) {
    float4 v[4][4]; float ss[4];
#pragma unroll
    for (int r = 0; r < 4; r++) {
      const float4* p = (const float4*)(x + (size_t)(row + r * nw) * 1024);
#pragma unroll
      for (int i = 0; i < 4; i++) v[r][i] = p[lane + 64 * i];
    }
#pragma unroll
    for (int r = 0; r < 4; r++) {
      float s = 0.f;
#pragma unroll
      for (int i = 0; i < 4; i++) s += v[r][i].x * v[r][i].x + v[r][i].y * v[r][i].y + v[r][i].z * v[r][i].z + v[r][i].w * v[r][i].w;
#pragma unroll
      for (int o = 32; o >= 1; o >>= 1) s += __shfl_xor(s, o);
      ss[r] = rsqrtf(s * (1.f / 1024.f) + 1e-6f);
    }
#pragma unroll
    for (int r = 0; r < 4; r++)
#pragma unroll
      for (int i = 0; i < 4; i++)
        *(bf16x4*)(xb + (size_t)(row + r * nw) * 1024 + (lane + 64 * i) * 4) =
            pack4(v[r][i].x * ss[r], v[r][i].y * ss[r], v[r][i].z * ss[r], v[r][i].w * ss[r]);
  }
  for (; row < nrows; row += nw) {
    const float4* p = (const float4*)(x + (size_t)row * 1024);
    float4 v[4]; float ss = 0.f;
#pragma unroll
    for (int i = 0; i < 4; i++) { v[i] = p[lane + 64 * i]; ss += v[i].x * v[i].x + v[i].y * v[i].y + v[i].z * v[i].z + v[i].w * v[i].w; }
#pragma unroll
    for (int o = 32; o >= 1; o >>= 1) ss += __shfl_xor(ss, o);
    float r = rsqrtf(ss * (1.f / 1024.f) + 1e-6f);
#pragma unroll
    for (int i = 0; i < 4; i++) {
      bf16x4 o = pack4(v[i].x * r, v[i].y * r, v[i].z * r, v[i].w * r);
      *(bf16x4*)(xb + (size_t)row * 1024 + (lane + 64 * i) * 4) = o;
    }
  }
}

__device__ void prep_wT(const float* __restrict__ w, const float* __restrict__ g, int gk0, int gk1, bf16_t* __restrict__ wt,
                        int K, int N, int Npad, int gtid, int gthreads) {
  const int ln = gtid & 63, gwv = gtid >> 6, nwv = gthreads >> 6;
  const int kblocks = K >> 6;
  const int total = (Npad >> 3) * kblocks;
  for (int uw = gwv; uw < total; uw += nwv) {
    const int kb = uw % kblocks, nbk = uw / kblocks;
    const int n = nbk * 8 + (ln >> 3), k8 = kb * 8 + (ln & 7);
    bf16x8 o;
#pragma unroll
    for (int j = 0; j < 8; j++) {
      int k = k8 * 8 + j; float v = 0.f;
      if (n < N) { v = w[(size_t)k * N + n]; if (g != nullptr && k >= gk0 && k < gk1) v *= g[k - gk0]; }
      o[j] = (short)f2bf(v);
    }
    *(bf16x8*)(wt + (size_t)n * K + k8 * 8) = o;
  }
}

__device__ void phase_prep(const Params& p) {
  const int gtid = blockIdx.x * 256 + threadIdx.x, gthreads = gridDim.x * 256;
  const int gw = gtid >> 6, nw = gthreads >> 6;
  prep_rows(p.x, p.XB, T_TOK, gw, nw);
  prep_rows(p.mem, p.MEMB, 2048, gw, nw);
  prep_wT(p.w_in, p.g_in, 0, 1024, p.WinT, 1024, NIN, NINP, gtid, gthreads);
  prep_wT(p.w_out, p.g_ssd, 512, 1024, p.WoutT, 1536, 1024, 1024, gtid, gthreads);
  prep_wT(p.w_kv, p.g_mem, 0, 1024, p.WkvT, 1024, 1024, 1024, gtid, gthreads);
  prep_wT(p.w1k, nullptr, 0, 0, p.W1kT, 2048, 256, 256, gtid, gthreads);
  prep_wT(p.w1v, nullptr, 0, 0, p.W1vT, 2048, 256, 256, gtid, gthreads);
  prep_wT(p.w2k, nullptr, 0, 0, p.W2kT, 256, 64, 64, gtid, gthreads);
  prep_wT(p.w2v, nullptr, 0, 0, p.W2vT, 256, 64, 64, gtid, gthreads);
  for (int i = gtid; i < T_TOK; i += gthreads) p.SS_OUT[i] = 0.f;
  for (int i = gtid; i < 16 * 64; i += gthreads) {
    int bg = i >> 6, d = i & 63;
    p.KCMP[((size_t)bg * 256 + 255) * 64 + d] = 0;
    p.VCMPT[((size_t)bg * 64 + d) * 256 + 255] = 0;
  }
}

template <int MODE>
__device__ void gemm_tile(const Params& p, int mt, int nt, char* smem) {
  const int tid = get_tid(), lane = tid & 63, wave = tid >> 6, lr = lane & 15, lg = lane >> 4;
  const int wr = wave >> 1, wc = wave & 1;
  const int m0 = mt * 128, n0 = nt * 128;
  const bf16_t* A; const bf16_t* Bt; int K;
  if (MODE == 0) { A = p.XB; Bt = p.WinT; K = 1024; }
  else if (MODE == 1) { A = p.MEMB; Bt = p.WkvT; K = 1024; }
  else { A = p.MIX; Bt = p.WoutT; K = 1536; }
  bf16_t* As = (bf16_t*)smem;
  bf16_t* Bs = As + 2 * 9216;
  const int lrow = tid >> 3, kc = tid & 7;
  const bf16_t* ga = A + (size_t)(m0 + lrow) * K + kc * 8;
  const bf16_t* gb = Bt + (size_t)(n0 + lrow) * K + kc * 8;
  float rs[4] = {1.f, 1.f, 1.f, 1.f};
  if (MODE == 2) {
#pragma unroll
    for (int i = 0; i < 4; i++) {
      const float4* sp = (const float4*)(p.SS_SSD + (size_t)(m0 + lrow + 32 * i) * 8);
      float4 a = sp[0], b = sp[1];
      rs[i] = rsqrtf((a.x + a.y + a.z + a.w + b.x + b.y + b.z + b.w) * (1.f / 512.f) + 1e-6f);
    }
  }
  bool swap;
  if (MODE == 0) swap = !(nt == 7 || nt == 9);
  else if (MODE == 1) swap = (nt < 4);
  else swap = true;
  const bf16_t* F = swap ? (Bs + (64 * wc) * 72) : (As + (64 * wr) * 72);
  const bf16_t* G = swap ? (As + (64 * wr) * 72) : (Bs + (64 * wc) * 72);
  f32x4 acc[4][4];
#pragma unroll
  for (int i = 0; i < 4; i++)
#pragma unroll
    for (int j = 0; j < 4; j++) acc[i][j] = (f32x4){0.f, 0.f, 0.f, 0.f};
  bf16x8 ra0[4], rb0[4], ra1[4], rb1[4];
  const int nk = K / 64;
  auto load = [&](int kt, bf16x8 (&ra)[4], bf16x8 (&rb)[4]) {
#pragma unroll
    for (int i = 0; i < 4; i++) {
      ra[i] = *(const bf16x8*)(ga + (size_t)(32 * i) * K + kt * 64);
      rb[i] = *(const bf16x8*)(gb + (size_t)(32 * i) * K + kt * 64);
    }
  };
  auto store = [&](int buf, int kt, bf16x8 (&ra)[4], bf16x8 (&rb)[4]) {
    if (MODE == 2) {
      if (kt >= 8 && kt < 16) {
#pragma unroll
        for (int i = 0; i < 4; i++) {
          bf16x8 v = ra[i];
          ra[i] = pack8(bfs(v[0]) * rs[i], bfs(v[1]) * rs[i], bfs(v[2]) * rs[i], bfs(v[3]) * rs[i],
                        bfs(v[4]) * rs[i], bfs(v[5]) * rs[i], bfs(v[6]) * rs[i], bfs(v[7]) * rs[i]);
        }
      }
    }
#pragma unroll
    for (int i = 0; i < 4; i++) {
      *(bf16x8*)(As + buf * 9216 + (lrow + 32 * i) * 72 + kc * 8) = ra[i];
      *(bf16x8*)(Bs + buf * 9216 + (lrow + 32 * i) * 72 + kc * 8) = rb[i];
    }
  };
  auto compute = [&](int buf) {
    const int cb = buf * 9216;
#pragma unroll
    for (int ks = 0; ks < 2; ks++) {
      bf16x8 ff[4], gg[4];
#pragma unroll
      for (int i = 0; i < 4; i++) {
        ff[i] = *(const bf16x8*)(F + cb + (16 * i + lr) * 72 + ks * 32 + lg * 8);
        gg[i] = *(const bf16x8*)(G + cb + (16 * i + lr) * 72 + ks * 32 + lg * 8);
      }
#pragma unroll
      for (int i = 0; i < 4; i++)
#pragma unroll
        for (int j = 0; j < 4; j++) acc[i][j] = mfma16(ff[i], gg[j], acc[i][j]);
    }
  };
  const int lastk = nk - 1;
  load(0, ra0, rb0);
  load(1, ra1, rb1);
  store(0, 0, ra0, rb0);
  load(2, ra0, rb0);
  __syncthreads();
  for (int kt = 0; kt < nk; kt += 2) {
    compute(0);
    store(1, kt + 1, ra1, rb1);
    load(min(kt + 3, lastk), ra1, rb1);
    __syncthreads();
    compute(1);
    store(0, min(kt + 2, lastk), ra0, rb0);
    load(min(kt + 4, lastk), ra0, rb0);
    __syncthreads();
  }
  if (swap) {
    if (MODE == 0) {
      const bool rope = (nt < 4) || nt == 6 || nt == 8;
#pragma unroll
      for (int mi = 0; mi < 4; mi++) {
        const int m = m0 + 64 * wr + 16 * mi + lr;
        if (rope) {
          const int pos = p.pos[m];
          f32x4 v = acc[0][mi];
          f32x4 o;
#pragma unroll
          for (int i = 0; i < 4; i++) {
            float pr = __shfl_xor(v[i], 32);
            float cs, sn; rope_cs(pos, 4 * (lg & 1) + i, cs, sn);
            o[i] = (lg < 2) ? (v[i] * cs - pr * sn) : (v[i] * cs + pr * sn);
          }
          acc[0][mi] = o;
        }
        {
          bf16_t* stg = (bf16_t*)smem + ((wave & 1) ? 2 * 9216 : 0) + (wave >> 1) * 4608;
#pragma unroll
          for (int ni = 0; ni < 4; ni++) {
            f32x4 v = acc[ni][mi];
            *(bf16x4*)(stg + (16 * mi + lr) * 72 + 16 * ni + 4 * lg) = pack4(v[0], v[1], v[2], v[3]);
          }
        }
      }
      {
        const bf16_t* stg = (const bf16_t*)smem + ((wave & 1) ? 2 * 9216 : 0) + (wave >> 1) * 4608;
        const int rr = lane >> 3, ch = lane & 7;
        const int nb0 = n0 + 64 * wc + ch * 8;
#pragma unroll
        for (int it = 0; it < 8; it++) {
          const int row = it * 8 + rr;
          const int m = m0 + 64 * wr + row;
          bf16x8 v = *(const bf16x8*)(stg + row * 72 + ch * 8);
          if (nt == 6 || nt == 8) {
            bf16_t* kd = ((nt == 6) ? p.KSC : p.KWC) + (((size_t)(m >> 12) * 2 + wc) * S_LEN + (m & 4095)) * 64;
            *(bf16x8*)(kd + ch * 8) = v;
          } else if (nb0 < NIN) {
            *(bf16x8*)(p.PROJ + (size_t)m * NIN + nb0) = v;
          }
        }
      }
      __syncthreads();
    } else if (MODE == 1) {
#pragma unroll
      for (int mi = 0; mi < 4; mi++) {
        const int m = m0 + 64 * wr + 16 * mi + lr;
#pragma unroll
        for (int ni = 0; ni < 4; ni++) {
          const int n = n0 + 64 * wc + 16 * ni + 4 * lg;
          f32x4 v = acc[ni][mi];
          *(bf16x4*)(p.KMEM + (size_t)m * 512 + n) = pack4(v[0], v[1], v[2], v[3]);
        }
      }
    } else {
#pragma unroll
      for (int mi = 0; mi < 4; mi++) {
        const int m = m0 + 64 * wr + 16 * mi + lr;
        float ss = 0.f;
#pragma unroll
        for (int ni = 0; ni < 4; ni++) {
          const int n = n0 + 64 * wc + 16 * ni + 4 * lg;
          float4 xv = *(const float4*)(p.x + (size_t)m * 1024 + n);
          f32x4 v = acc[ni][mi];
          float4 h; h.x = xv.x + v[0]; h.y = xv.y + v[1]; h.z = xv.z + v[2]; h.w = xv.w + v[3];
          ss += h.x * h.x + h.y * h.y + h.z * h.z + h.w * h.w;
          *(float4*)(p.out + (size_t)m * 1024 + n) = h;
        }
        ss += __shfl_xor(ss, 16); ss += __shfl_xor(ss, 32);
        if (lg == 0) atomicAdd(p.SS_OUT + m, ss);
      }
    }
  } else {
#pragma unroll
    for (int mi = 0; mi < 4; mi++)
#pragma unroll
      for (int ni = 0; ni < 4; ni++) {
        f32x4 v = acc[mi][ni];
        bf16x4 o = pack4(v[0], v[1], v[2], v[3]);
        if (MODE == 0) {
          const int b = m0 >> 12, s = (m0 & 4095) + 64 * wr + 16 * mi + 4 * lg;
          const int d = 16 * ni + lr;
          bf16_t* dst = (nt == 7) ? p.VST : p.VWT;
          *(bf16x4*)(dst + ((size_t)(b * 2 + wc) * 64 + d) * S_LEN + s) = o;
        } else {
          const int b = m0 >> 8, s = (m0 & 255) + 64 * wr + 16 * mi + 4 * lg;
          const int col = n0 - 512 + 64 * wc + 16 * ni + lr;
          const int h = col >> 7, d = col & 127;
          *(bf16x4*)(p.VMEMT + ((size_t)(b * 4 + h) * 128 + d) * 256 + s) = o;
        }
      }
  }
}

template <int DQK, int DV, int MASK, typename MaskF>
__device__ __forceinline__ void attn_tile(const bf16_t* sK, const bf16_t* sVt, const bf16x8 (&qf)[2][DQK / 32], f32x4 (&o)[DV / 16][2],
                                          float (&m)[2], float (&l)[2], float c, bool qsel0, bool qsel1, MaskF valid) {
  constexpr int KST = DQK + 8;
  const int lane = get_tid() & 63, lr = lane & 15, lg = lane >> 4;
  f32x4 s[4][2];
#pragma unroll
  for (int kt = 0; kt < 4; kt++) { s[kt][0] = (f32x4){0.f, 0.f, 0.f, 0.f}; s[kt][1] = (f32x4){0.f, 0.f, 0.f, 0.f}; }
#pragma unroll
  for (int ks = 0; ks < DQK / 32; ks++)
#pragma unroll
    for (int kt = 0; kt < 4; kt++) {
      bf16x8 a = *(const bf16x8*)(sK + (16 * kt + lr) * KST + ks * 32 + lg * 8);
      s[kt][0] = mfma16(a, qf[0][ks], s[kt][0]);
      s[kt][1] = mfma16(a, qf[1][ks], s[kt][1]);
    }
#pragma unroll
  for (int qt = 0; qt < 2; qt++) {
    const bool qs = qt ? qsel1 : qsel0;
    float mx = -1e30f;
    if (MASK) {
#pragma unroll
      for (int kt = 0; kt < 4; kt++)
#pragma unroll
        for (int i = 0; i < 4; i++) {
          bool v = valid(16 * kt + 4 * lg + i, qt);
          float sv = v ? s[kt][qt][i] * c : -1e30f;
          s[kt][qt][i] = sv; mx = fmaxf(mx, sv);
        }
    } else {
#pragma unroll
      for (int kt = 0; kt < 4; kt++) mx = fmaxf(fmaxf(mx, fmaxf(s[kt][qt][0], s[kt][qt][1])), fmaxf(s[kt][qt][2], s[kt][qt][3]));
      mx = qs ? mx * c : -1e30f;
    }
    mx = rowmax4(mx);
    const float mn = fmaxf(m[qt], mx);
    const float alpha = fexp2(m[qt] - mn);
    m[qt] = mn;
    float me;
    if (MASK) me = (mn > -1e29f) ? mn : 1e30f; else me = qs ? mn : 1e30f;
    float rs = 0.f;
#pragma unroll
    for (int kt = 0; kt < 4; kt++)
#pragma unroll
      for (int i = 0; i < 4; i++) {
        float pv = MASK ? fexp2(s[kt][qt][i] - me) : fexp2(fmaf(s[kt][qt][i], c, -me));
        s[kt][qt][i] = pv; rs += pv;
      }
    rs = rowsum4(rs);
    l[qt] = l[qt] * alpha + rs;
#pragma unroll
    for (int dt = 0; dt < DV / 16; dt++) {
      o[dt][qt][0] *= alpha; o[dt][qt][1] *= alpha; o[dt][qt][2] *= alpha; o[dt][qt][3] *= alpha;
    }
  }
#pragma unroll
  for (int k2 = 0; k2 < 2; k2++) {
    bf16x8 pb[2];
#pragma unroll
    for (int qt = 0; qt < 2; qt++)
      pb[qt] = pack8(s[2 * k2][qt][0], s[2 * k2][qt][1], s[2 * k2][qt][2], s[2 * k2][qt][3],
                     s[2 * k2 + 1][qt][0], s[2 * k2 + 1][qt][1], s[2 * k2 + 1][qt][2], s[2 * k2 + 1][qt][3]);
#pragma unroll
    for (int dt = 0; dt < DV / 16; dt++) {
      const bf16_t* vp = sVt + (16 * dt + lr) * 72 + 32 * k2 + 4 * lg;
      bf16x8 a = cat44(*(const bf16x4*)vp, *(const bf16x4*)(vp + 16));
      o[dt][0] = mfma16(a, pb[0], o[dt][0]);
      o[dt][1] = mfma16(a, pb[1], o[dt][1]);
    }
  }
}

__device__ __forceinline__ int next_bit_below(unsigned long long m, int below) {
  unsigned long long mm = (below >= 64) ? m : (m & ((1ull << below) - 1ull));
  return mm ? (63 - __clzll((long long)mm)) : -1;
}

__device__ void nsa_item(const Params& p, int item, char* smem) {
  const int tid = get_tid(), lane = tid & 63, wave = tid >> 6, lr = lane & 15, lg = lane >> 4;
  const int bg = item & 15, qb = 127 - (item >> 4);
  const int b = bg >> 1, g = bg & 1;
  const int t0 = qb * 32, cur = t0 >> 6;
  const int hq = g * 4 + wave;
  float* sImp = (float*)(smem + 55296);
  unsigned long long* sSel = (unsigned long long*)(smem + 63616);
  const float c = 0.125f * LOG2E;
  const size_t tokbase = (size_t)b * S_LEN + t0;
  const int r0 = tid >> 3, cc = tid & 7;

  bf16x8 qf[2][2];
#pragma unroll
  for (int qt = 0; qt < 2; qt++) {
    const bf16_t* row = p.PROJ + (tokbase + 16 * qt + lr) * NIN;
#pragma unroll
    for (int ks = 0; ks < 2; ks++) qf[qt][ks] = *(const bf16x8*)(row + C_Q + hq * 64 + 32 * ks + 8 * lg);
  }
  auto emit = [&](f32x4 (&o)[4][2], float (&l)[2], int br) {
#pragma unroll
    for (int qt = 0; qt < 2; qt++) {
      const size_t tok = tokbase + 16 * qt + lr;
      const float gsc = sigmoid_f(bf2f(p.PROJ[tok * NIN + C_GL + hq * 3 + br])) / fmaxf(l[qt], 1e-30f);
#pragma unroll
      for (int dt = 0; dt < 4; dt++) {
        const int dbase = hq * 64 + 16 * dt + 4 * lg;
        bf16_t* dst = p.MIX + tok * 1536 + dbase;
        f32x4 r = o[dt][qt];
        r[0] *= gsc; r[1] *= gsc; r[2] *= gsc; r[3] *= gsc;
        if (br > 0) { bf16x4 pv = *(const bf16x4*)dst; r[0] += bfs(pv[0]); r[1] += bfs(pv[1]); r[2] += bfs(pv[2]); r[3] += bfs(pv[3]); }
        if (br == 2) {
          bf16x4 ga = *(const bf16x4*)(p.PROJ + tok * NIN + C_GA + dbase);
          r[0] *= silu_f(bfs(ga[0])); r[1] *= silu_f(bfs(ga[1])); r[2] *= silu_f(bfs(ga[2])); r[3] *= silu_f(bfs(ga[3]));
        }
        *(bf16x4*)dst = pack4(r[0], r[1], r[2], r[3]);
      }
    }
  };
  auto store_kv = [&](int buf, bf16x8 (&rg)[4]) {
    bf16_t* sK = (bf16_t*)(smem + buf * 27648);
    bf16_t* sVt = sK + 64 * 72;
    *(bf16x8*)(sK + r0 * 72 + cc * 8) = rg[0];
    *(bf16x8*)(sK + (r0 + 32) * 72 + cc * 8) = rg[1];
    *(bf16x8*)(sVt + r0 * 72 + cc * 8) = rg[2];
    *(bf16x8*)(sVt + (r0 + 32) * 72 + cc * 8) = rg[3];
  };

  {
    const int ntiles = (t0 >> 10) + 1;
    const bf16_t* kb = p.KCMP + (size_t)bg * 256 * 64;
    const bf16_t* vb = p.VCMPT + (size_t)bg * 64 * 256;
    for (int pass = 0; pass < 2; pass++) {
      f32x4 o[4][2]; float m[2] = {-1e30f, -1e30f}, l[2] = {0.f, 0.f};
#pragma unroll
      for (int dt = 0; dt < 4; dt++) { o[dt][0] = (f32x4){0.f, 0.f, 0.f, 0.f}; o[dt][1] = (f32x4){0.f, 0.f, 0.f, 0.f}; }
      int ldn = 0;
      tile_pipeline<4>(ntiles,
        [&](int i, bf16x8 (&rg)[4]) {
          rg[0] = *(const bf16x8*)(kb + (size_t)(64 * i + r0) * 64 + cc * 8);
          rg[1] = *(const bf16x8*)(kb + (size_t)(64 * i + r0 + 32) * 64 + cc * 8);
          if (pass == 0) {
            rg[2] = *(const bf16x8*)(vb + (size_t)r0 * 256 + 64 * i + cc * 8);
            rg[3] = *(const bf16x8*)(vb + (size_t)(r0 + 32) * 256 + 64 * i + cc * 8);
          }
        },
        [&](int buf, bf16x8 (&rg)[4]) {
          const int nt = ldn++;
          if (pass == 1) {
#pragma unroll
            for (int i2 = 0; i2 < 2; i2++) {
              const int j = r0 + 32 * i2;
              bf16x8 ov;
#pragma unroll
              for (int x = 0; x < 8; x++) { int n = 64 * nt + cc * 8 + x; ov[x] = (n >= 4 * j - 1 && n <= 4 * j + 3) ? (short)0x3F80 : (short)0; }
              rg[2 + i2] = ov;
            }
          }
          store_kv(buf, rg);
        },
        [&](int i, int buf) {
          const bf16_t* sK = (const bf16_t*)(smem + buf * 27648);
          attn_tile<64, 64, 1>(sK, sK + 64 * 72, qf, o, m, l, c, true, true,
                               [&](int key, int qt) { return 16 * (64 * i + key) + 31 <= t0 + 16 * qt + lr; });
        });
      if (pass == 0) {
        emit(o, l, 0);
      } else {
        float inv[2];
#pragma unroll
        for (int qt = 0; qt < 2; qt++) inv[qt] = 1.f / fmaxf(l[qt], 1e-30f);
        for (int e2 = 0; e2 < 4; e2++) {
          if (wave == e2) {
#pragma unroll
            for (int dt = 0; dt < 4; dt++)
#pragma unroll
              for (int qt = 0; qt < 2; qt++)
#pragma unroll
                for (int i = 0; i < 4; i++) {
                  int j = 16 * dt + 4 * lg + i, q = 16 * qt + lr;
                  float v = o[dt][qt][i] * inv[qt];
                  if (e2 == 0) sImp[q * 65 + j] = v; else sImp[q * 65 + j] += v;
                }
          }
          __syncthreads();
        }
      }
    }
  }
  for (int qq = 0; qq < 8; qq++) {
    const int q = wave * 8 + qq;
    const int j = lane;
    float v = sImp[q * 65 + j];
    bool valid = j <= cur;
    bool forced = (j == 0) || (j == cur) || (j == cur - 1);
    float val = forced ? 1e9f : (valid ? v : -1e9f);
    int rank = 0;
#pragma unroll 16
    for (int jj = 0; jj < 64; jj++) {
      float ov = __int_as_float(__builtin_amdgcn_readlane(__float_as_int(val), jj));
      rank += ((ov > val) || (ov == val && jj < j)) ? 1 : 0;
    }
    unsigned long long mask = __ballot((rank < 16) && valid);
    if (lane == 0) sSel[q] = mask;
  }
  __syncthreads();
  unsigned long long any = 0ull;
  for (int q = 0; q < 32; q++) any |= sSel[q];
  unsigned long long mk[2];
  mk[0] = sSel[lr]; mk[1] = sSel[16 + lr];

  {
    f32x4 o[4][2]; float m[2] = {-1e30f, -1e30f}, l[2] = {0.f, 0.f};
#pragma unroll
    for (int dt = 0; dt < 4; dt++) { o[dt][0] = (f32x4){0.f, 0.f, 0.f, 0.f}; o[dt][1] = (f32x4){0.f, 0.f, 0.f, 0.f}; }
    const bf16_t* kb = p.KSC + (size_t)bg * S_LEN * 64;
    const bf16_t* vb = p.VST + (size_t)bg * 64 * S_LEN;
    const int ntiles = __popcll(any);
    int jl = 64, jc = 64;
    tile_pipeline<4>(ntiles,
      [&](int, bf16x8 (&rg)[4]) {
        jl = (jl > 0) ? next_bit_below(any, jl) : -1;
        const int jj = jl < 0 ? 0 : jl;
        rg[0] = *(const bf16x8*)(kb + (size_t)(64 * jj + r0) * 64 + cc * 8);
        rg[1] = *(const bf16x8*)(kb + (size_t)(64 * jj + r0 + 32) * 64 + cc * 8);
        rg[2] = *(const bf16x8*)(vb + (size_t)r0 * S_LEN + 64 * jj + cc * 8);
        rg[3] = *(const bf16x8*)(vb + (size_t)(r0 + 32) * S_LEN + 64 * jj + cc * 8);
      },
      store_kv,
      [&](int, int buf) {
        jc = next_bit_below(any, jc);
        const int j = jc;
        const bf16_t* sK = (const bf16_t*)(smem + buf * 27648);
        if (j == cur) {
          attn_tile<64, 64, 1>(sK, sK + 64 * 72, qf, o, m, l, c, true, true,
                               [&](int key, int qt) { return 64 * j + key <= t0 + 16 * qt + lr; });
        } else {
          attn_tile<64, 64, 0>(sK, sK + 64 * 72, qf, o, m, l, c, ((mk[0] >> j) & 1ull) != 0ull, ((mk[1] >> j) & 1ull) != 0ull,
                               [&](int, int) { return true; });
        }
      });
    emit(o, l, 1);
  }
  {
    f32x4 o[4][2]; float m[2] = {-1e30f, -1e30f}, l[2] = {0.f, 0.f};
#pragma unroll
    for (int dt = 0; dt < 4; dt++) { o[dt][0] = (f32x4){0.f, 0.f, 0.f, 0.f}; o[dt][1] = (f32x4){0.f, 0.f, 0.f, 0.f}; }
    const int jlo = (cur - 8 > 0) ? (cur - 8) : 0;
    const bf16_t* kb = p.KWC + (size_t)bg * S_LEN * 64;
    const bf16_t* vb = p.VWT + (size_t)bg * 64 * S_LEN;
    tile_pipeline<4>(cur - jlo + 1,
      [&](int i, bf16x8 (&rg)[4]) {
        const int j = cur - i;
        rg[0] = *(const bf16x8*)(kb + (size_t)(64 * j + r0) * 64 + cc * 8);
        rg[1] = *(const bf16x8*)(kb + (size_t)(64 * j + r0 + 32) * 64 + cc * 8);
        rg[2] = *(const bf16x8*)(vb + (size_t)r0 * S_LEN + 64 * j + cc * 8);
        rg[3] = *(const bf16x8*)(vb + (size_t)(r0 + 32) * S_LEN + 64 * j + cc * 8);
      },
      store_kv,
      [&](int i, int buf) {
        const int j = cur - i;
        const bf16_t* sK = (const bf16_t*)(smem + buf * 27648);
        if (j == cur || j == cur - 8) {
          attn_tile<64, 64, 1>(sK, sK + 64 * 72, qf, o, m, l, c, true, true, [&](int key, int qt) {
            int tq = t0 + 16 * qt + lr, kp = 64 * j + key;
            return (kp <= tq) && (kp > tq - 512);
          });
        } else {
          attn_tile<64, 64, 0>(sK, sK + 64 * 72, qf, o, m, l, c, true, true, [&](int, int) { return true; });
        }
      });
    emit(o, l, 2);
  }
}

__device__ void memattn_item(const Params& p, int item, char* smem) {
  const int tid = get_tid(), lane = tid & 63, wave = tid >> 6, lr = lane & 15, lg = lane >> 4;
  const int b = item >> 7, h = (item >> 5) & 3, qb = item & 31;
  const int t0 = qb * 128 + wave * 32;
  const size_t tokbase = (size_t)b * S_LEN + t0;
  bf16x8 qf[2][4];
#pragma unroll
  for (int qt = 0; qt < 2; qt++)
#pragma unroll
    for (int ks = 0; ks < 4; ks++) qf[qt][ks] = *(const bf16x8*)(p.PROJ + (tokbase + 16 * qt + lr) * NIN + C_QX + h * 128 + 32 * ks + 8 * lg);
  f32x4 o[8][2]; float m[2] = {-1e30f, -1e30f}, l[2] = {0.f, 0.f};
#pragma unroll
  for (int dt = 0; dt < 8; dt++) { o[dt][0] = (f32x4){0.f, 0.f, 0.f, 0.f}; o[dt][1] = (f32x4){0.f, 0.f, 0.f, 0.f}; }
  const float c = 0.08838834764831845f * LOG2E;
  const bf16_t* kb = p.KMEM + (size_t)b * 256 * 512 + h * 128;
  const bf16_t* vb = p.VMEMT + (size_t)(b * 4 + h) * 128 * 256;
  tile_pipeline1<8>(4,
    [&](int kt, bf16x8 (&rg)[8]) {
#pragma unroll
      for (int i = 0; i < 4; i++) {
        int ch = tid + 256 * i;
        rg[i] = *(const bf16x8*)(kb + (size_t)(64 * kt + (ch >> 4)) * 512 + (ch & 15) * 8);
        rg[4 + i] = *(const bf16x8*)(vb + (size_t)(ch >> 3) * 256 + 64 * kt + (ch & 7) * 8);
      }
    },
    [&](int buf, bf16x8 (&rg)[8]) {
      bf16_t* sK = (bf16_t*)(smem + buf * 35840);
      bf16_t* sVt = sK + 64 * 136;
#pragma unroll
      for (int i = 0; i < 4; i++) {
        int ch = tid + 256 * i;
        *(bf16x8*)(sK + (ch >> 4) * 136 + (ch & 15) * 8) = rg[i];
        *(bf16x8*)(sVt + (ch >> 3) * 72 + (ch & 7) * 8) = rg[4 + i];
      }
    },
    [&](int, int buf) {
      const bf16_t* sK = (const bf16_t*)(smem + buf * 35840);
      attn_tile<128, 128, 0>(sK, sK + 64 * 136, qf, o, m, l, c, true, true, [&](int, int) { return true; });
    });
#pragma unroll
  for (int qt = 0; qt < 2; qt++) {
    const size_t tok = tokbase + 16 * qt + lr;
    const float inv = 1.f / fmaxf(l[qt], 1e-30f);
#pragma unroll
    for (int dt = 0; dt < 8; dt++) {
      const int dbase = h * 128 + 16 * dt + 4 * lg;
      bf16x4 ga = *(const bf16x4*)(p.PROJ + tok * NIN + C_GX + dbase);
      f32x4 r = o[dt][qt];
      *(bf16x4*)(p.MIX + tok * 1536 + 1024 + dbase) =
          pack4(r[0] * inv * silu_f(bfs(ga[0])), r[1] * inv * silu_f(bfs(ga[1])), r[2] * inv * silu_f(bfs(ga[2])), r[3] * inv * silu_f(bfs(ga[3])));
    }
  }
}

__device__ void compress_item(const Params& p, int item, char* smem) {
  const int tid = get_tid(), lane = tid & 63, wave = tid >> 6, lr = lane & 15, lg = lane >> 4;
  const int which = item >> 7, rho0 = (item & 127) * 32;
  const bf16_t* W1T = which ? p.W1vT : p.W1kT;
  const bf16_t* W2T = which ? p.W2vT : p.W2kT;
  const float* pe = which ? p.cpv : p.cpk;
  const int col0 = which ? C_VC : C_KC;
  bf16_t* sA = (bf16_t*)smem;
  bf16_t* sW = sA + 32 * 72;
  bf16_t* sH = sW + 256 * 72;
  const int arow = tid >> 3, akc = tid & 7;
  const bf16_t* abase;
  {
    int rho = rho0 + arow; if (rho > 4079) rho = 4079;
    int b = rho / 510, rem = rho - b * 510, n = rem >> 1, g = rem & 1;
    abase = p.PROJ + ((size_t)b * S_LEN + 16 * n) * NIN + col0 + g * 64 + akc * 8;
  }
  const bf16_t* wbase = W1T + (size_t)arow * 2048 + akc * 8;
  f32x4 acc[2][4];
#pragma unroll
  for (int i = 0; i < 2; i++)
#pragma unroll
    for (int j = 0; j < 4; j++) acc[i][j] = (f32x4){0.f, 0.f, 0.f, 0.f};
  bf16x8 ra, rw[8];
  float4 rp0, rp1;
  auto load = [&](int kt) {
    ra = *(const bf16x8*)(abase + (size_t)kt * NIN);
    rp0 = *(const float4*)(pe + kt * 64 + akc * 8); rp1 = *(const float4*)(pe + kt * 64 + akc * 8 + 4);
#pragma unroll
    for (int i = 0; i < 8; i++) rw[i] = *(const bf16x8*)(wbase + (size_t)(32 * i) * 2048 + kt * 64);
  };
  load(0);
  for (int kt = 0; kt < 32; kt++) {
    __syncthreads();
    *(bf16x8*)(sA + arow * 72 + akc * 8) =
        pack8(bfs(ra[0]) + rp0.x, bfs(ra[1]) + rp0.y, bfs(ra[2]) + rp0.z, bfs(ra[3]) + rp0.w,
              bfs(ra[4]) + rp1.x, bfs(ra[5]) + rp1.y, bfs(ra[6]) + rp1.z, bfs(ra[7]) + rp1.w);
#pragma unroll
    for (int i = 0; i < 8; i++) *(bf16x8*)(sW + (arow + 32 * i) * 72 + akc * 8) = rw[i];
    __syncthreads();
    load(kt < 31 ? kt + 1 : 31);
#pragma unroll
    for (int ks = 0; ks < 2; ks++) {
      bf16x8 a0 = *(const bf16x8*)(sA + lr * 72 + ks * 32 + 8 * lg);
      bf16x8 a1 = *(const bf16x8*)(sA + (16 + lr) * 72 + ks * 32 + 8 * lg);
#pragma unroll
      for (int ct = 0; ct < 4; ct++) {
        bf16x8 bf = *(const bf16x8*)(sW + (64 * wave + 16 * ct + lr) * 72 + ks * 32 + 8 * lg);
        acc[0][ct] = mfma16(a0, bf, acc[0][ct]);
        acc[1][ct] = mfma16(a1, bf, acc[1][ct]);
      }
    }
  }
  __syncthreads();
#pragma unroll
  for (int rt = 0; rt < 2; rt++)
#pragma unroll
    for (int ct = 0; ct < 4; ct++)
#pragma unroll
      for (int i = 0; i < 4; i++) sH[(16 * rt + 4 * lg + i) * 264 + 64 * wave + 16 * ct + lr] = f2bf(silu_f(acc[rt][ct][i]));
  __syncthreads();
  f32x4 acc2[2] = {(f32x4){0.f, 0.f, 0.f, 0.f}, (f32x4){0.f, 0.f, 0.f, 0.f}};
#pragma unroll
  for (int ks = 0; ks < 8; ks++) {
    bf16x8 bf = *(const bf16x8*)(W2T + (size_t)(16 * wave + lr) * 256 + 32 * ks + 8 * lg);
#pragma unroll
    for (int rt = 0; rt < 2; rt++) {
      bf16x8 a = *(const bf16x8*)(sH + (16 * rt + lr) * 264 + 32 * ks + 8 * lg);
      acc2[rt] = mfma16(a, bf, acc2[rt]);
    }
  }
  const int col = 16 * wave + lr;
#pragma unroll
  for (int rt = 0; rt < 2; rt++)
#pragma unroll
    for (int i = 0; i < 4; i++) {
      int rho = rho0 + 16 * rt + 4 * lg + i;
      bool ok = rho < 4080;
      int rc = ok ? rho : 4079;
      int b = rc / 510, rem = rc - b * 510, n = rem >> 1, g = rem & 1;
      float v = acc2[rt][i];
      float pr = __shfl_xor(v, 8);
      if (which == 0) {
        if (wave == 0) {
          int pos = p.pos[b * S_LEN + 16 * n + 31];
          float cs, sn; rope_cs(pos, lr & 7, cs, sn);
          v = (lr < 8) ? (v * cs - pr * sn) : (v * cs + pr * sn);
        }
        if (ok) p.KCMP[((size_t)(b * 2 + g) * 256 + n) * 64 + col] = f2bf(v);
      } else {
        if (ok) p.VCMPT[((size_t)(b * 2 + g) * 64 + col) * 256 + n] = f2bf(v);
      }
    }
}

__device__ void conv_units(const Params& p, int u) {
  const int it = u >> 8, wvi = (u >> 6) & 3, ln = u & 63;
  const int cgp = ((it & 3) * 4 + wvi) * 8 + (ln >> 3), tg = (it >> 2) * 8 + (ln & 7);
  const int tok0 = tg * 8, s0 = tok0 & 4095, ch0 = cgp * 8;
  const int b = tok0 >> 12;
  bf16x8 in[11];
#pragma unroll
  for (int r = 0; r < 11; r++) {
    int s = s0 - 3 + r;
    if (s >= 0) in[r] = *(const bf16x8*)(p.PROJ + (size_t)(tok0 - 3 + r) * NIN + C_XBC + ch0);
    else in[r] = (bf16x8){0, 0, 0, 0, 0, 0, 0, 0};
  }
  float4 wv[4][2];
#pragma unroll
  for (int k = 0; k < 4; k++) { wv[k][0] = *(const float4*)(p.conv_w + k * 1024 + ch0); wv[k][1] = *(const float4*)(p.conv_w + k * 1024 + ch0 + 4); }
  float4 bv0 = *(const float4*)(p.conv_b + ch0), bv1 = *(const float4*)(p.conv_b + ch0 + 4);
  float w[4][8], bias[8];
#pragma unroll
  for (int k = 0; k < 4; k++) { w[k][0] = wv[k][0].x; w[k][1] = wv[k][0].y; w[k][2] = wv[k][0].z; w[k][3] = wv[k][0].w; w[k][4] = wv[k][1].x; w[k][5] = wv[k][1].y; w[k][6] = wv[k][1].z; w[k][7] = wv[k][1].w; }
  bias[0] = bv0.x; bias[1] = bv0.y; bias[2] = bv0.z; bias[3] = bv0.w; bias[4] = bv1.x; bias[5] = bv1.y; bias[6] = bv1.z; bias[7] = bv1.w;
  if (ch0 >= 512) {
#pragma unroll
    for (int tt = 0; tt < 8; tt++) {
      bf16x8 o;
#pragma unroll
      for (int j = 0; j < 8; j++) {
        float a = bias[j];
#pragma unroll
        for (int k = 0; k < 4; k++) a += bfs(in[tt + k][j]) * w[k][j];
        o[j] = (short)f2bf(silu_f(a));
      }
      *(bf16x8*)(p.BC + (size_t)(tok0 + tt) * 512 + (ch0 - 512)) = o;
    }
  }
  if (ch0 < 768) {
#pragma unroll
    for (int j = 0; j < 8; j++) {
      bf16x8 o;
#pragma unroll
      for (int tt = 0; tt < 8; tt++) {
        float a = bias[j];
#pragma unroll
        for (int k = 0; k < 4; k++) a += bfs(in[tt + k][j]) * w[k][j];
        o[tt] = (short)f2bf(silu_f(a));
      }
      const int ch = ch0 + j;
      bf16_t* dst;
      if (ch0 < 512) dst = p.XT + ((size_t)(b * 8 + (ch >> 6)) * 64 + (ch & 63)) * S_LEN + s0;
      else dst = p.BT + ((size_t)(b * 2 + ((ch - 512) >> 7)) * 128 + ((ch - 512) & 127)) * S_LEN + s0;
      *(bf16x8*)dst = o;
    }
  }
}

__device__ void ssd_states_item(const Params& p, int item, char* smem) {
  const int tid = get_tid(), lane = tid & 63, wave = tid >> 6, lr = lane & 15, lg = lane >> 4;
  const int h = item & 7, c = (item >> 3) & 31, b = item >> 8;
  const int g = h >> 2;
  float* sAcs = (float*)smem;
  float* sW = sAcs + 128;
  float* sTot = sW + 128;
  const size_t tok0 = (size_t)b * S_LEN + c * 128;
  __syncthreads();
  float dt = 0.f, cs = 0.f;
  if (tid < 128) {
    float raw = bf2f(p.PROJ[(tok0 + tid) * NIN + C_DT + h]) + p.dt_bias[h];
    dt = fmaxf(raw, 0.f) + log1pf(__expf(-fabsf(raw)));
    float a = -__expf(p.a_log[h]);
    cs = dt * a;
#pragma unroll
    for (int o = 1; o < 64; o <<= 1) { float t = __shfl_up(cs, o); if (lane >= o) cs += t; }
    if (lane == 63) sTot[wave] = cs;
  }
  __syncthreads();
  if (tid < 128) {
    if (wave == 1) cs += sTot[0];
    sAcs[tid] = cs;
  }
  __syncthreads();
  if (tid < 128) {
    float last = sAcs[127];
    sW[tid] = dt * __expf(last - cs);
    const size_t o = ((size_t)(b * 32 + c) * 8 + h) * 128 + tid;
    p.ACS[o] = cs; p.DTV[o] = dt;
    if (tid == 0) p.CHDEC[(b * 32 + c) * 8 + h] = __expf(last);
  }
  __syncthreads();
  f32x4 acc[4][2];
#pragma unroll
  for (int i = 0; i < 4; i++) { acc[i][0] = (f32x4){0.f, 0.f, 0.f, 0.f}; acc[i][1] = (f32x4){0.f, 0.f, 0.f, 0.f}; }
  const bf16_t* xt = p.XT + (size_t)(b * 8 + h) * 64 * S_LEN + c * 128;
  const bf16_t* bt = p.BT + (size_t)(b * 2 + g) * 128 * S_LEN + c * 128;
#pragma unroll
  for (int ks = 0; ks < 4; ks++) {
    const int l0 = 32 * ks + 8 * lg;
    float4 w0 = *(const float4*)(sW + l0), w1 = *(const float4*)(sW + l0 + 4);
    bf16x8 bf0 = *(const bf16x8*)(bt + (size_t)(32 * wave + lr) * S_LEN + l0);
    bf16x8 bf1 = *(const bf16x8*)(bt + (size_t)(32 * wave + 16 + lr) * S_LEN + l0);
#pragma unroll
    for (int pt = 0; pt < 4; pt++) {
      bf16x8 raw = *(const bf16x8*)(xt + (size_t)(16 * pt + lr) * S_LEN + l0);
      bf16x8 a;
      a[0] = (short)f2bf(bfs(raw[0]) * w0.x); a[1] = (short)f2bf(bfs(raw[1]) * w0.y); a[2] = (short)f2bf(bfs(raw[2]) * w0.z); a[3] = (short)f2bf(bfs(raw[3]) * w0.w);
      a[4] = (short)f2bf(bfs(raw[4]) * w1.x); a[5] = (short)f2bf(bfs(raw[5]) * w1.y); a[6] = (short)f2bf(bfs(raw[6]) * w1.z); a[7] = (short)f2bf(bfs(raw[7]) * w1.w);
      acc[pt][0] = mfma16(a, bf0, acc[pt][0]);
      acc[pt][1] = mfma16(a, bf1, acc[pt][1]);
    }
  }
  float* st = p.STATES + ((size_t)(b * 32 + c) * 8 + h) * 8192;
#pragma unroll
  for (int pt = 0; pt < 4; pt++)
#pragma unroll
    for (int x = 0; x < 2; x++)
#pragma unroll
      for (int i = 0; i < 4; i++) st[(16 * pt + 4 * lg + i) * 128 + 32 * wave + 16 * x + lr] = acc[pt][x][i];
}

__device__ void scan_units(const Params& p, int q) {
  const int b = q >> 16, r = q & 65535, h = r >> 13;
  float hs = 0.f;
  for (int c0 = 0; c0 < 32; c0 += 16) {
    float s[16], d[16];
#pragma unroll
    for (int i = 0; i < 16; i++) { s[i] = p.STATES[(size_t)(b * 32 + c0 + i) * 65536 + r]; d[i] = p.CHDEC[(b * 32 + c0 + i) * 8 + h]; }
#pragma unroll
    for (int i = 0; i < 16; i++) { p.STATES[(size_t)(b * 32 + c0 + i) * 65536 + r] = hs; hs = hs * d[i] + s[i]; }
  }
}

__device__ void ssd_y_item(const Params& p, int item, char* smem) {
  const int tid = get_tid(), lane = tid & 63, wave = tid >> 6, lr = lane & 15, lg = lane >> 4;
  const int h = item & 7, c = (item >> 3) & 31, b = item >> 8;
  const int g = h >> 2;
  bf16_t* sB = (bf16_t*)smem;
  bf16_t* sXT = sB + 128 * 136;
  float* sAcs = (float*)(smem + (128 + 64) * 136 * 2);
  float* sDt = sAcs + 128;
  bf16_t* sPrev = (bf16_t*)(smem + (128 + 64) * 136 * 2 + 1024);
  const size_t tok0 = (size_t)b * S_LEN + c * 128;
  const bf16_t* xt = p.XT + (size_t)(b * 8 + h) * 64 * S_LEN + c * 128;
  const int LT[2] = {wave, 7 - wave};
  const float* prev = p.STATES + ((size_t)(b * 32 + c) * 8 + h) * 8192;
  __syncthreads();
  {
    bf16x8 tb[8], tx[4];
    float4 tp[8];
#pragma unroll
    for (int i = 0; i < 8; i++) { int ch = tid + 256 * i; tp[i] = *(const float4*)(prev + (ch >> 5) * 128 + (ch & 31) * 4); }
#pragma unroll
    for (int i = 0; i < 8; i++) { int ch = tid + 256 * i; tb[i] = *(const bf16x8*)(p.BC + (tok0 + (ch >> 4)) * 512 + g * 128 + (ch & 15) * 8); }
#pragma unroll
    for (int i = 0; i < 4; i++) { int ch = tid + 256 * i; tx[i] = *(const bf16x8*)(xt + (size_t)(ch >> 4) * S_LEN + (ch & 15) * 8); }
    if (tid < 128) {
      const size_t o = ((size_t)(b * 32 + c) * 8 + h) * 128 + tid;
      sAcs[tid] = p.ACS[o]; sDt[tid] = p.DTV[o];
    }
#pragma unroll
    for (int i = 0; i < 8; i++) { int ch = tid + 256 * i; *(bf16x8*)(sB + (ch >> 4) * 136 + (ch & 15) * 8) = tb[i]; }
#pragma unroll
    for (int i = 0; i < 4; i++) { int ch = tid + 256 * i; *(bf16x8*)(sXT + (ch >> 4) * 136 + (ch & 15) * 8) = tx[i]; }
#pragma unroll
    for (int i = 0; i < 8; i++) { int ch = tid + 256 * i; *(bf16x4*)(sPrev + (ch >> 5) * 136 + (ch & 31) * 4) = pack4(tp[i].x, tp[i].y, tp[i].z, tp[i].w); }
  }
  bf16x8 cf[2][4];
  bf16x4 zpre[2][4];
#pragma unroll
  for (int li = 0; li < 2; li++) {
#pragma unroll
    for (int ks = 0; ks < 4; ks++)
      cf[li][ks] = *(const bf16x8*)(p.BC + (tok0 + 16 * LT[li] + lr) * 512 + 256 + g * 128 + 32 * ks + 8 * lg);
#pragma unroll
    for (int pt = 0; pt < 4; pt++)
      zpre[li][pt] = *(const bf16x4*)(p.PROJ + (tok0 + 16 * LT[li] + lr) * NIN + C_Z + h * 64 + 16 * pt + 4 * lg);
  }
  f32x4 acc[4][2];
#pragma unroll
  for (int i = 0; i < 4; i++) { acc[i][0] = (f32x4){0.f, 0.f, 0.f, 0.f}; acc[i][1] = (f32x4){0.f, 0.f, 0.f, 0.f}; }
  __syncthreads();
#pragma unroll
  for (int pt = 0; pt < 4; pt++)
#pragma unroll
    for (int ks = 0; ks < 4; ks++) {
      bf16x8 a = *(const bf16x8*)(sPrev + (16 * pt + lr) * 136 + 32 * ks + 8 * lg);
      acc[pt][0] = mfma16(a, cf[0][ks], acc[pt][0]);
      acc[pt][1] = mfma16(a, cf[1][ks], acc[pt][1]);
    }
#pragma unroll
  for (int li = 0; li < 2; li++) {
    float e = __expf(sAcs[16 * LT[li] + lr]);
#pragma unroll
    for (int pt = 0; pt < 4; pt++) { acc[pt][li][0] *= e; acc[pt][li][1] *= e; acc[pt][li][2] *= e; acc[pt][li][3] *= e; }
  }
#pragma unroll
  for (int li = 0; li < 2; li++) {
    const int lt = LT[li];
    const int lpos = 16 * lt + lr;
    const float acl = sAcs[lpos];
    for (int sp = 0; sp <= (lt >> 1); sp++) {
      f32x4 cb[2] = {(f32x4){0.f, 0.f, 0.f, 0.f}, (f32x4){0.f, 0.f, 0.f, 0.f}};
#pragma unroll
      for (int x = 0; x < 2; x++)
#pragma unroll
        for (int ks = 0; ks < 4; ks++) {
          bf16x8 bfr = *(const bf16x8*)(sB + (32 * sp + 16 * x + lr) * 136 + 32 * ks + 8 * lg);
          cb[x] = mfma16(bfr, cf[li][ks], cb[x]);
        }
      float mv[8];
#pragma unroll
      for (int x = 0; x < 2; x++)
#pragma unroll
        for (int i = 0; i < 4; i++) {
          const int s = 32 * sp + 16 * x + 4 * lg + i;
          mv[4 * x + i] = (s <= lpos) ? cb[x][i] * __expf(acl - sAcs[s]) * sDt[s] : 0.f;
        }
      bf16x8 mb = pack8(mv[0], mv[1], mv[2], mv[3], mv[4], mv[5], mv[6], mv[7]);
#pragma unroll
      for (int pt = 0; pt < 4; pt++) {
        const bf16_t* xp = sXT + (16 * pt + lr) * 136 + 32 * sp + 4 * lg;
        bf16x8 a = cat44(*(const bf16x4*)xp, *(const bf16x4*)(xp + 16));
        acc[pt][li] = mfma16(a, mb, acc[pt][li]);
      }
    }
  }
  const float dsk = p.d_skip[h];
#pragma unroll
  for (int li = 0; li < 2; li++) {
    const int lpos = 16 * LT[li] + lr;
    const size_t tok = tok0 + lpos;
    float ss = 0.f;
#pragma unroll
    for (int pt = 0; pt < 4; pt++) {
      const int pb = 16 * pt + 4 * lg;
      bf16x4 zv = zpre[li][pt];
      float y[4];
#pragma unroll
      for (int i = 0; i < 4; i++) {
        float xv = bf2f(sXT[(pb + i) * 136 + lpos]);
        y[i] = (acc[pt][li][i] + dsk * xv) * silu_f(bfs(zv[i]));
        ss += y[i] * y[i];
      }
      *(bf16x4*)(p.MIX + tok * 1536 + 512 + h * 64 + pb) = pack4(y[0], y[1], y[2], y[3]);
    }
    ss += __shfl_xor(ss, 16); ss += __shfl_xor(ss, 32);
    if (lg == 0) p.SS_SSD[tok * 8 + h] = ss;
  }
}

__device__ void final_rows(const Params& p, int gw, int nw) {
  const int lane = threadIdx.x & 63;
  for (int row = gw; row < T_TOK; row += nw) {
    float r = rsqrtf(p.SS_OUT[row] * (1.f / 1024.f) + 1e-6f);
    float4* o = (float4*)(p.out + (size_t)row * 1024);
    const float4* gf = (const float4*)p.g_final;
#pragma unroll
    for (int i = 0; i < 4; i++) {
      float4 v = o[lane + 64 * i], gg = gf[lane + 64 * i];
      v.x *= r * gg.x; v.y *= r * gg.y; v.z *= r * gg.z; v.w *= r * gg.w;
      o[lane + 64 * i] = v;
    }
  }
}

__device__ __forceinline__ void grid_bar(unsigned* bar, unsigned k) {
  asm volatile("s_waitcnt vmcnt(0)" ::: "memory");
  __syncthreads();
  if (threadIdx.x == 0) {
    const unsigned nb = gridDim.x, r = blockIdx.x & 7u;
    const unsigned nsub = (nb - r + 7u) >> 3;
    const unsigned ngrp = nb < 8u ? nb : 8u;
    __builtin_amdgcn_fence(__ATOMIC_RELEASE, "agent");
    asm volatile("s_waitcnt vmcnt(0)" ::: "memory");
    const unsigned old = __hip_atomic_fetch_add(bar + 64 * r, 1u, __ATOMIC_RELAXED, __HIP_MEMORY_SCOPE_AGENT);
    if (old + 1u == k * nsub) {
      __builtin_amdgcn_fence(__ATOMIC_ACQ_REL, "agent");
      asm volatile("s_waitcnt vmcnt(0)" ::: "memory");
      __hip_atomic_fetch_add(bar + 64 * 8, 1u, __ATOMIC_RELAXED, __HIP_MEMORY_SCOPE_AGENT);
    }
    while (__hip_atomic_load(bar + 64 * 8, __ATOMIC_RELAXED, __HIP_MEMORY_SCOPE_AGENT) < k * ngrp) __builtin_amdgcn_s_sleep(1);
    __builtin_amdgcn_fence(__ATOMIC_ACQUIRE, "agent");
    asm volatile("s_waitcnt vmcnt(0)" ::: "memory");
  }
  __syncthreads();
}

__device__ __forceinline__ int next_item(unsigned* ctr, char* smem) {
  int* sh = (int*)(smem + SMEM_BYTES - 16);
  __syncthreads();
  if (threadIdx.x == 0) *sh = (int)__hip_atomic_fetch_add(ctr, 1u, __ATOMIC_RELAXED, __HIP_MEMORY_SCOPE_AGENT);
  __syncthreads();
  return *sh;
}

__global__ void __launch_bounds__(256, 2) hymba_fwd(Params p) {
  cg::grid_group grid = cg::this_grid();
  __shared__ __attribute__((aligned(16))) char smem[SMEM_BYTES];
  const int nb = gridDim.x, bid = blockIdx.x;
  unsigned bk = 0;

  if (p.out == nullptr) grid.sync();
  for (int rep = 0; rep < REP0; rep++) {
  phase_prep(p);
  grid_bar(p.BAR, ++bk);
  }
  for (int rep = 0; rep < REP1; rep++) {
  if ((nb & 7) == 0) {
    const int xcd = bid & 7, li = bid >> 3, nbx = nb >> 3;
    for (int e = li; e < 1120; e += nbx) {
      const int grp = e / 280, r = e - grp * 280;
      gemm_tile<0>(p, xcd * 32 + grp * 8 + (r & 7), r >> 3, smem);
    }
  } else {
    for (int it = bid; it < 256 * 35; it += nb) gemm_tile<0>(p, it / 35, it % 35, smem);
  }
  for (int j = bid; j < 128; j += nb) gemm_tile<1>(p, j >> 3, j & 7, smem);
  grid_bar(p.BAR, ++bk);
  }
  for (int rep = 0; rep < REP2; rep++) {
  for (int it = next_item(p.BAR + 64 * (9 + rep), smem); it < 256 + 1024 + 2048; it = next_item(p.BAR + 64 * (9 + rep), smem)) {
    if (it < 256) compress_item(p, it, smem);
    else if (it < 1280) memattn_item(p, it - 256, smem);
    else conv_units(p, (it - 1280) * 256 + get_tid());
  }
  grid_bar(p.BAR, ++bk);
  }
  for (int rep = 0; rep < REP3; rep++) {
  {
    const int xq = bid & 7;
    unsigned* ctr = p.BAR + 64 * (16 + xq + 8 * rep);
    for (int li = next_item(ctr, smem); li < 512; li = next_item(ctr, smem)) {
      if (li < 256) nsa_item(p, ((li >> 1) << 4) | (xq + 8 * (li & 1)), smem);
      else ssd_states_item(p, (li - 256) * 8 + xq, smem);
    }
  }
  grid_bar(p.BAR, ++bk);
  }
  for (int it = bid; it < 2048; it += nb) scan_units(p, it * 256 + get_tid());
  grid_bar(p.BAR, ++bk);
  for (int rep = 0; rep < REP5; rep++) {
  for (int it = bid; it < 2048; it += nb) ssd_y_item(p, it, smem);
  grid_bar(p.BAR, ++bk);
  }
  if ((nb & 7) == 0) {
    const int xcd = bid & 7, li = bid >> 3, nbx = nb >> 3;
    for (int e = li; e < 256; e += nbx) gemm_tile<2>(p, xcd * 32 + (e >> 3), e & 7, smem);
  } else {
    for (int it = bid; it < 256 * 8; it += nb) gemm_tile<2>(p, it >> 3, it & 7, smem);
  }
  grid_bar(p.BAR, ++bk);
  final_rows(p, (bid * 256 + threadIdx.x) >> 6, (nb * 256) >> 6);
}

extern "C" void kernel_launch(void* const* d_in, const int* in_sizes, int n_in, void* d_out, int out_size, void* d_ws, size_t ws_size,
                              hipStream_t stream) {
  static int grid_blocks = 0;
  if (!grid_blocks) {
    int dev = 0, cus = 0, per_cu = 0;
    hipGetDevice(&dev);
    hipDeviceGetAttribute(&cus, hipDeviceAttributeMultiprocessorCount, dev);
    hipOccupancyMaxActiveBlocksPerMultiprocessor(&per_cu, hymba_fwd, 256, 0);
    if (per_cu < 1) per_cu = 1;
    if (per_cu > 4) per_cu = 4;
    grid_blocks = cus * per_cu;
  }
  Params p{};
  p.x = (const float*)d_in[0]; p.mem = (const float*)d_in[1]; p.pos = (const int*)d_in[2];
  p.g_in = (const float*)d_in[3]; p.w_in = (const float*)d_in[4]; p.cpk = (const float*)d_in[5];
  p.w1k = (const float*)d_in[6]; p.w2k = (const float*)d_in[7]; p.cpv = (const float*)d_in[8];
  p.w1v = (const float*)d_in[9]; p.w2v = (const float*)d_in[10]; p.conv_w = (const float*)d_in[11];
  p.conv_b = (const float*)d_in[12]; p.dt_bias = (const float*)d_in[13]; p.a_log = (const float*)d_in[14];
  p.d_skip = (const float*)d_in[15]; p.g_ssd = (const float*)d_in[16]; p.g_mem = (const float*)d_in[17];
  p.w_kv = (const float*)d_in[18]; p.w_out = (const float*)d_in[19]; p.g_final = (const float*)d_in[20];
  p.out = (float*)d_out;
  char* w = (char*)d_ws; size_t off = 0;
  auto take = [&](size_t bytes) { char* r = w + off; off += (bytes + 255) & ~(size_t)255; return r; };
  p.WinT = (bf16_t*)take((size_t)NINP * 1024 * 2);
  p.WoutT = (bf16_t*)take((size_t)1024 * 1536 * 2);
  p.WkvT = (bf16_t*)take((size_t)1024 * 1024 * 2);
  p.W1kT = (bf16_t*)take((size_t)256 * 2048 * 2);
  p.W1vT = (bf16_t*)take((size_t)256 * 2048 * 2);
  p.W2kT = (bf16_t*)take((size_t)64 * 256 * 2);
  p.W2vT = (bf16_t*)take((size_t)64 * 256 * 2);
  p.MEMB = (bf16_t*)take((size_t)2048 * 1024 * 2);
  p.PROJ = (bf16_t*)take((size_t)T_TOK * NIN * 2);
  p.VST = (bf16_t*)take((size_t)16 * 64 * S_LEN * 2);
  p.VWT = (bf16_t*)take((size_t)16 * 64 * S_LEN * 2);
  p.KMEM = (bf16_t*)take((size_t)2048 * 512 * 2);
  p.VMEMT = (bf16_t*)take((size_t)32 * 128 * 256 * 2);
  p.KCMP = (bf16_t*)take((size_t)16 * 256 * 64 * 2);
  p.VCMPT = (bf16_t*)take((size_t)16 * 64 * 256 * 2);
  p.XT = (bf16_t*)take((size_t)64 * 64 * S_LEN * 2);
  p.BC = (bf16_t*)take((size_t)T_TOK * 512 * 2);
  p.BT = (bf16_t*)take((size_t)16 * 128 * S_LEN * 2);
  p.MIX = (bf16_t*)take((size_t)T_TOK * 1536 * 2);
  p.XB = p.MIX;
  p.CHDEC = (float*)take((size_t)8 * 32 * 8 * 4);
  p.ACS = (float*)take((size_t)8 * 32 * 8 * 128 * 4);
  p.DTV = (float*)take((size_t)8 * 32 * 8 * 128 * 4);
  p.SS_SSD = (float*)take((size_t)T_TOK * 8 * 4);
  p.SS_OUT = (float*)take((size_t)T_TOK * 4);
  p.BAR = (unsigned*)take((size_t)(64 * 32 + 256) * 4);
  p.MTCNT = p.BAR + 64 * 32;
  p.STATES = (float*)d_out;
  p.KSC = (bf16_t*)((char*)d_out + (size_t)80 * 1024 * 1024);
  p.KWC = p.KSC + (size_t)16 * S_LEN * 64;
  if (off > ws_size) { fprintf(stderr, "workspace too small: need %zu have %zu\n", off, ws_size); return; }
  hipMemsetAsync(p.BAR, 0, (64 * 32 + 256) * 4, stream);
  void* args[] = {&p};
  hipError_t e = hipLaunchCooperativeKernel((void*)hymba_fwd, dim3(grid_blocks), dim3(256), args, 0, stream);
  if (e != hipSuccess) fprintf(stderr, "cooperative launch failed: %s (grid %d)\n", hipGetErrorString(e), grid_blocks);
}
```

```cpp
#include <hip/hip_runtime.h>
#include <hip/hip_cooperative_groups.h>
#include <stdint.h>
#include <stdio.h>
namespace cg = cooperative_groups;

typedef unsigned short bf16_t;
typedef __attribute__((ext_vector_type(8))) short bf16x8;
typedef __attribute__((ext_vector_type(4))) short bf16x4;
typedef __attribute__((ext_vector_type(4))) float f32x4;

#define S_LEN 4096
#define T_TOK 32768
#define NIN 4384
#define NINP 4480
#define LOG2E 1.4426950408889634f

#define C_Q 0
#define C_KC 512
#define C_VC 640
#define C_KS 768
#define C_KW 1024
#define C_GL 1280
#define C_GA 1304
#define C_Z 1816
#define C_XBC 2328
#define C_DT 3352
#define C_QX 3360
#define C_GX 3872

#define SMEM_BYTES 73728
#ifndef REP0
#define REP0 1
#endif
#ifndef REP1
#define REP1 1
#endif
#ifndef REP2
#define REP2 1
#endif
#ifndef REP3
#define REP3 1
#endif
#ifndef REP5
#define REP5 1
#endif

struct Params {
  const float *x, *mem; const int* pos;
  const float *g_in, *w_in, *cpk, *w1k, *w2k, *cpv, *w1v, *w2v, *conv_w, *conv_b, *dt_bias, *a_log, *d_skip, *g_ssd, *g_mem, *w_kv, *w_out, *g_final;
  float* out;
  bf16_t *WinT, *WoutT, *WkvT, *W1kT, *W1vT, *W2kT, *W2vT, *XB, *MEMB, *PROJ, *VST, *VWT, *KMEM, *VMEMT, *KCMP, *VCMPT, *XT, *BC, *BT, *MIX, *KSC, *KWC;
  float *STATES, *CHDEC, *ACS, *DTV, *SS_SSD, *SS_OUT;
  unsigned* BAR;
  unsigned* MTCNT;
};

__device__ __forceinline__ bf16_t f2bf(float f) { uint32_t u = __float_as_uint(f); u += 0x7fffu + ((u >> 16) & 1u); return (bf16_t)(u >> 16); }
__device__ __forceinline__ float bf2f(bf16_t h) { return __uint_as_float(((uint32_t)h) << 16); }
__device__ __forceinline__ float bfs(short h) { return __uint_as_float(((uint32_t)(unsigned short)h) << 16); }
__device__ __forceinline__ float fexp2(float x) { return __builtin_amdgcn_exp2f(x); }
__device__ __forceinline__ float silu_f(float x) { return x * __builtin_amdgcn_rcpf(1.f + __builtin_amdgcn_exp2f(-1.4426950408889634f * x)); }
__device__ __forceinline__ float sigmoid_f(float x) { return __builtin_amdgcn_rcpf(1.f + __builtin_amdgcn_exp2f(-1.4426950408889634f * x)); }
__device__ __forceinline__ f32x4 mfma16(bf16x8 a, bf16x8 b, f32x4 c) { return __builtin_amdgcn_mfma_f32_16x16x32_bf16(a, b, c, 0, 0, 0); }
typedef __bf16 hbf2_t __attribute__((ext_vector_type(2)));
typedef float f2_t __attribute__((ext_vector_type(2)));
typedef uint32_t u32x2 __attribute__((ext_vector_type(2)));
typedef uint32_t u32x4 __attribute__((ext_vector_type(4)));
__device__ __forceinline__ uint32_t pk2(float a, float b) {
  f2_t v; v[0] = a; v[1] = b;
  hbf2_t r = __builtin_convertvector(v, hbf2_t);
  return __builtin_bit_cast(uint32_t, r);
}
__device__ __forceinline__ bf16x4 pack4(float a, float b, float c, float d) {
  u32x2 r; r[0] = pk2(a, b); r[1] = pk2(c, d); return __builtin_bit_cast(bf16x4, r);
}
__device__ __forceinline__ bf16x8 pack8(float a, float b, float c, float d, float e, float f, float g, float h) {
  u32x4 r; r[0] = pk2(a, b); r[1] = pk2(c, d); r[2] = pk2(e, f); r[3] = pk2(g, h); return __builtin_bit_cast(bf16x8, r);
}
__device__ __forceinline__ bf16x8 cat44(bf16x4 a, bf16x4 b) {
  u32x2 x = __builtin_bit_cast(u32x2, a), y = __builtin_bit_cast(u32x2, b);
  u32x4 r; r[0] = x[0]; r[1] = x[1]; r[2] = y[0]; r[3] = y[1]; return __builtin_bit_cast(bf16x8, r);
}
template <int NR, typename L, typename ST, typename C>
__device__ __forceinline__ void tile_pipeline(int n, L load, ST store, C compute) {
  if (n <= 0) return;
  bf16x8 ra[NR], rb[NR];
  const int last = n - 1;
  load(0, ra);
  load(min(1, last), rb);
  store(0, ra);
  load(min(2, last), ra);
  __syncthreads();
  for (int i = 0; i < n; i += 2) {
    compute(i, 0);
    store(1, rb);
    load(min(i + 3, last), rb);
    __syncthreads();
    if (i + 1 < n) compute(i + 1, 1);
    store(0, ra);
    load(min(i + 4, last), ra);
    __syncthreads();
  }
}
template <int NR, typename L, typename ST, typename C>
__device__ __forceinline__ void tile_pipeline1(int n, L load, ST store, C compute) {
  if (n <= 0) return;
  bf16x8 ra[NR];
  load(0, ra);
  store(0, ra);
  if (n > 1) load(1, ra);
  __syncthreads();
  for (int i = 0; i < n; i++) {
    compute(i, i & 1);
    if (i + 1 < n) { store((i + 1) & 1, ra); if (i + 2 < n) load(i + 2, ra); }
    __syncthreads();
  }
}
__device__ __forceinline__ void rope_cs(int pos, int j, float& cs, float& sn) {
  float inv = fexp2(-(float)j * (18.931568569324174f / 8.f));
  float a = (float)pos * inv;
  float n = rintf(a * 0.15915494309189535f);
  float r = fmaf(-n, 6.28125f, a);
  r = fmaf(-n, 1.9353071795864769e-3f, r);
  cs = __cosf(r); sn = __sinf(r);
}

__device__ __forceinline__ float rowmax4(float x) {
  unsigned xi = __float_as_uint(x);
  auto a = __builtin_amdgcn_permlane16_swap(xi, xi, false, false);
  float m = fmaxf(__uint_as_float(a[0]), __uint_as_float(a[1]));
  unsigned mi = __float_as_uint(m);
  auto b = __builtin_amdgcn_permlane32_swap(mi, mi, false, false);
  return fmaxf(__uint_as_float(b[0]), __uint_as_float(b[1]));
}
__device__ __forceinline__ float rowsum4(float x) {
  unsigned xi = __float_as_uint(x);
  auto a = __builtin_amdgcn_permlane16_swap(xi, xi, false, false);
  float m = __uint_as_float(a[0]) + __uint_as_float(a[1]);
  unsigned mi = __float_as_uint(m);
  auto b = __builtin_amdgcn_permlane32_swap(mi, mi, false, false);
  return __uint_as_float(b[0]) + __uint_as_float(b[1]);
}
__device__ __forceinline__ int get_tid() { int t = threadIdx.x; asm volatile("" : "+v"(t)); return t; }

__device__ void prep_rows(const float* __restrict__ x, bf16_t* __restrict__ xb, int nrows, int gw, int nw) {
  const int lane = threadIdx.x & 63;
  int row = gw;
  for (; row + 3 * nw < nrows; row += 4 * nw) {
    float4 v[4][4]; float ss[4];
#pragma unroll
    for (int r = 0; r < 4; r++) {
      const float4* p = (const float4*)(x + (size_t)(row + r * nw) * 1024);
#pragma unroll
      for (int i = 0; i < 4; i++) v[r][i] = p[lane + 64 * i];
    }
#pragma unroll
    for (int r = 0; r < 4; r++) {
      float s = 0.f;
#pragma unroll
      for (int i = 0; i < 4; i++) s += v[r][i].x * v[r][i].x + v[r][i].y * v[r][i].y + v[r][i].z * v[r][i].z + v[r][i].w * v[r][i].w;
#pragma unroll
      for (int o = 32; o >= 1; o >>= 1) s += __shfl_xor(s, o);
      ss[r] = rsqrtf(s * (1.f / 1024.f) + 1e-6f);
    }
#pragma unroll
    for (int r = 0; r < 4; r++)
#pragma unroll
      for (int i = 0; i < 4; i++)
        *(bf16x4*)(xb + (size_t)(row + r * nw) * 1024 + (lane + 64 * i) * 4) =
            pack4(v[r][i].x * ss[r], v[r][i].y * ss[r], v[r][i].z * ss[r], v[r][i].w * ss[r]);
  }
  for (; row < nrows; row += nw) {
    const float4* p = (const float4*)(x + (size_t)row * 1024);
    float4 v[4]; float ss = 0.f;
#pragma unroll
    for (int i = 0; i < 4; i++) { v[i] = p[lane + 64 * i]; ss += v[i].x * v[i].x + v[i].y * v[i].y + v[i].z * v[i].z + v[i].w * v[i].w; }
#pragma unroll
    for (int o = 32; o >= 1; o >>= 1) ss += __shfl_xor(ss, o);
    float r = rsqrtf(ss * (1.f / 1024.f) + 1e-6f);
#pragma unroll
    for (int i = 0; i < 4; i++) {
      bf16x4 o = pack4(v[i].x * r, v[i].y * r, v[i].z * r, v[i].w * r);
      *(bf16x4*)(xb + (size_t)row * 1024 + (lane + 64 * i) * 4) = o;
    }
  }
}

__device__ void prep_wT(const float* __restrict__ w, const float* __restrict__ g, int gk0, int gk1, bf16_t* __restrict__ wt,
                        int K, int N, int Npad, int gtid, int gthreads) {
  const int ln = gtid & 63, gwv = gtid >> 6, nwv = gthreads >> 6;
  const int kblocks = K >> 6;
  const int total = (Npad >> 3) * kblocks;
  for (int uw = gwv; uw < total; uw += nwv) {
    const int kb = uw % kblocks, nbk = uw / kblocks;
    const int n = nbk * 8 + (ln >> 3), k8 = kb * 8 + (ln & 7);
    bf16x8 o;
#pragma unroll
    for (int j = 0; j < 8; j++) {
      int k = k8 * 8 + j; float v = 0.f;
      if (n < N) { v = w[(size_t)k * N + n]; if (g != nullptr && k >= gk0 && k < gk1) v *= g[k - gk0]; }
      o[j] = (short)f2bf(v);
    }
    *(bf16x8*)(wt + (size_t)n * K + k8 * 8) = o;
  }
}

__device__ void phase_prep(const Params& p) {
  const int gtid = blockIdx.x * 256 + threadIdx.x, gthreads = gridDim.x * 256;
  const int gw = gtid >> 6, nw = gthreads >> 6;
  prep_rows(p.x, p.XB, T_TOK, gw, nw);
  prep_rows(p.mem, p.MEMB, 2048, gw, nw);
  prep_wT(p.w_in, p.g_in, 0, 1024, p.WinT, 1024, NIN, NINP, gtid, gthreads);
  prep_wT(p.w_out, p.g_ssd, 512, 1024, p.WoutT, 1536, 1024, 1024, gtid, gthreads);
  prep_wT(p.w_kv, p.g_mem, 0, 1024, p.WkvT, 1024, 1024, 1024, gtid, gthreads);
  prep_wT(p.w1k, nullptr, 0, 0, p.W1kT, 2048, 256, 256, gtid, gthreads);
  prep_wT(p.w1v, nullptr, 0, 0, p.W1vT, 2048, 256, 256, gtid, gthreads);
  prep_wT(p.w2k, nullptr, 0, 0, p.W2kT, 256, 64, 64, gtid, gthreads);
  prep_wT(p.w2v, nullptr, 0, 0, p.W2vT, 256, 64, 64, gtid, gthreads);
  for (int i = gtid; i < T_TOK; i += gthreads) p.SS_OUT[i] = 0.f;
  for (int i = gtid; i < 16 * 64; i += gthreads) {
    int bg = i >> 6, d = i & 63;
    p.KCMP[((size_t)bg * 256 + 255) * 64 + d] = 0;
    p.VCMPT[((size_t)bg * 64 + d) * 256 + 255] = 0;
  }
}

template <int MODE>
__device__ void gemm_tile(const Params& p, int mt, int nt, char* smem) {
  const int tid = get_tid(), lane = tid & 63, wave = tid >> 6, lr = lane & 15, lg = lane >> 4;
  const int wr = wave >> 1, wc = wave & 1;
  const int m0 = mt * 128, n0 = nt * 128;
  const bf16_t* A; const bf16_t* Bt; int K;
  if (MODE == 0) { A = p.XB; Bt = p.WinT; K = 1024; }
  else if (MODE == 1) { A = p.MEMB; Bt = p.WkvT; K = 1024; }
  else { A = p.MIX; Bt = p.WoutT; K = 1536; }
  bf16_t* As = (bf16_t*)smem;
  bf16_t* Bs = As + 2 * 9216;
  const int lrow = tid >> 3, kc = tid & 7;
  const bf16_t* ga = A + (size_t)(m0 + lrow) * K + kc * 8;
  const bf16_t* gb = Bt + (size_t)(n0 + lrow) * K + kc * 8;
  float rs[4] = {1.f, 1.f, 1.f, 1.f};
  if (MODE == 2) {
#pragma unroll
    for (int i = 0; i < 4; i++) {
      const float4* sp = (const float4*)(p.SS_SSD + (size_t)(m0 + lrow + 32 * i) * 8);
      float4 a = sp[0], b = sp[1];
      rs[i] = rsqrtf((a.x + a.y + a.z + a.w + b.x + b.y + b.z + b.w) * (1.f / 512.f) + 1e-6f);
    }
  }
  bool swap;
  if (MODE == 0) swap = !(nt == 7 || nt == 9);
  else if (MODE == 1) swap = (nt < 4);
  else swap = true;
  const bf16_t* F = swap ? (Bs + (64 * wc) * 72) : (As + (64 * wr) * 72);
  const bf16_t* G = swap ? (As + (64 * wr) * 72) : (Bs + (64 * wc) * 72);
  f32x4 acc[4][4];
#pragma unroll
  for (int i = 0; i < 4; i++)
#pragma unroll
    for (int j = 0; j < 4; j++) acc[i][j] = (f32x4){0.f, 0.f, 0.f, 0.f};
  bf16x8 ra0[4], rb0[4], ra1[4], rb1[4];
  const int nk = K / 64;
  auto load = [&](int kt, bf16x8 (&ra)[4], bf16x8 (&rb)[4]) {
#pragma unroll
    for (int i = 0; i < 4; i++) {
      ra[i] = *(const bf16x8*)(ga + (size_t)(32 * i) * K + kt * 64);
      rb[i] = *(const bf16x8*)(gb + (size_t)(32 * i) * K + kt * 64);
    }
  };
  auto store = [&](int buf, int kt, bf16x8 (&ra)[4], bf16x8 (&rb)[4]) {
    if (MODE == 2) {
      if (kt >= 8 && kt < 16) {
#pragma unroll
        for (int i = 0; i < 4; i++) {
          bf16x8 v = ra[i];
          ra[i] = pack8(bfs(v[0]) * rs[i], bfs(v[1]) * rs[i], bfs(v[2]) * rs[i], bfs(v[3]) * rs[i],
                        bfs(v[4]) * rs[i], bfs(v[5]) * rs[i], bfs(v[6]) * rs[i], bfs(v[7]) * rs[i]);
        }
      }
    }
#pragma unroll
    for (int i = 0; i < 4; i++) {
      *(bf16x8*)(As + buf * 9216 + (lrow + 32 * i) * 72 + kc * 8) = ra[i];
      *(bf16x8*)(Bs + buf * 9216 + (lrow + 32 * i) * 72 + kc * 8) = rb[i];
    }
  };
  auto compute = [&](int buf) {
    const int cb = buf * 9216;
#pragma unroll
    for (int ks = 0; ks < 2; ks++) {
      bf16x8 ff[4], gg[4];
#pragma unroll
      for (int i = 0; i < 4; i++) {
        ff[i] = *(const bf16x8*)(F + cb + (16 * i + lr) * 72 + ks * 32 + lg * 8);
        gg[i] = *(const bf16x8*)(G + cb + (16 * i + lr) * 72 + ks * 32 + lg * 8);
      }
#pragma unroll
      for (int i = 0; i < 4; i++)
#pragma unroll
        for (int j = 0; j < 4; j++) acc[i][j] = mfma16(ff[i], gg[j], acc[i][j]);
    }
  };
  const int lastk = nk - 1;
  load(0, ra0, rb0);
  load(1, ra1, rb1);
  store(0, 0, ra0, rb0);
  load(2, ra0, rb0);
  __syncthreads();
  for (int kt = 0; kt < nk; kt += 2) {
    compute(0);
    store(1, kt + 1, ra1, rb1);
    load(min(kt + 3, lastk), ra1, rb1);
    __syncthreads();
    compute(1);
    store(0, min(kt + 2, lastk), ra0, rb0);
    load(min(kt + 4, lastk), ra0, rb0);
    __syncthreads();
  }
  if (swap) {
    if (MODE == 0) {
      const bool rope = (nt < 4) || nt == 6 || nt == 8;
#pragma unroll
      for (int mi = 0; mi < 4; mi++) {
        const int m = m0 + 64 * wr + 16 * mi + lr;
        if (rope) {
          const int pos = p.pos[m];
          f32x4 v = acc[0][mi];
          f32x4 o;
#pragma unroll
          for (int i = 0; i < 4; i++) {
            float pr = __shfl_xor(v[i], 32);
            float cs, sn; rope_cs(pos, 4 * (lg & 1) + i, cs, sn);
            o[i] = (lg < 2) ? (v[i] * cs - pr * sn) : (v[i] * cs + pr * sn);
          }
          acc[0][mi] = o;
        }
        {
          bf16_t* stg = (bf16_t*)smem + ((wave & 1) ? 2 * 9216 : 0) + (wave >> 1) * 4608;
#pragma unroll
          for (int ni = 0; ni < 4; ni++) {
            f32x4 v = acc[ni][mi];
            *(bf16x4*)(stg + (16 * mi + lr) * 72 + 16 * ni + 4 * lg) = pack4(v[0], v[1], v[2], v[3]);
          }
        }
      }
      {
        const bf16_t* stg = (const bf16_t*)smem + ((wave & 1) ? 2 * 9216 : 0) + (wave >> 1) * 4608;
        const int rr = lane >> 3, ch = lane & 7;
        const int nb0 = n0 + 64 * wc + ch * 8;
#pragma unroll
        for (int it = 0; it < 8; it++) {
          const int row = it * 8 + rr;
          const int m = m0 + 64 * wr + row;
          bf16x8 v = *(const bf16x8*)(stg + row * 72 + ch * 8);
          if (nt == 6 || nt == 8) {
            bf16_t* kd = ((nt == 6) ? p.KSC : p.KWC) + (((size_t)(m >> 12) * 2 + wc) * S_LEN + (m & 4095)) * 64;
            *(bf16x8*)(kd + ch * 8) = v;
          } else if (nb0 < NIN) {
            *(bf16x8*)(p.PROJ + (size_t)m * NIN + nb0) = v;
          }
        }
      }
      __syncthreads();
    } else if (MODE == 1) {
#pragma unroll
      for (int mi = 0; mi < 4; mi++) {
        const int m = m0 + 64 * wr + 16 * mi + lr;
#pragma unroll
        for (int ni = 0; ni < 4; ni++) {
          const int n = n0 + 64 * wc + 16 * ni + 4 * lg;
          f32x4 v = acc[ni][mi];
          *(bf16x4*)(p.KMEM + (size_t)m * 512 + n) = pack4(v[0], v[1], v[2], v[3]);
        }
      }
    } else {
#pragma unroll
      for (int mi = 0; mi < 4; mi++) {
        const int m = m0 + 64 * wr + 16 * mi + lr;
        float ss = 0.f;
#pragma unroll
        for (int ni = 0; ni < 4; ni++) {
          const int n = n0 + 64 * wc + 16 * ni + 4 * lg;
          float4 xv = *(const float4*)(p.x + (size_t)m * 1024 + n);
          f32x4 v = acc[ni][mi];
          float4 h; h.x = xv.x + v[0]; h.y = xv.y + v[1]; h.z = xv.z + v[2]; h.w = xv.w + v[3];
          ss += h.x * h.x + h.y * h.y + h.z * h.z + h.w * h.w;
          *(float4*)(p.out + (size_t)m * 1024 + n) = h;
        }
        ss += __shfl_xor(ss, 16); ss += __shfl_xor(ss, 32);
        if (lg == 0) atomicAdd(p.SS_OUT + m, ss);
      }
    }
  } else {
#pragma unroll
    for (int mi = 0; mi < 4; mi++)
#pragma unroll
      for (int ni = 0; ni < 4; ni++) {
        f32x4 v = acc[mi][ni];
        bf16x4 o = pack4(v[0], v[1], v[2], v[3]);
        if (MODE == 0) {
          const int b = m0 >> 12, s = (m0 & 4095) + 64 * wr + 16 * mi + 4 * lg;
          const int d = 16 * ni + lr;
          bf16_t* dst = (nt == 7) ? p.VST : p.VWT;
          *(bf16x4*)(dst + ((size_t)(b * 2 + wc) * 64 + d) * S_LEN + s) = o;
        } else {
          const int b = m0 >> 8, s = (m0 & 255) + 64 * wr + 16 * mi + 4 * lg;
          const int col = n0 - 512 + 64 * wc + 16 * ni + lr;
          const int h = col >> 7, d = col & 127;
          *(bf16x4*)(p.VMEMT + ((size_t)(b * 4 + h) * 128 + d) * 256 + s) = o;
        }
      }
  }
}

template <int DQK, int DV, int MASK, typename MaskF>
__device__ __forceinline__ void attn_tile(const bf16_t* sK, const bf16_t* sVt, const bf16x8 (&qf)[2][DQK / 32], f32x4 (&o)[DV / 16][2],
                                          float (&m)[2], float (&l)[2], float c, bool qsel0, bool qsel1, MaskF valid) {
  constexpr int KST = DQK + 8;
  const int lane = get_tid() & 63, lr = lane & 15, lg = lane >> 4;
  f32x4 s[4][2];
#pragma unroll
  for (int kt = 0; kt < 4; kt++) { s[kt][0] = (f32x4){0.f, 0.f, 0.f, 0.f}; s[kt][1] = (f32x4){0.f, 0.f, 0.f, 0.f}; }
#pragma unroll
  for (int ks = 0; ks < DQK / 32; ks++)
#pragma unroll
    for (int kt = 0; kt < 4; kt++) {
      bf16x8 a = *(const bf16x8*)(sK + (16 * kt + lr) * KST + ks * 32 + lg * 8);
      s[kt][0] = mfma16(a, qf[0][ks], s[kt][0]);
      s[kt][1] = mfma16(a, qf[1][ks], s[kt][1]);
    }
#pragma unroll
  for (int qt = 0; qt < 2; qt++) {
    const bool qs = qt ? qsel1 : qsel0;
    float mx = -1e30f;
    if (MASK) {
#pragma unroll
      for (int kt = 0; kt < 4; kt++)
#pragma unroll
        for (int i = 0; i < 4; i++) {
          bool v = valid(16 * kt + 4 * lg + i, qt);
          float sv = v ? s[kt][qt][i] * c : -1e30f;
          s[kt][qt][i] = sv; mx = fmaxf(mx, sv);
        }
    } else {
#pragma unroll
      for (int kt = 0; kt < 4; kt++) mx = fmaxf(fmaxf(mx, fmaxf(s[kt][qt][0], s[kt][qt][1])), fmaxf(s[kt][qt][2], s[kt][qt][3]));
      mx = qs ? mx * c : -1e30f;
    }
    mx = rowmax4(mx);
    const float mn = fmaxf(m[qt], mx);
    const float alpha = fexp2(m[qt] - mn);
    m[qt] = mn;
    float me;
    if (MASK) me = (mn > -1e29f) ? mn : 1e30f; else me = qs ? mn : 1e30f;
    float rs = 0.f;
#pragma unroll
    for (int kt = 0; kt < 4; kt++)
#pragma unroll
      for (int i = 0; i < 4; i++) {
        float pv = MASK ? fexp2(s[kt][qt][i] - me) : fexp2(fmaf(s[kt][qt][i], c, -me));
        s[kt][qt][i] = pv; rs += pv;
      }
    rs = rowsum4(rs);
    l[qt] = l[qt] * alpha + rs;
#pragma unroll
    for (int dt = 0; dt < DV / 16; dt++) {
      o[dt][qt][0] *= alpha; o[dt][qt][1] *= alpha; o[dt][qt][2] *= alpha; o[dt][qt][3] *= alpha;
    }
  }
#pragma unroll
  for (int k2 = 0; k2 < 2; k2++) {
    bf16x8 pb[2];
#pragma unroll
    for (int qt = 0; qt < 2; qt++)
      pb[qt] = pack8(s[2 * k2][qt][0], s[2 * k2][qt][1], s[2 * k2][qt][2], s[2 * k2][qt][3],
                     s[2 * k2 + 1][qt][0], s[2 * k2 + 1][qt][1], s[2 * k2 + 1][qt][2], s[2 * k2 + 1][qt][3]);
#pragma unroll
    for (int dt = 0; dt < DV / 16; dt++) {
      const bf16_t* vp = sVt + (16 * dt + lr) * 72 + 32 * k2 + 4 * lg;
      bf16x8 a = cat44(*(const bf16x4*)vp, *(const bf16x4*)(vp + 16));
      o[dt][0] = mfma16(a, pb[0], o[dt][0]);
      o[dt][1] = mfma16(a, pb[1], o[dt][1]);
    }
  }
}

__device__ __forceinline__ int next_bit_below(unsigned long long m, int below) {
  unsigned long long mm = (below >= 64) ? m : (m & ((1ull << below) - 1ull));
  return mm ? (63 - __clzll((long long)mm)) : -1;
}

__device__ void nsa_item(const Params& p, int item, char* smem) {
  const int tid = get_tid(), lane = tid & 63, wave = tid >> 6, lr = lane & 15, lg = lane >> 4;
  const int bg = item & 15, qb = 127 - (item >> 4);
  const int b = bg >> 1, g = bg & 1;
  const int t0 = qb * 32, cur = t0 >> 6;
  const int hq = g * 4 + wave;
  float* sImp = (float*)(smem + 55296);
  unsigned long long* sSel = (unsigned long long*)(smem + 63616);
  const float c = 0.125f * LOG2E;
  const size_t tokbase = (size_t)b * S_LEN + t0;
  const int r0 = tid >> 3, cc = tid & 7;

  bf16x8 qf[2][2];
#pragma unroll
  for (int qt = 0; qt < 2; qt++) {
    const bf16_t* row = p.PROJ + (tokbase + 16 * qt + lr) * NIN;
#pragma unroll
    for (int ks = 0; ks < 2; ks++) qf[qt][ks] = *(const bf16x8*)(row + C_Q + hq * 64 + 32 * ks + 8 * lg);
  }
  auto emit = [&](f32x4 (&o)[4][2], float (&l)[2], int br) {
#pragma unroll
    for (int qt = 0; qt < 2; qt++) {
      const size_t tok = tokbase + 16 * qt + lr;
      const float gsc = sigmoid_f(bf2f(p.PROJ[tok * NIN + C_GL + hq * 3 + br])) / fmaxf(l[qt], 1e-30f);
#pragma unroll
      for (int dt = 0; dt < 4; dt++) {
        const int dbase = hq * 64 + 16 * dt + 4 * lg;
        bf16_t* dst = p.MIX + tok * 1536 + dbase;
        f32x4 r = o[dt][qt];
        r[0] *= gsc; r[1] *= gsc; r[2] *= gsc; r[3] *= gsc;
        if (br > 0) { bf16x4 pv = *(const bf16x4*)dst; r[0] += bfs(pv[0]); r[1] += bfs(pv[1]); r[2] += bfs(pv[2]); r[3] += bfs(pv[3]); }
        if (br == 2) {
          bf16x4 ga = *(const bf16x4*)(p.PROJ + tok * NIN + C_GA + dbase);
          r[0] *= silu_f(bfs(ga[0])); r[1] *= silu_f(bfs(ga[1])); r[2] *= silu_f(bfs(ga[2])); r[3] *= silu_f(bfs(ga[3]));
        }
        *(bf16x4*)dst = pack4(r[0], r[1], r[2], r[3]);
      }
    }
  };
  auto store_kv = [&](int buf, bf16x8 (&rg)[4]) {
    bf16_t* sK = (bf16_t*)(smem + buf * 27648);
    bf16_t* sVt = sK + 64 * 72;
    *(bf16x8*)(sK + r0 * 72 + cc * 8) = rg[0];
    *(bf16x8*)(sK + (r0 + 32) * 72 + cc * 8) = rg[1];
    *(bf16x8*)(sVt + r0 * 72 + cc * 8) = rg[2];
    *(bf16x8*)(sVt + (r0 + 32) * 72 + cc * 8) = rg[3];
  };

  {
    const int ntiles = (t0 >> 10) + 1;
    const bf16_t* kb = p.KCMP + (size_t)bg * 256 * 64;
    const bf16_t* vb = p.VCMPT + (size_t)bg * 64 * 256;
    for (int pass = 0; pass < 2; pass++) {
      f32x4 o[4][2]; float m[2] = {-1e30f, -1e30f}, l[2] = {0.f, 0.f};
#pragma unroll
      for (int dt = 0; dt < 4; dt++) { o[dt][0] = (f32x4){0.f, 0.f, 0.f, 0.f}; o[dt][1] = (f32x4){0.f, 0.f, 0.f, 0.f}; }
      int ldn = 0;
      tile_pipeline<4>(ntiles,
        [&](int i, bf16x8 (&rg)[4]) {
          rg[0] = *(const bf16x8*)(kb + (size_t)(64 * i + r0) * 64 + cc * 8);
          rg[1] = *(const bf16x8*)(kb + (size_t)(64 * i + r0 + 32) * 64 + cc * 8);
          if (pass == 0) {
            rg[2] = *(const bf16x8*)(vb + (size_t)r0 * 256 + 64 * i + cc * 8);
            rg[3] = *(const bf16x8*)(vb + (size_t)(r0 + 32) * 256 + 64 * i + cc * 8);
          }
        },
        [&](int buf, bf16x8 (&rg)[4]) {
          const int nt = ldn++;
          if (pass == 1) {
#pragma unroll
            for (int i2 = 0; i2 < 2; i2++) {
              const int j = r0 + 32 * i2;
              bf16x8 ov;
#pragma unroll
              for (int x = 0; x < 8; x++) { int n = 64 * nt + cc * 8 + x; ov[x] = (n >= 4 * j - 1 && n <= 4 * j + 3) ? (short)0x3F80 : (short)0; }
              rg[2 + i2] = ov;
            }
          }
          store_kv(buf, rg);
        },
        [&](int i, int buf) {
          const bf16_t* sK = (const bf16_t*)(smem + buf * 27648);
          attn_tile<64, 64, 1>(sK, sK + 64 * 72, qf, o, m, l, c, true, true,
                               [&](int key, int qt) { return 16 * (64 * i + key) + 31 <= t0 + 16 * qt + lr; });
        });
      if (pass == 0) {
        emit(o, l, 0);
      } else {
        float inv[2];
#pragma unroll
        for (int qt = 0; qt < 2; qt++) inv[qt] = 1.f / fmaxf(l[qt], 1e-30f);
        for (int e2 = 0; e2 < 4; e2++) {
          if (wave == e2) {
#pragma unroll
            for (int dt = 0; dt < 4; dt++)
#pragma unroll
              for (int qt = 0; qt < 2; qt++)
#pragma unroll
                for (int i = 0; i < 4; i++) {
                  int j = 16 * dt + 4 * lg + i, q = 16 * qt + lr;
                  float v = o[dt][qt][i] * inv[qt];
                  if (e2 == 0) sImp[q * 65 + j] = v; else sImp[q * 65 + j] += v;
                }
          }
          __syncthreads();
        }
      }
    }
  }
  for (int qq = 0; qq < 8; qq++) {
    const int q = wave * 8 + qq;
    const int j = lane;
    float v = sImp[q * 65 + j];
    bool valid = j <= cur;
    bool forced = (j == 0) || (j == cur) || (j == cur - 1);
    float val = forced ? 1e9f : (valid ? v : -1e9f);
    int rank = 0;
#pragma unroll 16
    for (int jj = 0; jj < 64; jj++) {
      float ov = __int_as_float(__builtin_amdgcn_readlane(__float_as_int(val), jj));
      rank += ((ov > val) || (ov == val && jj < j)) ? 1 : 0;
    }
    unsigned long long mask = __ballot((rank < 16) && valid);
    if (lane == 0) sSel[q] = mask;
  }
  __syncthreads();
  unsigned long long any = 0ull;
  for (int q = 0; q < 32; q++) any |= sSel[q];
  unsigned long long mk[2];
  mk[0] = sSel[lr]; mk[1] = sSel[16 + lr];

  {
    f32x4 o[4][2]; float m[2] = {-1e30f, -1e30f}, l[2] = {0.f, 0.f};
#pragma unroll
    for (int dt = 0; dt < 4; dt++) { o[dt][0] = (f32x4){0.f, 0.f, 0.f, 0.f}; o[dt][1] = (f32x4){0.f, 0.f, 0.f, 0.f}; }
    const bf16_t* kb = p.KSC + (size_t)bg * S_LEN * 64;
    const bf16_t* vb = p.VST + (size_t)bg * 64 * S_LEN;
    const int ntiles = __popcll(any);
    int jl = 64, jc = 64;
    tile_pipeline<4>(ntiles,
      [&](int, bf16x8 (&rg)[4]) {
        jl = (jl > 0) ? next_bit_below(any, jl) : -1;
        const int jj = jl < 0 ? 0 : jl;
        rg[0] = *(const bf16x8*)(kb + (size_t)(64 * jj + r0) * 64 + cc * 8);
        rg[1] = *(const bf16x8*)(kb + (size_t)(64 * jj + r0 + 32) * 64 + cc * 8);
        rg[2] = *(const bf16x8*)(vb + (size_t)r0 * S_LEN + 64 * jj + cc * 8);
        rg[3] = *(const bf16x8*)(vb + (size_t)(r0 + 32) * S_LEN + 64 * jj + cc * 8);
      },
      store_kv,
      [&](int, int buf) {
        jc = next_bit_below(any, jc);
        const int j = jc;
        const bf16_t* sK = (const bf16_t*)(smem + buf * 27648);
        if (j == cur) {
          attn_tile<64, 64, 1>(sK, sK + 64 * 72, qf, o, m, l, c, true, true,
                               [&](int key, int qt) { return 64 * j + key <= t0 + 16 * qt + lr; });
        } else {
          attn_tile<64, 64, 0>(sK, sK + 64 * 72, qf, o, m, l, c, ((mk[0] >> j) & 1ull) != 0ull, ((mk[1] >> j) & 1ull) != 0ull,
                               [&](int, int) { return true; });
        }
      });
    emit(o, l, 1);
  }
  {
    f32x4 o[4][2]; float m[2] = {-1e30f, -1e30f}, l[2] = {0.f, 0.f};
#pragma unroll
    for (int dt = 0; dt < 4; dt++) { o[dt][0] = (f32x4){0.f, 0.f, 0.f, 0.f}; o[dt][1] = (f32x4){0.f, 0.f, 0.f, 0.f}; }
    const int jlo = (cur - 8 > 0) ? (cur - 8) : 0;
    const bf16_t* kb = p.KWC + (size_t)bg * S_LEN * 64;
    const bf16_t* vb = p.VWT + (size_t)bg * 64 * S_LEN;
    tile_pipeline<4>(cur - jlo + 1,
      [&](int i, bf16x8 (&rg)[4]) {
        const int j = cur - i;
        rg[0] = *(const bf16x8*)(kb + (size_t)(64 * j + r0) * 64 + cc * 8);
        rg[1] = *(const bf16x8*)(kb + (size_t)(64 * j + r0 + 32) * 64 + cc * 8);
        rg[2] = *(const bf16x8*)(vb + (size_t)r0 * S_LEN + 64 * j + cc * 8);
        rg[3] = *(const bf16x8*)(vb + (size_t)(r0 + 32) * S_LEN + 64 * j + cc * 8);
      },
      store_kv,
      [&](int i, int buf) {
        const int j = cur - i;
        const bf16_t* sK = (const bf16_t*)(smem + buf * 27648);
        if (j == cur || j == cur - 8) {
          attn_tile<64, 64, 1>(sK, sK + 64 * 72, qf, o, m, l, c, true, true, [&](int key, int qt) {
            int tq = t0 + 16 * qt + lr, kp = 64 * j + key;
            return (kp <= tq) && (kp > tq - 512);
          });
        } else {
          attn_tile<64, 64, 0>(sK, sK + 64 * 72, qf, o, m, l, c, true, true, [&](int, int) { return true; });
        }
      });
    emit(o, l, 2);
  }
}

__device__ void memattn_item(const Params& p, int item, char* smem) {
  const int tid = get_tid(), lane = tid & 63, wave = tid >> 6, lr = lane & 15, lg = lane >> 4;
  const int b = item >> 7, h = (item >> 5) & 3, qb = item & 31;
  const int t0 = qb * 128 + wave * 32;
  const size_t tokbase = (size_t)b * S_LEN + t0;
  bf16x8 qf[2][4];
#pragma unroll
  for (int qt = 0; qt < 2; qt++)
#pragma unroll
    for (int ks = 0; ks < 4; ks++) qf[qt][ks] = *(const bf16x8*)(p.PROJ + (tokbase + 16 * qt + lr) * NIN + C_QX + h * 128 + 32 * ks + 8 * lg);
  f32x4 o[8][2]; float m[2] = {-1e30f, -1e30f}, l[2] = {0.f, 0.f};
#pragma unroll
  for (int dt = 0; dt < 8; dt++) { o[dt][0] = (f32x4){0.f, 0.f, 0.f, 0.f}; o[dt][1] = (f32x4){0.f, 0.f, 0.f, 0.f}; }
  const float c = 0.08838834764831845f * LOG2E;
  const bf16_t* kb = p.KMEM + (size_t)b * 256 * 512 + h * 128;
  const bf16_t* vb = p.VMEMT + (size_t)(b * 4 + h) * 128 * 256;
  tile_pipeline1<8>(4,
    [&](int kt, bf16x8 (&rg)[8]) {
#pragma unroll
      for (int i = 0; i < 4; i++) {
        int ch = tid + 256 * i;
        rg[i] = *(const bf16x8*)(kb + (size_t)(64 * kt + (ch >> 4)) * 512 + (ch & 15) * 8);
        rg[4 + i] = *(const bf16x8*)(vb + (size_t)(ch >> 3) * 256 + 64 * kt + (ch & 7) * 8);
      }
    },
    [&](int buf, bf16x8 (&rg)[8]) {
      bf16_t* sK = (bf16_t*)(smem + buf * 35840);
      bf16_t* sVt = sK + 64 * 136;
#pragma unroll
      for (int i = 0; i < 4; i++) {
        int ch = tid + 256 * i;
        *(bf16x8*)(sK + (ch >> 4) * 136 + (ch & 15) * 8) = rg[i];
        *(bf16x8*)(sVt + (ch >> 3) * 72 + (ch & 7) * 8) = rg[4 + i];
      }
    },
    [&](int, int buf) {
      const bf16_t* sK = (const bf16_t*)(smem + buf * 35840);
      attn_tile<128, 128, 0>(sK, sK + 64 * 136, qf, o, m, l, c, true, true, [&](int, int) { return true; });
    });
#pragma unroll
  for (int qt = 0; qt < 2; qt++) {
    const size_t tok = tokbase + 16 * qt + lr;
    const float inv = 1.f / fmaxf(l[qt], 1e-30f);
#pragma unroll
    for (int dt = 0; dt < 8; dt++) {
      const int dbase = h * 128 + 16 * dt + 4 * lg;
      bf16x4 ga = *(const bf16x4*)(p.PROJ + tok * NIN + C_GX + dbase);
      f32x4 r = o[dt][qt];
      *(bf16x4*)(p.MIX + tok * 1536 + 1024 + dbase) =
          pack4(r[0] * inv * silu_f(bfs(ga[0])), r[1] * inv * silu_f(bfs(ga[1])), r[2] * inv * silu_f(bfs(ga[2])), r[3] * inv * silu_f(bfs(ga[3])));
    }
  }
}

__device__ void compress_item(const Params& p, int item, char* smem) {
  const int tid = get_tid(), lane = tid & 63, wave = tid >> 6, lr = lane & 15, lg = lane >> 4;
  const int which = item >> 7, rho0 = (item & 127) * 32;
  const bf16_t* W1T = which ? p.W1vT : p.W1kT;
  const bf16_t* W2T = which ? p.W2vT : p.W2kT;
  const float* pe = which ? p.cpv : p.cpk;
  const int col0 = which ? C_VC : C_KC;
  bf16_t* sA = (bf16_t*)smem;
  bf16_t* sW = sA + 32 * 72;
  bf16_t* sH = sW + 256 * 72;
  const int arow = tid >> 3, akc = tid & 7;
  const bf16_t* abase;
  {
    int rho = rho0 + arow; if (rho > 4079) rho = 4079;
    int b = rho / 510, rem = rho - b * 510, n = rem >> 1, g = rem & 1;
    abase = p.PROJ + ((size_t)b * S_LEN + 16 * n) * NIN + col0 + g * 64 + akc * 8;
  }
  const bf16_t* wbase = W1T + (size_t)arow * 2048 + akc * 8;
  f32x4 acc[2][4];
#pragma unroll
  for (int i = 0; i < 2; i++)
#pragma unroll
    for (int j = 0; j < 4; j++) acc[i][j] = (f32x4){0.f, 0.f, 0.f, 0.f};
  bf16x8 ra, rw[8];
  float4 rp0, rp1;
  auto load = [&](int kt) {
    ra = *(const bf16x8*)(abase + (size_t)kt * NIN);
    rp0 = *(const float4*)(pe + kt * 64 + akc * 8); rp1 = *(const float4*)(pe + kt * 64 + akc * 8 + 4);
#pragma unroll
    for (int i = 0; i < 8; i++) rw[i] = *(const bf16x8*)(wbase + (size_t)(32 * i) * 2048 + kt * 64);
  };
  load(0);
  for (int kt = 0; kt < 32; kt++) {
    __syncthreads();
    *(bf16x8*)(sA + arow * 72 + akc * 8) =
        pack8(bfs(ra[0]) + rp0.x, bfs(ra[1]) + rp0.y, bfs(ra[2]) + rp0.z, bfs(ra[3]) + rp0.w,
              bfs(ra[4]) + rp1.x, bfs(ra[5]) + rp1.y, bfs(ra[6]) + rp1.z, bfs(ra[7]) + rp1.w);
#pragma unroll
    for (int i = 0; i < 8; i++) *(bf16x8*)(sW + (arow + 32 * i) * 72 + akc * 8) = rw[i];
    __syncthreads();
    load(kt < 31 ? kt + 1 : 31);
#pragma unroll
    for (int ks = 0; ks < 2; ks++) {
      bf16x8 a0 = *(const bf16x8*)(sA + lr * 72 + ks * 32 + 8 * lg);
      bf16x8 a1 = *(const bf16x8*)(sA + (16 + lr) * 72 + ks * 32 + 8 * lg);
#pragma unroll
      for (int ct = 0; ct < 4; ct++) {
        bf16x8 bf = *(const bf16x8*)(sW + (64 * wave + 16 * ct + lr) * 72 + ks * 32 + 8 * lg);
        acc[0][ct] = mfma16(a0, bf, acc[0][ct]);
        acc[1][ct] = mfma16(a1, bf, acc[1][ct]);
      }
    }
  }
  __syncthreads();
#pragma unroll
  for (int rt = 0; rt < 2; rt++)
#pragma unroll
    for (int ct = 0; ct < 4; ct++)
#pragma unroll
      for (int i = 0; i < 4; i++) sH[(16 * rt + 4 * lg + i) * 264 + 64 * wave + 16 * ct + lr] = f2bf(silu_f(acc[rt][ct][i]));
  __syncthreads();
  f32x4 acc2[2] = {(f32x4){0.f, 0.f, 0.f, 0.f}, (f32x4){0.f, 0.f, 0.f, 0.f}};
#pragma unroll
  for (int ks = 0; ks < 8; ks++) {
    bf16x8 bf = *(const bf16x8*)(W2T + (size_t)(16 * wave + lr) * 256 + 32 * ks + 8 * lg);
#pragma unroll
    for (int rt = 0; rt < 2; rt++) {
      bf16x8 a = *(const bf16x8*)(sH + (16 * rt + lr) * 264 + 32 * ks + 8 * lg);
      acc2[rt] = mfma16(a, bf, acc2[rt]);
    }
  }
  const int col = 16 * wave + lr;
#pragma unroll
  for (int rt = 0; rt < 2; rt++)
#pragma unroll
    for (int i = 0; i < 4; i++) {
      int rho = rho0 + 16 * rt + 4 * lg + i;
      bool ok = rho < 4080;
      int rc = ok ? rho : 4079;
      int b = rc / 510, rem = rc - b * 510, n = rem >> 1, g = rem & 1;
      float v = acc2[rt][i];
      float pr = __shfl_xor(v, 8);
      if (which == 0) {
        if (wave == 0) {
          int pos = p.pos[b * S_LEN + 16 * n + 31];
          float cs, sn; rope_cs(pos, lr & 7, cs, sn);
          v = (lr < 8) ? (v * cs - pr * sn) : (v * cs + pr * sn);
        }
        if (ok) p.KCMP[((size_t)(b * 2 + g) * 256 + n) * 64 + col] = f2bf(v);
      } else {
        if (ok) p.VCMPT[((size_t)(b * 2 + g) * 64 + col) * 256 + n] = f2bf(v);
      }
    }
}

__device__ void conv_units(const Params& p, int u) {
  const int it = u >> 8, wvi = (u >> 6) & 3, ln = u & 63;
  const int cgp = ((it & 3) * 4 + wvi) * 8 + (ln >> 3), tg = (it >> 2) * 8 + (ln & 7);
  const int tok0 = tg * 8, s0 = tok0 & 4095, ch0 = cgp * 8;
  const int b = tok0 >> 12;
  bf16x8 in[11];
#pragma unroll
  for (int r = 0; r < 11; r++) {
    int s = s0 - 3 + r;
    if (s >= 0) in[r] = *(const bf16x8*)(p.PROJ + (size_t)(tok0 - 3 + r) * NIN + C_XBC + ch0);
    else in[r] = (bf16x8){0, 0, 0, 0, 0, 0, 0, 0};
  }
  float4 wv[4][2];
#pragma unroll
  for (int k = 0; k < 4; k++) { wv[k][0] = *(const float4*)(p.conv_w + k * 1024 + ch0); wv[k][1] = *(const float4*)(p.conv_w + k * 1024 + ch0 + 4); }
  float4 bv0 = *(const float4*)(p.conv_b + ch0), bv1 = *(const float4*)(p.conv_b + ch0 + 4);
  float w[4][8], bias[8];
#pragma unroll
  for (int k = 0; k < 4; k++) { w[k][0] = wv[k][0].x; w[k][1] = wv[k][0].y; w[k][2] = wv[k][0].z; w[k][3] = wv[k][0].w; w[k][4] = wv[k][1].x; w[k][5] = wv[k][1].y; w[k][6] = wv[k][1].z; w[k][7] = wv[k][1].w; }
  bias[0] = bv0.x; bias[1] = bv0.y; bias[2] = bv0.z; bias[3] = bv0.w; bias[4] = bv1.x; bias[5] = bv1.y; bias[6] = bv1.z; bias[7] = bv1.w;
  if (ch0 >= 512) {
#pragma unroll
    for (int tt = 0; tt < 8; tt++) {
      bf16x8 o;
#pragma unroll
      for (int j = 0; j < 8; j++) {
        float a = bias[j];
#pragma unroll
        for (int k = 0; k < 4; k++) a += bfs(in[tt + k][j]) * w[k][j];
        o[j] = (short)f2bf(silu_f(a));
      }
      *(bf16x8*)(p.BC + (size_t)(tok0 + tt) * 512 + (ch0 - 512)) = o;
    }
  }
  if (ch0 < 768) {
#pragma unroll
    for (int j = 0; j < 8; j++) {
      bf16x8 o;
#pragma unroll
      for (int tt = 0; tt < 8; tt++) {
        float a = bias[j];
#pragma unroll
        for (int k = 0; k < 4; k++) a += bfs(in[tt + k][j]) * w[k][j];
        o[tt] = (short)f2bf(silu_f(a));
      }
      const int ch = ch0 + j;
      bf16_t* dst;
      if (ch0 < 512) dst = p.XT + ((size_t)(b * 8 + (ch >> 6)) * 64 + (ch & 63)) * S_LEN + s0;
      else dst = p.BT + ((size_t)(b * 2 + ((ch - 512) >> 7)) * 128 + ((ch - 512) & 127)) * S_LEN + s0;
      *(bf16x8*)dst = o;
    }
  }
}

__device__ void ssd_states_item(const Params& p, int item, char* smem) {
  const int tid = get_tid(), lane = tid & 63, wave = tid >> 6, lr = lane & 15, lg = lane >> 4;
  const int h = item & 7, c = (item >> 3) & 31, b = item >> 8;
  const int g = h >> 2;
  bf16_t* sX = (bf16_t*)smem;
  bf16_t* sBt = sX + 64 * 136;
  float* sAcs = (float*)(smem + (64 + 128) * 136 * 2);
  float* sW = sAcs + 128;
  float* sTot = sW + 128;
  const size_t tok0 = (size_t)b * S_LEN + c * 128;
  const bf16_t* xt = p.XT + (size_t)(b * 8 + h) * 64 * S_LEN + c * 128;
  const bf16_t* bt = p.BT + (size_t)(b * 2 + g) * 128 * S_LEN + c * 128;
  __syncthreads();
  bf16x8 tx[4], tb[8];
#pragma unroll
  for (int i = 0; i < 4; i++) { int ch = tid + 256 * i; tx[i] = *(const bf16x8*)(xt + (size_t)(ch >> 4) * S_LEN + (ch & 15) * 8); }
#pragma unroll
  for (int i = 0; i < 8; i++) { int ch = tid + 256 * i; tb[i] = *(const bf16x8*)(bt + (size_t)(ch >> 4) * S_LEN + (ch & 15) * 8); }
  float dt = 0.f, cs = 0.f;
  if (tid < 128) {
    float raw = bf2f(p.PROJ[(tok0 + tid) * NIN + C_DT + h]) + p.dt_bias[h];
    dt = fmaxf(raw, 0.f) + log1pf(__expf(-fabsf(raw)));
    float a = -__expf(p.a_log[h]);
    cs = dt * a;
#pragma unroll
    for (int o = 1; o < 64; o <<= 1) { float t = __shfl_up(cs, o); if (lane >= o) cs += t; }
    if (lane == 63) sTot[wave] = cs;
  }
  __syncthreads();
  if (tid < 128) {
    if (wave == 1) cs += sTot[0];
    sAcs[tid] = cs;
  }
  __syncthreads();
  if (tid < 128) {
    float last = sAcs[127];
    sW[tid] = dt * __expf(last - cs);
    const size_t o = ((size_t)(b * 32 + c) * 8 + h) * 128 + tid;
    p.ACS[o] = cs; p.DTV[o] = dt;
    if (tid == 0) p.CHDEC[(b * 32 + c) * 8 + h] = __expf(last);
  }
#pragma unroll
  for (int i = 0; i < 8; i++) { int ch = tid + 256 * i; *(bf16x8*)(sBt + (ch >> 4) * 136 + (ch & 15) * 8) = tb[i]; }
  __syncthreads();
#pragma unroll
  for (int i = 0; i < 4; i++) {
    int ch = tid + 256 * i;
    const int l0 = (ch & 15) * 8;
    float4 w0 = *(const float4*)(sW + l0), w1 = *(const float4*)(sW + l0 + 4);
    bf16x8 r = tx[i];
    *(bf16x8*)(sX + (ch >> 4) * 136 + l0) = pack8(bfs(r[0]) * w0.x, bfs(r[1]) * w0.y, bfs(r[2]) * w0.z, bfs(r[3]) * w0.w,
                                                  bfs(r[4]) * w1.x, bfs(r[5]) * w1.y, bfs(r[6]) * w1.z, bfs(r[7]) * w1.w);
  }
  __syncthreads();
  f32x4 acc[4][2];
#pragma unroll
  for (int i = 0; i < 4; i++) { acc[i][0] = (f32x4){0.f, 0.f, 0.f, 0.f}; acc[i][1] = (f32x4){0.f, 0.f, 0.f, 0.f}; }
#pragma unroll
  for (int ks = 0; ks < 4; ks++) {
    const int l0 = 32 * ks + 8 * lg;
    bf16x8 bf0 = *(const bf16x8*)(sBt + (32 * wave + lr) * 136 + l0);
    bf16x8 bf1 = *(const bf16x8*)(sBt + (32 * wave + 16 + lr) * 136 + l0);
#pragma unroll
    for (int pt = 0; pt < 4; pt++) {
      bf16x8 a = *(const bf16x8*)(sX + (16 * pt + lr) * 136 + l0);
      acc[pt][0] = mfma16(a, bf0, acc[pt][0]);
      acc[pt][1] = mfma16(a, bf1, acc[pt][1]);
    }
  }
  float* st = p.STATES + ((size_t)(b * 32 + c) * 8 + h) * 8192;
#pragma unroll
  for (int pt = 0; pt < 4; pt++)
#pragma unroll
    for (int x = 0; x < 2; x++)
#pragma unroll
      for (int i = 0; i < 4; i++) st[(16 * pt + 4 * lg + i) * 128 + 32 * wave + 16 * x + lr] = acc[pt][x][i];
}

__device__ void scan_units(const Params& p, int q) {
  const int b = q >> 16, r = q & 65535, h = r >> 13;
  float hs = 0.f;
  for (int c0 = 0; c0 < 32; c0 += 16) {
    float s[16], d[16];
#pragma unroll
    for (int i = 0; i < 16; i++) { s[i] = p.STATES[(size_t)(b * 32 + c0 + i) * 65536 + r]; d[i] = p.CHDEC[(b * 32 + c0 + i) * 8 + h]; }
#pragma unroll
    for (int i = 0; i < 16; i++) { p.STATES[(size_t)(b * 32 + c0 + i) * 65536 + r] = hs; hs = hs * d[i] + s[i]; }
  }
}

__device__ void ssd_y_item(const Params& p, int item, char* smem) {
  const int tid = get_tid(), lane = tid & 63, wave = tid >> 6, lr = lane & 15, lg = lane >> 4;
  const int h = item & 7, c = (item >> 3) & 31, b = item >> 8;
  const int g = h >> 2;
  bf16_t* sB = (bf16_t*)smem;
  bf16_t* sXT = sB + 128 * 136;
  float* sAcs = (float*)(smem + (128 + 64) * 136 * 2);
  float* sDt = sAcs + 128;
  bf16_t* sPrev = (bf16_t*)(smem + (128 + 64) * 136 * 2 + 1024);
  const size_t tok0 = (size_t)b * S_LEN + c * 128;
  const bf16_t* xt = p.XT + (size_t)(b * 8 + h) * 64 * S_LEN + c * 128;
  const int LT[2] = {wave, 7 - wave};
  const float* prev = p.STATES + ((size_t)(b * 32 + c) * 8 + h) * 8192;
  __syncthreads();
  {
    bf16x8 tb[8], tx[4];
    float4 tp[8];
#pragma unroll
    for (int i = 0; i < 8; i++) { int ch = tid + 256 * i; tp[i] = *(const float4*)(prev + (ch >> 5) * 128 + (ch & 31) * 4); }
#pragma unroll
    for (int i = 0; i < 8; i++) { int ch = tid + 256 * i; tb[i] = *(const bf16x8*)(p.BC + (tok0 + (ch >> 4)) * 512 + g * 128 + (ch & 15) * 8); }
#pragma unroll
    for (int i = 0; i < 4; i++) { int ch = tid + 256 * i; tx[i] = *(const bf16x8*)(xt + (size_t)(ch >> 4) * S_LEN + (ch & 15) * 8); }
    if (tid < 128) {
      const size_t o = ((size_t)(b * 32 + c) * 8 + h) * 128 + tid;
      sAcs[tid] = p.ACS[o]; sDt[tid] = p.DTV[o];
    }
#pragma unroll
    for (int i = 0; i < 8; i++) { int ch = tid + 256 * i; *(bf16x8*)(sB + (ch >> 4) * 136 + (ch & 15) * 8) = tb[i]; }
#pragma unroll
    for (int i = 0; i < 4; i++) { int ch = tid + 256 * i; *(bf16x8*)(sXT + (ch >> 4) * 136 + (ch & 15) * 8) = tx[i]; }
#pragma unroll
    for (int i = 0; i < 8; i++) { int ch = tid + 256 * i; *(bf16x4*)(sPrev + (ch >> 5) * 136 + (ch & 31) * 4) = pack4(tp[i].x, tp[i].y, tp[i].z, tp[i].w); }
  }
  bf16x8 cf[2][4];
  bf16x4 zpre[2][4];
#pragma unroll
  for (int li = 0; li < 2; li++) {
#pragma unroll
    for (int ks = 0; ks < 4; ks++)
      cf[li][ks] = *(const bf16x8*)(p.BC + (tok0 + 16 * LT[li] + lr) * 512 + 256 + g * 128 + 32 * ks + 8 * lg);
#pragma unroll
    for (int pt = 0; pt < 4; pt++)
      zpre[li][pt] = *(const bf16x4*)(p.PROJ + (tok0 + 16 * LT[li] + lr) * NIN + C_Z + h * 64 + 16 * pt + 4 * lg);
  }
  f32x4 acc[4][2];
#pragma unroll
  for (int i = 0; i < 4; i++) { acc[i][0] = (f32x4){0.f, 0.f, 0.f, 0.f}; acc[i][1] = (f32x4){0.f, 0.f, 0.f, 0.f}; }
  __syncthreads();
#pragma unroll
  for (int pt = 0; pt < 4; pt++)
#pragma unroll
    for (int ks = 0; ks < 4; ks++) {
      bf16x8 a = *(const bf16x8*)(sPrev + (16 * pt + lr) * 136 + 32 * ks + 8 * lg);
      acc[pt][0] = mfma16(a, cf[0][ks], acc[pt][0]);
      acc[pt][1] = mfma16(a, cf[1][ks], acc[pt][1]);
    }
#pragma unroll
  for (int li = 0; li < 2; li++) {
    float e = __expf(sAcs[16 * LT[li] + lr]);
#pragma unroll
    for (int pt = 0; pt < 4; pt++) { acc[pt][li][0] *= e; acc[pt][li][1] *= e; acc[pt][li][2] *= e; acc[pt][li][3] *= e; }
  }
#pragma unroll
  for (int li = 0; li < 2; li++) {
    const int lt = LT[li];
    const int lpos = 16 * lt + lr;
    const float acl = sAcs[lpos];
    for (int sp = 0; sp <= (lt >> 1); sp++) {
      f32x4 cb[2] = {(f32x4){0.f, 0.f, 0.f, 0.f}, (f32x4){0.f, 0.f, 0.f, 0.f}};
#pragma unroll
      for (int x = 0; x < 2; x++)
#pragma unroll
        for (int ks = 0; ks < 4; ks++) {
          bf16x8 bfr = *(const bf16x8*)(sB + (32 * sp + 16 * x + lr) * 136 + 32 * ks + 8 * lg);
          cb[x] = mfma16(bfr, cf[li][ks], cb[x]);
        }
      float mv[8];
#pragma unroll
      for (int x = 0; x < 2; x++)
#pragma unroll
        for (int i = 0; i < 4; i++) {
          const int s = 32 * sp + 16 * x + 4 * lg + i;
          mv[4 * x + i] = (s <= lpos) ? cb[x][i] * __expf(acl - sAcs[s]) * sDt[s] : 0.f;
        }
      bf16x8 mb = pack8(mv[0], mv[1], mv[2], mv[3], mv[4], mv[5], mv[6], mv[7]);
#pragma unroll
      for (int pt = 0; pt < 4; pt++) {
        const bf16_t* xp = sXT + (16 * pt + lr) * 136 + 32 * sp + 4 * lg;
        bf16x8 a = cat44(*(const bf16x4*)xp, *(const bf16x4*)(xp + 16));
        acc[pt][li] = mfma16(a, mb, acc[pt][li]);
      }
    }
  }
  const float dsk = p.d_skip[h];
#pragma unroll
  for (int li = 0; li < 2; li++) {
    const int lpos = 16 * LT[li] + lr;
    const size_t tok = tok0 + lpos;
    float ss = 0.f;
#pragma unroll
    for (int pt = 0; pt < 4; pt++) {
      const int pb = 16 * pt + 4 * lg;
      bf16x4 zv = zpre[li][pt];
      float y[4];
#pragma unroll
      for (int i = 0; i < 4; i++) {
        float xv = bf2f(sXT[(pb + i) * 136 + lpos]);
        y[i] = (acc[pt][li][i] + dsk * xv) * silu_f(bfs(zv[i]));
        ss += y[i] * y[i];
      }
      *(bf16x4*)(p.MIX + tok * 1536 + 512 + h * 64 + pb) = pack4(y[0], y[1], y[2], y[3]);
    }
    ss += __shfl_xor(ss, 16); ss += __shfl_xor(ss, 32);
    if (lg == 0) p.SS_SSD[tok * 8 + h] = ss;
  }
}

__device__ void final_rows(const Params& p, int gw, int nw) {
  const int lane = threadIdx.x & 63;
  for (int row = gw; row < T_TOK; row += nw) {
    float r = rsqrtf(p.SS_OUT[row] * (1.f / 1024.f) + 1e-6f);
    float4* o = (float4*)(p.out + (size_t)row * 1024);
    const float4* gf = (const float4*)p.g_final;
#pragma unroll
    for (int i = 0; i < 4; i++) {
      float4 v = o[lane + 64 * i], gg = gf[lane + 64 * i];
      v.x *= r * gg.x; v.y *= r * gg.y; v.z *= r * gg.z; v.w *= r * gg.w;
      o[lane + 64 * i] = v;
    }
  }
}

__device__ __forceinline__ void grid_bar(unsigned* bar, unsigned k) {
  asm volatile("s_waitcnt vmcnt(0)" ::: "memory");
  __syncthreads();
  if (threadIdx.x == 0) {
    const unsigned nb = gridDim.x, r = blockIdx.x & 7u;
    const unsigned nsub = (nb - r + 7u) >> 3;
    const unsigned ngrp = nb < 8u ? nb : 8u;
    __builtin_amdgcn_fence(__ATOMIC_RELEASE, "agent");
    asm volatile("s_waitcnt vmcnt(0)" ::: "memory");
    const unsigned old = __hip_atomic_fetch_add(bar + 64 * r, 1u, __ATOMIC_RELAXED, __HIP_MEMORY_SCOPE_AGENT);
    if (old + 1u == k * nsub) {
      __builtin_amdgcn_fence(__ATOMIC_ACQ_REL, "agent");
      asm volatile("s_waitcnt vmcnt(0)" ::: "memory");
      __hip_atomic_fetch_add(bar + 64 * 8, 1u, __ATOMIC_RELAXED, __HIP_MEMORY_SCOPE_AGENT);
    }
    while (__hip_atomic_load(bar + 64 * 8, __ATOMIC_RELAXED, __HIP_MEMORY_SCOPE_AGENT) < k * ngrp) __builtin_amdgcn_s_sleep(1);
    __builtin_amdgcn_fence(__ATOMIC_ACQUIRE, "agent");
    asm volatile("s_waitcnt vmcnt(0)" ::: "memory");
  }
  __syncthreads();
}

__device__ __forceinline__ int next_item(unsigned* ctr, char* smem) {
  int* sh = (int*)(smem + SMEM_BYTES - 16);
  __syncthreads();
  if (threadIdx.x == 0) *sh = (int)__hip_atomic_fetch_add(ctr, 1u, __ATOMIC_RELAXED, __HIP_MEMORY_SCOPE_AGENT);
  __syncthreads();
  return *sh;
}

__global__ void __launch_bounds__(256, 2) hymba_fwd(Params p) {
  cg::grid_group grid = cg::this_grid();
  __shared__ __attribute__((aligned(16))) char smem[SMEM_BYTES];
  const int nb = gridDim.x, bid = blockIdx.x;
  unsigned bk = 0;

  if (p.out == nullptr) grid.sync();
  for (int rep = 0; rep < REP0; rep++) {
  phase_prep(p);
  grid_bar(p.BAR, ++bk);
  }
  for (int rep = 0; rep < REP1; rep++) {
  if ((nb & 7) == 0) {
    const int xcd = bid & 7, li = bid >> 3, nbx = nb >> 3;
    for (int e = li; e < 1120; e += nbx) {
      const int grp = e / 280, r = e - grp * 280;
      gemm_tile<0>(p, xcd * 32 + grp * 8 + (r & 7), r >> 3, smem);
    }
  } else {
    for (int it = bid; it < 256 * 35; it += nb) gemm_tile<0>(p, it / 35, it % 35, smem);
  }
  for (int j = bid; j < 128; j += nb) gemm_tile<1>(p, j >> 3, j & 7, smem);
  grid_bar(p.BAR, ++bk);
  }
  for (int rep = 0; rep < REP2; rep++) {
  for (int it = next_item(p.BAR + 64 * (9 + rep), smem); it < 256 + 1024 + 2048; it = next_item(p.BAR + 64 * (9 + rep), smem)) {
    if (it < 256) compress_item(p, it, smem);
    else if (it < 1280) memattn_item(p, it - 256, smem);
    else conv_units(p, (it - 1280) * 256 + get_tid());
  }
  grid_bar(p.BAR, ++bk);
  }
  for (int rep = 0; rep < REP3; rep++) {
  {
    const int xq = bid & 7;
    unsigned* ctr = p.BAR + 64 * (16 + xq + 8 * rep);
    for (int li = next_item(ctr, smem); li < 512; li = next_item(ctr, smem)) {
      if (li < 256) nsa_item(p, ((li >> 1) << 4) | (xq + 8 * (li & 1)), smem);
      else ssd_states_item(p, (li - 256) * 8 + xq, smem);
    }
  }
  grid_bar(p.BAR, ++bk);
  }
  for (int it = bid; it < 2048; it += nb) scan_units(p, it * 256 + get_tid());
  grid_bar(p.BAR, ++bk);
  for (int rep = 0; rep < REP5; rep++) {
  for (int it = bid; it < 2048; it += nb) ssd_y_item(p, it, smem);
  grid_bar(p.BAR, ++bk);
  }
  if ((nb & 7) == 0) {
    const int xcd = bid & 7, li = bid >> 3, nbx = nb >> 3;
    for (int e = li; e < 256; e += nbx) gemm_tile<2>(p, xcd * 32 + (e >> 3), e & 7, smem);
  } else {
    for (int it = bid; it < 256 * 8; it += nb) gemm_tile<2>(p, it >> 3, it & 7, smem);
  }
  grid_bar(p.BAR, ++bk);
  final_rows(p, (bid * 256 + threadIdx.x) >> 6, (nb * 256) >> 6);
}

extern "C" void kernel_launch(void* const* d_in, const int* in_sizes, int n_in, void* d_out, int out_size, void* d_ws, size_t ws_size,
                              hipStream_t stream) {
  static int grid_blocks = 0;
  if (!grid_blocks) {
    int dev = 0, cus = 0, per_cu = 0;
    hipGetDevice(&dev);
    hipDeviceGetAttribute(&cus, hipDeviceAttributeMultiprocessorCount, dev);
    hipOccupancyMaxActiveBlocksPerMultiprocessor(&per_cu, hymba_fwd, 256, 0);
    if (per_cu < 1) per_cu = 1;
    if (per_cu > 4) per_cu = 4;
    grid_blocks = cus * per_cu;
  }
  Params p{};
  p.x = (const float*)d_in[0]; p.mem = (const float*)d_in[1]; p.pos = (const int*)d_in[2];
  p.g_in = (const float*)d_in[3]; p.w_in = (const float*)d_in[4]; p.cpk = (const float*)d_in[5];
  p.w1k = (const float*)d_in[6]; p.w2k = (const float*)d_in[7]; p.cpv = (const float*)d_in[8];
  p.w1v = (const float*)d_in[9]; p.w2v = (const float*)d_in[10]; p.conv_w = (const float*)d_in[11];
  p.conv_b = (const float*)d_in[12]; p.dt_bias = (const float*)d_in[13]; p.a_log = (const float*)d_in[14];
  p.d_skip = (const float*)d_in[15]; p.g_ssd = (const float*)d_in[16]; p.g_mem = (const float*)d_in[17];
  p.w_kv = (const float*)d_in[18]; p.w_out = (const float*)d_in[19]; p.g_final = (const float*)d_in[20];
  p.out = (float*)d_out;
  char* w = (char*)d_ws; size_t off = 0;
  auto take = [&](size_t bytes) { char* r = w + off; off += (bytes + 255) & ~(size_t)255; return r; };
  p.WinT = (bf16_t*)take((size_t)NINP * 1024 * 2);
  p.WoutT = (bf16_t*)take((size_t)1024 * 1536 * 2);
  p.WkvT = (bf16_t*)take((size_t)1024 * 1024 * 2);
  p.W1kT = (bf16_t*)take((size_t)256 * 2048 * 2);
  p.W1vT = (bf16_t*)take((size_t)256 * 2048 * 2);
  p.W2kT = (bf16_t*)take((size_t)64 * 256 * 2);
  p.W2vT = (bf16_t*)take((size_t)64 * 256 * 2);
  p.MEMB = (bf16_t*)take((size_t)2048 * 1024 * 2);
  p.PROJ = (bf16_t*)take((size_t)T_TOK * NIN * 2);
  p.VST = (bf16_t*)take((size_t)16 * 64 * S_LEN * 2);
  p.VWT = (bf16_t*)take((size_t)16 * 64 * S_LEN * 2);
  p.KMEM = (bf16_t*)take((size_t)2048 * 512 * 2);
  p.VMEMT = (bf16_t*)take((size_t)32 * 128 * 256 * 2);
  p.KCMP = (bf16_t*)take((size_t)16 * 256 * 64 * 2);
  p.VCMPT = (bf16_t*)take((size_t)16 * 64 * 256 * 2);
  p.XT = (bf16_t*)take((size_t)64 * 64 * S_LEN * 2);
  p.BC = (bf16_t*)take((size_t)T_TOK * 512 * 2);
  p.BT = (bf16_t*)take((size_t)16 * 128 * S_LEN * 2);
  p.MIX = (bf16_t*)take((size_t)T_TOK * 1536 * 2);
  p.XB = p.MIX;
  p.CHDEC = (float*)take((size_t)8 * 32 * 8 * 4);
  p.ACS = (float*)take((size_t)8 * 32 * 8 * 128 * 4);
  p.DTV = (float*)take((size_t)8 * 32 * 8 * 128 * 4);
  p.SS_SSD = (float*)take((size_t)T_TOK * 8 * 4);
  p.SS_OUT = (float*)take((size_t)T_TOK * 4);
  p.BAR = (unsigned*)take((size_t)(64 * 32 + 256) * 4);
  p.MTCNT = p.BAR + 64 * 32;
  p.STATES = (float*)d_out;
  p.KSC = (bf16_t*)((char*)d_out + (size_t)80 * 1024 * 1024);
  p.KWC = p.KSC + (size_t)16 * S_LEN * 64;
  if (off > ws_size) { fprintf(stderr, "workspace too small: need %zu have %zu\n", off, ws_size); return; }
  hipMemsetAsync(p.BAR, 0, (64 * 32 + 256) * 4, stream);
  void* args[] = {&p};
  hipError_t e = hipLaunchCooperativeKernel((void*)hymba_fwd, dim3(grid_blocks), dim3(256), args, 0, stream);
  if (e != hipSuccess) fprintf(stderr, "cooperative launch failed: %s (grid %d)\n", hipGetErrorString(e), grid_blocks);
}
```

```cpp
#include <hip/hip_runtime.h>
#include <hip/hip_cooperative_groups.h>
#include <stdint.h>
#include <stdio.h>
namespace cg = cooperative_groups;

typedef unsigned short bf16_t;
typedef __attribute__((ext_vector_type(8))) short bf16x8;
typedef __attribute__((ext_vector_type(4))) short bf16x4;
typedef __attribute__((ext_vector_type(4))) float f32x4;

#define S_LEN 4096
#define T_TOK 32768
#define NIN 4384
#define NINP 4480
#define LOG2E 1.4426950408889634f

#define C_Q 0
#define C_KC 512
#define C_VC 640
#define C_KS 768
#define C_KW 1024
#define C_GL 1280
#define C_GA 1304
#define C_Z 1816
#define C_XBC 2328
#define C_DT 3352
#define C_QX 3360
#define C_GX 3872

#define SMEM_BYTES 73728
#ifndef REP0
#define REP0 1
#endif
#ifndef REP1
#define REP1 1
#endif
#ifndef REP2
#define REP2 1
#endif
#ifndef REP3
#define REP3 1
#endif
#ifndef REP5
#define REP5 1
#endif

struct Params {
  const float *x, *mem; const int* pos;
  const float *g_in, *w_in, *cpk, *w1k, *w2k, *cpv, *w1v, *w2v, *conv_w, *conv_b, *dt_bias, *a_log, *d_skip, *g_ssd, *g_mem, *w_kv, *w_out, *g_final;
  float* out;
  bf16_t *WinT, *WoutT, *WkvT, *W1kT, *W1vT, *W2kT, *W2vT, *XB, *MEMB, *PROJ, *VST, *VWT, *KMEM, *VMEMT, *KCMP, *VCMPT, *XT, *BC, *BT, *MIX, *KSC, *KWC;
  float *STATES, *CHDEC, *ACS, *DTV, *SS_SSD, *SS_OUT;
  unsigned* BAR;
  unsigned* MTCNT;
};

__device__ __forceinline__ bf16_t f2bf(float f) { uint32_t u = __float_as_uint(f); u += 0x7fffu + ((u >> 16) & 1u); return (bf16_t)(u >> 16); }
__device__ __forceinline__ float bf2f(bf16_t h) { return __uint_as_float(((uint32_t)h) << 16); }
__device__ __forceinline__ float bfs(short h) { return __uint_as_float(((uint32_t)(unsigned short)h) << 16); }
__device__ __forceinline__ float fexp2(float x) { return __builtin_amdgcn_exp2f(x); }
__device__ __forceinline__ float silu_f(float x) { return x * __builtin_amdgcn_rcpf(1.f + __builtin_amdgcn_exp2f(-1.4426950408889634f * x)); }
__device__ __forceinline__ float sigmoid_f(float x) { return __builtin_amdgcn_rcpf(1.f + __builtin_amdgcn_exp2f(-1.4426950408889634f * x)); }
__device__ __forceinline__ f32x4 mfma16(bf16x8 a, bf16x8 b, f32x4 c) { return __builtin_amdgcn_mfma_f32_16x16x32_bf16(a, b, c, 0, 0, 0); }
typedef __bf16 hbf2_t __attribute__((ext_vector_type(2)));
typedef float f2_t __attribute__((ext_vector_type(2)));
typedef uint32_t u32x2 __attribute__((ext_vector_type(2)));
typedef uint32_t u32x4 __attribute__((ext_vector_type(4)));
__device__ __forceinline__ uint32_t pk2(float a, float b) {
  f2_t v; v[0] = a; v[1] = b;
  hbf2_t r = __builtin_convertvector(v, hbf2_t);
  return __builtin_bit_cast(uint32_t, r);
}
__device__ __forceinline__ bf16x4 pack4(float a, float b, float c, float d) {
  u32x2 r; r[0] = pk2(a, b); r[1] = pk2(c, d); return __builtin_bit_cast(bf16x4, r);
}
__device__ __forceinline__ bf16x8 pack8(float a, float b, float c, float d, float e, float f, float g, float h) {
  u32x4 r; r[0] = pk2(a, b); r[1] = pk2(c, d); r[2] = pk2(e, f); r[3] = pk2(g, h); return __builtin_bit_cast(bf16x8, r);
}
__device__ __forceinline__ bf16x8 cat44(bf16x4 a, bf16x4 b) {
  u32x2 x = __builtin_bit_cast(u32x2, a), y = __builtin_bit_cast(u32x2, b);
  u32x4 r; r[0] = x[0]; r[1] = x[1]; r[2] = y[0]; r[3] = y[1]; return __builtin_bit_cast(bf16x8, r);
}
template <int NR, typename L, typename ST, typename C>
__device__ __forceinline__ void tile_pipeline(int n, L load, ST store, C compute) {
  if (n <= 0) return;
  bf16x8 ra[NR], rb[NR];
  const int last = n - 1;
  load(0, ra);
  load(min(1, last), rb);
  store(0, ra);
  load(min(2, last), ra);
  __syncthreads();
  for (int i = 0; i < n; i += 2) {
    compute(i, 0);
    store(1, rb);
    load(min(i + 3, last), rb);
    __syncthreads();
    if (i + 1 < n) compute(i + 1, 1);
    store(0, ra);
    load(min(i + 4, last), ra);
    __syncthreads();
  }
}
template <int NR, typename L, typename ST, typename C>
__device__ __forceinline__ void tile_pipeline1(int n, L load, ST store, C compute) {
  if (n <= 0) return;
  bf16x8 ra[NR];
  load(0, ra);
  store(0, ra);
  if (n > 1) load(1, ra);
  __syncthreads();
  for (int i = 0; i < n; i++) {
    compute(i, i & 1);
    if (i + 1 < n) { store((i + 1) & 1, ra); if (i + 2 < n) load(i + 2, ra); }
    __syncthreads();
  }
}
__device__ __forceinline__ void rope_cs(int pos, int j, float& cs, float& sn) {
  float inv = fexp2(-(float)j * (18.931568569324174f / 8.f));
  float a = (float)pos * inv;
  float n = rintf(a * 0.15915494309189535f);
  float r = fmaf(-n, 6.28125f, a);
  r = fmaf(-n, 1.9353071795864769e-3f, r);
  cs = __cosf(r); sn = __sinf(r);
}

__device__ __forceinline__ float rowmax4(float x) {
  unsigned xi = __float_as_uint(x);
  auto a = __builtin_amdgcn_permlane16_swap(xi, xi, false, false);
  float m = fmaxf(__uint_as_float(a[0]), __uint_as_float(a[1]));
  unsigned mi = __float_as_uint(m);
  auto b = __builtin_amdgcn_permlane32_swap(mi, mi, false, false);
  return fmaxf(__uint_as_float(b[0]), __uint_as_float(b[1]));
}
__device__ __forceinline__ float rowsum4(float x) {
  unsigned xi = __float_as_uint(x);
  auto a = __builtin_amdgcn_permlane16_swap(xi, xi, false, false);
  float m = __uint_as_float(a[0]) + __uint_as_float(a[1]);
  unsigned mi = __float_as_uint(m);
  auto b = __builtin_amdgcn_permlane32_swap(mi, mi, false, false);
  return __uint_as_float(b[0]) + __uint_as_float(b[1]);
}
__device__ __forceinline__ int get_tid() { int t = threadIdx.x; asm volatile("" : "+v"(t)); return t; }

__device__ void prep_rows(const float* __restrict__ x, bf16_t* __restrict__ xb, int nrows, int gw, int nw) {
  const int lane = threadIdx.x & 63;
  int row = gw;
  for (; row + 3 * nw < nrows; row += 4 * nw) {
    float4 v[4][4]; float ss[4];
#pragma unroll
    for (int r = 0; r < 4; r++) {
      const float4* p = (const float4*)(x + (size_t)(row + r * nw) * 1024);
#pragma unroll
      for (int i = 0; i < 4; i++) v[r][i] = p[lane + 64 * i];
    }
#pragma unroll
    for (int r = 0; r < 4; r++) {
      float s = 0.f;
#pragma unroll
      for (int i = 0; i < 4; i++) s += v[r][i].x * v[r][i].x + v[r][i].y * v[r][i].y + v[r][i].z * v[r][i].z + v[r][i].w * v[r][i].w;
#pragma unroll
      for (int o = 32; o >= 1; o >>= 1) s += __shfl_xor(s, o);
      ss[r] = rsqrtf(s * (1.f / 1024.f) + 1e-6f);
    }
#pragma unroll
    for (int r = 0; r < 4; r++)
#pragma unroll
      for (int i = 0; i < 4; i++)
        *(bf16x4*)(xb + (size_t)(row + r * nw) * 1024 + (lane + 64 * i) * 4) =
            pack4(v[r][i].x * ss[r], v[r][i].y * ss[r], v[r][i].z * ss[r], v[r][i].w * ss[r]);
  }
  for (; row < nrows; row += nw) {
    const float4* p = (const float4*)(x + (size_t)row * 1024);
    float4 v[4]; float ss = 0.f;
#pragma unroll
    for (int i = 0; i < 4; i++) { v[i] = p[lane + 64 * i]; ss += v[i].x * v[i].x + v[i].y * v[i].y + v[i].z * v[i].z + v[i].w * v[i].w; }
#pragma unroll
    for (int o = 32; o >= 1; o >>= 1) ss += __shfl_xor(ss, o);
    float r = rsqrtf(ss * (1.f / 1024.f) + 1e-6f);
#pragma unroll
    for (int i = 0; i < 4; i++) {
      bf16x4 o = pack4(v[i].x * r, v[i].y * r, v[i].z * r, v[i].w * r);
      *(bf16x4*)(xb + (size_t)row * 1024 + (lane + 64 * i) * 4) = o;
    }
  }
}

__device__ void prep_wT(const float* __restrict__ w, const float* __restrict__ g, int gk0, int gk1, bf16_t* __restrict__ wt,
                        int K, int N, int Npad, int gtid, int gthreads) {
  const int ln = gtid & 63, gwv = gtid >> 6, nwv = gthreads >> 6;
  const int kblocks = K >> 6;
  const int total = (Npad >> 3) * kblocks;
  for (int uw = gwv; uw < total; uw += nwv) {
    const int kb = uw % kblocks, nbk = uw / kblocks;
    const int n = nbk * 8 + (ln >> 3), k8 = kb * 8 + (ln & 7);
    bf16x8 o;
#pragma unroll
    for (int j = 0; j < 8; j++) {
      int k = k8 * 8 + j; float v = 0.f;
      if (n < N) { v = w[(size_t)k * N + n]; if (g != nullptr && k >= gk0 && k < gk1) v *= g[k - gk0]; }
      o[j] = (short)f2bf(v);
    }
    *(bf16x8*)(wt + (size_t)n * K + k8 * 8) = o;
  }
}

__device__ void phase_prep(const Params& p) {
  const int gtid = blockIdx.x * 256 + threadIdx.x, gthreads = gridDim.x * 256;
  const int gw = gtid >> 6, nw = gthreads >> 6;
  prep_rows(p.x, p.XB, T_TOK, gw, nw);
  prep_rows(p.mem, p.MEMB, 2048, gw, nw);
  prep_wT(p.w_in, p.g_in, 0, 1024, p.WinT, 1024, NIN, NINP, gtid, gthreads);
  prep_wT(p.w_out, p.g_ssd, 512, 1024, p.WoutT, 1536, 1024, 1024, gtid, gthreads);
  prep_wT(p.w_kv, p.g_mem, 0, 1024, p.WkvT, 1024, 1024, 1024, gtid, gthreads);
  prep_wT(p.w1k, nullptr, 0, 0, p.W1kT, 2048, 256, 256, gtid, gthreads);
  prep_wT(p.w1v, nullptr, 0, 0, p.W1vT, 2048, 256, 256, gtid, gthreads);
  prep_wT(p.w2k, nullptr, 0, 0, p.W2kT, 256, 64, 64, gtid, gthreads);
  prep_wT(p.w2v, nullptr, 0, 0, p.W2vT, 256, 64, 64, gtid, gthreads);
  for (int i = gtid; i < T_TOK; i += gthreads) p.SS_OUT[i] = 0.f;
  for (int i = gtid; i < 16 * 64; i += gthreads) {
    int bg = i >> 6, d = i & 63;
    p.KCMP[((size_t)bg * 256 + 255) * 64 + d] = 0;
    p.VCMPT[((size_t)bg * 64 + d) * 256 + 255] = 0;
  }
}

template <int MODE>
__device__ void gemm_tile(const Params& p, int mt, int nt, char* smem) {
  const int tid = get_tid(), lane = tid & 63, wave = tid >> 6, lr = lane & 15, lg = lane >> 4;
  const int wr = wave >> 1, wc = wave & 1;
  const int m0 = mt * 128, n0 = nt * 128;
  const bf16_t* A; const bf16_t* Bt; int K;
  if (MODE == 0) { A = p.XB; Bt = p.WinT; K = 1024; }
  else if (MODE == 1) { A = p.MEMB; Bt = p.WkvT; K = 1024; }
  else { A = p.MIX; Bt = p.WoutT; K = 1536; }
  bf16_t* As = (bf16_t*)smem;
  bf16_t* Bs = As + 2 * 9216;
  const int lrow = tid >> 3, kc = tid & 7;
  const bf16_t* ga = A + (size_t)(m0 + lrow) * K + kc * 8;
  const bf16_t* gb = Bt + (size_t)(n0 + lrow) * K + kc * 8;
  float rs[4] = {1.f, 1.f, 1.f, 1.f};
  if (MODE == 2) {
#pragma unroll
    for (int i = 0; i < 4; i++) {
      const float4* sp = (const float4*)(p.SS_SSD + (size_t)(m0 + lrow + 32 * i) * 8);
      float4 a = sp[0], b = sp[1];
      rs[i] = rsqrtf((a.x + a.y + a.z + a.w + b.x + b.y + b.z + b.w) * (1.f / 512.f) + 1e-6f);
    }
  }
  bool swap;
  if (MODE == 0) swap = !(nt == 7 || nt == 9);
  else if (MODE == 1) swap = (nt < 4);
  else swap = true;
  const bf16_t* F = swap ? (Bs + (64 * wc) * 72) : (As + (64 * wr) * 72);
  const bf16_t* G = swap ? (As + (64 * wr) * 72) : (Bs + (64 * wc) * 72);
  f32x4 acc[4][4];
#pragma unroll
  for (int i = 0; i < 4; i++)
#pragma unroll
    for (int j = 0; j < 4; j++) acc[i][j] = (f32x4){0.f, 0.f, 0.f, 0.f};
  bf16x8 ra0[4], rb0[4], ra1[4], rb1[4];
  const int nk = K / 64;
  auto load = [&](int kt, bf16x8 (&ra)[4], bf16x8 (&rb)[4]) {
#pragma unroll
    for (int i = 0; i < 4; i++) {
      ra[i] = *(const bf16x8*)(ga + (size_t)(32 * i) * K + kt * 64);
      rb[i] = *(const bf16x8*)(gb + (size_t)(32 * i) * K + kt * 64);
    }
  };
  auto store = [&](int buf, int kt, bf16x8 (&ra)[4], bf16x8 (&rb)[4]) {
    if (MODE == 2) {
      if (kt >= 8 && kt < 16) {
#pragma unroll
        for (int i = 0; i < 4; i++) {
          bf16x8 v = ra[i];
          ra[i] = pack8(bfs(v[0]) * rs[i], bfs(v[1]) * rs[i], bfs(v[2]) * rs[i], bfs(v[3]) * rs[i],
                        bfs(v[4]) * rs[i], bfs(v[5]) * rs[i], bfs(v[6]) * rs[i], bfs(v[7]) * rs[i]);
        }
      }
    }
#pragma unroll
    for (int i = 0; i < 4; i++) {
      *(bf16x8*)(As + buf * 9216 + (lrow + 32 * i) * 72 + kc * 8) = ra[i];
      *(bf16x8*)(Bs + buf * 9216 + (lrow + 32 * i) * 72 + kc * 8) = rb[i];
    }
  };
  auto compute = [&](int buf) {
    const int cb = buf * 9216;
#pragma unroll
    for (int ks = 0; ks < 2; ks++) {
      bf16x8 ff[4], gg[4];
#pragma unroll
      for (int i = 0; i < 4; i++) {
        ff[i] = *(const bf16x8*)(F + cb + (16 * i + lr) * 72 + ks * 32 + lg * 8);
        gg[i] = *(const bf16x8*)(G + cb + (16 * i + lr) * 72 + ks * 32 + lg * 8);
      }
#pragma unroll
      for (int i = 0; i < 4; i++)
#pragma unroll
        for (int j = 0; j < 4; j++) acc[i][j] = mfma16(ff[i], gg[j], acc[i][j]);
    }
  };
  const int lastk = nk - 1;
  load(0, ra0, rb0);
  load(1, ra1, rb1);
  store(0, 0, ra0, rb0);
  load(2, ra0, rb0);
  __syncthreads();
  for (int kt = 0; kt < nk; kt += 2) {
    compute(0);
    store(1, kt + 1, ra1, rb1);
    load(min(kt + 3, lastk), ra1, rb1);
    __syncthreads();
    compute(1);
    store(0, min(kt + 2, lastk), ra0, rb0);
    load(min(kt + 4, lastk), ra0, rb0);
    __syncthreads();
  }
  if (swap) {
    if (MODE == 0) {
      const bool rope = (nt < 4) || nt == 6 || nt == 8;
#pragma unroll
      for (int mi = 0; mi < 4; mi++) {
        const int m = m0 + 64 * wr + 16 * mi + lr;
        if (rope) {
          const int pos = p.pos[m];
          f32x4 v = acc[0][mi];
          f32x4 o;
#pragma unroll
          for (int i = 0; i < 4; i++) {
            float pr = __shfl_xor(v[i], 32);
            float cs, sn; rope_cs(pos, 4 * (lg & 1) + i, cs, sn);
            o[i] = (lg < 2) ? (v[i] * cs - pr * sn) : (v[i] * cs + pr * sn);
          }
          acc[0][mi] = o;
        }
        {
          bf16_t* stg = (bf16_t*)smem + ((wave & 1) ? 2 * 9216 : 0) + (wave >> 1) * 4608;
#pragma unroll
          for (int ni = 0; ni < 4; ni++) {
            f32x4 v = acc[ni][mi];
            *(bf16x4*)(stg + (16 * mi + lr) * 72 + 16 * ni + 4 * lg) = pack4(v[0], v[1], v[2], v[3]);
          }
        }
      }
      {
        const bf16_t* stg = (const bf16_t*)smem + ((wave & 1) ? 2 * 9216 : 0) + (wave >> 1) * 4608;
        const int rr = lane >> 3, ch = lane & 7;
        const int nb0 = n0 + 64 * wc + ch * 8;
#pragma unroll
        for (int it = 0; it < 8; it++) {
          const int row = it * 8 + rr;
          const int m = m0 + 64 * wr + row;
          bf16x8 v = *(const bf16x8*)(stg + row * 72 + ch * 8);
          if (nt == 6 || nt == 8) {
            bf16_t* kd = ((nt == 6) ? p.KSC : p.KWC) + (((size_t)(m >> 12) * 2 + wc) * S_LEN + (m & 4095)) * 64;
            *(bf16x8*)(kd + ch * 8) = v;
          } else if (nb0 < NIN) {
            *(bf16x8*)(p.PROJ + (size_t)m * NIN + nb0) = v;
          }
        }
      }
      __syncthreads();
    } else if (MODE == 1) {
#pragma unroll
      for (int mi = 0; mi < 4; mi++) {
        const int m = m0 + 64 * wr + 16 * mi + lr;
#pragma unroll
        for (int ni = 0; ni < 4; ni++) {
          const int n = n0 + 64 * wc + 16 * ni + 4 * lg;
          f32x4 v = acc[ni][mi];
          *(bf16x4*)(p.KMEM + (size_t)m * 512 + n) = pack4(v[0], v[1], v[2], v[3]);
        }
      }
    } else {
#pragma unroll
      for (int mi = 0; mi < 4; mi++) {
        const int m = m0 + 64 * wr + 16 * mi + lr;
        float ss = 0.f;
#pragma unroll
        for (int ni = 0; ni < 4; ni++) {
          const int n = n0 + 64 * wc + 16 * ni + 4 * lg;
          float4 xv = *(const float4*)(p.x + (size_t)m * 1024 + n);
          f32x4 v = acc[ni][mi];
          float4 h; h.x = xv.x + v[0]; h.y = xv.y + v[1]; h.z = xv.z + v[2]; h.w = xv.w + v[3];
          ss += h.x * h.x + h.y * h.y + h.z * h.z + h.w * h.w;
          *(float4*)(p.out + (size_t)m * 1024 + n) = h;
        }
        ss += __shfl_xor(ss, 16); ss += __shfl_xor(ss, 32);
        if (lg == 0) atomicAdd(p.SS_OUT + m, ss);
      }
    }
  } else {
#pragma unroll
    for (int mi = 0; mi < 4; mi++)
#pragma unroll
      for (int ni = 0; ni < 4; ni++) {
        f32x4 v = acc[mi][ni];
        bf16x4 o = pack4(v[0], v[1], v[2], v[3]);
        if (MODE == 0) {
          const int b = m0 >> 12, s = (m0 & 4095) + 64 * wr + 16 * mi + 4 * lg;
          const int d = 16 * ni + lr;
          bf16_t* dst = (nt == 7) ? p.VST : p.VWT;
          *(bf16x4*)(dst + ((size_t)(b * 2 + wc) * 64 + d) * S_LEN + s) = o;
        } else {
          const int b = m0 >> 8, s = (m0 & 255) + 64 * wr + 16 * mi + 4 * lg;
          const int col = n0 - 512 + 64 * wc + 16 * ni + lr;
          const int h = col >> 7, d = col & 127;
          *(bf16x4*)(p.VMEMT + ((size_t)(b * 4 + h) * 128 + d) * 256 + s) = o;
        }
      }
  }
}

template <int DQK, int DV, int MASK, typename MaskF>
__device__ __forceinline__ void attn_tile(const bf16_t* sK, const bf16_t* sVt, const bf16x8 (&qf)[2][DQK / 32], f32x4 (&o)[DV / 16][2],
                                          float (&m)[2], float (&l)[2], float c, bool qsel0, bool qsel1, MaskF valid) {
  constexpr int KST = DQK + 8;
  const int lane = get_tid() & 63, lr = lane & 15, lg = lane >> 4;
  f32x4 s[4][2];
#pragma unroll
  for (int kt = 0; kt < 4; kt++) { s[kt][0] = (f32x4){0.f, 0.f, 0.f, 0.f}; s[kt][1] = (f32x4){0.f, 0.f, 0.f, 0.f}; }
#pragma unroll
  for (int ks = 0; ks < DQK / 32; ks++)
#pragma unroll
    for (int kt = 0; kt < 4; kt++) {
      bf16x8 a = *(const bf16x8*)(sK + (16 * kt + lr) * KST + ks * 32 + lg * 8);
      s[kt][0] = mfma16(a, qf[0][ks], s[kt][0]);
      s[kt][1] = mfma16(a, qf[1][ks], s[kt][1]);
    }
#pragma unroll
  for (int qt = 0; qt < 2; qt++) {
    const bool qs = qt ? qsel1 : qsel0;
    float mx = -1e30f;
    if (MASK) {
#pragma unroll
      for (int kt = 0; kt < 4; kt++)
#pragma unroll
        for (int i = 0; i < 4; i++) {
          bool v = valid(16 * kt + 4 * lg + i, qt);
          float sv = v ? s[kt][qt][i] * c : -1e30f;
          s[kt][qt][i] = sv; mx = fmaxf(mx, sv);
        }
    } else {
#pragma unroll
      for (int kt = 0; kt < 4; kt++) mx = fmaxf(fmaxf(mx, fmaxf(s[kt][qt][0], s[kt][qt][1])), fmaxf(s[kt][qt][2], s[kt][qt][3]));
      mx = qs ? mx * c : -1e30f;
    }
    mx = rowmax4(mx);
    const float mn = fmaxf(m[qt], mx);
    const float alpha = fexp2(m[qt] - mn);
    m[qt] = mn;
    float me;
    if (MASK) me = (mn > -1e29f) ? mn : 1e30f; else me = qs ? mn : 1e30f;
    float rs = 0.f;
#pragma unroll
    for (int kt = 0; kt < 4; kt++)
#pragma unroll
      for (int i = 0; i < 4; i++) {
        float pv = MASK ? fexp2(s[kt][qt][i] - me) : fexp2(fmaf(s[kt][qt][i], c, -me));
        s[kt][qt][i] = pv; rs += pv;
      }
    rs = rowsum4(rs);
    l[qt] = l[qt] * alpha + rs;
#pragma unroll
    for (int dt = 0; dt < DV / 16; dt++) {
      o[dt][qt][0] *= alpha; o[dt][qt][1] *= alpha; o[dt][qt][2] *= alpha; o[dt][qt][3] *= alpha;
    }
  }
#pragma unroll
  for (int k2 = 0; k2 < 2; k2++) {
    bf16x8 pb[2];
#pragma unroll
    for (int qt = 0; qt < 2; qt++)
      pb[qt] = pack8(s[2 * k2][qt][0], s[2 * k2][qt][1], s[2 * k2][qt][2], s[2 * k2][qt][3],
                     s[2 * k2 + 1][qt][0], s[2 * k2 + 1][qt][1], s[2 * k2 + 1][qt][2], s[2 * k2 + 1][qt][3]);
#pragma unroll
    for (int dt = 0; dt < DV / 16; dt++) {
      const bf16_t* vp = sVt + (16 * dt + lr) * 72 + 32 * k2 + 4 * lg;
      bf16x8 a = cat44(*(const bf16x4*)vp, *(const bf16x4*)(vp + 16));
      o[dt][0] = mfma16(a, pb[0], o[dt][0]);
      o[dt][1] = mfma16(a, pb[1], o[dt][1]);
    }
  }
}

__device__ __forceinline__ int next_bit_below(unsigned long long m, int below) {
  unsigned long long mm = (below >= 64) ? m : (m & ((1ull << below) - 1ull));
  return mm ? (63 - __clzll((long long)mm)) : -1;
}

__device__ void nsa_item(const Params& p, int item, char* smem) {
  const int tid = get_tid(), lane = tid & 63, wave = tid >> 6, lr = lane & 15, lg = lane >> 4;
  const int bg = item & 15, qb = 127 - (item >> 4);
  const int b = bg >> 1, g = bg & 1;
  const int t0 = qb * 32, cur = t0 >> 6;
  const int hq = g * 4 + wave;
  float* sImp = (float*)(smem + 55296);
  unsigned long long* sSel = (unsigned long long*)(smem + 63616);
  const float c = 0.125f * LOG2E;
  const size_t tokbase = (size_t)b * S_LEN + t0;
  const int r0 = tid >> 3, cc = tid & 7;

  bf16x8 qf[2][2];
#pragma unroll
  for (int qt = 0; qt < 2; qt++) {
    const bf16_t* row = p.PROJ + (tokbase + 16 * qt + lr) * NIN;
#pragma unroll
    for (int ks = 0; ks < 2; ks++) qf[qt][ks] = *(const bf16x8*)(row + C_Q + hq * 64 + 32 * ks + 8 * lg);
  }
  bf16_t* slab = (bf16_t*)(smem + 36864 + wave * 4608);
  auto emit = [&](f32x4 (&o)[4][2], float (&l)[2], int br) {
#pragma unroll
    for (int qt = 0; qt < 2; qt++) {
      const size_t tok = tokbase + 16 * qt + lr;
      const float gsc = sigmoid_f(bf2f(p.PROJ[tok * NIN + C_GL + hq * 3 + br])) / fmaxf(l[qt], 1e-30f);
#pragma unroll
      for (int dt = 0; dt < 4; dt++) {
        bf16_t* dst = slab + (16 * qt + lr) * 72 + 16 * dt + 4 * lg;
        f32x4 r = o[dt][qt];
        r[0] *= gsc; r[1] *= gsc; r[2] *= gsc; r[3] *= gsc;
        if (br > 0) { bf16x4 pv = *(const bf16x4*)dst; r[0] += bfs(pv[0]); r[1] += bfs(pv[1]); r[2] += bfs(pv[2]); r[3] += bfs(pv[3]); }
        *(bf16x4*)dst = pack4(r[0], r[1], r[2], r[3]);
      }
    }
    if (br == 2) {
      const int rr = lane >> 3, ch = lane & 7;
#pragma unroll
      for (int it = 0; it < 4; it++) {
        const int row = it * 8 + rr;
        const size_t tok = tokbase + row;
        const bf16x8 v = *(const bf16x8*)(slab + row * 72 + ch * 8);
        const bf16x8 ga = *(const bf16x8*)(p.PROJ + tok * NIN + C_GA + hq * 64 + ch * 8);
        *(bf16x8*)(p.MIX + tok * 1536 + hq * 64 + ch * 8) =
            pack8(bfs(v[0]) * silu_f(bfs(ga[0])), bfs(v[1]) * silu_f(bfs(ga[1])), bfs(v[2]) * silu_f(bfs(ga[2])), bfs(v[3]) * silu_f(bfs(ga[3])),
                  bfs(v[4]) * silu_f(bfs(ga[4])), bfs(v[5]) * silu_f(bfs(ga[5])), bfs(v[6]) * silu_f(bfs(ga[6])), bfs(v[7]) * silu_f(bfs(ga[7])));
      }
    }
  };
  auto store_kv = [&](int buf, bf16x8 (&rg)[4]) {
    bf16_t* sK = (bf16_t*)(smem + buf * 18432);
    bf16_t* sVt = sK + 64 * 72;
    *(bf16x8*)(sK + r0 * 72 + cc * 8) = rg[0];
    *(bf16x8*)(sK + (r0 + 32) * 72 + cc * 8) = rg[1];
    *(bf16x8*)(sVt + r0 * 72 + cc * 8) = rg[2];
    *(bf16x8*)(sVt + (r0 + 32) * 72 + cc * 8) = rg[3];
  };

  {
    const int ntiles = (t0 >> 10) + 1;
    const bf16_t* kb = p.KCMP + (size_t)bg * 256 * 64;
    const bf16_t* vb = p.VCMPT + (size_t)bg * 64 * 256;
    for (int pass = 0; pass < 2; pass++) {
      f32x4 o[4][2]; float m[2] = {-1e30f, -1e30f}, l[2] = {0.f, 0.f};
#pragma unroll
      for (int dt = 0; dt < 4; dt++) { o[dt][0] = (f32x4){0.f, 0.f, 0.f, 0.f}; o[dt][1] = (f32x4){0.f, 0.f, 0.f, 0.f}; }
      int ldn = 0;
      tile_pipeline<4>(ntiles,
        [&](int i, bf16x8 (&rg)[4]) {
          rg[0] = *(const bf16x8*)(kb + (size_t)(64 * i + r0) * 64 + cc * 8);
          rg[1] = *(const bf16x8*)(kb + (size_t)(64 * i + r0 + 32) * 64 + cc * 8);
          if (pass == 0) {
            rg[2] = *(const bf16x8*)(vb + (size_t)r0 * 256 + 64 * i + cc * 8);
            rg[3] = *(const bf16x8*)(vb + (size_t)(r0 + 32) * 256 + 64 * i + cc * 8);
          }
        },
        [&](int buf, bf16x8 (&rg)[4]) {
          const int nt = ldn++;
          if (pass == 1) {
#pragma unroll
            for (int i2 = 0; i2 < 2; i2++) {
              const int j = r0 + 32 * i2;
              bf16x8 ov;
#pragma unroll
              for (int x = 0; x < 8; x++) { int n = 64 * nt + cc * 8 + x; ov[x] = (n >= 4 * j - 1 && n <= 4 * j + 3) ? (short)0x3F80 : (short)0; }
              rg[2 + i2] = ov;
            }
          }
          store_kv(buf, rg);
        },
        [&](int i, int buf) {
          const bf16_t* sK = (const bf16_t*)(smem + buf * 18432);
          attn_tile<64, 64, 1>(sK, sK + 64 * 72, qf, o, m, l, c, true, true,
                               [&](int key, int qt) { return 16 * (64 * i + key) + 31 <= t0 + 16 * qt + lr; });
        });
      if (pass == 0) {
        emit(o, l, 0);
      } else {
        float inv[2];
#pragma unroll
        for (int qt = 0; qt < 2; qt++) inv[qt] = 1.f / fmaxf(l[qt], 1e-30f);
        for (int e2 = 0; e2 < 4; e2++) {
          if (wave == e2) {
#pragma unroll
            for (int dt = 0; dt < 4; dt++)
#pragma unroll
              for (int qt = 0; qt < 2; qt++)
#pragma unroll
                for (int i = 0; i < 4; i++) {
                  int j = 16 * dt + 4 * lg + i, q = 16 * qt + lr;
                  float v = o[dt][qt][i] * inv[qt];
                  if (e2 == 0) sImp[q * 65 + j] = v; else sImp[q * 65 + j] += v;
                }
          }
          __syncthreads();
        }
      }
    }
  }
  for (int qq = 0; qq < 8; qq++) {
    const int q = wave * 8 + qq;
    const int j = lane;
    float v = sImp[q * 65 + j];
    bool valid = j <= cur;
    bool forced = (j == 0) || (j == cur) || (j == cur - 1);
    float val = forced ? 1e9f : (valid ? v : -1e9f);
    int rank = 0;
#pragma unroll 16
    for (int jj = 0; jj < 64; jj++) {
      float ov = __int_as_float(__builtin_amdgcn_readlane(__float_as_int(val), jj));
      rank += ((ov > val) || (ov == val && jj < j)) ? 1 : 0;
    }
    unsigned long long mask = __ballot((rank < 16) && valid);
    if (lane == 0) sSel[q] = mask;
  }
  __syncthreads();
  unsigned long long any = 0ull;
  for (int q = 0; q < 32; q++) any |= sSel[q];
  unsigned long long mk[2];
  mk[0] = sSel[lr]; mk[1] = sSel[16 + lr];

  {
    f32x4 o[4][2]; float m[2] = {-1e30f, -1e30f}, l[2] = {0.f, 0.f};
#pragma unroll
    for (int dt = 0; dt < 4; dt++) { o[dt][0] = (f32x4){0.f, 0.f, 0.f, 0.f}; o[dt][1] = (f32x4){0.f, 0.f, 0.f, 0.f}; }
    const bf16_t* kb = p.KSC + (size_t)bg * S_LEN * 64;
    const bf16_t* vb = p.VST + (size_t)bg * 64 * S_LEN;
    const int ntiles = __popcll(any);
    int jl = 64, jc = 64;
    tile_pipeline<4>(ntiles,
      [&](int, bf16x8 (&rg)[4]) {
        jl = (jl > 0) ? next_bit_below(any, jl) : -1;
        const int jj = jl < 0 ? 0 : jl;
        rg[0] = *(const bf16x8*)(kb + (size_t)(64 * jj + r0) * 64 + cc * 8);
        rg[1] = *(const bf16x8*)(kb + (size_t)(64 * jj + r0 + 32) * 64 + cc * 8);
        rg[2] = *(const bf16x8*)(vb + (size_t)r0 * S_LEN + 64 * jj + cc * 8);
        rg[3] = *(const bf16x8*)(vb + (size_t)(r0 + 32) * S_LEN + 64 * jj + cc * 8);
      },
      store_kv,
      [&](int, int buf) {
        jc = next_bit_below(any, jc);
        const int j = jc;
        const bf16_t* sK = (const bf16_t*)(smem + buf * 18432);
        if (j == cur) {
          attn_tile<64, 64, 1>(sK, sK + 64 * 72, qf, o, m, l, c, true, true,
                               [&](int key, int qt) { return 64 * j + key <= t0 + 16 * qt + lr; });
        } else {
          attn_tile<64, 64, 0>(sK, sK + 64 * 72, qf, o, m, l, c, ((mk[0] >> j) & 1ull) != 0ull, ((mk[1] >> j) & 1ull) != 0ull,
                               [&](int, int) { return true; });
        }
      });
    emit(o, l, 1);
  }
  {
    f32x4 o[4][2]; float m[2] = {-1e30f, -1e30f}, l[2] = {0.f, 0.f};
#pragma unroll
    for (int dt = 0; dt < 4; dt++) { o[dt][0] = (f32x4){0.f, 0.f, 0.f, 0.f}; o[dt][1] = (f32x4){0.f, 0.f, 0.f, 0.f}; }
    const int jlo = (cur - 8 > 0) ? (cur - 8) : 0;
    const bf16_t* kb = p.KWC + (size_t)bg * S_LEN * 64;
    const bf16_t* vb = p.VWT + (size_t)bg * 64 * S_LEN;
    tile_pipeline<4>(cur - jlo + 1,
      [&](int i, bf16x8 (&rg)[4]) {
        const int j = cur - i;
        rg[0] = *(const bf16x8*)(kb + (size_t)(64 * j + r0) * 64 + cc * 8);
        rg[1] = *(const bf16x8*)(kb + (size_t)(64 * j + r0 + 32) * 64 + cc * 8);
        rg[2] = *(const bf16x8*)(vb + (size_t)r0 * S_LEN + 64 * j + cc * 8);
        rg[3] = *(const bf16x8*)(vb + (size_t)(r0 + 32) * S_LEN + 64 * j + cc * 8);
      },
      store_kv,
      [&](int i, int buf) {
        const int j = cur - i;
        const bf16_t* sK = (const bf16_t*)(smem + buf * 18432);
        if (j == cur || j == cur - 8) {
          attn_tile<64, 64, 1>(sK, sK + 64 * 72, qf, o, m, l, c, true, true, [&](int key, int qt) {
            int tq = t0 + 16 * qt + lr, kp = 64 * j + key;
            return (kp <= tq) && (kp > tq - 512);
          });
        } else {
          attn_tile<64, 64, 0>(sK, sK + 64 * 72, qf, o, m, l, c, true, true, [&](int, int) { return true; });
        }
      });
    emit(o, l, 2);
  }
}

__device__ void memattn_item(const Params& p, int item, char* smem) {
  const int tid = get_tid(), lane = tid & 63, wave = tid >> 6, lr = lane & 15, lg = lane >> 4;
  const int b = item >> 7, h = (item >> 5) & 3, qb = item & 31;
  const int t0 = qb * 128 + wave * 32;
  const size_t tokbase = (size_t)b * S_LEN + t0;
  bf16x8 qf[2][4];
#pragma unroll
  for (int qt = 0; qt < 2; qt++)
#pragma unroll
    for (int ks = 0; ks < 4; ks++) qf[qt][ks] = *(const bf16x8*)(p.PROJ + (tokbase + 16 * qt + lr) * NIN + C_QX + h * 128 + 32 * ks + 8 * lg);
  f32x4 o[8][2]; float m[2] = {-1e30f, -1e30f}, l[2] = {0.f, 0.f};
#pragma unroll
  for (int dt = 0; dt < 8; dt++) { o[dt][0] = (f32x4){0.f, 0.f, 0.f, 0.f}; o[dt][1] = (f32x4){0.f, 0.f, 0.f, 0.f}; }
  const float c = 0.08838834764831845f * LOG2E;
  const bf16_t* kb = p.KMEM + (size_t)b * 256 * 512 + h * 128;
  const bf16_t* vb = p.VMEMT + (size_t)(b * 4 + h) * 128 * 256;
  tile_pipeline1<8>(4,
    [&](int kt, bf16x8 (&rg)[8]) {
#pragma unroll
      for (int i = 0; i < 4; i++) {
        int ch = tid + 256 * i;
        rg[i] = *(const bf16x8*)(kb + (size_t)(64 * kt + (ch >> 4)) * 512 + (ch & 15) * 8);
        rg[4 + i] = *(const bf16x8*)(vb + (size_t)(ch >> 3) * 256 + 64 * kt + (ch & 7) * 8);
      }
    },
    [&](int buf, bf16x8 (&rg)[8]) {
      bf16_t* sK = (bf16_t*)(smem + buf * 35840);
      bf16_t* sVt = sK + 64 * 136;
#pragma unroll
      for (int i = 0; i < 4; i++) {
        int ch = tid + 256 * i;
        *(bf16x8*)(sK + (ch >> 4) * 136 + (ch & 15) * 8) = rg[i];
        *(bf16x8*)(sVt + (ch >> 3) * 72 + (ch & 7) * 8) = rg[4 + i];
      }
    },
    [&](int, int buf) {
      const bf16_t* sK = (const bf16_t*)(smem + buf * 35840);
      attn_tile<128, 128, 0>(sK, sK + 64 * 136, qf, o, m, l, c, true, true, [&](int, int) { return true; });
    });
#pragma unroll
  for (int qt = 0; qt < 2; qt++) {
    const size_t tok = tokbase + 16 * qt + lr;
    const float inv = 1.f / fmaxf(l[qt], 1e-30f);
#pragma unroll
    for (int dt = 0; dt < 8; dt++) {
      const int dbase = h * 128 + 16 * dt + 4 * lg;
      bf16x4 ga = *(const bf16x4*)(p.PROJ + tok * NIN + C_GX + dbase);
      f32x4 r = o[dt][qt];
      *(bf16x4*)(p.MIX + tok * 1536 + 1024 + dbase) =
          pack4(r[0] * inv * silu_f(bfs(ga[0])), r[1] * inv * silu_f(bfs(ga[1])), r[2] * inv * silu_f(bfs(ga[2])), r[3] * inv * silu_f(bfs(ga[3])));
    }
  }
}

__device__ void compress_item(const Params& p, int item, char* smem) {
  const int tid = get_tid(), lane = tid & 63, wave = tid >> 6, lr = lane & 15, lg = lane >> 4;
  const int which = item >> 7, rho0 = (item & 127) * 32;
  const bf16_t* W1T = which ? p.W1vT : p.W1kT;
  const bf16_t* W2T = which ? p.W2vT : p.W2kT;
  const float* pe = which ? p.cpv : p.cpk;
  const int col0 = which ? C_VC : C_KC;
  bf16_t* sA = (bf16_t*)smem;
  bf16_t* sW = sA + 32 * 72;
  bf16_t* sH = sW + 256 * 72;
  const int arow = tid >> 3, akc = tid & 7;
  const bf16_t* abase;
  {
    int rho = rho0 + arow; if (rho > 4079) rho = 4079;
    int b = rho / 510, rem = rho - b * 510, n = rem >> 1, g = rem & 1;
    abase = p.PROJ + ((size_t)b * S_LEN + 16 * n) * NIN + col0 + g * 64 + akc * 8;
  }
  const bf16_t* wbase = W1T + (size_t)arow * 2048 + akc * 8;
  f32x4 acc[2][4];
#pragma unroll
  for (int i = 0; i < 2; i++)
#pragma unroll
    for (int j = 0; j < 4; j++) acc[i][j] = (f32x4){0.f, 0.f, 0.f, 0.f};
  bf16x8 ra, rw[8];
  float4 rp0, rp1;
  auto load = [&](int kt) {
    ra = *(const bf16x8*)(abase + (size_t)kt * NIN);
    rp0 = *(const float4*)(pe + kt * 64 + akc * 8); rp1 = *(const float4*)(pe + kt * 64 + akc * 8 + 4);
#pragma unroll
    for (int i = 0; i < 8; i++) rw[i] = *(const bf16x8*)(wbase + (size_t)(32 * i) * 2048 + kt * 64);
  };
  load(0);
  for (int kt = 0; kt < 32; kt++) {
    __syncthreads();
    *(bf16x8*)(sA + arow * 72 + akc * 8) =
        pack8(bfs(ra[0]) + rp0.x, bfs(ra[1]) + rp0.y, bfs(ra[2]) + rp0.z, bfs(ra[3]) + rp0.w,
              bfs(ra[4]) + rp1.x, bfs(ra[5]) + rp1.y, bfs(ra[6]) + rp1.z, bfs(ra[7]) + rp1.w);
#pragma unroll
    for (int i = 0; i < 8; i++) *(bf16x8*)(sW + (arow + 32 * i) * 72 + akc * 8) = rw[i];
    __syncthreads();
    load(kt < 31 ? kt + 1 : 31);
#pragma unroll
    for (int ks = 0; ks < 2; ks++) {
      bf16x8 a0 = *(const bf16x8*)(sA + lr * 72 + ks * 32 + 8 * lg);
      bf16x8 a1 = *(const bf16x8*)(sA + (16 + lr) * 72 + ks * 32 + 8 * lg);
#pragma unroll
      for (int ct = 0; ct < 4; ct++) {
        bf16x8 bf = *(const bf16x8*)(sW + (64 * wave + 16 * ct + lr) * 72 + ks * 32 + 8 * lg);
        acc[0][ct] = mfma16(a0, bf, acc[0][ct]);
        acc[1][ct] = mfma16(a1, bf, acc[1][ct]);
      }
    }
  }
  __syncthreads();
#pragma unroll
  for (int rt = 0; rt < 2; rt++)
#pragma unroll
    for (int ct = 0; ct < 4; ct++)
#pragma unroll
      for (int i = 0; i < 4; i++) sH[(16 * rt + 4 * lg + i) * 264 + 64 * wave + 16 * ct + lr] = f2bf(silu_f(acc[rt][ct][i]));
  __syncthreads();
  f32x4 acc2[2] = {(f32x4){0.f, 0.f, 0.f, 0.f}, (f32x4){0.f, 0.f, 0.f, 0.f}};
#pragma unroll
  for (int ks = 0; ks < 8; ks++) {
    bf16x8 bf = *(const bf16x8*)(W2T + (size_t)(16 * wave + lr) * 256 + 32 * ks + 8 * lg);
#pragma unroll
    for (int rt = 0; rt < 2; rt++) {
      bf16x8 a = *(const bf16x8*)(sH + (16 * rt + lr) * 264 + 32 * ks + 8 * lg);
      acc2[rt] = mfma16(a, bf, acc2[rt]);
    }
  }
  const int col = 16 * wave + lr;
#pragma unroll
  for (int rt = 0; rt < 2; rt++)
#pragma unroll
    for (int i = 0; i < 4; i++) {
      int rho = rho0 + 16 * rt + 4 * lg + i;
      bool ok = rho < 4080;
      int rc = ok ? rho : 4079;
      int b = rc / 510, rem = rc - b * 510, n = rem >> 1, g = rem & 1;
      float v = acc2[rt][i];
      float pr = __shfl_xor(v, 8);
      if (which == 0) {
        if (wave == 0) {
          int pos = p.pos[b * S_LEN + 16 * n + 31];
          float cs, sn; rope_cs(pos, lr & 7, cs, sn);
          v = (lr < 8) ? (v * cs - pr * sn) : (v * cs + pr * sn);
        }
        if (ok) p.KCMP[((size_t)(b * 2 + g) * 256 + n) * 64 + col] = f2bf(v);
      } else {
        if (ok) p.VCMPT[((size_t)(b * 2 + g) * 64 + col) * 256 + n] = f2bf(v);
      }
    }
}

__device__ void conv_units(const Params& p, int u) {
  const int it = u >> 8, wvi = (u >> 6) & 3, ln = u & 63;
  const int cgp = ((it & 3) * 4 + wvi) * 8 + (ln >> 3), tg = (it >> 2) * 8 + (ln & 7);
  const int tok0 = tg * 8, s0 = tok0 & 4095, ch0 = cgp * 8;
  const int b = tok0 >> 12;
  bf16x8 in[11];
#pragma unroll
  for (int r = 0; r < 11; r++) {
    int s = s0 - 3 + r;
    if (s >= 0) in[r] = *(const bf16x8*)(p.PROJ + (size_t)(tok0 - 3 + r) * NIN + C_XBC + ch0);
    else in[r] = (bf16x8){0, 0, 0, 0, 0, 0, 0, 0};
  }
  float4 wv[4][2];
#pragma unroll
  for (int k = 0; k < 4; k++) { wv[k][0] = *(const float4*)(p.conv_w + k * 1024 + ch0); wv[k][1] = *(const float4*)(p.conv_w + k * 1024 + ch0 + 4); }
  float4 bv0 = *(const float4*)(p.conv_b + ch0), bv1 = *(const float4*)(p.conv_b + ch0 + 4);
  float w[4][8], bias[8];
#pragma unroll
  for (int k = 0; k < 4; k++) { w[k][0] = wv[k][0].x; w[k][1] = wv[k][0].y; w[k][2] = wv[k][0].z; w[k][3] = wv[k][0].w; w[k][4] = wv[k][1].x; w[k][5] = wv[k][1].y; w[k][6] = wv[k][1].z; w[k][7] = wv[k][1].w; }
  bias[0] = bv0.x; bias[1] = bv0.y; bias[2] = bv0.z; bias[3] = bv0.w; bias[4] = bv1.x; bias[5] = bv1.y; bias[6] = bv1.z; bias[7] = bv1.w;
  if (ch0 >= 512) {
#pragma unroll
    for (int tt = 0; tt < 8; tt++) {
      bf16x8 o;
#pragma unroll
      for (int j = 0; j < 8; j++) {
        float a = bias[j];
#pragma unroll
        for (int k = 0; k < 4; k++) a += bfs(in[tt + k][j]) * w[k][j];
        o[j] = (short)f2bf(silu_f(a));
      }
      *(bf16x8*)(p.BC + (size_t)(tok0 + tt) * 512 + (ch0 - 512)) = o;
    }
  }
  if (ch0 < 768) {
#pragma unroll
    for (int j = 0; j < 8; j++) {
      bf16x8 o;
#pragma unroll
      for (int tt = 0; tt < 8; tt++) {
        float a = bias[j];
#pragma unroll
        for (int k = 0; k < 4; k++) a += bfs(in[tt + k][j]) * w[k][j];
        o[tt] = (short)f2bf(silu_f(a));
      }
      const int ch = ch0 + j;
      bf16_t* dst;
      if (ch0 < 512) dst = p.XT + ((size_t)(b * 8 + (ch >> 6)) * 64 + (ch & 63)) * S_LEN + s0;
      else dst = p.BT + ((size_t)(b * 2 + ((ch - 512) >> 7)) * 128 + ((ch - 512) & 127)) * S_LEN + s0;
      *(bf16x8*)dst = o;
    }
  }
}

__device__ void ssd_states_item(const Params& p, int item, char* smem) {
  const int tid = get_tid(), lane = tid & 63, wave = tid >> 6, lr = lane & 15, lg = lane >> 4;
  const int h = item & 7, c = (item >> 3) & 31, b = item >> 8;
  const int g = h >> 2;
  bf16_t* sX = (bf16_t*)smem;
  bf16_t* sBt = sX + 64 * 136;
  float* sAcs = (float*)(smem + (64 + 128) * 136 * 2);
  float* sW = sAcs + 128;
  float* sTot = sW + 128;
  const size_t tok0 = (size_t)b * S_LEN + c * 128;
  const bf16_t* xt = p.XT + (size_t)(b * 8 + h) * 64 * S_LEN + c * 128;
  const bf16_t* bt = p.BT + (size_t)(b * 2 + g) * 128 * S_LEN + c * 128;
  __syncthreads();
  bf16x8 tx[4], tb[8];
#pragma unroll
  for (int i = 0; i < 4; i++) { int ch = tid + 256 * i; tx[i] = *(const bf16x8*)(xt + (size_t)(ch >> 4) * S_LEN + (ch & 15) * 8); }
#pragma unroll
  for (int i = 0; i < 8; i++) { int ch = tid + 256 * i; tb[i] = *(const bf16x8*)(bt + (size_t)(ch >> 4) * S_LEN + (ch & 15) * 8); }
  float dt = 0.f, cs = 0.f;
  if (tid < 128) {
    float raw = bf2f(p.PROJ[(tok0 + tid) * NIN + C_DT + h]) + p.dt_bias[h];
    dt = fmaxf(raw, 0.f) + log1pf(__expf(-fabsf(raw)));
    float a = -__expf(p.a_log[h]);
    cs = dt * a;
#pragma unroll
    for (int o = 1; o < 64; o <<= 1) { float t = __shfl_up(cs, o); if (lane >= o) cs += t; }
    if (lane == 63) sTot[wave] = cs;
  }
  __syncthreads();
  if (tid < 128) {
    if (wave == 1) cs += sTot[0];
    sAcs[tid] = cs;
  }
  __syncthreads();
  if (tid < 128) {
    float last = sAcs[127];
    sW[tid] = dt * __expf(last - cs);
    const size_t o = ((size_t)(b * 32 + c) * 8 + h) * 128 + tid;
    p.ACS[o] = cs; p.DTV[o] = dt;
    if (tid == 0) p.CHDEC[(b * 32 + c) * 8 + h] = __expf(last);
  }
#pragma unroll
  for (int i = 0; i < 8; i++) { int ch = tid + 256 * i; *(bf16x8*)(sBt + (ch >> 4) * 136 + (ch & 15) * 8) = tb[i]; }
  __syncthreads();
#pragma unroll
  for (int i = 0; i < 4; i++) {
    int ch = tid + 256 * i;
    const int l0 = (ch & 15) * 8;
    float4 w0 = *(const float4*)(sW + l0), w1 = *(const float4*)(sW + l0 + 4);
    bf16x8 r = tx[i];
    *(bf16x8*)(sX + (ch >> 4) * 136 + l0) = pack8(bfs(r[0]) * w0.x, bfs(r[1]) * w0.y, bfs(r[2]) * w0.z, bfs(r[3]) * w0.w,
                                                  bfs(r[4]) * w1.x, bfs(r[5]) * w1.y, bfs(r[6]) * w1.z, bfs(r[7]) * w1.w);
  }
  __syncthreads();
  f32x4 acc[4][2];
#pragma unroll
  for (int i = 0; i < 4; i++) { acc[i][0] = (f32x4){0.f, 0.f, 0.f, 0.f}; acc[i][1] = (f32x4){0.f, 0.f, 0.f, 0.f}; }
#pragma unroll
  for (int ks = 0; ks < 4; ks++) {
    const int l0 = 32 * ks + 8 * lg;
    bf16x8 bf0 = *(const bf16x8*)(sBt + (32 * wave + lr) * 136 + l0);
    bf16x8 bf1 = *(const bf16x8*)(sBt + (32 * wave + 16 + lr) * 136 + l0);
#pragma unroll
    for (int pt = 0; pt < 4; pt++) {
      bf16x8 a = *(const bf16x8*)(sX + (16 * pt + lr) * 136 + l0);
      acc[pt][0] = mfma16(a, bf0, acc[pt][0]);
      acc[pt][1] = mfma16(a, bf1, acc[pt][1]);
    }
  }
  float* st = p.STATES + ((size_t)(b * 32 + c) * 8 + h) * 8192;
#pragma unroll
  for (int pt = 0; pt < 4; pt++)
#pragma unroll
    for (int x = 0; x < 2; x++)
#pragma unroll
      for (int i = 0; i < 4; i++) st[(16 * pt + 4 * lg + i) * 128 + 32 * wave + 16 * x + lr] = acc[pt][x][i];
}

__device__ void scan_units(const Params& p, int q) {
  const int b = q >> 16, r = q & 65535, h = r >> 13;
  float hs = 0.f;
  for (int c0 = 0; c0 < 32; c0 += 16) {
    float s[16], d[16];
#pragma unroll
    for (int i = 0; i < 16; i++) { s[i] = p.STATES[(size_t)(b * 32 + c0 + i) * 65536 + r]; d[i] = p.CHDEC[(b * 32 + c0 + i) * 8 + h]; }
#pragma unroll
    for (int i = 0; i < 16; i++) { p.STATES[(size_t)(b * 32 + c0 + i) * 65536 + r] = hs; hs = hs * d[i] + s[i]; }
  }
}

__device__ void ssd_y_item(const Params& p, int item, char* smem) {
  const int tid = get_tid(), lane = tid & 63, wave = tid >> 6, lr = lane & 15, lg = lane >> 4;
  const int h = item & 7, c = (item >> 3) & 31, b = item >> 8;
  const int g = h >> 2;
  bf16_t* sB = (bf16_t*)smem;
  bf16_t* sXT = sB + 128 * 136;
  float* sAcs = (float*)(smem + (128 + 64) * 136 * 2);
  float* sDt = sAcs + 128;
  bf16_t* sPrev = (bf16_t*)(smem + (128 + 64) * 136 * 2 + 1024);
  const size_t tok0 = (size_t)b * S_LEN + c * 128;
  const bf16_t* xt = p.XT + (size_t)(b * 8 + h) * 64 * S_LEN + c * 128;
  const int LT[2] = {wave, 7 - wave};
  const float* prev = p.STATES + ((size_t)(b * 32 + c) * 8 + h) * 8192;
  __syncthreads();
  {
    bf16x8 tb[8], tx[4];
    float4 tp[8];
#pragma unroll
    for (int i = 0; i < 8; i++) { int ch = tid + 256 * i; tp[i] = *(const float4*)(prev + (ch >> 5) * 128 + (ch & 31) * 4); }
#pragma unroll
    for (int i = 0; i < 8; i++) { int ch = tid + 256 * i; tb[i] = *(const bf16x8*)(p.BC + (tok0 + (ch >> 4)) * 512 + g * 128 + (ch & 15) * 8); }
#pragma unroll
    for (int i = 0; i < 4; i++) { int ch = tid + 256 * i; tx[i] = *(const bf16x8*)(xt + (size_t)(ch >> 4) * S_LEN + (ch & 15) * 8); }
    if (tid < 128) {
      const size_t o = ((size_t)(b * 32 + c) * 8 + h) * 128 + tid;
      sAcs[tid] = p.ACS[o]; sDt[tid] = p.DTV[o];
    }
#pragma unroll
    for (int i = 0; i < 8; i++) { int ch = tid + 256 * i; *(bf16x8*)(sB + (ch >> 4) * 136 + (ch & 15) * 8) = tb[i]; }
#pragma unroll
    for (int i = 0; i < 4; i++) { int ch = tid + 256 * i; *(bf16x8*)(sXT + (ch >> 4) * 136 + (ch & 15) * 8) = tx[i]; }
#pragma unroll
    for (int i = 0; i < 8; i++) { int ch = tid + 256 * i; *(bf16x4*)(sPrev + (ch >> 5) * 136 + (ch & 31) * 4) = pack4(tp[i].x, tp[i].y, tp[i].z, tp[i].w); }
  }
  bf16x8 cf[2][4];
  bf16x4 zpre[2][4];
#pragma unroll
  for (int li = 0; li < 2; li++) {
#pragma unroll
    for (int ks = 0; ks < 4; ks++)
      cf[li][ks] = *(const bf16x8*)(p.BC + (tok0 + 16 * LT[li] + lr) * 512 + 256 + g * 128 + 32 * ks + 8 * lg);
#pragma unroll
    for (int pt = 0; pt < 4; pt++)
      zpre[li][pt] = *(const bf16x4*)(p.PROJ + (tok0 + 16 * LT[li] + lr) * NIN + C_Z + h * 64 + 16 * pt + 4 * lg);
  }
  f32x4 acc[4][2];
#pragma unroll
  for (int i = 0; i < 4; i++) { acc[i][0] = (f32x4){0.f, 0.f, 0.f, 0.f}; acc[i][1] = (f32x4){0.f, 0.f, 0.f, 0.f}; }
  __syncthreads();
#pragma unroll
  for (int pt = 0; pt < 4; pt++)
#pragma unroll
    for (int ks = 0; ks < 4; ks++) {
      bf16x8 a = *(const bf16x8*)(sPrev + (16 * pt + lr) * 136 + 32 * ks + 8 * lg);
      acc[pt][0] = mfma16(a, cf[0][ks], acc[pt][0]);
      acc[pt][1] = mfma16(a, cf[1][ks], acc[pt][1]);
    }
#pragma unroll
  for (int li = 0; li < 2; li++) {
    float e = __expf(sAcs[16 * LT[li] + lr]);
#pragma unroll
    for (int pt = 0; pt < 4; pt++) { acc[pt][li][0] *= e; acc[pt][li][1] *= e; acc[pt][li][2] *= e; acc[pt][li][3] *= e; }
  }
#pragma unroll
  for (int li = 0; li < 2; li++) {
    const int lt = LT[li];
    const int lpos = 16 * lt + lr;
    const float acl = sAcs[lpos];
    for (int sp = 0; sp <= (lt >> 1); sp++) {
      f32x4 cb[2] = {(f32x4){0.f, 0.f, 0.f, 0.f}, (f32x4){0.f, 0.f, 0.f, 0.f}};
#pragma unroll
      for (int x = 0; x < 2; x++)
#pragma unroll
        for (int ks = 0; ks < 4; ks++) {
          bf16x8 bfr = *(const bf16x8*)(sB + (32 * sp + 16 * x + lr) * 136 + 32 * ks + 8 * lg);
          cb[x] = mfma16(bfr, cf[li][ks], cb[x]);
        }
      float mv[8];
#pragma unroll
      for (int x = 0; x < 2; x++)
#pragma unroll
        for (int i = 0; i < 4; i++) {
          const int s = 32 * sp + 16 * x + 4 * lg + i;
          mv[4 * x + i] = (s <= lpos) ? cb[x][i] * __expf(acl - sAcs[s]) * sDt[s] : 0.f;
        }
      bf16x8 mb = pack8(mv[0], mv[1], mv[2], mv[3], mv[4], mv[5], mv[6], mv[7]);
#pragma unroll
      for (int pt = 0; pt < 4; pt++) {
        const bf16_t* xp = sXT + (16 * pt + lr) * 136 + 32 * sp + 4 * lg;
        bf16x8 a = cat44(*(const bf16x4*)xp, *(const bf16x4*)(xp + 16));
        acc[pt][li] = mfma16(a, mb, acc[pt][li]);
      }
    }
  }
  const float dsk = p.d_skip[h];
#pragma unroll
  for (int li = 0; li < 2; li++) {
    const int lpos = 16 * LT[li] + lr;
    const size_t tok = tok0 + lpos;
    float ss = 0.f;
#pragma unroll
    for (int pt = 0; pt < 4; pt++) {
      const int pb = 16 * pt + 4 * lg;
      bf16x4 zv = zpre[li][pt];
      float y[4];
#pragma unroll
      for (int i = 0; i < 4; i++) {
        float xv = bf2f(sXT[(pb + i) * 136 + lpos]);
        y[i] = (acc[pt][li][i] + dsk * xv) * silu_f(bfs(zv[i]));
        ss += y[i] * y[i];
      }
      *(bf16x4*)(p.MIX + tok * 1536 + 512 + h * 64 + pb) = pack4(y[0], y[1], y[2], y[3]);
    }
    ss += __shfl_xor(ss, 16); ss += __shfl_xor(ss, 32);
    if (lg == 0) p.SS_SSD[tok * 8 + h] = ss;
  }
}

__device__ void final_rows(const Params& p, int gw, int nw) {
  const int lane = threadIdx.x & 63;
  for (int row = gw; row < T_TOK; row += nw) {
    float r = rsqrtf(p.SS_OUT[row] * (1.f / 1024.f) + 1e-6f);
    float4* o = (float4*)(p.out + (size_t)row * 1024);
    const float4* gf = (const float4*)p.g_final;
#pragma unroll
    for (int i = 0; i < 4; i++) {
      float4 v = o[lane + 64 * i], gg = gf[lane + 64 * i];
      v.x *= r * gg.x; v.y *= r * gg.y; v.z *= r * gg.z; v.w *= r * gg.w;
      o[lane + 64 * i] = v;
    }
  }
}

__device__ __forceinline__ void grid_bar(unsigned* bar, unsigned k) {
  asm volatile("s_waitcnt vmcnt(0)" ::: "memory");
  __syncthreads();
  if (threadIdx.x == 0) {
    const unsigned nb = gridDim.x, r = blockIdx.x & 7u;
    const unsigned nsub = (nb - r + 7u) >> 3;
    const unsigned ngrp = nb < 8u ? nb : 8u;
    __builtin_amdgcn_fence(__ATOMIC_RELEASE, "agent");
    asm volatile("s_waitcnt vmcnt(0)" ::: "memory");
    const unsigned old = __hip_atomic_fetch_add(bar + 64 * r, 1u, __ATOMIC_RELAXED, __HIP_MEMORY_SCOPE_AGENT);
    if (old + 1u == k * nsub) {
      __builtin_amdgcn_fence(__ATOMIC_ACQ_REL, "agent");
      asm volatile("s_waitcnt vmcnt(0)" ::: "memory");
      __hip_atomic_fetch_add(bar + 64 * 8, 1u, __ATOMIC_RELAXED, __HIP_MEMORY_SCOPE_AGENT);
    }
    while (__hip_atomic_load(bar + 64 * 8, __ATOMIC_RELAXED, __HIP_MEMORY_SCOPE_AGENT) < k * ngrp) __builtin_amdgcn_s_sleep(1);
    __builtin_amdgcn_fence(__ATOMIC_ACQUIRE, "agent");
    asm volatile("s_waitcnt vmcnt(0)" ::: "memory");
  }
  __syncthreads();
}

__device__ __forceinline__ int next_item(unsigned* ctr, char* smem) {
  int* sh = (int*)(smem + SMEM_BYTES - 16);
  __syncthreads();
  if (threadIdx.x == 0) *sh = (int)__hip_atomic_fetch_add(ctr, 1u, __ATOMIC_RELAXED, __HIP_MEMORY_SCOPE_AGENT);
  __syncthreads();
  return *sh;
}

__global__ void __launch_bounds__(256, 2) hymba_fwd(Params p) {
  cg::grid_group grid = cg::this_grid();
  __shared__ __attribute__((aligned(16))) char smem[SMEM_BYTES];
  const int nb = gridDim.x, bid = blockIdx.x;
  unsigned bk = 0;

  if (p.out == nullptr) grid.sync();
  for (int rep = 0; rep < REP0; rep++) {
  phase_prep(p);
  grid_bar(p.BAR, ++bk);
  }
  for (int rep = 0; rep < REP1; rep++) {
  if ((nb & 7) == 0) {
    const int xcd = bid & 7, li = bid >> 3, nbx = nb >> 3;
    for (int e = li; e < 1120; e += nbx) {
      const int grp = e / 280, r = e - grp * 280;
      gemm_tile<0>(p, xcd * 32 + grp * 8 + (r & 7), r >> 3, smem);
    }
  } else {
    for (int it = bid; it < 256 * 35; it += nb) gemm_tile<0>(p, it / 35, it % 35, smem);
  }
  for (int j = bid; j < 128; j += nb) gemm_tile<1>(p, j >> 3, j & 7, smem);
  grid_bar(p.BAR, ++bk);
  }
  for (int rep = 0; rep < REP2; rep++) {
  for (int it = next_item(p.BAR + 64 * (9 + rep), smem); it < 256 + 1024 + 2048; it = next_item(p.BAR + 64 * (9 + rep), smem)) {
    if (it < 256) compress_item(p, it, smem);
    else if (it < 1280) memattn_item(p, it - 256, smem);
    else conv_units(p, (it - 1280) * 256 + get_tid());
  }
  grid_bar(p.BAR, ++bk);
  }
  for (int rep = 0; rep < REP3; rep++) {
  {
    const int xq = bid & 7;
    unsigned* ctr = p.BAR + 64 * (16 + xq + 8 * rep);
    for (int li = next_item(ctr, smem); li < 512; li = next_item(ctr, smem)) {
      if (li < 256) nsa_item(p, ((li >> 1) << 4) | (xq + 8 * (li & 1)), smem);
      else ssd_states_item(p, (li - 256) * 8 + xq, smem);
    }
  }
  grid_bar(p.BAR, ++bk);
  }
  for (int it = bid; it < 2048; it += nb) scan_units(p, it * 256 + get_tid());
  grid_bar(p.BAR, ++bk);
  for (int rep = 0; rep < REP5; rep++) {
  for (int it = bid; it < 2048; it += nb) ssd_y_item(p, it, smem);
  grid_bar(p.BAR, ++bk);
  }
  if ((nb & 7) == 0) {
    const int xcd = bid & 7, li = bid >> 3, nbx = nb >> 3;
    for (int e = li; e < 256; e += nbx) gemm_tile<2>(p, xcd * 32 + (e >> 3), e & 7, smem);
  } else {
    for (int it = bid; it < 256 * 8; it += nb) gemm_tile<2>(p, it >> 3, it & 7, smem);
  }
  grid_bar(p.BAR, ++bk);
  final_rows(p, (bid * 256 + threadIdx.x) >> 6, (nb * 256) >> 6);
}

extern "C" void kernel_launch(void* const* d_in, const int* in_sizes, int n_in, void* d_out, int out_size, void* d_ws, size_t ws_size,
                              hipStream_t stream) {
  static int grid_blocks = 0;
  if (!grid_blocks) {
    int dev = 0, cus = 0, per_cu = 0;
    hipGetDevice(&dev);
    hipDeviceGetAttribute(&cus, hipDeviceAttributeMultiprocessorCount, dev);
    hipOccupancyMaxActiveBlocksPerMultiprocessor(&per_cu, hymba_fwd, 256, 0);
    if (per_cu < 1) per_cu = 1;
    if (per_cu > 4) per_cu = 4;
    grid_blocks = cus * per_cu;
  }
  Params p{};
  p.x = (const float*)d_in[0]; p.mem = (const float*)d_in[1]; p.pos = (const int*)d_in[2];
  p.g_in = (const float*)d_in[3]; p.w_in = (const float*)d_in[4]; p.cpk = (const float*)d_in[5];
  p.w1k = (const float*)d_in[6]; p.w2k = (const float*)d_in[7]; p.cpv = (const float*)d_in[8];
  p.w1v = (const float*)d_in[9]; p.w2v = (const float*)d_in[10]; p.conv_w = (const float*)d_in[11];
  p.conv_b = (const float*)d_in[12]; p.dt_bias = (const float*)d_in[13]; p.a_log = (const float*)d_in[14];
  p.d_skip = (const float*)d_in[15]; p.g_ssd = (const float*)d_in[16]; p.g_mem = (const float*)d_in[17];
  p.w_kv = (const float*)d_in[18]; p.w_out = (const float*)d_in[19]; p.g_final = (const float*)d_in[20];
  p.out = (float*)d_out;
  char* w = (char*)d_ws; size_t off = 0;
  auto take = [&](size_t bytes) { char* r = w + off; off += (bytes + 255) & ~(size_t)255; return r; };
  p.WinT = (bf16_t*)take((size_t)NINP * 1024 * 2);
  p.WoutT = (bf16_t*)take((size_t)1024 * 1536 * 2);
  p.WkvT = (bf16_t*)take((size_t)1024 * 1024 * 2);
  p.W1kT = (bf16_t*)take((size_t)256 * 2048 * 2);
  p.W1vT = (bf16_t*)take((size_t)256 * 2048 * 2);
  p.W2kT = (bf16_t*)take((size_t)64 * 256 * 2);
  p.W2vT = (bf16_t*)take((size_t)64 * 256 * 2);
  p.MEMB = (bf16_t*)take((size_t)2048 * 1024 * 2);
  p.PROJ = (bf16_t*)take((size_t)T_TOK * NIN * 2);
  p.VST = (bf16_t*)take((size_t)16 * 64 * S_LEN * 2);
  p.VWT = (bf16_t*)take((size_t)16 * 64 * S_LEN * 2);
  p.KMEM = (bf16_t*)take((size_t)2048 * 512 * 2);
  p.VMEMT = (bf16_t*)take((size_t)32 * 128 * 256 * 2);
  p.KCMP = (bf16_t*)take((size_t)16 * 256 * 64 * 2);
  p.VCMPT = (bf16_t*)take((size_t)16 * 64 * 256 * 2);
  p.XT = (bf16_t*)take((size_t)64 * 64 * S_LEN * 2);
  p.BC = (bf16_t*)take((size_t)T_TOK * 512 * 2);
  p.BT = (bf16_t*)take((size_t)16 * 128 * S_LEN * 2);
  p.MIX = (bf16_t*)take((size_t)T_TOK * 1536 * 2);
  p.XB = p.MIX;
  p.CHDEC = (float*)take((size_t)8 * 32 * 8 * 4);
  p.ACS = (float*)take((size_t)8 * 32 * 8 * 128 * 4);
  p.DTV = (float*)take((size_t)8 * 32 * 8 * 128 * 4);
  p.SS_SSD = (float*)take((size_t)T_TOK * 8 * 4);
  p.SS_OUT = (float*)take((size_t)T_TOK * 4);
  p.BAR = (unsigned*)take((size_t)(64 * 32 + 256) * 4);
  p.MTCNT = p.BAR + 64 * 32;
  p.STATES = (float*)d_out;
  p.KSC = (bf16_t*)((char*)d_out + (size_t)80 * 1024 * 1024);
  p.KWC = p.KSC + (size_t)16 * S_LEN * 64;
  if (off > ws_size) { fprintf(stderr, "workspace too small: need %zu have %zu\n", off, ws_size); return; }
  hipMemsetAsync(p.BAR, 0, (64 * 32 + 256) * 4, stream);
  void* args[] = {&p};
  hipError_t e = hipLaunchCooperativeKernel((void*)hymba_fwd, dim3(grid_blocks), dim3(256), args, 0, stream);
  if (e != hipSuccess) fprintf(stderr, "cooperative launch failed: %s (grid %d)\n", hipGetErrorString(e), grid_blocks);
}
```

```cpp
#include <hip/hip_runtime.h>
#include <hip/hip_cooperative_groups.h>
#include <stdint.h>
#include <stdio.h>
namespace cg = cooperative_groups;

typedef unsigned short bf16_t;
typedef __attribute__((ext_vector_type(8))) short bf16x8;
typedef __attribute__((ext_vector_type(4))) short bf16x4;
typedef __attribute__((ext_vector_type(4))) float f32x4;

#define S_LEN 4096
#define T_TOK 32768
#define NIN 4384
#define NINP 4480
#define LOG2E 1.4426950408889634f

#define C_Q 0
#define C_KC 512
#define C_VC 640
#define C_KS 768
#define C_KW 1024
#define C_GL 1280
#define C_GA 1304
#define C_Z 1816
#define C_XBC 2328
#define C_DT 3352
#define C_QX 3360
#define C_GX 3872

#define SMEM_BYTES 73728
#ifndef REP0
#define REP0 1
#endif
#ifndef REP1
#define REP1 1
#endif
#ifndef REP2
#define REP2 1
#endif
#ifndef REP3
#define REP3 1
#endif
#ifndef REP5
#define REP5 1
#endif

struct Params {
  const float *x, *mem; const int* pos;
  const float *g_in, *w_in, *cpk, *w1k, *w2k, *cpv, *w1v, *w2v, *conv_w, *conv_b, *dt_bias, *a_log, *d_skip, *g_ssd, *g_mem, *w_kv, *w_out, *g_final;
  float* out;
  bf16_t *WinT, *WoutT, *WkvT, *W1kT, *W1vT, *W2kT, *W2vT, *XB, *MEMB, *PROJ, *VST, *VWT, *KMEM, *VMEMT, *KCMP, *VCMPT, *XT, *BC, *BT, *MIX, *KSC, *KWC;
  float *STATES, *CHDEC, *ACS, *DTV, *SS_SSD, *SS_OUT;
  unsigned* BAR;
  unsigned* MTCNT;
};

__device__ __forceinline__ bf16_t f2bf(float f) { uint32_t u = __float_as_uint(f); u += 0x7fffu + ((u >> 16) & 1u); return (bf16_t)(u >> 16); }
__device__ __forceinline__ float bf2f(bf16_t h) { return __uint_as_float(((uint32_t)h) << 16); }
__device__ __forceinline__ float bfs(short h) { return __uint_as_float(((uint32_t)(unsigned short)h) << 16); }
__device__ __forceinline__ float fexp2(float x) { return __builtin_amdgcn_exp2f(x); }
__device__ __forceinline__ float silu_f(float x) { return x * __builtin_amdgcn_rcpf(1.f + __builtin_amdgcn_exp2f(-1.4426950408889634f * x)); }
__device__ __forceinline__ float sigmoid_f(float x) { return __builtin_amdgcn_rcpf(1.f + __builtin_amdgcn_exp2f(-1.4426950408889634f * x)); }
__device__ __forceinline__ f32x4 mfma16(bf16x8 a, bf16x8 b, f32x4 c) { return __builtin_amdgcn_mfma_f32_16x16x32_bf16(a, b, c, 0, 0, 0); }
typedef __bf16 hbf2_t __attribute__((ext_vector_type(2)));
typedef float f2_t __attribute__((ext_vector_type(2)));
typedef uint32_t u32x2 __attribute__((ext_vector_type(2)));
typedef uint32_t u32x4 __attribute__((ext_vector_type(4)));
__device__ __forceinline__ uint32_t pk2(float a, float b) {
  f2_t v; v[0] = a; v[1] = b;
  hbf2_t r = __builtin_convertvector(v, hbf2_t);
  return __builtin_bit_cast(uint32_t, r);
}
__device__ __forceinline__ bf16x4 pack4(float a, float b, float c, float d) {
  u32x2 r; r[0] = pk2(a, b); r[1] = pk2(c, d); return __builtin_bit_cast(bf16x4, r);
}
__device__ __forceinline__ bf16x8 pack8(float a, float b, float c, float d, float e, float f, float g, float h) {
  u32x4 r; r[0] = pk2(a, b); r[1] = pk2(c, d); r[2] = pk2(e, f); r[3] = pk2(g, h); return __builtin_bit_cast(bf16x8, r);
}
__device__ __forceinline__ bf16x8 cat44(bf16x4 a, bf16x4 b) {
  u32x2 x = __builtin_bit_cast(u32x2, a), y = __builtin_bit_cast(u32x2, b);
  u32x4 r; r[0] = x[0]; r[1] = x[1]; r[2] = y[0]; r[3] = y[1]; return __builtin_bit_cast(bf16x8, r);
}
template <int NR, typename L, typename ST, typename C>
__device__ __forceinline__ void tile_pipeline(int n, L load, ST store, C compute) {
  if (n <= 0) return;
  bf16x8 ra[NR], rb[NR];
  const int last = n - 1;
  load(0, ra);
  load(min(1, last), rb);
  store(0, ra);
  load(min(2, last), ra);
  __syncthreads();
  for (int i = 0; i < n; i += 2) {
    compute(i, 0);
    store(1, rb);
    load(min(i + 3, last), rb);
    __syncthreads();
    if (i + 1 < n) compute(i + 1, 1);
    store(0, ra);
    load(min(i + 4, last), ra);
    __syncthreads();
  }
}
template <int NR, typename L, typename ST, typename C>
__device__ __forceinline__ void tile_pipeline1(int n, L load, ST store, C compute) {
  if (n <= 0) return;
  bf16x8 ra[NR];
  load(0, ra);
  store(0, ra);
  if (n > 1) load(1, ra);
  __syncthreads();
  for (int i = 0; i < n; i++) {
    compute(i, i & 1);
    if (i + 1 < n) { store((i + 1) & 1, ra); if (i + 2 < n) load(i + 2, ra); }
    __syncthreads();
  }
}
__device__ __forceinline__ void rope_cs(int pos, int j, float& cs, float& sn) {
  float inv = fexp2(-(float)j * (18.931568569324174f / 8.f));
  float a = (float)pos * inv;
  float n = rintf(a * 0.15915494309189535f);
  float r = fmaf(-n, 6.28125f, a);
  r = fmaf(-n, 1.9353071795864769e-3f, r);
  cs = __cosf(r); sn = __sinf(r);
}

__device__ __forceinline__ float rowmax4(float x) {
  unsigned xi = __float_as_uint(x);
  auto a = __builtin_amdgcn_permlane16_swap(xi, xi, false, false);
  float m = fmaxf(__uint_as_float(a[0]), __uint_as_float(a[1]));
  unsigned mi = __float_as_uint(m);
  auto b = __builtin_amdgcn_permlane32_swap(mi, mi, false, false);
  return fmaxf(__uint_as_float(b[0]), __uint_as_float(b[1]));
}
__device__ __forceinline__ float rowsum4(float x) {
  unsigned xi = __float_as_uint(x);
  auto a = __builtin_amdgcn_permlane16_swap(xi, xi, false, false);
  float m = __uint_as_float(a[0]) + __uint_as_float(a[1]);
  unsigned mi = __float_as_uint(m);
  auto b = __builtin_amdgcn_permlane32_swap(mi, mi, false, false);
  return __uint_as_float(b[0]) + __uint_as_float(b[1]);
}
__device__ __forceinline__ int get_tid() { int t = threadIdx.x; asm volatile("" : "+v"(t)); return t; }

__device__ void prep_rows(const float* __restrict__ x, bf16_t* __restrict__ xb, int nrows, int gw, int nw) {
  const int lane = threadIdx.x & 63;
  int row = gw;
  for (; row + 3 * nw < nrows; row += 4 * nw) {
    float4 v[4][4]; float ss[4];
#pragma unroll
    for (int r = 0; r < 4; r++) {
      const float4* p = (const float4*)(x + (size_t)(row + r * nw) * 1024);
#pragma unroll
      for (int i = 0; i < 4; i++) v[r][i] = p[lane + 64 * i];
    }
#pragma unroll
    for (int r = 0; r < 4; r++) {
      float s = 0.f;
#pragma unroll
      for (int i = 0; i < 4; i++) s += v[r][i].x * v[r][i].x + v[r][i].y * v[r][i].y + v[r][i].z * v[r][i].z + v[r][i].w * v[r][i].w;
#pragma unroll
      for (int o = 32; o >= 1; o >>= 1) s += __shfl_xor(s, o);
      ss[r] = rsqrtf(s * (1.f / 1024.f) + 1e-6f);
    }
#pragma unroll
    for (int r = 0; r < 4; r++)
#pragma unroll
      for (int i = 0; i < 4; i++)
        *(bf16x4*)(xb + (size_t)(row + r * nw) * 1024 + (lane + 64 * i) * 4) =
            pack4(v[r][i].x * ss[r], v[r][i].y * ss[r], v[r][i].z * ss[r], v[r][i].w * ss[r]);
  }
  for (; row < nrows; row += nw) {
    const float4* p = (const float4*)(x + (size_t)row * 1024);
    float4 v[4]; float ss = 0.f;
#pragma unroll
    for (int i = 0; i < 4; i++) { v[i] = p[lane + 64 * i]; ss += v[i].x * v[i].x + v[i].y * v[i].y + v[i].z * v[i].z + v[i].w * v[i].w; }
#pragma unroll
    for (int o = 32; o >= 1; o >>= 1) ss += __shfl_xor(ss, o);
    float r = rsqrtf(ss * (1.f / 1024.f) + 1e-6f);
#pragma unroll
    for (int i = 0; i < 4; i++) {
      bf16x4 o = pack4(v[i].x * r, v[i].y * r, v[i].z * r, v[i].w * r);
      *(bf16x4*)(xb + (size_t)row * 1024 + (lane + 64 * i) * 4) = o;
    }
  }
}

__device__ void prep_wT(const float* __restrict__ w, const float* __restrict__ g, int gk0, int gk1, bf16_t* __restrict__ wt,
                        int K, int N, int Npad, int gtid, int gthreads) {
  const int ln = gtid & 63, gwv = gtid >> 6, nwv = gthreads >> 6;
  const int kblocks = K >> 6;
  const int total = (Npad >> 3) * kblocks;
  for (int uw = gwv; uw < total; uw += nwv) {
    const int kb = uw % kblocks, nbk = uw / kblocks;
    const int n = nbk * 8 + (ln >> 3), k8 = kb * 8 + (ln & 7);
    bf16x8 o;
#pragma unroll
    for (int j = 0; j < 8; j++) {
      int k = k8 * 8 + j; float v = 0.f;
      if (n < N) { v = w[(size_t)k * N + n]; if (g != nullptr && k >= gk0 && k < gk1) v *= g[k - gk0]; }
      o[j] = (short)f2bf(v);
    }
    *(bf16x8*)(wt + (size_t)n * K + k8 * 8) = o;
  }
}

__device__ void phase_prep(const Params& p) {
  const int gtid = blockIdx.x * 256 + threadIdx.x, gthreads = gridDim.x * 256;
  const int gw = gtid >> 6, nw = gthreads >> 6;
  prep_rows(p.x, p.XB, T_TOK, gw, nw);
  prep_rows(p.mem, p.MEMB, 2048, gw, nw);
  prep_wT(p.w_in, p.g_in, 0, 1024, p.WinT, 1024, NIN, NINP, gtid, gthreads);
  prep_wT(p.w_out, p.g_ssd, 512, 1024, p.WoutT, 1536, 1024, 1024, gtid, gthreads);
  prep_wT(p.w_kv, p.g_mem, 0, 1024, p.WkvT, 1024, 1024, 1024, gtid, gthreads);
  prep_wT(p.w1k, nullptr, 0, 0, p.W1kT, 2048, 256, 256, gtid, gthreads);
  prep_wT(p.w1v, nullptr, 0, 0, p.W1vT, 2048, 256, 256, gtid, gthreads);
  prep_wT(p.w2k, nullptr, 0, 0, p.W2kT, 256, 64, 64, gtid, gthreads);
  prep_wT(p.w2v, nullptr, 0, 0, p.W2vT, 256, 64, 64, gtid, gthreads);
  for (int i = gtid; i < T_TOK; i += gthreads) p.SS_OUT[i] = 0.f;
  for (int i = gtid; i < 16 * 64; i += gthreads) {
    int bg = i >> 6, d = i & 63;
    p.KCMP[((size_t)bg * 256 + 255) * 64 + d] = 0;
    p.VCMPT[((size_t)bg * 64 + d) * 256 + 255] = 0;
  }
}

typedef __attribute__((address_space(3))) unsigned lds_u32_t;
typedef __attribute__((address_space(1))) const unsigned glb_u32_t;
__device__ __forceinline__ void glds16(const bf16_t* g, char* l) {
  __builtin_amdgcn_global_load_lds((glb_u32_t*)g, (lds_u32_t*)l, 16, 0, 0);
}
template <int MODE>
__device__ void gemm_tile_reg(const Params& p, int mt, int nt, char* smem) {
  const int tid = get_tid(), lane = tid & 63, wave = tid >> 6, lr = lane & 15, lg = lane >> 4;
  const int wr = wave >> 1, wc = wave & 1;
  const int m0 = mt * 128, n0 = nt * 128;
  const bf16_t* A; const bf16_t* Bt; int K;
  if (MODE == 0) { A = p.XB; Bt = p.WinT; K = 1024; }
  else if (MODE == 1) { A = p.MEMB; Bt = p.WkvT; K = 1024; }
  else { A = p.MIX; Bt = p.WoutT; K = 1536; }
  bf16_t* As = (bf16_t*)smem;
  bf16_t* Bs = As + 2 * 9216;
  const int lrow = tid >> 3, kc = tid & 7;
  const bf16_t* ga = A + (size_t)(m0 + lrow) * K + kc * 8;
  const bf16_t* gb = Bt + (size_t)(n0 + lrow) * K + kc * 8;
  float rs[4] = {1.f, 1.f, 1.f, 1.f};
  if (MODE == 2) {
#pragma unroll
    for (int i = 0; i < 4; i++) {
      const float4* sp = (const float4*)(p.SS_SSD + (size_t)(m0 + lrow + 32 * i) * 8);
      float4 a = sp[0], b = sp[1];
      rs[i] = rsqrtf((a.x + a.y + a.z + a.w + b.x + b.y + b.z + b.w) * (1.f / 512.f) + 1e-6f);
    }
  }
  bool swap;
  if (MODE == 0) swap = !(nt == 7 || nt == 9);
  else if (MODE == 1) swap = (nt < 4);
  else swap = true;
  const bf16_t* F = swap ? (Bs + (64 * wc) * 72) : (As + (64 * wr) * 72);
  const bf16_t* G = swap ? (As + (64 * wr) * 72) : (Bs + (64 * wc) * 72);
  f32x4 acc[4][4];
#pragma unroll
  for (int i = 0; i < 4; i++)
#pragma unroll
    for (int j = 0; j < 4; j++) acc[i][j] = (f32x4){0.f, 0.f, 0.f, 0.f};
  bf16x8 ra0[4], rb0[4], ra1[4], rb1[4];
  const int nk = K / 64;
  auto load = [&](int kt, bf16x8 (&ra)[4], bf16x8 (&rb)[4]) {
#pragma unroll
    for (int i = 0; i < 4; i++) {
      ra[i] = *(const bf16x8*)(ga + (size_t)(32 * i) * K + kt * 64);
      rb[i] = *(const bf16x8*)(gb + (size_t)(32 * i) * K + kt * 64);
    }
  };
  auto store = [&](int buf, int kt, bf16x8 (&ra)[4], bf16x8 (&rb)[4]) {
    if (MODE == 2) {
      if (kt >= 8 && kt < 16) {
#pragma unroll
        for (int i = 0; i < 4; i++) {
          bf16x8 v = ra[i];
          ra[i] = pack8(bfs(v[0]) * rs[i], bfs(v[1]) * rs[i], bfs(v[2]) * rs[i], bfs(v[3]) * rs[i],
                        bfs(v[4]) * rs[i], bfs(v[5]) * rs[i], bfs(v[6]) * rs[i], bfs(v[7]) * rs[i]);
        }
      }
    }
#pragma unroll
    for (int i = 0; i < 4; i++) {
      *(bf16x8*)(As + buf * 9216 + (lrow + 32 * i) * 72 + kc * 8) = ra[i];
      *(bf16x8*)(Bs + buf * 9216 + (lrow + 32 * i) * 72 + kc * 8) = rb[i];
    }
  };
  auto compute = [&](int buf) {
    const int cb = buf * 9216;
#pragma unroll
    for (int ks = 0; ks < 2; ks++) {
      bf16x8 ff[4], gg[4];
#pragma unroll
      for (int i = 0; i < 4; i++) {
        ff[i] = *(const bf16x8*)(F + cb + (16 * i + lr) * 72 + ks * 32 + lg * 8);
        gg[i] = *(const bf16x8*)(G + cb + (16 * i + lr) * 72 + ks * 32 + lg * 8);
      }
#pragma unroll
      for (int i = 0; i < 4; i++)
#pragma unroll
        for (int j = 0; j < 4; j++) acc[i][j] = mfma16(ff[i], gg[j], acc[i][j]);
    }
  };
  const int lastk = nk - 1;
  load(0, ra0, rb0);
  load(1, ra1, rb1);
  store(0, 0, ra0, rb0);
  load(2, ra0, rb0);
  __syncthreads();
  for (int kt = 0; kt < nk; kt += 2) {
    compute(0);
    store(1, kt + 1, ra1, rb1);
    load(min(kt + 3, lastk), ra1, rb1);
    __syncthreads();
    compute(1);
    store(0, min(kt + 2, lastk), ra0, rb0);
    load(min(kt + 4, lastk), ra0, rb0);
    __syncthreads();
  }
  if (swap) {
    if (MODE == 0) {
      const bool rope = (nt < 4) || nt == 6 || nt == 8;
#pragma unroll
      for (int mi = 0; mi < 4; mi++) {
        const int m = m0 + 64 * wr + 16 * mi + lr;
        if (rope) {
          const int pos = p.pos[m];
          f32x4 v = acc[0][mi];
          f32x4 o;
#pragma unroll
          for (int i = 0; i < 4; i++) {
            float pr = __shfl_xor(v[i], 32);
            float cs, sn; rope_cs(pos, 4 * (lg & 1) + i, cs, sn);
            o[i] = (lg < 2) ? (v[i] * cs - pr * sn) : (v[i] * cs + pr * sn);
          }
          acc[0][mi] = o;
        }
        {
          bf16_t* stg = (bf16_t*)smem + ((wave & 1) ? 2 * 9216 : 0) + (wave >> 1) * 4608;
#pragma unroll
          for (int ni = 0; ni < 4; ni++) {
            f32x4 v = acc[ni][mi];
            *(bf16x4*)(stg + (16 * mi + lr) * 72 + 16 * ni + 4 * lg) = pack4(v[0], v[1], v[2], v[3]);
          }
        }
      }
      {
        const bf16_t* stg = (const bf16_t*)smem + ((wave & 1) ? 2 * 9216 : 0) + (wave >> 1) * 4608;
        const int rr = lane >> 3, ch = lane & 7;
        const int nb0 = n0 + 64 * wc + ch * 8;
#pragma unroll
        for (int it = 0; it < 8; it++) {
          const int row = it * 8 + rr;
          const int m = m0 + 64 * wr + row;
          bf16x8 v = *(const bf16x8*)(stg + row * 72 + ch * 8);
          if (nt == 6 || nt == 8) {
            bf16_t* kd = ((nt == 6) ? p.KSC : p.KWC) + (((size_t)(m >> 12) * 2 + wc) * S_LEN + (m & 4095)) * 64;
            *(bf16x8*)(kd + ch * 8) = v;
          } else if (nb0 < NIN) {
            *(bf16x8*)(p.PROJ + (size_t)m * NIN + nb0) = v;
          }
        }
      }
      __syncthreads();
    } else if (MODE == 1) {
#pragma unroll
      for (int mi = 0; mi < 4; mi++) {
        const int m = m0 + 64 * wr + 16 * mi + lr;
#pragma unroll
        for (int ni = 0; ni < 4; ni++) {
          const int n = n0 + 64 * wc + 16 * ni + 4 * lg;
          f32x4 v = acc[ni][mi];
          *(bf16x4*)(p.KMEM + (size_t)m * 512 + n) = pack4(v[0], v[1], v[2], v[3]);
        }
      }
    } else {
#pragma unroll
      for (int mi = 0; mi < 4; mi++) {
        const int m = m0 + 64 * wr + 16 * mi + lr;
        float ss = 0.f;
#pragma unroll
        for (int ni = 0; ni < 4; ni++) {
          const int n = n0 + 64 * wc + 16 * ni + 4 * lg;
          float4 xv = *(const float4*)(p.x + (size_t)m * 1024 + n);
          f32x4 v = acc[ni][mi];
          float4 h; h.x = xv.x + v[0]; h.y = xv.y + v[1]; h.z = xv.z + v[2]; h.w = xv.w + v[3];
          ss += h.x * h.x + h.y * h.y + h.z * h.z + h.w * h.w;
          *(float4*)(p.out + (size_t)m * 1024 + n) = h;
        }
        ss += __shfl_xor(ss, 16); ss += __shfl_xor(ss, 32);
        if (lg == 0) atomicAdd(p.SS_OUT + m, ss);
      }
    }
  } else {
#pragma unroll
    for (int mi = 0; mi < 4; mi++)
#pragma unroll
      for (int ni = 0; ni < 4; ni++) {
        f32x4 v = acc[mi][ni];
        bf16x4 o = pack4(v[0], v[1], v[2], v[3]);
        if (MODE == 0) {
          const int b = m0 >> 12, s = (m0 & 4095) + 64 * wr + 16 * mi + 4 * lg;
          const int d = 16 * ni + lr;
          bf16_t* dst = (nt == 7) ? p.VST : p.VWT;
          *(bf16x4*)(dst + ((size_t)(b * 2 + wc) * 64 + d) * S_LEN + s) = o;
        } else {
          const int b = m0 >> 8, s = (m0 & 255) + 64 * wr + 16 * mi + 4 * lg;
          const int col = n0 - 512 + 64 * wc + 16 * ni + lr;
          const int h = col >> 7, d = col & 127;
          *(bf16x4*)(p.VMEMT + ((size_t)(b * 4 + h) * 128 + d) * 256 + s) = o;
        }
      }
  }
}

template <int MODE>
__device__ void gemm_tile_glds(const Params& p, int mt, int nt, char* smem) {
  const int tid = get_tid(), lane = tid & 63, wave = tid >> 6, lr = lane & 15, lg = lane >> 4;
  const int wr = wave >> 1, wc = wave & 1;
  const int m0 = mt * 128, n0 = nt * 128;
  const bf16_t* A; const bf16_t* Bt; int K;
  if (MODE == 0) { A = p.XB; Bt = p.WinT; K = 1024; }
  else if (MODE == 1) { A = p.MEMB; Bt = p.WkvT; K = 1024; }
  else { A = p.MIX; Bt = p.WoutT; K = 1536; }
  float rs[4] = {1.f, 1.f, 1.f, 1.f};
  if (MODE == 2) {
#pragma unroll
    for (int i = 0; i < 4; i++) {
      const float4* sp = (const float4*)(p.SS_SSD + (size_t)(m0 + 64 * wr + 16 * i + lr) * 8);
      float4 a = sp[0], b = sp[1];
      rs[i] = rsqrtf((a.x + a.y + a.z + a.w + b.x + b.y + b.z + b.w) * (1.f / 512.f) + 1e-6f);
    }
  }
  bool swap;
  if (MODE == 0) swap = !(nt == 7 || nt == 9);
  else if (MODE == 1) swap = (nt < 4);
  else swap = true;
  const int rl = lane >> 3, pcx = lane & 7;
  const bf16_t* gA[4]; const bf16_t* gB[4];
#pragma unroll
  for (int q = 0; q < 4; q++) {
    const int row = (wave * 4 + q) * 8 + rl;
    const int c = pcx ^ ((row >> 1) & 7);
    gA[q] = A + (size_t)(m0 + row) * K + c * 8;
    gB[q] = Bt + (size_t)(n0 + row) * K + c * 8;
  }
  char* lbase = smem + wave * 4096 + lane * 16;
  auto stage = [&](int buf, int koff) {
#pragma unroll
    for (int q = 0; q < 4; q++) {
      glds16(gA[q] + koff, lbase + buf * 32768 + q * 1024);
      glds16(gB[q] + koff, lbase + buf * 32768 + 16384 + q * 1024);
    }
  };
  const int fro = (swap ? (16384 + 64 * wc * 128) : (64 * wr * 128)) + lr * 128;
  const int gro = (swap ? (64 * wr * 128) : (16384 + 64 * wc * 128)) + lr * 128;
  const int sw = (lr >> 1) & 7;
  f32x4 acc[4][4];
#pragma unroll
  for (int i = 0; i < 4; i++)
#pragma unroll
    for (int j = 0; j < 4; j++) acc[i][j] = (f32x4){0.f, 0.f, 0.f, 0.f};
  const int nk = K / 64;
  auto kof = [&](int i) { return (MODE == 2) ? ((i < 8) ? (8 + i) : ((i < 16) ? (i - 8) : i)) * 64 : i * 64; };
  stage(0, kof(0));
  for (int kt = 0; kt < nk; kt++) {
    __syncthreads();
    if (kt + 1 < nk) stage((kt + 1) & 1, kof(kt + 1));
    const char* sb = smem + (kt & 1) * 32768;
#pragma unroll
    for (int ks = 0; ks < 2; ks++) {
      bf16x8 ff[4], gg[4];
      const int co = ((ks * 4 + lg) ^ sw) * 16;
#pragma unroll
      for (int i = 0; i < 4; i++) {
        ff[i] = *(const bf16x8*)(sb + fro + i * 2048 + co);
        gg[i] = *(const bf16x8*)(sb + gro + i * 2048 + co);
      }
#pragma unroll
      for (int i = 0; i < 4; i++)
#pragma unroll
        for (int j = 0; j < 4; j++) acc[i][j] = mfma16(ff[i], gg[j], acc[i][j]);
    }
    if (MODE == 2) {
      if (kt == 7) {
#pragma unroll
        for (int i = 0; i < 4; i++)
#pragma unroll
          for (int j = 0; j < 4; j++) { acc[i][j][0] *= rs[j]; acc[i][j][1] *= rs[j]; acc[i][j][2] *= rs[j]; acc[i][j][3] *= rs[j]; }
      }
    }
  }
  __syncthreads();
  if (swap) {
    if (MODE == 0) {
      const bool rope = (nt < 4) || nt == 6 || nt == 8;
#pragma unroll
      for (int mi = 0; mi < 4; mi++) {
        const int m = m0 + 64 * wr + 16 * mi + lr;
        if (rope) {
          const int pos = p.pos[m];
          f32x4 v = acc[0][mi];
          f32x4 o;
#pragma unroll
          for (int i = 0; i < 4; i++) {
            float pr = __shfl_xor(v[i], 32);
            float cs, sn; rope_cs(pos, 4 * (lg & 1) + i, cs, sn);
            o[i] = (lg < 2) ? (v[i] * cs - pr * sn) : (v[i] * cs + pr * sn);
          }
          acc[0][mi] = o;
        }
        {
          bf16_t* stg = (bf16_t*)smem + ((wave & 1) ? 2 * 9216 : 0) + (wave >> 1) * 4608;
#pragma unroll
          for (int ni = 0; ni < 4; ni++) {
            f32x4 v = acc[ni][mi];
            *(bf16x4*)(stg + (16 * mi + lr) * 72 + 16 * ni + 4 * lg) = pack4(v[0], v[1], v[2], v[3]);
          }
        }
      }
      {
        const bf16_t* stg = (const bf16_t*)smem + ((wave & 1) ? 2 * 9216 : 0) + (wave >> 1) * 4608;
        const int rr = lane >> 3, ch = lane & 7;
        const int nb0 = n0 + 64 * wc + ch * 8;
#pragma unroll
        for (int it = 0; it < 8; it++) {
          const int row = it * 8 + rr;
          const int m = m0 + 64 * wr + row;
          bf16x8 v = *(const bf16x8*)(stg + row * 72 + ch * 8);
          if (nt == 6 || nt == 8) {
            bf16_t* kd = ((nt == 6) ? p.KSC : p.KWC) + (((size_t)(m >> 12) * 2 + wc) * S_LEN + (m & 4095)) * 64;
            *(bf16x8*)(kd + ch * 8) = v;
          } else if (nb0 < NIN) {
            *(bf16x8*)(p.PROJ + (size_t)m * NIN + nb0) = v;
          }
        }
      }
      __syncthreads();
    } else if (MODE == 1) {
#pragma unroll
      for (int mi = 0; mi < 4; mi++) {
        const int m = m0 + 64 * wr + 16 * mi + lr;
#pragma unroll
        for (int ni = 0; ni < 4; ni++) {
          const int n = n0 + 64 * wc + 16 * ni + 4 * lg;
          f32x4 v = acc[ni][mi];
          *(bf16x4*)(p.KMEM + (size_t)m * 512 + n) = pack4(v[0], v[1], v[2], v[3]);
        }
      }
    } else {
#pragma unroll
      for (int mi = 0; mi < 4; mi++) {
        const int m = m0 + 64 * wr + 16 * mi + lr;
        float ss = 0.f;
#pragma unroll
        for (int ni = 0; ni < 4; ni++) {
          const int n = n0 + 64 * wc + 16 * ni + 4 * lg;
          float4 xv = *(const float4*)(p.x + (size_t)m * 1024 + n);
          f32x4 v = acc[ni][mi];
          float4 h; h.x = xv.x + v[0]; h.y = xv.y + v[1]; h.z = xv.z + v[2]; h.w = xv.w + v[3];
          ss += h.x * h.x + h.y * h.y + h.z * h.z + h.w * h.w;
          *(float4*)(p.out + (size_t)m * 1024 + n) = h;
        }
        ss += __shfl_xor(ss, 16); ss += __shfl_xor(ss, 32);
        if (lg == 0) atomicAdd(p.SS_OUT + m, ss);
      }
    }
  } else {
#pragma unroll
    for (int mi = 0; mi < 4; mi++)
#pragma unroll
      for (int ni = 0; ni < 4; ni++) {
        f32x4 v = acc[mi][ni];
        bf16x4 o = pack4(v[0], v[1], v[2], v[3]);
        if (MODE == 0) {
          const int b = m0 >> 12, s = (m0 & 4095) + 64 * wr + 16 * mi + 4 * lg;
          const int d = 16 * ni + lr;
          bf16_t* dst = (nt == 7) ? p.VST : p.VWT;
          *(bf16x4*)(dst + ((size_t)(b * 2 + wc) * 64 + d) * S_LEN + s) = o;
        } else {
          const int b = m0 >> 8, s = (m0 & 255) + 64 * wr + 16 * mi + 4 * lg;
          const int col = n0 - 512 + 64 * wc + 16 * ni + lr;
          const int h = col >> 7, d = col & 127;
          *(bf16x4*)(p.VMEMT + ((size_t)(b * 4 + h) * 128 + d) * 256 + s) = o;
        }
      }
  }
}

template <int MODE>
__device__ __forceinline__ void gemm_tile(const Params& p, int mt, int nt, char* smem) {
  if (MODE == 2) gemm_tile_reg<MODE>(p, mt, nt, smem); else gemm_tile_glds<MODE>(p, mt, nt, smem);
}

template <int DQK, int DV, int MASK, typename MaskF>
__device__ __forceinline__ void attn_tile(const bf16_t* sK, const bf16_t* sVt, const bf16x8 (&qf)[2][DQK / 32], f32x4 (&o)[DV / 16][2],
                                          float (&m)[2], float (&l)[2], float c, bool qsel0, bool qsel1, MaskF valid) {
  constexpr int KST = DQK + 8;
  const int lane = get_tid() & 63, lr = lane & 15, lg = lane >> 4;
  f32x4 s[4][2];
#pragma unroll
  for (int kt = 0; kt < 4; kt++) { s[kt][0] = (f32x4){0.f, 0.f, 0.f, 0.f}; s[kt][1] = (f32x4){0.f, 0.f, 0.f, 0.f}; }
#pragma unroll
  for (int ks = 0; ks < DQK / 32; ks++)
#pragma unroll
    for (int kt = 0; kt < 4; kt++) {
      bf16x8 a = *(const bf16x8*)(sK + (16 * kt + lr) * KST + ks * 32 + lg * 8);
      s[kt][0] = mfma16(a, qf[0][ks], s[kt][0]);
      s[kt][1] = mfma16(a, qf[1][ks], s[kt][1]);
    }
#pragma unroll
  for (int qt = 0; qt < 2; qt++) {
    const bool qs = qt ? qsel1 : qsel0;
    float mx = -1e30f;
    if (MASK) {
#pragma unroll
      for (int kt = 0; kt < 4; kt++)
#pragma unroll
        for (int i = 0; i < 4; i++) {
          bool v = valid(16 * kt + 4 * lg + i, qt);
          float sv = v ? s[kt][qt][i] * c : -1e30f;
          s[kt][qt][i] = sv; mx = fmaxf(mx, sv);
        }
    } else {
#pragma unroll
      for (int kt = 0; kt < 4; kt++) mx = fmaxf(fmaxf(mx, fmaxf(s[kt][qt][0], s[kt][qt][1])), fmaxf(s[kt][qt][2], s[kt][qt][3]));
      mx = qs ? mx * c : -1e30f;
    }
    mx = rowmax4(mx);
    const float mn = fmaxf(m[qt], mx);
    const float alpha = fexp2(m[qt] - mn);
    m[qt] = mn;
    float me;
    if (MASK) me = (mn > -1e29f) ? mn : 1e30f; else me = qs ? mn : 1e30f;
    float rs = 0.f;
#pragma unroll
    for (int kt = 0; kt < 4; kt++)
#pragma unroll
      for (int i = 0; i < 4; i++) {
        float pv = MASK ? fexp2(s[kt][qt][i] - me) : fexp2(fmaf(s[kt][qt][i], c, -me));
        s[kt][qt][i] = pv; rs += pv;
      }
    rs = rowsum4(rs);
    l[qt] = l[qt] * alpha + rs;
#pragma unroll
    for (int dt = 0; dt < DV / 16; dt++) {
      o[dt][qt][0] *= alpha; o[dt][qt][1] *= alpha; o[dt][qt][2] *= alpha; o[dt][qt][3] *= alpha;
    }
  }
#pragma unroll
  for (int k2 = 0; k2 < 2; k2++) {
    bf16x8 pb[2];
#pragma unroll
    for (int qt = 0; qt < 2; qt++)
      pb[qt] = pack8(s[2 * k2][qt][0], s[2 * k2][qt][1], s[2 * k2][qt][2], s[2 * k2][qt][3],
                     s[2 * k2 + 1][qt][0], s[2 * k2 + 1][qt][1], s[2 * k2 + 1][qt][2], s[2 * k2 + 1][qt][3]);
#pragma unroll
    for (int dt = 0; dt < DV / 16; dt++) {
      const bf16_t* vp = sVt + (16 * dt + lr) * 72 + 32 * k2 + 4 * lg;
      bf16x8 a = cat44(*(const bf16x4*)vp, *(const bf16x4*)(vp + 16));
      o[dt][0] = mfma16(a, pb[0], o[dt][0]);
      o[dt][1] = mfma16(a, pb[1], o[dt][1]);
    }
  }
}

__device__ __forceinline__ int next_bit_below(unsigned long long m, int below) {
  unsigned long long mm = (below >= 64) ? m : (m & ((1ull << below) - 1ull));
  return mm ? (63 - __clzll((long long)mm)) : -1;
}

__device__ void nsa_item(const Params& p, int item, char* smem) {
  const int tid = get_tid(), lane = tid & 63, wave = tid >> 6, lr = lane & 15, lg = lane >> 4;
  const int bg = item & 15, qb = 127 - (item >> 4);
  const int b = bg >> 1, g = bg & 1;
  const int t0 = qb * 32, cur = t0 >> 6;
  const int hq = g * 4 + wave;
  float* sImp = (float*)(smem + 55296);
  unsigned long long* sSel = (unsigned long long*)(smem + 63616);
  const float c = 0.125f * LOG2E;
  const size_t tokbase = (size_t)b * S_LEN + t0;
  const int r0 = tid >> 3, cc = tid & 7;

  bf16x8 qf[2][2];
#pragma unroll
  for (int qt = 0; qt < 2; qt++) {
    const bf16_t* row = p.PROJ + (tokbase + 16 * qt + lr) * NIN;
#pragma unroll
    for (int ks = 0; ks < 2; ks++) qf[qt][ks] = *(const bf16x8*)(row + C_Q + hq * 64 + 32 * ks + 8 * lg);
  }
  bf16_t* slab = (bf16_t*)(smem + 36864 + wave * 4608);
  auto emit = [&](f32x4 (&o)[4][2], float (&l)[2], int br) {
#pragma unroll
    for (int qt = 0; qt < 2; qt++) {
      const size_t tok = tokbase + 16 * qt + lr;
      const float gsc = sigmoid_f(bf2f(p.PROJ[tok * NIN + C_GL + hq * 3 + br])) / fmaxf(l[qt], 1e-30f);
#pragma unroll
      for (int dt = 0; dt < 4; dt++) {
        bf16_t* dst = slab + (16 * qt + lr) * 72 + 16 * dt + 4 * lg;
        f32x4 r = o[dt][qt];
        r[0] *= gsc; r[1] *= gsc; r[2] *= gsc; r[3] *= gsc;
        if (br > 0) { bf16x4 pv = *(const bf16x4*)dst; r[0] += bfs(pv[0]); r[1] += bfs(pv[1]); r[2] += bfs(pv[2]); r[3] += bfs(pv[3]); }
        *(bf16x4*)dst = pack4(r[0], r[1], r[2], r[3]);
      }
    }
    if (br == 2) {
      const int rr = lane >> 3, ch = lane & 7;
#pragma unroll
      for (int it = 0; it < 4; it++) {
        const int row = it * 8 + rr;
        const size_t tok = tokbase + row;
        const bf16x8 v = *(const bf16x8*)(slab + row * 72 + ch * 8);
        const bf16x8 ga = *(const bf16x8*)(p.PROJ + tok * NIN + C_GA + hq * 64 + ch * 8);
        *(bf16x8*)(p.MIX + tok * 1536 + hq * 64 + ch * 8) =
            pack8(bfs(v[0]) * silu_f(bfs(ga[0])), bfs(v[1]) * silu_f(bfs(ga[1])), bfs(v[2]) * silu_f(bfs(ga[2])), bfs(v[3]) * silu_f(bfs(ga[3])),
                  bfs(v[4]) * silu_f(bfs(ga[4])), bfs(v[5]) * silu_f(bfs(ga[5])), bfs(v[6]) * silu_f(bfs(ga[6])), bfs(v[7]) * silu_f(bfs(ga[7])));
      }
    }
  };
  auto store_kv = [&](int buf, bf16x8 (&rg)[4]) {
    bf16_t* sK = (bf16_t*)(smem + buf * 18432);
    bf16_t* sVt = sK + 64 * 72;
    *(bf16x8*)(sK + r0 * 72 + cc * 8) = rg[0];
    *(bf16x8*)(sK + (r0 + 32) * 72 + cc * 8) = rg[1];
    *(bf16x8*)(sVt + r0 * 72 + cc * 8) = rg[2];
    *(bf16x8*)(sVt + (r0 + 32) * 72 + cc * 8) = rg[3];
  };

  {
    const int ntiles = (t0 >> 10) + 1;
    const bf16_t* kb = p.KCMP + (size_t)bg * 256 * 64;
    const bf16_t* vb = p.VCMPT + (size_t)bg * 64 * 256;
    for (int pass = 0; pass < 2; pass++) {
      f32x4 o[4][2]; float m[2] = {-1e30f, -1e30f}, l[2] = {0.f, 0.f};
#pragma unroll
      for (int dt = 0; dt < 4; dt++) { o[dt][0] = (f32x4){0.f, 0.f, 0.f, 0.f}; o[dt][1] = (f32x4){0.f, 0.f, 0.f, 0.f}; }
      int ldn = 0;
      tile_pipeline<4>(ntiles,
        [&](int i, bf16x8 (&rg)[4]) {
          rg[0] = *(const bf16x8*)(kb + (size_t)(64 * i + r0) * 64 + cc * 8);
          rg[1] = *(const bf16x8*)(kb + (size_t)(64 * i + r0 + 32) * 64 + cc * 8);
          if (pass == 0) {
            rg[2] = *(const bf16x8*)(vb + (size_t)r0 * 256 + 64 * i + cc * 8);
            rg[3] = *(const bf16x8*)(vb + (size_t)(r0 + 32) * 256 + 64 * i + cc * 8);
          }
        },
        [&](int buf, bf16x8 (&rg)[4]) {
          const int nt = ldn++;
          if (pass == 1) {
#pragma unroll
            for (int i2 = 0; i2 < 2; i2++) {
              const int j = r0 + 32 * i2;
              bf16x8 ov;
#pragma unroll
              for (int x = 0; x < 8; x++) { int n = 64 * nt + cc * 8 + x; ov[x] = (n >= 4 * j - 1 && n <= 4 * j + 3) ? (short)0x3F80 : (short)0; }
              rg[2 + i2] = ov;
            }
          }
          store_kv(buf, rg);
        },
        [&](int i, int buf) {
          const bf16_t* sK = (const bf16_t*)(smem + buf * 18432);
          attn_tile<64, 64, 1>(sK, sK + 64 * 72, qf, o, m, l, c, true, true,
                               [&](int key, int qt) { return 16 * (64 * i + key) + 31 <= t0 + 16 * qt + lr; });
        });
      if (pass == 0) {
        emit(o, l, 0);
      } else {
        float inv[2];
#pragma unroll
        for (int qt = 0; qt < 2; qt++) inv[qt] = 1.f / fmaxf(l[qt], 1e-30f);
        for (int e2 = 0; e2 < 4; e2++) {
          if (wave == e2) {
#pragma unroll
            for (int dt = 0; dt < 4; dt++)
#pragma unroll
              for (int qt = 0; qt < 2; qt++)
#pragma unroll
                for (int i = 0; i < 4; i++) {
                  int j = 16 * dt + 4 * lg + i, q = 16 * qt + lr;
                  float v = o[dt][qt][i] * inv[qt];
                  if (e2 == 0) sImp[q * 65 + j] = v; else sImp[q * 65 + j] += v;
                }
          }
          __syncthreads();
        }
      }
    }
  }
  for (int qq = 0; qq < 8; qq++) {
    const int q = wave * 8 + qq;
    const int j = lane;
    float v = sImp[q * 65 + j];
    bool valid = j <= cur;
    bool forced = (j == 0) || (j == cur) || (j == cur - 1);
    float val = forced ? 1e9f : (valid ? v : -1e9f);
    int rank = 0;
#pragma unroll 16
    for (int jj = 0; jj < 64; jj++) {
      float ov = __int_as_float(__builtin_amdgcn_readlane(__float_as_int(val), jj));
      rank += ((ov > val) || (ov == val && jj < j)) ? 1 : 0;
    }
    unsigned long long mask = __ballot((rank < 16) && valid);
    if (lane == 0) sSel[q] = mask;
  }
  __syncthreads();
  unsigned long long any = 0ull;
  for (int q = 0; q < 32; q++) any |= sSel[q];
  unsigned long long mk[2];
  mk[0] = sSel[lr]; mk[1] = sSel[16 + lr];

  {
    f32x4 o[4][2]; float m[2] = {-1e30f, -1e30f}, l[2] = {0.f, 0.f};
#pragma unroll
    for (int dt = 0; dt < 4; dt++) { o[dt][0] = (f32x4){0.f, 0.f, 0.f, 0.f}; o[dt][1] = (f32x4){0.f, 0.f, 0.f, 0.f}; }
    const bf16_t* kb = p.KSC + (size_t)bg * S_LEN * 64;
    const bf16_t* vb = p.VST + (size_t)bg * 64 * S_LEN;
    const int ntiles = __popcll(any);
    int jl = 64, jc = 64;
    tile_pipeline<4>(ntiles,
      [&](int, bf16x8 (&rg)[4]) {
        jl = (jl > 0) ? next_bit_below(any, jl) : -1;
        const int jj = jl < 0 ? 0 : jl;
        rg[0] = *(const bf16x8*)(kb + (size_t)(64 * jj + r0) * 64 + cc * 8);
        rg[1] = *(const bf16x8*)(kb + (size_t)(64 * jj + r0 + 32) * 64 + cc * 8);
        rg[2] = *(const bf16x8*)(vb + (size_t)r0 * S_LEN + 64 * jj + cc * 8);
        rg[3] = *(const bf16x8*)(vb + (size_t)(r0 + 32) * S_LEN + 64 * jj + cc * 8);
      },
      store_kv,
      [&](int, int buf) {
        jc = next_bit_below(any, jc);
        const int j = jc;
        const bf16_t* sK = (const bf16_t*)(smem + buf * 18432);
        if (j == cur) {
          attn_tile<64, 64, 1>(sK, sK + 64 * 72, qf, o, m, l, c, true, true,
                               [&](int key, int qt) { return 64 * j + key <= t0 + 16 * qt + lr; });
        } else {
          attn_tile<64, 64, 0>(sK, sK + 64 * 72, qf, o, m, l, c, ((mk[0] >> j) & 1ull) != 0ull, ((mk[1] >> j) & 1ull) != 0ull,
                               [&](int, int) { return true; });
        }
      });
    emit(o, l, 1);
  }
  {
    f32x4 o[4][2]; float m[2] = {-1e30f, -1e30f}, l[2] = {0.f, 0.f};
#pragma unroll
    for (int dt = 0; dt < 4; dt++) { o[dt][0] = (f32x4){0.f, 0.f, 0.f, 0.f}; o[dt][1] = (f32x4){0.f, 0.f, 0.f, 0.f}; }
    const int jlo = (cur - 8 > 0) ? (cur - 8) : 0;
    const bf16_t* kb = p.KWC + (size_t)bg * S_LEN * 64;
    const bf16_t* vb = p.VWT + (size_t)bg * 64 * S_LEN;
    tile_pipeline<4>(cur - jlo + 1,
      [&](int i, bf16x8 (&rg)[4]) {
        const int j = cur - i;
        rg[0] = *(const bf16x8*)(kb + (size_t)(64 * j + r0) * 64 + cc * 8);
        rg[1] = *(const bf16x8*)(kb + (size_t)(64 * j + r0 + 32) * 64 + cc * 8);
        rg[2] = *(const bf16x8*)(vb + (size_t)r0 * S_LEN + 64 * j + cc * 8);
        rg[3] = *(const bf16x8*)(vb + (size_t)(r0 + 32) * S_LEN + 64 * j + cc * 8);
      },
      store_kv,
      [&](int i, int buf) {
        const int j = cur - i;
        const bf16_t* sK = (const bf16_t*)(smem + buf * 18432);
        if (j == cur || j == cur - 8) {
          attn_tile<64, 64, 1>(sK, sK + 64 * 72, qf, o, m, l, c, true, true, [&](int key, int qt) {
            int tq = t0 + 16 * qt + lr, kp = 64 * j + key;
            return (kp <= tq) && (kp > tq - 512);
          });
        } else {
          attn_tile<64, 64, 0>(sK, sK + 64 * 72, qf, o, m, l, c, true, true, [&](int, int) { return true; });
        }
      });
    emit(o, l, 2);
  }
}

__device__ void memattn_item(const Params& p, int item, char* smem) {
  const int tid = get_tid(), lane = tid & 63, wave = tid >> 6, lr = lane & 15, lg = lane >> 4;
  const int b = item >> 7, h = (item >> 5) & 3, qb = item & 31;
  const int t0 = qb * 128 + wave * 32;
  const size_t tokbase = (size_t)b * S_LEN + t0;
  bf16x8 qf[2][4];
#pragma unroll
  for (int qt = 0; qt < 2; qt++)
#pragma unroll
    for (int ks = 0; ks < 4; ks++) qf[qt][ks] = *(const bf16x8*)(p.PROJ + (tokbase + 16 * qt + lr) * NIN + C_QX + h * 128 + 32 * ks + 8 * lg);
  f32x4 o[8][2]; float m[2] = {-1e30f, -1e30f}, l[2] = {0.f, 0.f};
#pragma unroll
  for (int dt = 0; dt < 8; dt++) { o[dt][0] = (f32x4){0.f, 0.f, 0.f, 0.f}; o[dt][1] = (f32x4){0.f, 0.f, 0.f, 0.f}; }
  const float c = 0.08838834764831845f * LOG2E;
  const bf16_t* kb = p.KMEM + (size_t)b * 256 * 512 + h * 128;
  const bf16_t* vb = p.VMEMT + (size_t)(b * 4 + h) * 128 * 256;
  tile_pipeline1<8>(4,
    [&](int kt, bf16x8 (&rg)[8]) {
#pragma unroll
      for (int i = 0; i < 4; i++) {
        int ch = tid + 256 * i;
        rg[i] = *(const bf16x8*)(kb + (size_t)(64 * kt + (ch >> 4)) * 512 + (ch & 15) * 8);
        rg[4 + i] = *(const bf16x8*)(vb + (size_t)(ch >> 3) * 256 + 64 * kt + (ch & 7) * 8);
      }
    },
    [&](int buf, bf16x8 (&rg)[8]) {
      bf16_t* sK = (bf16_t*)(smem + buf * 35840);
      bf16_t* sVt = sK + 64 * 136;
#pragma unroll
      for (int i = 0; i < 4; i++) {
        int ch = tid + 256 * i;
        *(bf16x8*)(sK + (ch >> 4) * 136 + (ch & 15) * 8) = rg[i];
        *(bf16x8*)(sVt + (ch >> 3) * 72 + (ch & 7) * 8) = rg[4 + i];
      }
    },
    [&](int, int buf) {
      const bf16_t* sK = (const bf16_t*)(smem + buf * 35840);
      attn_tile<128, 128, 0>(sK, sK + 64 * 136, qf, o, m, l, c, true, true, [&](int, int) { return true; });
    });
#pragma unroll
  for (int qt = 0; qt < 2; qt++) {
    const size_t tok = tokbase + 16 * qt + lr;
    const float inv = 1.f / fmaxf(l[qt], 1e-30f);
#pragma unroll
    for (int dt = 0; dt < 8; dt++) {
      const int dbase = h * 128 + 16 * dt + 4 * lg;
      bf16x4 ga = *(const bf16x4*)(p.PROJ + tok * NIN + C_GX + dbase);
      f32x4 r = o[dt][qt];
      *(bf16x4*)(p.MIX + tok * 1536 + 1024 + dbase) =
          pack4(r[0] * inv * silu_f(bfs(ga[0])), r[1] * inv * silu_f(bfs(ga[1])), r[2] * inv * silu_f(bfs(ga[2])), r[3] * inv * silu_f(bfs(ga[3])));
    }
  }
}

__device__ void compress_item(const Params& p, int item, char* smem) {
  const int tid = get_tid(), lane = tid & 63, wave = tid >> 6, lr = lane & 15, lg = lane >> 4;
  const int which = item >> 7, rho0 = (item & 127) * 32;
  const bf16_t* W1T = which ? p.W1vT : p.W1kT;
  const bf16_t* W2T = which ? p.W2vT : p.W2kT;
  const float* pe = which ? p.cpv : p.cpk;
  const int col0 = which ? C_VC : C_KC;
  bf16_t* sA = (bf16_t*)smem;
  bf16_t* sW = sA + 32 * 72;
  bf16_t* sH = sW + 256 * 72;
  const int arow = tid >> 3, akc = tid & 7;
  const bf16_t* abase;
  {
    int rho = rho0 + arow; if (rho > 4079) rho = 4079;
    int b = rho / 510, rem = rho - b * 510, n = rem >> 1, g = rem & 1;
    abase = p.PROJ + ((size_t)b * S_LEN + 16 * n) * NIN + col0 + g * 64 + akc * 8;
  }
  const bf16_t* wbase = W1T + (size_t)arow * 2048 + akc * 8;
  f32x4 acc[2][4];
#pragma unroll
  for (int i = 0; i < 2; i++)
#pragma unroll
    for (int j = 0; j < 4; j++) acc[i][j] = (f32x4){0.f, 0.f, 0.f, 0.f};
  bf16x8 ra, rw[8];
  float4 rp0, rp1;
  auto load = [&](int kt) {
    ra = *(const bf16x8*)(abase + (size_t)kt * NIN);
    rp0 = *(const float4*)(pe + kt * 64 + akc * 8); rp1 = *(const float4*)(pe + kt * 64 + akc * 8 + 4);
#pragma unroll
    for (int i = 0; i < 8; i++) rw[i] = *(const bf16x8*)(wbase + (size_t)(32 * i) * 2048 + kt * 64);
  };
  load(0);
  for (int kt = 0; kt < 32; kt++) {
    __syncthreads();
    *(bf16x8*)(sA + arow * 72 + akc * 8) =
        pack8(bfs(ra[0]) + rp0.x, bfs(ra[1]) + rp0.y, bfs(ra[2]) + rp0.z, bfs(ra[3]) + rp0.w,
              bfs(ra[4]) + rp1.x, bfs(ra[5]) + rp1.y, bfs(ra[6]) + rp1.z, bfs(ra[7]) + rp1.w);
#pragma unroll
    for (int i = 0; i < 8; i++) *(bf16x8*)(sW + (arow + 32 * i) * 72 + akc * 8) = rw[i];
    __syncthreads();
    load(kt < 31 ? kt + 1 : 31);
#pragma unroll
    for (int ks = 0; ks < 2; ks++) {
      bf16x8 a0 = *(const bf16x8*)(sA + lr * 72 + ks * 32 + 8 * lg);
      bf16x8 a1 = *(const bf16x8*)(sA + (16 + lr) * 72 + ks * 32 + 8 * lg);
#pragma unroll
      for (int ct = 0; ct < 4; ct++) {
        bf16x8 bf = *(const bf16x8*)(sW + (64 * wave + 16 * ct + lr) * 72 + ks * 32 + 8 * lg);
        acc[0][ct] = mfma16(a0, bf, acc[0][ct]);
        acc[1][ct] = mfma16(a1, bf, acc[1][ct]);
      }
    }
  }
  __syncthreads();
#pragma unroll
  for (int rt = 0; rt < 2; rt++)
#pragma unroll
    for (int ct = 0; ct < 4; ct++)
#pragma unroll
      for (int i = 0; i < 4; i++) sH[(16 * rt + 4 * lg + i) * 264 + 64 * wave + 16 * ct + lr] = f2bf(silu_f(acc[rt][ct][i]));
  __syncthreads();
  f32x4 acc2[2] = {(f32x4){0.f, 0.f, 0.f, 0.f}, (f32x4){0.f, 0.f, 0.f, 0.f}};
#pragma unroll
  for (int ks = 0; ks < 8; ks++) {
    bf16x8 bf = *(const bf16x8*)(W2T + (size_t)(16 * wave + lr) * 256 + 32 * ks + 8 * lg);
#pragma unroll
    for (int rt = 0; rt < 2; rt++) {
      bf16x8 a = *(const bf16x8*)(sH + (16 * rt + lr) * 264 + 32 * ks + 8 * lg);
      acc2[rt] = mfma16(a, bf, acc2[rt]);
    }
  }
  const int col = 16 * wave + lr;
#pragma unroll
  for (int rt = 0; rt < 2; rt++)
#pragma unroll
    for (int i = 0; i < 4; i++) {
      int rho = rho0 + 16 * rt + 4 * lg + i;
      bool ok = rho < 4080;
      int rc = ok ? rho : 4079;
      int b = rc / 510, rem = rc - b * 510, n = rem >> 1, g = rem & 1;
      float v = acc2[rt][i];
      float pr = __shfl_xor(v, 8);
      if (which == 0) {
        if (wave == 0) {
          int pos = p.pos[b * S_LEN + 16 * n + 31];
          float cs, sn; rope_cs(pos, lr & 7, cs, sn);
          v = (lr < 8) ? (v * cs - pr * sn) : (v * cs + pr * sn);
        }
        if (ok) p.KCMP[((size_t)(b * 2 + g) * 256 + n) * 64 + col] = f2bf(v);
      } else {
        if (ok) p.VCMPT[((size_t)(b * 2 + g) * 64 + col) * 256 + n] = f2bf(v);
      }
    }
}

__device__ void conv_units(const Params& p, int u) {
  const int it = u >> 8, wvi = (u >> 6) & 3, ln = u & 63;
  const int cgp = ((it & 3) * 4 + wvi) * 8 + (ln >> 3), tg = (it >> 2) * 8 + (ln & 7);
  const int tok0 = tg * 8, s0 = tok0 & 4095, ch0 = cgp * 8;
  const int b = tok0 >> 12;
  bf16x8 in[11];
#pragma unroll
  for (int r = 0; r < 11; r++) {
    int s = s0 - 3 + r;
    if (s >= 0) in[r] = *(const bf16x8*)(p.PROJ + (size_t)(tok0 - 3 + r) * NIN + C_XBC + ch0);
    else in[r] = (bf16x8){0, 0, 0, 0, 0, 0, 0, 0};
  }
  float4 wv[4][2];
#pragma unroll
  for (int k = 0; k < 4; k++) { wv[k][0] = *(const float4*)(p.conv_w + k * 1024 + ch0); wv[k][1] = *(const float4*)(p.conv_w + k * 1024 + ch0 + 4); }
  float4 bv0 = *(const float4*)(p.conv_b + ch0), bv1 = *(const float4*)(p.conv_b + ch0 + 4);
  float w[4][8], bias[8];
#pragma unroll
  for (int k = 0; k < 4; k++) { w[k][0] = wv[k][0].x; w[k][1] = wv[k][0].y; w[k][2] = wv[k][0].z; w[k][3] = wv[k][0].w; w[k][4] = wv[k][1].x; w[k][5] = wv[k][1].y; w[k][6] = wv[k][1].z; w[k][7] = wv[k][1].w; }
  bias[0] = bv0.x; bias[1] = bv0.y; bias[2] = bv0.z; bias[3] = bv0.w; bias[4] = bv1.x; bias[5] = bv1.y; bias[6] = bv1.z; bias[7] = bv1.w;
  if (ch0 >= 512) {
#pragma unroll
    for (int tt = 0; tt < 8; tt++) {
      bf16x8 o;
#pragma unroll
      for (int j = 0; j < 8; j++) {
        float a = bias[j];
#pragma unroll
        for (int k = 0; k < 4; k++) a += bfs(in[tt + k][j]) * w[k][j];
        o[j] = (short)f2bf(silu_f(a));
      }
      *(bf16x8*)(p.BC + (size_t)(tok0 + tt) * 512 + (ch0 - 512)) = o;
    }
  }
  if (ch0 < 768) {
#pragma unroll
    for (int j = 0; j < 8; j++) {
      bf16x8 o;
#pragma unroll
      for (int tt = 0; tt < 8; tt++) {
        float a = bias[j];
#pragma unroll
        for (int k = 0; k < 4; k++) a += bfs(in[tt + k][j]) * w[k][j];
        o[tt] = (short)f2bf(silu_f(a));
      }
      const int ch = ch0 + j;
      bf16_t* dst;
      if (ch0 < 512) dst = p.XT + ((size_t)(b * 8 + (ch >> 6)) * 64 + (ch & 63)) * S_LEN + s0;
      else dst = p.BT + ((size_t)(b * 2 + ((ch - 512) >> 7)) * 128 + ((ch - 512) & 127)) * S_LEN + s0;
      *(bf16x8*)dst = o;
    }
  }
}

__device__ void ssd_states_item(const Params& p, int item, char* smem) {
  const int tid = get_tid(), lane = tid & 63, wave = tid >> 6, lr = lane & 15, lg = lane >> 4;
  const int h = item & 7, c = (item >> 3) & 31, b = item >> 8;
  const int g = h >> 2;
  bf16_t* sX = (bf16_t*)smem;
  bf16_t* sBt = sX + 64 * 136;
  float* sAcs = (float*)(smem + (64 + 128) * 136 * 2);
  float* sW = sAcs + 128;
  float* sTot = sW + 128;
  const size_t tok0 = (size_t)b * S_LEN + c * 128;
  const bf16_t* xt = p.XT + (size_t)(b * 8 + h) * 64 * S_LEN + c * 128;
  const bf16_t* bt = p.BT + (size_t)(b * 2 + g) * 128 * S_LEN + c * 128;
  __syncthreads();
  bf16x8 tx[4], tb[8];
#pragma unroll
  for (int i = 0; i < 4; i++) { int ch = tid + 256 * i; tx[i] = *(const bf16x8*)(xt + (size_t)(ch >> 4) * S_LEN + (ch & 15) * 8); }
#pragma unroll
  for (int i = 0; i < 8; i++) { int ch = tid + 256 * i; tb[i] = *(const bf16x8*)(bt + (size_t)(ch >> 4) * S_LEN + (ch & 15) * 8); }
  float dt = 0.f, cs = 0.f;
  if (tid < 128) {
    float raw = bf2f(p.PROJ[(tok0 + tid) * NIN + C_DT + h]) + p.dt_bias[h];
    dt = fmaxf(raw, 0.f) + log1pf(__expf(-fabsf(raw)));
    float a = -__expf(p.a_log[h]);
    cs = dt * a;
#pragma unroll
    for (int o = 1; o < 64; o <<= 1) { float t = __shfl_up(cs, o); if (lane >= o) cs += t; }
    if (lane == 63) sTot[wave] = cs;
  }
  __syncthreads();
  if (tid < 128) {
    if (wave == 1) cs += sTot[0];
    sAcs[tid] = cs;
  }
  __syncthreads();
  if (tid < 128) {
    float last = sAcs[127];
    sW[tid] = dt * __expf(last - cs);
    const size_t o = ((size_t)(b * 32 + c) * 8 + h) * 128 + tid;
    p.ACS[o] = cs; p.DTV[o] = dt;
    if (tid == 0) p.CHDEC[(b * 32 + c) * 8 + h] = __expf(last);
  }
#pragma unroll
  for (int i = 0; i < 8; i++) { int ch = tid + 256 * i; *(bf16x8*)(sBt + (ch >> 4) * 136 + (ch & 15) * 8) = tb[i]; }
  __syncthreads();
#pragma unroll
  for (int i = 0; i < 4; i++) {
    int ch = tid + 256 * i;
    const int l0 = (ch & 15) * 8;
    float4 w0 = *(const float4*)(sW + l0), w1 = *(const float4*)(sW + l0 + 4);
    bf16x8 r = tx[i];
    *(bf16x8*)(sX + (ch >> 4) * 136 + l0) = pack8(bfs(r[0]) * w0.x, bfs(r[1]) * w0.y, bfs(r[2]) * w0.z, bfs(r[3]) * w0.w,
                                                  bfs(r[4]) * w1.x, bfs(r[5]) * w1.y, bfs(r[6]) * w1.z, bfs(r[7]) * w1.w);
  }
  __syncthreads();
  f32x4 acc[4][2];
#pragma unroll
  for (int i = 0; i < 4; i++) { acc[i][0] = (f32x4){0.f, 0.f, 0.f, 0.f}; acc[i][1] = (f32x4){0.f, 0.f, 0.f, 0.f}; }
#pragma unroll
  for (int ks = 0; ks < 4; ks++) {
    const int l0 = 32 * ks + 8 * lg;
    bf16x8 bf0 = *(const bf16x8*)(sBt + (32 * wave + lr) * 136 + l0);
    bf16x8 bf1 = *(const bf16x8*)(sBt + (32 * wave + 16 + lr) * 136 + l0);
#pragma unroll
    for (int pt = 0; pt < 4; pt++) {
      bf16x8 a = *(const bf16x8*)(sX + (16 * pt + lr) * 136 + l0);
      acc[pt][0] = mfma16(a, bf0, acc[pt][0]);
      acc[pt][1] = mfma16(a, bf1, acc[pt][1]);
    }
  }
  float* st = p.STATES + ((size_t)(b * 32 + c) * 8 + h) * 8192;
#pragma unroll
  for (int pt = 0; pt < 4; pt++)
#pragma unroll
    for (int x = 0; x < 2; x++)
#pragma unroll
      for (int i = 0; i < 4; i++) st[(16 * pt + 4 * lg + i) * 128 + 32 * wave + 16 * x + lr] = acc[pt][x][i];
}

__device__ void scan_units(const Params& p, int q) {
  const int b = q >> 16, r = q & 65535, h = r >> 13;
  float hs = 0.f;
  for (int c0 = 0; c0 < 32; c0 += 16) {
    float s[16], d[16];
#pragma unroll
    for (int i = 0; i < 16; i++) { s[i] = p.STATES[(size_t)(b * 32 + c0 + i) * 65536 + r]; d[i] = p.CHDEC[(b * 32 + c0 + i) * 8 + h]; }
#pragma unroll
    for (int i = 0; i < 16; i++) { p.STATES[(size_t)(b * 32 + c0 + i) * 65536 + r] = hs; hs = hs * d[i] + s[i]; }
  }
}

__device__ void ssd_y_item(const Params& p, int item, char* smem) {
  const int tid = get_tid(), lane = tid & 63, wave = tid >> 6, lr = lane & 15, lg = lane >> 4;
  const int h = item & 7, c = (item >> 3) & 31, b = item >> 8;
  const int g = h >> 2;
  bf16_t* sB = (bf16_t*)smem;
  bf16_t* sXT = sB + 128 * 136;
  float* sAcs = (float*)(smem + (128 + 64) * 136 * 2);
  float* sDt = sAcs + 128;
  bf16_t* sPrev = (bf16_t*)(smem + (128 + 64) * 136 * 2 + 1024);
  const size_t tok0 = (size_t)b * S_LEN + c * 128;
  const bf16_t* xt = p.XT + (size_t)(b * 8 + h) * 64 * S_LEN + c * 128;
  const int LT[2] = {wave, 7 - wave};
  const float* prev = p.STATES + ((size_t)(b * 32 + c) * 8 + h) * 8192;
  __syncthreads();
  {
    bf16x8 tb[8], tx[4];
    float4 tp[8];
#pragma unroll
    for (int i = 0; i < 8; i++) { int ch = tid + 256 * i; tp[i] = *(const float4*)(prev + (ch >> 5) * 128 + (ch & 31) * 4); }
#pragma unroll
    for (int i = 0; i < 8; i++) { int ch = tid + 256 * i; tb[i] = *(const bf16x8*)(p.BC + (tok0 + (ch >> 4)) * 512 + g * 128 + (ch & 15) * 8); }
#pragma unroll
    for (int i = 0; i < 4; i++) { int ch = tid + 256 * i; tx[i] = *(const bf16x8*)(xt + (size_t)(ch >> 4) * S_LEN + (ch & 15) * 8); }
    if (tid < 128) {
      const size_t o = ((size_t)(b * 32 + c) * 8 + h) * 128 + tid;
      sAcs[tid] = p.ACS[o]; sDt[tid] = p.DTV[o];
    }
#pragma unroll
    for (int i = 0; i < 8; i++) { int ch = tid + 256 * i; *(bf16x8*)(sB + (ch >> 4) * 136 + (ch & 15) * 8) = tb[i]; }
#pragma unroll
    for (int i = 0; i < 4; i++) { int ch = tid + 256 * i; *(bf16x8*)(sXT + (ch >> 4) * 136 + (ch & 15) * 8) = tx[i]; }
#pragma unroll
    for (int i = 0; i < 8; i++) { int ch = tid + 256 * i; *(bf16x4*)(sPrev + (ch >> 5) * 136 + (ch & 31) * 4) = pack4(tp[i].x, tp[i].y, tp[i].z, tp[i].w); }
  }
  bf16x8 cf[2][4];
  bf16x4 zpre[2][4];
#pragma unroll
  for (int li = 0; li < 2; li++) {
#pragma unroll
    for (int ks = 0; ks < 4; ks++)
      cf[li][ks] = *(const bf16x8*)(p.BC + (tok0 + 16 * LT[li] + lr) * 512 + 256 + g * 128 + 32 * ks + 8 * lg);
#pragma unroll
    for (int pt = 0; pt < 4; pt++)
      zpre[li][pt] = *(const bf16x4*)(p.PROJ + (tok0 + 16 * LT[li] + lr) * NIN + C_Z + h * 64 + 16 * pt + 4 * lg);
  }
  f32x4 acc[4][2];
#pragma unroll
  for (int i = 0; i < 4; i++) { acc[i][0] = (f32x4){0.f, 0.f, 0.f, 0.f}; acc[i][1] = (f32x4){0.f, 0.f, 0.f, 0.f}; }
  __syncthreads();
#pragma unroll
  for (int pt = 0; pt < 4; pt++)
#pragma unroll
    for (int ks = 0; ks < 4; ks++) {
      bf16x8 a = *(const bf16x8*)(sPrev + (16 * pt + lr) * 136 + 32 * ks + 8 * lg);
      acc[pt][0] = mfma16(a, cf[0][ks], acc[pt][0]);
      acc[pt][1] = mfma16(a, cf[1][ks], acc[pt][1]);
    }
#pragma unroll
  for (int li = 0; li < 2; li++) {
    float e = __expf(sAcs[16 * LT[li] + lr]);
#pragma unroll
    for (int pt = 0; pt < 4; pt++) { acc[pt][li][0] *= e; acc[pt][li][1] *= e; acc[pt][li][2] *= e; acc[pt][li][3] *= e; }
  }
#pragma unroll
  for (int li = 0; li < 2; li++) {
    const int lt = LT[li];
    const int lpos = 16 * lt + lr;
    const float acl = sAcs[lpos];
    for (int sp = 0; sp <= (lt >> 1); sp++) {
      f32x4 cb[2] = {(f32x4){0.f, 0.f, 0.f, 0.f}, (f32x4){0.f, 0.f, 0.f, 0.f}};
#pragma unroll
      for (int x = 0; x < 2; x++)
#pragma unroll
        for (int ks = 0; ks < 4; ks++) {
          bf16x8 bfr = *(const bf16x8*)(sB + (32 * sp + 16 * x + lr) * 136 + 32 * ks + 8 * lg);
          cb[x] = mfma16(bfr, cf[li][ks], cb[x]);
        }
      float mv[8];
#pragma unroll
      for (int x = 0; x < 2; x++)
#pragma unroll
        for (int i = 0; i < 4; i++) {
          const int s = 32 * sp + 16 * x + 4 * lg + i;
          mv[4 * x + i] = (s <= lpos) ? cb[x][i] * __expf(acl - sAcs[s]) * sDt[s] : 0.f;
        }
      bf16x8 mb = pack8(mv[0], mv[1], mv[2], mv[3], mv[4], mv[5], mv[6], mv[7]);
#pragma unroll
      for (int pt = 0; pt < 4; pt++) {
        const bf16_t* xp = sXT + (16 * pt + lr) * 136 + 32 * sp + 4 * lg;
        bf16x8 a = cat44(*(const bf16x4*)xp, *(const bf16x4*)(xp + 16));
        acc[pt][li] = mfma16(a, mb, acc[pt][li]);
      }
    }
  }
  const float dsk = p.d_skip[h];
#pragma unroll
  for (int li = 0; li < 2; li++) {
    const int lpos = 16 * LT[li] + lr;
    const size_t tok = tok0 + lpos;
    float ss = 0.f;
#pragma unroll
    for (int pt = 0; pt < 4; pt++) {
      const int pb = 16 * pt + 4 * lg;
      bf16x4 zv = zpre[li][pt];
      float y[4];
#pragma unroll
      for (int i = 0; i < 4; i++) {
        float xv = bf2f(sXT[(pb + i) * 136 + lpos]);
        y[i] = (acc[pt][li][i] + dsk * xv) * silu_f(bfs(zv[i]));
        ss += y[i] * y[i];
      }
      *(bf16x4*)(p.MIX + tok * 1536 + 512 + h * 64 + pb) = pack4(y[0], y[1], y[2], y[3]);
    }
    ss += __shfl_xor(ss, 16); ss += __shfl_xor(ss, 32);
    if (lg == 0) p.SS_SSD[tok * 8 + h] = ss;
  }
}

__device__ void final_rows(const Params& p, int gw, int nw) {
  const int lane = threadIdx.x & 63;
  for (int row = gw; row < T_TOK; row += nw) {
    float r = rsqrtf(p.SS_OUT[row] * (1.f / 1024.f) + 1e-6f);
    float4* o = (float4*)(p.out + (size_t)row * 1024);
    const float4* gf = (const float4*)p.g_final;
#pragma unroll
    for (int i = 0; i < 4; i++) {
      float4 v = o[lane + 64 * i], gg = gf[lane + 64 * i];
      v.x *= r * gg.x; v.y *= r * gg.y; v.z *= r * gg.z; v.w *= r * gg.w;
      o[lane + 64 * i] = v;
    }
  }
}

__device__ __forceinline__ void grid_bar(unsigned* bar, unsigned k) {
  asm volatile("s_waitcnt vmcnt(0)" ::: "memory");
  __syncthreads();
  if (threadIdx.x == 0) {
    const unsigned nb = gridDim.x, r = blockIdx.x & 7u;
    const unsigned nsub = (nb - r + 7u) >> 3;
    const unsigned ngrp = nb < 8u ? nb : 8u;
    __builtin_amdgcn_fence(__ATOMIC_RELEASE, "agent");
    asm volatile("s_waitcnt vmcnt(0)" ::: "memory");
    const unsigned old = __hip_atomic_fetch_add(bar + 64 * r, 1u, __ATOMIC_RELAXED, __HIP_MEMORY_SCOPE_AGENT);
    if (old + 1u == k * nsub) {
      __builtin_amdgcn_fence(__ATOMIC_ACQ_REL, "agent");
      asm volatile("s_waitcnt vmcnt(0)" ::: "memory");
      __hip_atomic_fetch_add(bar + 64 * 8, 1u, __ATOMIC_RELAXED, __HIP_MEMORY_SCOPE_AGENT);
    }
    while (__hip_atomic_load(bar + 64 * 8, __ATOMIC_RELAXED, __HIP_MEMORY_SCOPE_AGENT) < k * ngrp) __builtin_amdgcn_s_sleep(1);
    __builtin_amdgcn_fence(__ATOMIC_ACQUIRE, "agent");
    asm volatile("s_waitcnt vmcnt(0)" ::: "memory");
  }
  __syncthreads();
}

__device__ __forceinline__ int next_item(unsigned* ctr, char* smem) {
  int* sh = (int*)(smem + SMEM_BYTES - 16);
  __syncthreads();
  if (threadIdx.x == 0) *sh = (int)__hip_atomic_fetch_add(ctr, 1u, __ATOMIC_RELAXED, __HIP_MEMORY_SCOPE_AGENT);
  __syncthreads();
  return *sh;
}

__global__ void __launch_bounds__(256, 2) hymba_fwd(Params p) {
  cg::grid_group grid = cg::this_grid();
  __shared__ __attribute__((aligned(16))) char smem[SMEM_BYTES];
  const int nb = gridDim.x, bid = blockIdx.x;
  unsigned bk = 0;

  if (p.out == nullptr) grid.sync();
  for (int rep = 0; rep < REP0; rep++) {
  phase_prep(p);
  grid_bar(p.BAR, ++bk);
  }
  for (int rep = 0; rep < REP1; rep++) {
  if ((nb & 7) == 0) {
    const int xcd = bid & 7, li = bid >> 3, nbx = nb >> 3;
    for (int e = li; e < 1120; e += nbx) {
      const int grp = e / 280, r = e - grp * 280;
      gemm_tile<0>(p, xcd * 32 + grp * 8 + (r & 7), r >> 3, smem);
    }
  } else {
    for (int it = bid; it < 256 * 35; it += nb) gemm_tile<0>(p, it / 35, it % 35, smem);
  }
  for (int j = bid; j < 128; j += nb) gemm_tile<1>(p, j >> 3, j & 7, smem);
  grid_bar(p.BAR, ++bk);
  }
  for (int rep = 0; rep < REP2; rep++) {
  for (int it = next_item(p.BAR + 64 * (9 + rep), smem); it < 256 + 1024 + 2048; it = next_item(p.BAR + 64 * (9 + rep), smem)) {
    if (it < 256) compress_item(p, it, smem);
    else if (it < 1280) memattn_item(p, it - 256, smem);
    else conv_units(p, (it - 1280) * 256 + get_tid());
  }
  grid_bar(p.BAR, ++bk);
  }
  for (int rep = 0; rep < REP3; rep++) {
  {
    const int xq = bid & 7;
    unsigned* ctr = p.BAR + 64 * (16 + xq + 8 * rep);
    for (int li = next_item(ctr, smem); li < 512; li = next_item(ctr, smem)) {
      if (li < 256) nsa_item(p, ((li >> 1) << 4) | (xq + 8 * (li & 1)), smem);
      else ssd_states_item(p, (li - 256) * 8 + xq, smem);
    }
  }
  grid_bar(p.BAR, ++bk);
  }
  for (int it = bid; it < 2048; it += nb) scan_units(p, it * 256 + get_tid());
  grid_bar(p.BAR, ++bk);
  for (int rep = 0; rep < REP5; rep++) {
  for (int it = bid; it < 2048; it += nb) ssd_y_item(p, it, smem);
  grid_bar(p.BAR, ++bk);
  }
  if ((nb & 7) == 0) {
    const int xcd = bid & 7, li = bid >> 3, nbx = nb >> 3;
    for (int e = li; e < 256; e += nbx) gemm_tile<2>(p, xcd * 32 + (e >> 3), e & 7, smem);
  } else {
    for (int it = bid; it < 256 * 8; it += nb) gemm_tile<2>(p, it >> 3, it & 7, smem);
  }
  grid_bar(p.BAR, ++bk);
  final_rows(p, (bid * 256 + threadIdx.x) >> 6, (nb * 256) >> 6);
}

extern "C" void kernel_launch(void* const* d_in, const int* in_sizes, int n_in, void* d_out, int out_size, void* d_ws, size_t ws_size,
                              hipStream_t stream) {
  static int grid_blocks = 0;
  if (!grid_blocks) {
    int dev = 0, cus = 0, per_cu = 0;
    hipGetDevice(&dev);
    hipDeviceGetAttribute(&cus, hipDeviceAttributeMultiprocessorCount, dev);
    hipOccupancyMaxActiveBlocksPerMultiprocessor(&per_cu, hymba_fwd, 256, 0);
    if (per_cu < 1) per_cu = 1;
    if (per_cu > 4) per_cu = 4;
    grid_blocks = cus * per_cu;
  }
  Params p{};
  p.x = (const float*)d_in[0]; p.mem = (const float*)d_in[1]; p.pos = (const int*)d_in[2];
  p.g_in = (const float*)d_in[3]; p.w_in = (const float*)d_in[4]; p.cpk = (const float*)d_in[5];
  p.w1k = (const float*)d_in[6]; p.w2k = (const float*)d_in[7]; p.cpv = (const float*)d_in[8];
  p.w1v = (const float*)d_in[9]; p.w2v = (const float*)d_in[10]; p.conv_w = (const float*)d_in[11];
  p.conv_b = (const float*)d_in[12]; p.dt_bias = (const float*)d_in[13]; p.a_log = (const float*)d_in[14];
  p.d_skip = (const float*)d_in[15]; p.g_ssd = (const float*)d_in[16]; p.g_mem = (const float*)d_in[17];
  p.w_kv = (const float*)d_in[18]; p.w_out = (const float*)d_in[19]; p.g_final = (const float*)d_in[20];
  p.out = (float*)d_out;
  char* w = (char*)d_ws; size_t off = 0;
  auto take = [&](size_t bytes) { char* r = w + off; off += (bytes + 255) & ~(size_t)255; return r; };
  p.WinT = (bf16_t*)take((size_t)NINP * 1024 * 2);
  p.WoutT = (bf16_t*)take((size_t)1024 * 1536 * 2);
  p.WkvT = (bf16_t*)take((size_t)1024 * 1024 * 2);
  p.W1kT = (bf16_t*)take((size_t)256 * 2048 * 2);
  p.W1vT = (bf16_t*)take((size_t)256 * 2048 * 2);
  p.W2kT = (bf16_t*)take((size_t)64 * 256 * 2);
  p.W2vT = (bf16_t*)take((size_t)64 * 256 * 2);
  p.MEMB = (bf16_t*)take((size_t)2048 * 1024 * 2);
  p.PROJ = (bf16_t*)take((size_t)T_TOK * NIN * 2);
  p.VST = (bf16_t*)take((size_t)16 * 64 * S_LEN * 2);
  p.VWT = (bf16_t*)take((size_t)16 * 64 * S_LEN * 2);
  p.KMEM = (bf16_t*)take((size_t)2048 * 512 * 2);
  p.VMEMT = (bf16_t*)take((size_t)32 * 128 * 256 * 2);
  p.KCMP = (bf16_t*)take((size_t)16 * 256 * 64 * 2);
  p.VCMPT = (bf16_t*)take((size_t)16 * 64 * 256 * 2);
  p.XT = (bf16_t*)take((size_t)64 * 64 * S_LEN * 2);
  p.BC = (bf16_t*)take((size_t)T_TOK * 512 * 2);
  p.BT = (bf16_t*)take((size_t)16 * 128 * S_LEN * 2);
  p.MIX = (bf16_t*)take((size_t)T_TOK * 1536 * 2);
  p.XB = p.MIX;
  p.CHDEC = (float*)take((size_t)8 * 32 * 8 * 4);
  p.ACS = (float*)take((size_t)8 * 32 * 8 * 128 * 4);
  p.DTV = (float*)take((size_t)8 * 32 * 8 * 128 * 4);
  p.SS_SSD = (float*)take((size_t)T_TOK * 8 * 4);
  p.SS_OUT = (float*)take((size_t)T_TOK * 4);
  p.BAR = (unsigned*)take((size_t)(64 * 32 + 256) * 4);
  p.MTCNT = p.BAR + 64 * 32;
  p.STATES = (float*)d_out;
  p.KSC = (bf16_t*)((char*)d_out + (size_t)80 * 1024 * 1024);
  p.KWC = p.KSC + (size_t)16 * S_LEN * 64;
  if (off > ws_size) { fprintf(stderr, "workspace too small: need %zu have %zu\n", off, ws_size); return; }
  hipMemsetAsync(p.BAR, 0, (64 * 32 + 256) * 4, stream);
  void* args[] = {&p};
  hipError_t e = hipLaunchCooperativeKernel((void*)hymba_fwd, dim3(grid_blocks), dim3(256), args, 0, stream);
  if (e != hipSuccess) fprintf(stderr, "cooperative launch failed: %s (grid %d)\n", hipGetErrorString(e), grid_blocks);
}
```

```cpp
#include <hip/hip_runtime.h>
#include <hip/hip_cooperative_groups.h>
#include <stdint.h>
#include <stdio.h>
namespace cg = cooperative_groups;

typedef unsigned short bf16_t;
typedef __attribute__((ext_vector_type(8))) short bf16x8;
typedef __attribute__((ext_vector_type(4))) short bf16x4;
typedef __attribute__((ext_vector_type(4))) float f32x4;

#define S_LEN 4096
#define T_TOK 32768
#define NIN 4384
#define NINP 4480
#define LOG2E 1.4426950408889634f

#define C_Q 0
#define C_KC 512
#define C_VC 640
#define C_KS 768
#define C_KW 1024
#define C_GL 1280
#define C_GA 1304
#define C_Z 1816
#define C_XBC 2328
#define C_DT 3352
#define C_QX 3360
#define C_GX 3872

#define SMEM_BYTES 73728
#ifndef REP0
#define REP0 1
#endif
#ifndef REP1
#define REP1 1
#endif
#ifndef REP2
#define REP2 1
#endif
#ifndef REP3
#define REP3 1
#endif
#ifndef REP5
#define REP5 1
#endif

struct Params {
  const float *x, *mem; const int* pos;
  const float *g_in, *w_in, *cpk, *w1k, *w2k, *cpv, *w1v, *w2v, *conv_w, *conv_b, *dt_bias, *a_log, *d_skip, *g_ssd, *g_mem, *w_kv, *w_out, *g_final;
  float* out;
  bf16_t *WinT, *WoutT, *WkvT, *W1kT, *W1vT, *W2kT, *W2vT, *XB, *MEMB, *PROJ, *VST, *VWT, *KMEM, *VMEMT, *KCMP, *VCMPT, *XT, *BC, *BT, *MIX, *KSC, *KWC;
  float *STATES, *CHDEC, *ACS, *DTV, *SS_SSD, *SS_OUT;
  unsigned* BAR;
  unsigned* MTCNT;
};

__device__ __forceinline__ bf16_t f2bf(float f) { uint32_t u = __float_as_uint(f); u += 0x7fffu + ((u >> 16) & 1u); return (bf16_t)(u >> 16); }
__device__ __forceinline__ float bf2f(bf16_t h) { return __uint_as_float(((uint32_t)h) << 16); }
__device__ __forceinline__ float bfs(short h) { return __uint_as_float(((uint32_t)(unsigned short)h) << 16); }
__device__ __forceinline__ float fexp2(float x) { return __builtin_amdgcn_exp2f(x); }
__device__ __forceinline__ float silu_f(float x) { return x * __builtin_amdgcn_rcpf(1.f + __builtin_amdgcn_exp2f(-1.4426950408889634f * x)); }
__device__ __forceinline__ float sigmoid_f(float x) { return __builtin_amdgcn_rcpf(1.f + __builtin_amdgcn_exp2f(-1.4426950408889634f * x)); }
__device__ __forceinline__ f32x4 mfma16(bf16x8 a, bf16x8 b, f32x4 c) { return __builtin_amdgcn_mfma_f32_16x16x32_bf16(a, b, c, 0, 0, 0); }
typedef __bf16 hbf2_t __attribute__((ext_vector_type(2)));
typedef float f2_t __attribute__((ext_vector_type(2)));
typedef uint32_t u32x2 __attribute__((ext_vector_type(2)));
typedef uint32_t u32x4 __attribute__((ext_vector_type(4)));
__device__ __forceinline__ uint32_t pk2(float a, float b) {
  f2_t v; v[0] = a; v[1] = b;
  hbf2_t r = __builtin_convertvector(v, hbf2_t);
  return __builtin_bit_cast(uint32_t, r);
}
__device__ __forceinline__ bf16x4 pack4(float a, float b, float c, float d) {
  u32x2 r; r[0] = pk2(a, b); r[1] = pk2(c, d); return __builtin_bit_cast(bf16x4, r);
}
__device__ __forceinline__ bf16x8 pack8(float a, float b, float c, float d, float e, float f, float g, float h) {
  u32x4 r; r[0] = pk2(a, b); r[1] = pk2(c, d); r[2] = pk2(e, f); r[3] = pk2(g, h); return __builtin_bit_cast(bf16x8, r);
}
__device__ __forceinline__ bf16x8 cat44(bf16x4 a, bf16x4 b) {
  u32x2 x = __builtin_bit_cast(u32x2, a), y = __builtin_bit_cast(u32x2, b);
  u32x4 r; r[0] = x[0]; r[1] = x[1]; r[2] = y[0]; r[3] = y[1]; return __builtin_bit_cast(bf16x8, r);
}
template <int NR, typename L, typename ST, typename C>
__device__ __forceinline__ void tile_pipeline(int n, L load, ST store, C compute) {
  if (n <= 0) return;
  bf16x8 ra[NR], rb[NR];
  const int last = n - 1;
  load(0, ra);
  load(min(1, last), rb);
  store(0, ra);
  load(min(2, last), ra);
  __syncthreads();
  for (int i = 0; i < n; i += 2) {
    compute(i, 0);
    store(1, rb);
    load(min(i + 3, last), rb);
    __syncthreads();
    if (i + 1 < n) compute(i + 1, 1);
    store(0, ra);
    load(min(i + 4, last), ra);
    __syncthreads();
  }
}
template <int NR, typename L, typename ST, typename C>
__device__ __forceinline__ void tile_pipeline1(int n, L load, ST store, C compute) {
  if (n <= 0) return;
  bf16x8 ra[NR];
  load(0, ra);
  store(0, ra);
  if (n > 1) load(1, ra);
  __syncthreads();
  for (int i = 0; i < n; i++) {
    compute(i, i & 1);
    if (i + 1 < n) { store((i + 1) & 1, ra); if (i + 2 < n) load(i + 2, ra); }
    __syncthreads();
  }
}
__device__ __forceinline__ void rope_cs(int pos, int j, float& cs, float& sn) {
  float inv = fexp2(-(float)j * (18.931568569324174f / 8.f));
  float a = (float)pos * inv;
  float n = rintf(a * 0.15915494309189535f);
  float r = fmaf(-n, 6.28125f, a);
  r = fmaf(-n, 1.9353071795864769e-3f, r);
  cs = __cosf(r); sn = __sinf(r);
}

__device__ __forceinline__ float rowmax4(float x) {
  unsigned xi = __float_as_uint(x);
  auto a = __builtin_amdgcn_permlane16_swap(xi, xi, false, false);
  float m = fmaxf(__uint_as_float(a[0]), __uint_as_float(a[1]));
  unsigned mi = __float_as_uint(m);
  auto b = __builtin_amdgcn_permlane32_swap(mi, mi, false, false);
  return fmaxf(__uint_as_float(b[0]), __uint_as_float(b[1]));
}
__device__ __forceinline__ float rowsum4(float x) {
  unsigned xi = __float_as_uint(x);
  auto a = __builtin_amdgcn_permlane16_swap(xi, xi, false, false);
  float m = __uint_as_float(a[0]) + __uint_as_float(a[1]);
  unsigned mi = __float_as_uint(m);
  auto b = __builtin_amdgcn_permlane32_swap(mi, mi, false, false);
  return __uint_as_float(b[0]) + __uint_as_float(b[1]);
}
__device__ __forceinline__ int get_tid() { int t = threadIdx.x; asm volatile("" : "+v"(t)); return t; }

__device__ void prep_rows(const float* __restrict__ x, bf16_t* __restrict__ xb, int nrows, int gw, int nw) {
  const int lane = threadIdx.x & 63;
  int row = gw;
  for (; row + 3 * nw < nrows; row += 4 * nw) {
    float4 v[4][4]; float ss[4];
#pragma unroll
    for (int r = 0; r < 4; r++) {
      const float4* p = (const float4*)(x + (size_t)(row + r * nw) * 1024);
#pragma unroll
      for (int i = 0; i < 4; i++) v[r][i] = p[lane + 64 * i];
    }
#pragma unroll
    for (int r = 0; r < 4; r++) {
      float s = 0.f;
#pragma unroll
      for (int i = 0; i < 4; i++) s += v[r][i].x * v[r][i].x + v[r][i].y * v[r][i].y + v[r][i].z * v[r][i].z + v[r][i].w * v[r][i].w;
#pragma unroll
      for (int o = 32; o >= 1; o >>= 1) s += __shfl_xor(s, o);
      ss[r] = rsqrtf(s * (1.f / 1024.f) + 1e-6f);
    }
#pragma unroll
    for (int r = 0; r < 4; r++)
#pragma unroll
      for (int i = 0; i < 4; i++)
        *(bf16x4*)(xb + (size_t)(row + r * nw) * 1024 + (lane + 64 * i) * 4) =
            pack4(v[r][i].x * ss[r], v[r][i].y * ss[r], v[r][i].z * ss[r], v[r][i].w * ss[r]);
  }
  for (; row < nrows; row += nw) {
    const float4* p = (const float4*)(x + (size_t)row * 1024);
    float4 v[4]; float ss = 0.f;
#pragma unroll
    for (int i = 0; i < 4; i++) { v[i] = p[lane + 64 * i]; ss += v[i].x * v[i].x + v[i].y * v[i].y + v[i].z * v[i].z + v[i].w * v[i].w; }
#pragma unroll
    for (int o = 32; o >= 1; o >>= 1) ss += __shfl_xor(ss, o);
    float r = rsqrtf(ss * (1.f / 1024.f) + 1e-6f);
#pragma unroll
    for (int i = 0; i < 4; i++) {
      bf16x4 o = pack4(v[i].x * r, v[i].y * r, v[i].z * r, v[i].w * r);
      *(bf16x4*)(xb + (size_t)row * 1024 + (lane + 64 * i) * 4) = o;
    }
  }
}

__device__ void prep_wT(const float* __restrict__ w, const float* __restrict__ g, int gk0, int gk1, bf16_t* __restrict__ wt,
                        int K, int N, int Npad, int gtid, int gthreads) {
  const int ln = gtid & 63, gwv = gtid >> 6, nwv = gthreads >> 6;
  const int kblocks = K >> 6;
  const int total = (Npad >> 3) * kblocks;
  for (int uw = gwv; uw < total; uw += nwv) {
    const int kb = uw % kblocks, nbk = uw / kblocks;
    const int n = nbk * 8 + (ln >> 3), k8 = kb * 8 + (ln & 7);
    bf16x8 o;
#pragma unroll
    for (int j = 0; j < 8; j++) {
      int k = k8 * 8 + j; float v = 0.f;
      if (n < N) { v = w[(size_t)k * N + n]; if (g != nullptr && k >= gk0 && k < gk1) v *= g[k - gk0]; }
      o[j] = (short)f2bf(v);
    }
    *(bf16x8*)(wt + (size_t)n * K + k8 * 8) = o;
  }
}

__device__ void phase_prep(const Params& p) {
  const int gtid = blockIdx.x * 256 + threadIdx.x, gthreads = gridDim.x * 256;
  const int gw = gtid >> 6, nw = gthreads >> 6;
  prep_rows(p.x, p.XB, T_TOK, gw, nw);
  prep_rows(p.mem, p.MEMB, 2048, gw, nw);
  prep_wT(p.w_in, p.g_in, 0, 1024, p.WinT, 1024, NIN, NINP, gtid, gthreads);
  prep_wT(p.w_out, p.g_ssd, 512, 1024, p.WoutT, 1536, 1024, 1024, gtid, gthreads);
  prep_wT(p.w_kv, p.g_mem, 0, 1024, p.WkvT, 1024, 1024, 1024, gtid, gthreads);
  prep_wT(p.w1k, nullptr, 0, 0, p.W1kT, 2048, 256, 256, gtid, gthreads);
  prep_wT(p.w1v, nullptr, 0, 0, p.W1vT, 2048, 256, 256, gtid, gthreads);
  prep_wT(p.w2k, nullptr, 0, 0, p.W2kT, 256, 64, 64, gtid, gthreads);
  prep_wT(p.w2v, nullptr, 0, 0, p.W2vT, 256, 64, 64, gtid, gthreads);
  for (int i = gtid; i < T_TOK; i += gthreads) p.SS_OUT[i] = 0.f;
  for (int i = gtid; i < 16 * 64; i += gthreads) {
    int bg = i >> 6, d = i & 63;
    p.KCMP[((size_t)bg * 256 + 255) * 64 + d] = 0;
    p.VCMPT[((size_t)bg * 64 + d) * 256 + 255] = 0;
  }
}

typedef __attribute__((address_space(3))) unsigned lds_u32_t;
typedef __attribute__((address_space(1))) const unsigned glb_u32_t;
__device__ __forceinline__ void glds16(const bf16_t* g, char* l) {
  __builtin_amdgcn_global_load_lds((glb_u32_t*)g, (lds_u32_t*)l, 16, 0, 0);
}
template <int MODE>
__device__ void gemm_tile_reg(const Params& p, int mt, int nt, char* smem) {
  const int tid = get_tid(), lane = tid & 63, wave = tid >> 6, lr = lane & 15, lg = lane >> 4;
  const int wr = wave >> 1, wc = wave & 1;
  const int m0 = mt * 128, n0 = nt * 128;
  const bf16_t* A; const bf16_t* Bt; int K;
  if (MODE == 0) { A = p.XB; Bt = p.WinT; K = 1024; }
  else if (MODE == 1) { A = p.MEMB; Bt = p.WkvT; K = 1024; }
  else { A = p.MIX; Bt = p.WoutT; K = 1536; }
  bf16_t* As = (bf16_t*)smem;
  bf16_t* Bs = As + 2 * 9216;
  const int lrow = tid >> 3, kc = tid & 7;
  const bf16_t* ga = A + (size_t)(m0 + lrow) * K + kc * 8;
  const bf16_t* gb = Bt + (size_t)(n0 + lrow) * K + kc * 8;
  float rs[4] = {1.f, 1.f, 1.f, 1.f};
  if (MODE == 2) {
#pragma unroll
    for (int i = 0; i < 4; i++) {
      const float4* sp = (const float4*)(p.SS_SSD + (size_t)(m0 + lrow + 32 * i) * 8);
      float4 a = sp[0], b = sp[1];
      rs[i] = rsqrtf((a.x + a.y + a.z + a.w + b.x + b.y + b.z + b.w) * (1.f / 512.f) + 1e-6f);
    }
  }
  bool swap;
  if (MODE == 0) swap = !(nt == 7 || nt == 9);
  else if (MODE == 1) swap = (nt < 4);
  else swap = true;
  const bf16_t* F = swap ? (Bs + (64 * wc) * 72) : (As + (64 * wr) * 72);
  const bf16_t* G = swap ? (As + (64 * wr) * 72) : (Bs + (64 * wc) * 72);
  f32x4 acc[4][4];
#pragma unroll
  for (int i = 0; i < 4; i++)
#pragma unroll
    for (int j = 0; j < 4; j++) acc[i][j] = (f32x4){0.f, 0.f, 0.f, 0.f};
  bf16x8 ra0[4], rb0[4], ra1[4], rb1[4];
  const int nk = K / 64;
  auto load = [&](int kt, bf16x8 (&ra)[4], bf16x8 (&rb)[4]) {
#pragma unroll
    for (int i = 0; i < 4; i++) {
      ra[i] = *(const bf16x8*)(ga + (size_t)(32 * i) * K + kt * 64);
      rb[i] = *(const bf16x8*)(gb + (size_t)(32 * i) * K + kt * 64);
    }
  };
  auto store = [&](int buf, int kt, bf16x8 (&ra)[4], bf16x8 (&rb)[4]) {
    if (MODE == 2) {
      if (kt >= 8 && kt < 16) {
#pragma unroll
        for (int i = 0; i < 4; i++) {
          bf16x8 v = ra[i];
          ra[i] = pack8(bfs(v[0]) * rs[i], bfs(v[1]) * rs[i], bfs(v[2]) * rs[i], bfs(v[3]) * rs[i],
                        bfs(v[4]) * rs[i], bfs(v[5]) * rs[i], bfs(v[6]) * rs[i], bfs(v[7]) * rs[i]);
        }
      }
    }
#pragma unroll
    for (int i = 0; i < 4; i++) {
      *(bf16x8*)(As + buf * 9216 + (lrow + 32 * i) * 72 + kc * 8) = ra[i];
      *(bf16x8*)(Bs + buf * 9216 + (lrow + 32 * i) * 72 + kc * 8) = rb[i];
    }
  };
  auto compute = [&](int buf) {
    const int cb = buf * 9216;
#pragma unroll
    for (int ks = 0; ks < 2; ks++) {
      bf16x8 ff[4], gg[4];
#pragma unroll
      for (int i = 0; i < 4; i++) {
        ff[i] = *(const bf16x8*)(F + cb + (16 * i + lr) * 72 + ks * 32 + lg * 8);
        gg[i] = *(const bf16x8*)(G + cb + (16 * i + lr) * 72 + ks * 32 + lg * 8);
      }
#pragma unroll
      for (int i = 0; i < 4; i++)
#pragma unroll
        for (int j = 0; j < 4; j++) acc[i][j] = mfma16(ff[i], gg[j], acc[i][j]);
    }
  };
  const int lastk = nk - 1;
  load(0, ra0, rb0);
  load(1, ra1, rb1);
  store(0, 0, ra0, rb0);
  load(2, ra0, rb0);
  __syncthreads();
  for (int kt = 0; kt < nk; kt += 2) {
    compute(0);
    store(1, kt + 1, ra1, rb1);
    load(min(kt + 3, lastk), ra1, rb1);
    __syncthreads();
    compute(1);
    store(0, min(kt + 2, lastk), ra0, rb0);
    load(min(kt + 4, lastk), ra0, rb0);
    __syncthreads();
  }
  if (swap) {
    if (MODE == 0) {
      const bool rope = (nt < 4) || nt == 6 || nt == 8;
#pragma unroll
      for (int mi = 0; mi < 4; mi++) {
        const int m = m0 + 64 * wr + 16 * mi + lr;
        if (rope) {
          const int pos = p.pos[m];
          f32x4 v = acc[0][mi];
          f32x4 o;
#pragma unroll
          for (int i = 0; i < 4; i++) {
            float pr = __shfl_xor(v[i], 32);
            float cs, sn; rope_cs(pos, 4 * (lg & 1) + i, cs, sn);
            o[i] = (lg < 2) ? (v[i] * cs - pr * sn) : (v[i] * cs + pr * sn);
          }
          acc[0][mi] = o;
        }
        {
          bf16_t* stg = (bf16_t*)smem + ((wave & 1) ? 2 * 9216 : 0) + (wave >> 1) * 4608;
#pragma unroll
          for (int ni = 0; ni < 4; ni++) {
            f32x4 v = acc[ni][mi];
            *(bf16x4*)(stg + (16 * mi + lr) * 72 + 16 * ni + 4 * lg) = pack4(v[0], v[1], v[2], v[3]);
          }
        }
      }
      {
        const bf16_t* stg = (const bf16_t*)smem + ((wave & 1) ? 2 * 9216 : 0) + (wave >> 1) * 4608;
        const int rr = lane >> 3, ch = lane & 7;
        const int nb0 = n0 + 64 * wc + ch * 8;
#pragma unroll
        for (int it = 0; it < 8; it++) {
          const int row = it * 8 + rr;
          const int m = m0 + 64 * wr + row;
          bf16x8 v = *(const bf16x8*)(stg + row * 72 + ch * 8);
          if (nt == 6 || nt == 8) {
            bf16_t* kd = ((nt == 6) ? p.KSC : p.KWC) + (((size_t)(m >> 12) * 2 + wc) * S_LEN + (m & 4095)) * 64;
            *(bf16x8*)(kd + ch * 8) = v;
          } else if (nb0 < NIN) {
            *(bf16x8*)(p.PROJ + (size_t)m * NIN + nb0) = v;
          }
        }
      }
      __syncthreads();
    } else if (MODE == 1) {
#pragma unroll
      for (int mi = 0; mi < 4; mi++) {
        const int m = m0 + 64 * wr + 16 * mi + lr;
#pragma unroll
        for (int ni = 0; ni < 4; ni++) {
          const int n = n0 + 64 * wc + 16 * ni + 4 * lg;
          f32x4 v = acc[ni][mi];
          *(bf16x4*)(p.KMEM + (size_t)m * 512 + n) = pack4(v[0], v[1], v[2], v[3]);
        }
      }
    } else {
#pragma unroll
      for (int mi = 0; mi < 4; mi++) {
        const int m = m0 + 64 * wr + 16 * mi + lr;
        float ss = 0.f;
#pragma unroll
        for (int ni = 0; ni < 4; ni++) {
          const int n = n0 + 64 * wc + 16 * ni + 4 * lg;
          float4 xv = *(const float4*)(p.x + (size_t)m * 1024 + n);
          f32x4 v = acc[ni][mi];
          float4 h; h.x = xv.x + v[0]; h.y = xv.y + v[1]; h.z = xv.z + v[2]; h.w = xv.w + v[3];
          ss += h.x * h.x + h.y * h.y + h.z * h.z + h.w * h.w;
          *(float4*)(p.out + (size_t)m * 1024 + n) = h;
        }
        ss += __shfl_xor(ss, 16); ss += __shfl_xor(ss, 32);
        if (lg == 0) atomicAdd(p.SS_OUT + m, ss);
      }
    }
  } else {
#pragma unroll
    for (int mi = 0; mi < 4; mi++)
#pragma unroll
      for (int ni = 0; ni < 4; ni++) {
        f32x4 v = acc[mi][ni];
        bf16x4 o = pack4(v[0], v[1], v[2], v[3]);
        if (MODE == 0) {
          const int b = m0 >> 12, s = (m0 & 4095) + 64 * wr + 16 * mi + 4 * lg;
          const int d = 16 * ni + lr;
          bf16_t* dst = (nt == 7) ? p.VST : p.VWT;
          *(bf16x4*)(dst + ((size_t)(b * 2 + wc) * 64 + d) * S_LEN + s) = o;
        } else {
          const int b = m0 >> 8, s = (m0 & 255) + 64 * wr + 16 * mi + 4 * lg;
          const int col = n0 - 512 + 64 * wc + 16 * ni + lr;
          const int h = col >> 7, d = col & 127;
          *(bf16x4*)(p.VMEMT + ((size_t)(b * 4 + h) * 128 + d) * 256 + s) = o;
        }
      }
  }
}

template <int MODE>
__device__ void gemm_tile_glds(const Params& p, int mt, int nt, char* smem) {
  const int tid = get_tid(), lane = tid & 63, wave = tid >> 6, lr = lane & 15, lg = lane >> 4;
  const int wr = wave >> 1, wc = wave & 1;
  const int m0 = mt * 128, n0 = nt * 128;
  const bf16_t* A; const bf16_t* Bt; int K;
  if (MODE == 0) { A = p.XB; Bt = p.WinT; K = 1024; }
  else if (MODE == 1) { A = p.MEMB; Bt = p.WkvT; K = 1024; }
  else { A = p.MIX; Bt = p.WoutT; K = 1536; }
  float rs[4] = {1.f, 1.f, 1.f, 1.f};
  if (MODE == 2) {
#pragma unroll
    for (int i = 0; i < 4; i++) {
      const float4* sp = (const float4*)(p.SS_SSD + (size_t)(m0 + (wave * 4 + i) * 8 + (lane >> 3)) * 8);
      float4 a = sp[0], b = sp[1];
      rs[i] = rsqrtf((a.x + a.y + a.z + a.w + b.x + b.y + b.z + b.w) * (1.f / 512.f) + 1e-6f);
    }
  }
  bool swap;
  if (MODE == 0) swap = !(nt == 7 || nt == 9);
  else if (MODE == 1) swap = (nt < 4);
  else swap = true;
  const int rl = lane >> 3, pcx = lane & 7;
  const bf16_t* gA[4]; const bf16_t* gB[4];
#pragma unroll
  for (int q = 0; q < 4; q++) {
    const int row = (wave * 4 + q) * 8 + rl;
    const int c = pcx ^ ((row >> 1) & 7);
    gA[q] = A + (size_t)(m0 + row) * K + c * 8;
    gB[q] = Bt + (size_t)(n0 + row) * K + c * 8;
  }
  char* lbase = smem + wave * 4096 + lane * 16;
  auto stage = [&](int buf, int koff) {
#pragma unroll
    for (int q = 0; q < 4; q++) {
      glds16(gA[q] + koff, lbase + buf * 32768 + q * 1024);
      glds16(gB[q] + koff, lbase + buf * 32768 + 16384 + q * 1024);
    }
  };
  const int fro = (swap ? (16384 + 64 * wc * 128) : (64 * wr * 128)) + lr * 128;
  const int gro = (swap ? (64 * wr * 128) : (16384 + 64 * wc * 128)) + lr * 128;
  const int sw = (lr >> 1) & 7;
  f32x4 acc[4][4];
#pragma unroll
  for (int i = 0; i < 4; i++)
#pragma unroll
    for (int j = 0; j < 4; j++) acc[i][j] = (f32x4){0.f, 0.f, 0.f, 0.f};
  const int nk = K / 64;
  auto kof = [&](int i) { return i * 64; };
  stage(0, kof(0));
  for (int kt = 0; kt < nk; kt++) {
    __syncthreads();
    if (kt + 1 < nk) stage((kt + 1) & 1, kof(kt + 1));
    if (MODE == 2) {
      if (kt >= 8 && kt < 16) {
#pragma unroll
        for (int q = 0; q < 4; q++) {
          bf16x8* cp = (bf16x8*)(lbase + (kt & 1) * 32768 + q * 1024);
          bf16x8 v = *cp;
          *cp = pack8(bfs(v[0]) * rs[q], bfs(v[1]) * rs[q], bfs(v[2]) * rs[q], bfs(v[3]) * rs[q],
                      bfs(v[4]) * rs[q], bfs(v[5]) * rs[q], bfs(v[6]) * rs[q], bfs(v[7]) * rs[q]);
        }
        __syncthreads();
      }
    }
    const char* sb = smem + (kt & 1) * 32768;
#pragma unroll
    for (int ks = 0; ks < 2; ks++) {
      bf16x8 ff[4], gg[4];
      const int co = ((ks * 4 + lg) ^ sw) * 16;
#pragma unroll
      for (int i = 0; i < 4; i++) {
        ff[i] = *(const bf16x8*)(sb + fro + i * 2048 + co);
        gg[i] = *(const bf16x8*)(sb + gro + i * 2048 + co);
      }
#pragma unroll
      for (int i = 0; i < 4; i++)
#pragma unroll
        for (int j = 0; j < 4; j++) acc[i][j] = mfma16(ff[i], gg[j], acc[i][j]);
    }
  }
  __syncthreads();
  if (swap) {
    if (MODE == 0) {
      const bool rope = (nt < 4) || nt == 6 || nt == 8;
#pragma unroll
      for (int mi = 0; mi < 4; mi++) {
        const int m = m0 + 64 * wr + 16 * mi + lr;
        if (rope) {
          const int pos = p.pos[m];
          f32x4 v = acc[0][mi];
          f32x4 o;
#pragma unroll
          for (int i = 0; i < 4; i++) {
            float pr = __shfl_xor(v[i], 32);
            float cs, sn; rope_cs(pos, 4 * (lg & 1) + i, cs, sn);
            o[i] = (lg < 2) ? (v[i] * cs - pr * sn) : (v[i] * cs + pr * sn);
          }
          acc[0][mi] = o;
        }
        {
          bf16_t* stg = (bf16_t*)smem + ((wave & 1) ? 2 * 9216 : 0) + (wave >> 1) * 4608;
#pragma unroll
          for (int ni = 0; ni < 4; ni++) {
            f32x4 v = acc[ni][mi];
            *(bf16x4*)(stg + (16 * mi + lr) * 72 + 16 * ni + 4 * lg) = pack4(v[0], v[1], v[2], v[3]);
          }
        }
      }
      {
        const bf16_t* stg = (const bf16_t*)smem + ((wave & 1) ? 2 * 9216 : 0) + (wave >> 1) * 4608;
        const int rr = lane >> 3, ch = lane & 7;
        const int nb0 = n0 + 64 * wc + ch * 8;
#pragma unroll
        for (int it = 0; it < 8; it++) {
          const int row = it * 8 + rr;
          const int m = m0 + 64 * wr + row;
          bf16x8 v = *(const bf16x8*)(stg + row * 72 + ch * 8);
          if (nt == 6 || nt == 8) {
            bf16_t* kd = ((nt == 6) ? p.KSC : p.KWC) + (((size_t)(m >> 12) * 2 + wc) * S_LEN + (m & 4095)) * 64;
            *(bf16x8*)(kd + ch * 8) = v;
          } else if (nb0 < NIN) {
            *(bf16x8*)(p.PROJ + (size_t)m * NIN + nb0) = v;
          }
        }
      }
      __syncthreads();
    } else if (MODE == 1) {
#pragma unroll
      for (int mi = 0; mi < 4; mi++) {
        const int m = m0 + 64 * wr + 16 * mi + lr;
#pragma unroll
        for (int ni = 0; ni < 4; ni++) {
          const int n = n0 + 64 * wc + 16 * ni + 4 * lg;
          f32x4 v = acc[ni][mi];
          *(bf16x4*)(p.KMEM + (size_t)m * 512 + n) = pack4(v[0], v[1], v[2], v[3]);
        }
      }
    } else {
#pragma unroll
      for (int mi = 0; mi < 4; mi++) {
        const int m = m0 + 64 * wr + 16 * mi + lr;
        float ss = 0.f;
#pragma unroll
        for (int ni = 0; ni < 4; ni++) {
          const int n = n0 + 64 * wc + 16 * ni + 4 * lg;
          float4 xv = *(const float4*)(p.x + (size_t)m * 1024 + n);
          f32x4 v = acc[ni][mi];
          float4 h; h.x = xv.x + v[0]; h.y = xv.y + v[1]; h.z = xv.z + v[2]; h.w = xv.w + v[3];
          ss += h.x * h.x + h.y * h.y + h.z * h.z + h.w * h.w;
          *(float4*)(p.out + (size_t)m * 1024 + n) = h;
        }
        ss += __shfl_xor(ss, 16); ss += __shfl_xor(ss, 32);
        if (lg == 0) atomicAdd(p.SS_OUT + m, ss);
      }
    }
  } else {
#pragma unroll
    for (int mi = 0; mi < 4; mi++)
#pragma unroll
      for (int ni = 0; ni < 4; ni++) {
        f32x4 v = acc[mi][ni];
        bf16x4 o = pack4(v[0], v[1], v[2], v[3]);
        if (MODE == 0) {
          const int b = m0 >> 12, s = (m0 & 4095) + 64 * wr + 16 * mi + 4 * lg;
          const int d = 16 * ni + lr;
          bf16_t* dst = (nt == 7) ? p.VST : p.VWT;
          *(bf16x4*)(dst + ((size_t)(b * 2 + wc) * 64 + d) * S_LEN + s) = o;
        } else {
          const int b = m0 >> 8, s = (m0 & 255) + 64 * wr + 16 * mi + 4 * lg;
          const int col = n0 - 512 + 64 * wc + 16 * ni + lr;
          const int h = col >> 7, d = col & 127;
          *(bf16x4*)(p.VMEMT + ((size_t)(b * 4 + h) * 128 + d) * 256 + s) = o;
        }
      }
  }
}

template <int MODE>
__device__ __forceinline__ void gemm_tile(const Params& p, int mt, int nt, char* smem) {
  gemm_tile_glds<MODE>(p, mt, nt, smem);
}

template <int DQK, int DV, int MASK, typename MaskF>
__device__ __forceinline__ void attn_tile(const bf16_t* sK, const bf16_t* sVt, const bf16x8 (&qf)[2][DQK / 32], f32x4 (&o)[DV / 16][2],
                                          float (&m)[2], float (&l)[2], float c, bool qsel0, bool qsel1, MaskF valid) {
  constexpr int KST = DQK + 8;
  const int lane = get_tid() & 63, lr = lane & 15, lg = lane >> 4;
  f32x4 s[4][2];
#pragma unroll
  for (int kt = 0; kt < 4; kt++) { s[kt][0] = (f32x4){0.f, 0.f, 0.f, 0.f}; s[kt][1] = (f32x4){0.f, 0.f, 0.f, 0.f}; }
#pragma unroll
  for (int ks = 0; ks < DQK / 32; ks++)
#pragma unroll
    for (int kt = 0; kt < 4; kt++) {
      bf16x8 a = *(const bf16x8*)(sK + (16 * kt + lr) * KST + ks * 32 + lg * 8);
      s[kt][0] = mfma16(a, qf[0][ks], s[kt][0]);
      s[kt][1] = mfma16(a, qf[1][ks], s[kt][1]);
    }
#pragma unroll
  for (int qt = 0; qt < 2; qt++) {
    const bool qs = qt ? qsel1 : qsel0;
    float mx = -1e30f;
    if (MASK) {
#pragma unroll
      for (int kt = 0; kt < 4; kt++)
#pragma unroll
        for (int i = 0; i < 4; i++) {
          bool v = valid(16 * kt + 4 * lg + i, qt);
          float sv = v ? s[kt][qt][i] * c : -1e30f;
          s[kt][qt][i] = sv; mx = fmaxf(mx, sv);
        }
    } else {
#pragma unroll
      for (int kt = 0; kt < 4; kt++) mx = fmaxf(fmaxf(mx, fmaxf(s[kt][qt][0], s[kt][qt][1])), fmaxf(s[kt][qt][2], s[kt][qt][3]));
      mx = qs ? mx * c : -1e30f;
    }
    mx = rowmax4(mx);
    const float mn = fmaxf(m[qt], mx);
    const float alpha = fexp2(m[qt] - mn);
    m[qt] = mn;
    float me;
    if (MASK) me = (mn > -1e29f) ? mn : 1e30f; else me = qs ? mn : 1e30f;
    float rs = 0.f;
#pragma unroll
    for (int kt = 0; kt < 4; kt++)
#pragma unroll
      for (int i = 0; i < 4; i++) {
        float pv = MASK ? fexp2(s[kt][qt][i] - me) : fexp2(fmaf(s[kt][qt][i], c, -me));
        s[kt][qt][i] = pv; rs += pv;
      }
    rs = rowsum4(rs);
    l[qt] = l[qt] * alpha + rs;
#pragma unroll
    for (int dt = 0; dt < DV / 16; dt++) {
      o[dt][qt][0] *= alpha; o[dt][qt][1] *= alpha; o[dt][qt][2] *= alpha; o[dt][qt][3] *= alpha;
    }
  }
#pragma unroll
  for (int k2 = 0; k2 < 2; k2++) {
    bf16x8 pb[2];
#pragma unroll
    for (int qt = 0; qt < 2; qt++)
      pb[qt] = pack8(s[2 * k2][qt][0], s[2 * k2][qt][1], s[2 * k2][qt][2], s[2 * k2][qt][3],
                     s[2 * k2 + 1][qt][0], s[2 * k2 + 1][qt][1], s[2 * k2 + 1][qt][2], s[2 * k2 + 1][qt][3]);
#pragma unroll
    for (int dt = 0; dt < DV / 16; dt++) {
      const bf16_t* vp = sVt + (16 * dt + lr) * 72 + 32 * k2 + 4 * lg;
      bf16x8 a = cat44(*(const bf16x4*)vp, *(const bf16x4*)(vp + 16));
      o[dt][0] = mfma16(a, pb[0], o[dt][0]);
      o[dt][1] = mfma16(a, pb[1], o[dt][1]);
    }
  }
}

__device__ __forceinline__ int next_bit_below(unsigned long long m, int below) {
  unsigned long long mm = (below >= 64) ? m : (m & ((1ull << below) - 1ull));
  return mm ? (63 - __clzll((long long)mm)) : -1;
}

__device__ void nsa_item(const Params& p, int item, char* smem) {
  const int tid = get_tid(), lane = tid & 63, wave = tid >> 6, lr = lane & 15, lg = lane >> 4;
  const int bg = item & 15, qb = 127 - (item >> 4);
  const int b = bg >> 1, g = bg & 1;
  const int t0 = qb * 32, cur = t0 >> 6;
  const int hq = g * 4 + wave;
  float* sImp = (float*)(smem + 55296);
  unsigned long long* sSel = (unsigned long long*)(smem + 63616);
  const float c = 0.125f * LOG2E;
  const size_t tokbase = (size_t)b * S_LEN + t0;
  const int r0 = tid >> 3, cc = tid & 7;

  bf16x8 qf[2][2];
#pragma unroll
  for (int qt = 0; qt < 2; qt++) {
    const bf16_t* row = p.PROJ + (tokbase + 16 * qt + lr) * NIN;
#pragma unroll
    for (int ks = 0; ks < 2; ks++) qf[qt][ks] = *(const bf16x8*)(row + C_Q + hq * 64 + 32 * ks + 8 * lg);
  }
  bf16_t* slab = (bf16_t*)(smem + 36864 + wave * 4608);
  auto emit = [&](f32x4 (&o)[4][2], float (&l)[2], int br) {
#pragma unroll
    for (int qt = 0; qt < 2; qt++) {
      const size_t tok = tokbase + 16 * qt + lr;
      const float gsc = sigmoid_f(bf2f(p.PROJ[tok * NIN + C_GL + hq * 3 + br])) / fmaxf(l[qt], 1e-30f);
#pragma unroll
      for (int dt = 0; dt < 4; dt++) {
        bf16_t* dst = slab + (16 * qt + lr) * 72 + 16 * dt + 4 * lg;
        f32x4 r = o[dt][qt];
        r[0] *= gsc; r[1] *= gsc; r[2] *= gsc; r[3] *= gsc;
        if (br > 0) { bf16x4 pv = *(const bf16x4*)dst; r[0] += bfs(pv[0]); r[1] += bfs(pv[1]); r[2] += bfs(pv[2]); r[3] += bfs(pv[3]); }
        *(bf16x4*)dst = pack4(r[0], r[1], r[2], r[3]);
      }
    }
    if (br == 2) {
      const int rr = lane >> 3, ch = lane & 7;
#pragma unroll
      for (int it = 0; it < 4; it++) {
        const int row = it * 8 + rr;
        const size_t tok = tokbase + row;
        const bf16x8 v = *(const bf16x8*)(slab + row * 72 + ch * 8);
        const bf16x8 ga = *(const bf16x8*)(p.PROJ + tok * NIN + C_GA + hq * 64 + ch * 8);
        *(bf16x8*)(p.MIX + tok * 1536 + hq * 64 + ch * 8) =
            pack8(bfs(v[0]) * silu_f(bfs(ga[0])), bfs(v[1]) * silu_f(bfs(ga[1])), bfs(v[2]) * silu_f(bfs(ga[2])), bfs(v[3]) * silu_f(bfs(ga[3])),
                  bfs(v[4]) * silu_f(bfs(ga[4])), bfs(v[5]) * silu_f(bfs(ga[5])), bfs(v[6]) * silu_f(bfs(ga[6])), bfs(v[7]) * silu_f(bfs(ga[7])));
      }
    }
  };
  auto store_kv = [&](int buf, bf16x8 (&rg)[4]) {
    bf16_t* sK = (bf16_t*)(smem + buf * 18432);
    bf16_t* sVt = sK + 64 * 72;
    *(bf16x8*)(sK + r0 * 72 + cc * 8) = rg[0];
    *(bf16x8*)(sK + (r0 + 32) * 72 + cc * 8) = rg[1];
    *(bf16x8*)(sVt + r0 * 72 + cc * 8) = rg[2];
    *(bf16x8*)(sVt + (r0 + 32) * 72 + cc * 8) = rg[3];
  };

  {
    const int ntiles = (t0 >> 10) + 1;
    const bf16_t* kb = p.KCMP + (size_t)bg * 256 * 64;
    const bf16_t* vb = p.VCMPT + (size_t)bg * 64 * 256;
    for (int pass = 0; pass < 2; pass++) {
      f32x4 o[4][2]; float m[2] = {-1e30f, -1e30f}, l[2] = {0.f, 0.f};
#pragma unroll
      for (int dt = 0; dt < 4; dt++) { o[dt][0] = (f32x4){0.f, 0.f, 0.f, 0.f}; o[dt][1] = (f32x4){0.f, 0.f, 0.f, 0.f}; }
      int ldn = 0;
      tile_pipeline<4>(ntiles,
        [&](int i, bf16x8 (&rg)[4]) {
          rg[0] = *(const bf16x8*)(kb + (size_t)(64 * i + r0) * 64 + cc * 8);
          rg[1] = *(const bf16x8*)(kb + (size_t)(64 * i + r0 + 32) * 64 + cc * 8);
          if (pass == 0) {
            rg[2] = *(const bf16x8*)(vb + (size_t)r0 * 256 + 64 * i + cc * 8);
            rg[3] = *(const bf16x8*)(vb + (size_t)(r0 + 32) * 256 + 64 * i + cc * 8);
          }
        },
        [&](int buf, bf16x8 (&rg)[4]) {
          const int nt = ldn++;
          if (pass == 1) {
#pragma unroll
            for (int i2 = 0; i2 < 2; i2++) {
              const int j = r0 + 32 * i2;
              bf16x8 ov;
#pragma unroll
              for (int x = 0; x < 8; x++) { int n = 64 * nt + cc * 8 + x; ov[x] = (n >= 4 * j - 1 && n <= 4 * j + 3) ? (short)0x3F80 : (short)0; }
              rg[2 + i2] = ov;
            }
          }
          store_kv(buf, rg);
        },
        [&](int i, int buf) {
          const bf16_t* sK = (const bf16_t*)(smem + buf * 18432);
          attn_tile<64, 64, 1>(sK, sK + 64 * 72, qf, o, m, l, c, true, true,
                               [&](int key, int qt) { return 16 * (64 * i + key) + 31 <= t0 + 16 * qt + lr; });
        });
      if (pass == 0) {
        emit(o, l, 0);
      } else {
        float inv[2];
#pragma unroll
        for (int qt = 0; qt < 2; qt++) inv[qt] = 1.f / fmaxf(l[qt], 1e-30f);
        for (int e2 = 0; e2 < 4; e2++) {
          if (wave == e2) {
#pragma unroll
            for (int dt = 0; dt < 4; dt++)
#pragma unroll
              for (int qt = 0; qt < 2; qt++)
#pragma unroll
                for (int i = 0; i < 4; i++) {
                  int j = 16 * dt + 4 * lg + i, q = 16 * qt + lr;
                  float v = o[dt][qt][i] * inv[qt];
                  if (e2 == 0) sImp[q * 65 + j] = v; else sImp[q * 65 + j] += v;
                }
          }
          __syncthreads();
        }
      }
    }
  }
  for (int qq = 0; qq < 8; qq++) {
    const int q = wave * 8 + qq;
    const int j = lane;
    float v = sImp[q * 65 + j];
    bool valid = j <= cur;
    bool forced = (j == 0) || (j == cur) || (j == cur - 1);
    float val = forced ? 1e9f : (valid ? v : -1e9f);
    int rank = 0;
#pragma unroll 16
    for (int jj = 0; jj < 64; jj++) {
      float ov = __int_as_float(__builtin_amdgcn_readlane(__float_as_int(val), jj));
      rank += ((ov > val) || (ov == val && jj < j)) ? 1 : 0;
    }
    unsigned long long mask = __ballot((rank < 16) && valid);
    if (lane == 0) sSel[q] = mask;
  }
  __syncthreads();
  unsigned long long any = 0ull;
  for (int q = 0; q < 32; q++) any |= sSel[q];
  unsigned long long mk[2];
  mk[0] = sSel[lr]; mk[1] = sSel[16 + lr];

  {
    f32x4 o[4][2]; float m[2] = {-1e30f, -1e30f}, l[2] = {0.f, 0.f};
#pragma unroll
    for (int dt = 0; dt < 4; dt++) { o[dt][0] = (f32x4){0.f, 0.f, 0.f, 0.f}; o[dt][1] = (f32x4){0.f, 0.f, 0.f, 0.f}; }
    const bf16_t* kb = p.KSC + (size_t)bg * S_LEN * 64;
    const bf16_t* vb = p.VST + (size_t)bg * 64 * S_LEN;
    const int ntiles = __popcll(any);
    int jl = 64, jc = 64;
    tile_pipeline<4>(ntiles,
      [&](int, bf16x8 (&rg)[4]) {
        jl = (jl > 0) ? next_bit_below(any, jl) : -1;
        const int jj = jl < 0 ? 0 : jl;
        rg[0] = *(const bf16x8*)(kb + (size_t)(64 * jj + r0) * 64 + cc * 8);
        rg[1] = *(const bf16x8*)(kb + (size_t)(64 * jj + r0 + 32) * 64 + cc * 8);
        rg[2] = *(const bf16x8*)(vb + (size_t)r0 * S_LEN + 64 * jj + cc * 8);
        rg[3] = *(const bf16x8*)(vb + (size_t)(r0 + 32) * S_LEN + 64 * jj + cc * 8);
      },
      store_kv,
      [&](int, int buf) {
        jc = next_bit_below(any, jc);
        const int j = jc;
        const bf16_t* sK = (const bf16_t*)(smem + buf * 18432);
        if (j == cur) {
          attn_tile<64, 64, 1>(sK, sK + 64 * 72, qf, o, m, l, c, true, true,
                               [&](int key, int qt) { return 64 * j + key <= t0 + 16 * qt + lr; });
        } else {
          attn_tile<64, 64, 0>(sK, sK + 64 * 72, qf, o, m, l, c, ((mk[0] >> j) & 1ull) != 0ull, ((mk[1] >> j) & 1ull) != 0ull,
                               [&](int, int) { return true; });
        }
      });
    emit(o, l, 1);
  }
  {
    f32x4 o[4][2]; float m[2] = {-1e30f, -1e30f}, l[2] = {0.f, 0.f};
#pragma unroll
    for (int dt = 0; dt < 4; dt++) { o[dt][0] = (f32x4){0.f, 0.f, 0.f, 0.f}; o[dt][1] = (f32x4){0.f, 0.f, 0.f, 0.f}; }
    const int jlo = (cur - 8 > 0) ? (cur - 8) : 0;
    const bf16_t* kb = p.KWC + (size_t)bg * S_LEN * 64;
    const bf16_t* vb = p.VWT + (size_t)bg * 64 * S_LEN;
    tile_pipeline<4>(cur - jlo + 1,
      [&](int i, bf16x8 (&rg)[4]) {
        const int j = cur - i;
        rg[0] = *(const bf16x8*)(kb + (size_t)(64 * j + r0) * 64 + cc * 8);
        rg[1] = *(const bf16x8*)(kb + (size_t)(64 * j + r0 + 32) * 64 + cc * 8);
        rg[2] = *(const bf16x8*)(vb + (size_t)r0 * S_LEN + 64 * j + cc * 8);
        rg[3] = *(const bf16x8*)(vb + (size_t)(r0 + 32) * S_LEN + 64 * j + cc * 8);
      },
      store_kv,
      [&](int i, int buf) {
        const int j = cur - i;
        const bf16_t* sK = (const bf16_t*)(smem + buf * 18432);
        if (j == cur || j == cur - 8) {
          attn_tile<64, 64, 1>(sK, sK + 64 * 72, qf, o, m, l, c, true, true, [&](int key, int qt) {
            int tq = t0 + 16 * qt + lr, kp = 64 * j + key;
            return (kp <= tq) && (kp > tq - 512);
          });
        } else {
          attn_tile<64, 64, 0>(sK, sK + 64 * 72, qf, o, m, l, c, true, true, [&](int, int) { return true; });
        }
      });
    emit(o, l, 2);
  }
}

__device__ void memattn_item(const Params& p, int item, char* smem) {
  const int tid = get_tid(), lane = tid & 63, wave = tid >> 6, lr = lane & 15, lg = lane >> 4;
  const int b = item >> 7, h = (item >> 5) & 3, qb = item & 31;
  const int t0 = qb * 128 + wave * 32;
  const size_t tokbase = (size_t)b * S_LEN + t0;
  bf16x8 qf[2][4];
#pragma unroll
  for (int qt = 0; qt < 2; qt++)
#pragma unroll
    for (int ks = 0; ks < 4; ks++) qf[qt][ks] = *(const bf16x8*)(p.PROJ + (tokbase + 16 * qt + lr) * NIN + C_QX + h * 128 + 32 * ks + 8 * lg);
  f32x4 o[8][2]; float m[2] = {-1e30f, -1e30f}, l[2] = {0.f, 0.f};
#pragma unroll
  for (int dt = 0; dt < 8; dt++) { o[dt][0] = (f32x4){0.f, 0.f, 0.f, 0.f}; o[dt][1] = (f32x4){0.f, 0.f, 0.f, 0.f}; }
  const float c = 0.08838834764831845f * LOG2E;
  const bf16_t* kb = p.KMEM + (size_t)b * 256 * 512 + h * 128;
  const bf16_t* vb = p.VMEMT + (size_t)(b * 4 + h) * 128 * 256;
  tile_pipeline1<8>(4,
    [&](int kt, bf16x8 (&rg)[8]) {
#pragma unroll
      for (int i = 0; i < 4; i++) {
        int ch = tid + 256 * i;
        rg[i] = *(const bf16x8*)(kb + (size_t)(64 * kt + (ch >> 4)) * 512 + (ch & 15) * 8);
        rg[4 + i] = *(const bf16x8*)(vb + (size_t)(ch >> 3) * 256 + 64 * kt + (ch & 7) * 8);
      }
    },
    [&](int buf, bf16x8 (&rg)[8]) {
      bf16_t* sK = (bf16_t*)(smem + buf * 35840);
      bf16_t* sVt = sK + 64 * 136;
#pragma unroll
      for (int i = 0; i < 4; i++) {
        int ch = tid + 256 * i;
        *(bf16x8*)(sK + (ch >> 4) * 136 + (ch & 15) * 8) = rg[i];
        *(bf16x8*)(sVt + (ch >> 3) * 72 + (ch & 7) * 8) = rg[4 + i];
      }
    },
    [&](int, int buf) {
      const bf16_t* sK = (const bf16_t*)(smem + buf * 35840);
      attn_tile<128, 128, 0>(sK, sK + 64 * 136, qf, o, m, l, c, true, true, [&](int, int) { return true; });
    });
#pragma unroll
  for (int qt = 0; qt < 2; qt++) {
    const size_t tok = tokbase + 16 * qt + lr;
    const float inv = 1.f / fmaxf(l[qt], 1e-30f);
#pragma unroll
    for (int dt = 0; dt < 8; dt++) {
      const int dbase = h * 128 + 16 * dt + 4 * lg;
      bf16x4 ga = *(const bf16x4*)(p.PROJ + tok * NIN + C_GX + dbase);
      f32x4 r = o[dt][qt];
      *(bf16x4*)(p.MIX + tok * 1536 + 1024 + dbase) =
          pack4(r[0] * inv * silu_f(bfs(ga[0])), r[1] * inv * silu_f(bfs(ga[1])), r[2] * inv * silu_f(bfs(ga[2])), r[3] * inv * silu_f(bfs(ga[3])));
    }
  }
}

__device__ void compress_item(const Params& p, int item, char* smem) {
  const int tid = get_tid(), lane = tid & 63, wave = tid >> 6, lr = lane & 15, lg = lane >> 4;
  const int which = item >> 7, rho0 = (item & 127) * 32;
  const bf16_t* W1T = which ? p.W1vT : p.W1kT;
  const bf16_t* W2T = which ? p.W2vT : p.W2kT;
  const float* pe = which ? p.cpv : p.cpk;
  const int col0 = which ? C_VC : C_KC;
  bf16_t* sA = (bf16_t*)smem;
  bf16_t* sW = sA + 32 * 72;
  bf16_t* sH = sW + 256 * 72;
  const int arow = tid >> 3, akc = tid & 7;
  const bf16_t* abase;
  {
    int rho = rho0 + arow; if (rho > 4079) rho = 4079;
    int b = rho / 510, rem = rho - b * 510, n = rem >> 1, g = rem & 1;
    abase = p.PROJ + ((size_t)b * S_LEN + 16 * n) * NIN + col0 + g * 64 + akc * 8;
  }
  const bf16_t* wbase = W1T + (size_t)arow * 2048 + akc * 8;
  f32x4 acc[2][4];
#pragma unroll
  for (int i = 0; i < 2; i++)
#pragma unroll
    for (int j = 0; j < 4; j++) acc[i][j] = (f32x4){0.f, 0.f, 0.f, 0.f};
  bf16x8 ra, rw[8];
  float4 rp0, rp1;
  auto load = [&](int kt) {
    ra = *(const bf16x8*)(abase + (size_t)kt * NIN);
    rp0 = *(const float4*)(pe + kt * 64 + akc * 8); rp1 = *(const float4*)(pe + kt * 64 + akc * 8 + 4);
#pragma unroll
    for (int i = 0; i < 8; i++) rw[i] = *(const bf16x8*)(wbase + (size_t)(32 * i) * 2048 + kt * 64);
  };
  load(0);
  for (int kt = 0; kt < 32; kt++) {
    __syncthreads();
    *(bf16x8*)(sA + arow * 72 + akc * 8) =
        pack8(bfs(ra[0]) + rp0.x, bfs(ra[1]) + rp0.y, bfs(ra[2]) + rp0.z, bfs(ra[3]) + rp0.w,
              bfs(ra[4]) + rp1.x, bfs(ra[5]) + rp1.y, bfs(ra[6]) + rp1.z, bfs(ra[7]) + rp1.w);
#pragma unroll
    for (int i = 0; i < 8; i++) *(bf16x8*)(sW + (arow + 32 * i) * 72 + akc * 8) = rw[i];
    __syncthreads();
    load(kt < 31 ? kt + 1 : 31);
#pragma unroll
    for (int ks = 0; ks < 2; ks++) {
      bf16x8 a0 = *(const bf16x8*)(sA + lr * 72 + ks * 32 + 8 * lg);
      bf16x8 a1 = *(const bf16x8*)(sA + (16 + lr) * 72 + ks * 32 + 8 * lg);
#pragma unroll
      for (int ct = 0; ct < 4; ct++) {
        bf16x8 bf = *(const bf16x8*)(sW + (64 * wave + 16 * ct + lr) * 72 + ks * 32 + 8 * lg);
        acc[0][ct] = mfma16(a0, bf, acc[0][ct]);
        acc[1][ct] = mfma16(a1, bf, acc[1][ct]);
      }
    }
  }
  __syncthreads();
#pragma unroll
  for (int rt = 0; rt < 2; rt++)
#pragma unroll
    for (int ct = 0; ct < 4; ct++)
#pragma unroll
      for (int i = 0; i < 4; i++) sH[(16 * rt + 4 * lg + i) * 264 + 64 * wave + 16 * ct + lr] = f2bf(silu_f(acc[rt][ct][i]));
  __syncthreads();
  f32x4 acc2[2] = {(f32x4){0.f, 0.f, 0.f, 0.f}, (f32x4){0.f, 0.f, 0.f, 0.f}};
#pragma unroll
  for (int ks = 0; ks < 8; ks++) {
    bf16x8 bf = *(const bf16x8*)(W2T + (size_t)(16 * wave + lr) * 256 + 32 * ks + 8 * lg);
#pragma unroll
    for (int rt = 0; rt < 2; rt++) {
      bf16x8 a = *(const bf16x8*)(sH + (16 * rt + lr) * 264 + 32 * ks + 8 * lg);
      acc2[rt] = mfma16(a, bf, acc2[rt]);
    }
  }
  const int col = 16 * wave + lr;
#pragma unroll
  for (int rt = 0; rt < 2; rt++)
#pragma unroll
    for (int i = 0; i < 4; i++) {
      int rho = rho0 + 16 * rt + 4 * lg + i;
      bool ok = rho < 4080;
      int rc = ok ? rho : 4079;
      int b = rc / 510, rem = rc - b * 510, n = rem >> 1, g = rem & 1;
      float v = acc2[rt][i];
      float pr = __shfl_xor(v, 8);
      if (which == 0) {
        if (wave == 0) {
          int pos = p.pos[b * S_LEN + 16 * n + 31];
          float cs, sn; rope_cs(pos, lr & 7, cs, sn);
          v = (lr < 8) ? (v * cs - pr * sn) : (v * cs + pr * sn);
        }
        if (ok) p.KCMP[((size_t)(b * 2 + g) * 256 + n) * 64 + col] = f2bf(v);
      } else {
        if (ok) p.VCMPT[((size_t)(b * 2 + g) * 64 + col) * 256 + n] = f2bf(v);
      }
    }
}

__device__ void conv_units(const Params& p, int u) {
  const int it = u >> 8, wvi = (u >> 6) & 3, ln = u & 63;
  const int cgp = ((it & 3) * 4 + wvi) * 8 + (ln >> 3), tg = (it >> 2) * 8 + (ln & 7);
  const int tok0 = tg * 8, s0 = tok0 & 4095, ch0 = cgp * 8;
  const int b = tok0 >> 12;
  bf16x8 in[11];
#pragma unroll
  for (int r = 0; r < 11; r++) {
    int s = s0 - 3 + r;
    if (s >= 0) in[r] = *(const bf16x8*)(p.PROJ + (size_t)(tok0 - 3 + r) * NIN + C_XBC + ch0);
    else in[r] = (bf16x8){0, 0, 0, 0, 0, 0, 0, 0};
  }
  float4 wv[4][2];
#pragma unroll
  for (int k = 0; k < 4; k++) { wv[k][0] = *(const float4*)(p.conv_w + k * 1024 + ch0); wv[k][1] = *(const float4*)(p.conv_w + k * 1024 + ch0 + 4); }
  float4 bv0 = *(const float4*)(p.conv_b + ch0), bv1 = *(const float4*)(p.conv_b + ch0 + 4);
  float w[4][8], bias[8];
#pragma unroll
  for (int k = 0; k < 4; k++) { w[k][0] = wv[k][0].x; w[k][1] = wv[k][0].y; w[k][2] = wv[k][0].z; w[k][3] = wv[k][0].w; w[k][4] = wv[k][1].x; w[k][5] = wv[k][1].y; w[k][6] = wv[k][1].z; w[k][7] = wv[k][1].w; }
  bias[0] = bv0.x; bias[1] = bv0.y; bias[2] = bv0.z; bias[3] = bv0.w; bias[4] = bv1.x; bias[5] = bv1.y; bias[6] = bv1.z; bias[7] = bv1.w;
  if (ch0 >= 512) {
#pragma unroll
    for (int tt = 0; tt < 8; tt++) {
      bf16x8 o;
#pragma unroll
      for (int j = 0; j < 8; j++) {
        float a = bias[j];
#pragma unroll
        for (int k = 0; k < 4; k++) a += bfs(in[tt + k][j]) * w[k][j];
        o[j] = (short)f2bf(silu_f(a));
      }
      *(bf16x8*)(p.BC + (size_t)(tok0 + tt) * 512 + (ch0 - 512)) = o;
    }
  }
  if (ch0 < 768) {
#pragma unroll
    for (int j = 0; j < 8; j++) {
      bf16x8 o;
#pragma unroll
      for (int tt = 0; tt < 8; tt++) {
        float a = bias[j];
#pragma unroll
        for (int k = 0; k < 4; k++) a += bfs(in[tt + k][j]) * w[k][j];
        o[tt] = (short)f2bf(silu_f(a));
      }
      const int ch = ch0 + j;
      bf16_t* dst;
      if (ch0 < 512) dst = p.XT + ((size_t)(b * 8 + (ch >> 6)) * 64 + (ch & 63)) * S_LEN + s0;
      else dst = p.BT + ((size_t)(b * 2 + ((ch - 512) >> 7)) * 128 + ((ch - 512) & 127)) * S_LEN + s0;
      *(bf16x8*)dst = o;
    }
  }
}

__device__ void ssd_states_item(const Params& p, int item, char* smem) {
  const int tid = get_tid(), lane = tid & 63, wave = tid >> 6, lr = lane & 15, lg = lane >> 4;
  const int h = item & 7, c = (item >> 3) & 31, b = item >> 8;
  const int g = h >> 2;
  bf16_t* sX = (bf16_t*)smem;
  bf16_t* sBt = sX + 64 * 136;
  float* sAcs = (float*)(smem + (64 + 128) * 136 * 2);
  float* sW = sAcs + 128;
  float* sTot = sW + 128;
  const size_t tok0 = (size_t)b * S_LEN + c * 128;
  const bf16_t* xt = p.XT + (size_t)(b * 8 + h) * 64 * S_LEN + c * 128;
  const bf16_t* bt = p.BT + (size_t)(b * 2 + g) * 128 * S_LEN + c * 128;
  __syncthreads();
  bf16x8 tx[4], tb[8];
#pragma unroll
  for (int i = 0; i < 4; i++) { int ch = tid + 256 * i; tx[i] = *(const bf16x8*)(xt + (size_t)(ch >> 4) * S_LEN + (ch & 15) * 8); }
#pragma unroll
  for (int i = 0; i < 8; i++) { int ch = tid + 256 * i; tb[i] = *(const bf16x8*)(bt + (size_t)(ch >> 4) * S_LEN + (ch & 15) * 8); }
  float dt = 0.f, cs = 0.f;
  if (tid < 128) {
    float raw = bf2f(p.PROJ[(tok0 + tid) * NIN + C_DT + h]) + p.dt_bias[h];
    dt = fmaxf(raw, 0.f) + log1pf(__expf(-fabsf(raw)));
    float a = -__expf(p.a_log[h]);
    cs = dt * a;
#pragma unroll
    for (int o = 1; o < 64; o <<= 1) { float t = __shfl_up(cs, o); if (lane >= o) cs += t; }
    if (lane == 63) sTot[wave] = cs;
  }
  __syncthreads();
  if (tid < 128) {
    if (wave == 1) cs += sTot[0];
    sAcs[tid] = cs;
  }
  __syncthreads();
  if (tid < 128) {
    float last = sAcs[127];
    sW[tid] = dt * __expf(last - cs);
    const size_t o = ((size_t)(b * 32 + c) * 8 + h) * 128 + tid;
    p.ACS[o] = cs; p.DTV[o] = dt;
    if (tid == 0) p.CHDEC[(b * 32 + c) * 8 + h] = __expf(last);
  }
#pragma unroll
  for (int i = 0; i < 8; i++) { int ch = tid + 256 * i; *(bf16x8*)(sBt + (ch >> 4) * 136 + (ch & 15) * 8) = tb[i]; }
  __syncthreads();
#pragma unroll
  for (int i = 0; i < 4; i++) {
    int ch = tid + 256 * i;
    const int l0 = (ch & 15) * 8;
    float4 w0 = *(const float4*)(sW + l0), w1 = *(const float4*)(sW + l0 + 4);
    bf16x8 r = tx[i];
    *(bf16x8*)(sX + (ch >> 4) * 136 + l0) = pack8(bfs(r[0]) * w0.x, bfs(r[1]) * w0.y, bfs(r[2]) * w0.z, bfs(r[3]) * w0.w,
                                                  bfs(r[4]) * w1.x, bfs(r[5]) * w1.y, bfs(r[6]) * w1.z, bfs(r[7]) * w1.w);
  }
  __syncthreads();
  f32x4 acc[4][2];
#pragma unroll
  for (int i = 0; i < 4; i++) { acc[i][0] = (f32x4){0.f, 0.f, 0.f, 0.f}; acc[i][1] = (f32x4){0.f, 0.f, 0.f, 0.f}; }
#pragma unroll
  for (int ks = 0; ks < 4; ks++) {
    const int l0 = 32 * ks + 8 * lg;
    bf16x8 bf0 = *(const bf16x8*)(sBt + (32 * wave + lr) * 136 + l0);
    bf16x8 bf1 = *(const bf16x8*)(sBt + (32 * wave + 16 + lr) * 136 + l0);
#pragma unroll
    for (int pt = 0; pt < 4; pt++) {
      bf16x8 a = *(const bf16x8*)(sX + (16 * pt + lr) * 136 + l0);
      acc[pt][0] = mfma16(a, bf0, acc[pt][0]);
      acc[pt][1] = mfma16(a, bf1, acc[pt][1]);
    }
  }
  float* st = p.STATES + ((size_t)(b * 32 + c) * 8 + h) * 8192;
#pragma unroll
  for (int pt = 0; pt < 4; pt++)
#pragma unroll
    for (int x = 0; x < 2; x++)
#pragma unroll
      for (int i = 0; i < 4; i++) st[(16 * pt + 4 * lg + i) * 128 + 32 * wave + 16 * x + lr] = acc[pt][x][i];
}

__device__ void scan_units(const Params& p, int q) {
  const int b = q >> 16, r = q & 65535, h = r >> 13;
  float hs = 0.f;
  for (int c0 = 0; c0 < 32; c0 += 16) {
    float s[16], d[16];
#pragma unroll
    for (int i = 0; i < 16; i++) { s[i] = p.STATES[(size_t)(b * 32 + c0 + i) * 65536 + r]; d[i] = p.CHDEC[(b * 32 + c0 + i) * 8 + h]; }
#pragma unroll
    for (int i = 0; i < 16; i++) { p.STATES[(size_t)(b * 32 + c0 + i) * 65536 + r] = hs; hs = hs * d[i] + s[i]; }
  }
}

__device__ void ssd_y_item(const Params& p, int item, char* smem) {
  const int tid = get_tid(), lane = tid & 63, wave = tid >> 6, lr = lane & 15, lg = lane >> 4;
  const int h = item & 7, c = (item >> 3) & 31, b = item >> 8;
  const int g = h >> 2;
  bf16_t* sB = (bf16_t*)smem;
  bf16_t* sXT = sB + 128 * 136;
  float* sAcs = (float*)(smem + (128 + 64) * 136 * 2);
  float* sDt = sAcs + 128;
  bf16_t* sPrev = (bf16_t*)(smem + (128 + 64) * 136 * 2 + 1024);
  const size_t tok0 = (size_t)b * S_LEN + c * 128;
  const bf16_t* xt = p.XT + (size_t)(b * 8 + h) * 64 * S_LEN + c * 128;
  const int LT[2] = {wave, 7 - wave};
  const float* prev = p.STATES + ((size_t)(b * 32 + c) * 8 + h) * 8192;
  __syncthreads();
  {
    bf16x8 tb[8], tx[4];
    float4 tp[8];
#pragma unroll
    for (int i = 0; i < 8; i++) { int ch = tid + 256 * i; tp[i] = *(const float4*)(prev + (ch >> 5) * 128 + (ch & 31) * 4); }
#pragma unroll
    for (int i = 0; i < 8; i++) { int ch = tid + 256 * i; tb[i] = *(const bf16x8*)(p.BC + (tok0 + (ch >> 4)) * 512 + g * 128 + (ch & 15) * 8); }
#pragma unroll
    for (int i = 0; i < 4; i++) { int ch = tid + 256 * i; tx[i] = *(const bf16x8*)(xt + (size_t)(ch >> 4) * S_LEN + (ch & 15) * 8); }
    if (tid < 128) {
      const size_t o = ((size_t)(b * 32 + c) * 8 + h) * 128 + tid;
      sAcs[tid] = p.ACS[o]; sDt[tid] = p.DTV[o];
    }
#pragma unroll
    for (int i = 0; i < 8; i++) { int ch = tid + 256 * i; *(bf16x8*)(sB + (ch >> 4) * 136 + (ch & 15) * 8) = tb[i]; }
#pragma unroll
    for (int i = 0; i < 4; i++) { int ch = tid + 256 * i; *(bf16x8*)(sXT + (ch >> 4) * 136 + (ch & 15) * 8) = tx[i]; }
#pragma unroll
    for (int i = 0; i < 8; i++) { int ch = tid + 256 * i; *(bf16x4*)(sPrev + (ch >> 5) * 136 + (ch & 31) * 4) = pack4(tp[i].x, tp[i].y, tp[i].z, tp[i].w); }
  }
  bf16x8 cf[2][4];
  bf16x4 zpre[2][4];
#pragma unroll
  for (int li = 0; li < 2; li++) {
#pragma unroll
    for (int ks = 0; ks < 4; ks++)
      cf[li][ks] = *(const bf16x8*)(p.BC + (tok0 + 16 * LT[li] + lr) * 512 + 256 + g * 128 + 32 * ks + 8 * lg);
#pragma unroll
    for (int pt = 0; pt < 4; pt++)
      zpre[li][pt] = *(const bf16x4*)(p.PROJ + (tok0 + 16 * LT[li] + lr) * NIN + C_Z + h * 64 + 16 * pt + 4 * lg);
  }
  f32x4 acc[4][2];
#pragma unroll
  for (int i = 0; i < 4; i++) { acc[i][0] = (f32x4){0.f, 0.f, 0.f, 0.f}; acc[i][1] = (f32x4){0.f, 0.f, 0.f, 0.f}; }
  __syncthreads();
#pragma unroll
  for (int pt = 0; pt < 4; pt++)
#pragma unroll
    for (int ks = 0; ks < 4; ks++) {
      bf16x8 a = *(const bf16x8*)(sPrev + (16 * pt + lr) * 136 + 32 * ks + 8 * lg);
      acc[pt][0] = mfma16(a, cf[0][ks], acc[pt][0]);
      acc[pt][1] = mfma16(a, cf[1][ks], acc[pt][1]);
    }
#pragma unroll
  for (int li = 0; li < 2; li++) {
    float e = __expf(sAcs[16 * LT[li] + lr]);
#pragma unroll
    for (int pt = 0; pt < 4; pt++) { acc[pt][li][0] *= e; acc[pt][li][1] *= e; acc[pt][li][2] *= e; acc[pt][li][3] *= e; }
  }
#pragma unroll
  for (int li = 0; li < 2; li++) {
    const int lt = LT[li];
    const int lpos = 16 * lt + lr;
    const float acl = sAcs[lpos];
    for (int sp = 0; sp <= (lt >> 1); sp++) {
      f32x4 cb[2] = {(f32x4){0.f, 0.f, 0.f, 0.f}, (f32x4){0.f, 0.f, 0.f, 0.f}};
#pragma unroll
      for (int x = 0; x < 2; x++)
#pragma unroll
        for (int ks = 0; ks < 4; ks++) {
          bf16x8 bfr = *(const bf16x8*)(sB + (32 * sp + 16 * x + lr) * 136 + 32 * ks + 8 * lg);
          cb[x] = mfma16(bfr, cf[li][ks], cb[x]);
        }
      float mv[8];
#pragma unroll
      for (int x = 0; x < 2; x++)
#pragma unroll
        for (int i = 0; i < 4; i++) {
          const int s = 32 * sp + 16 * x + 4 * lg + i;
          mv[4 * x + i] = (s <= lpos) ? cb[x][i] * __expf(acl - sAcs[s]) * sDt[s] : 0.f;
        }
      bf16x8 mb = pack8(mv[0], mv[1], mv[2], mv[3], mv[4], mv[5], mv[6], mv[7]);
#pragma unroll
      for (int pt = 0; pt < 4; pt++) {
        const bf16_t* xp = sXT + (16 * pt + lr) * 136 + 32 * sp + 4 * lg;
        bf16x8 a = cat44(*(const bf16x4*)xp, *(const bf16x4*)(xp + 16));
        acc[pt][li] = mfma16(a, mb, acc[pt][li]);
      }
    }
  }
  const float dsk = p.d_skip[h];
#pragma unroll
  for (int li = 0; li < 2; li++) {
    const int lpos = 16 * LT[li] + lr;
    const size_t tok = tok0 + lpos;
    float ss = 0.f;
#pragma unroll
    for (int pt = 0; pt < 4; pt++) {
      const int pb = 16 * pt + 4 * lg;
      bf16x4 zv = zpre[li][pt];
      float y[4];
#pragma unroll
      for (int i = 0; i < 4; i++) {
        float xv = bf2f(sXT[(pb + i) * 136 + lpos]);
        y[i] = (acc[pt][li][i] + dsk * xv) * silu_f(bfs(zv[i]));
        ss += y[i] * y[i];
      }
      *(bf16x4*)(p.MIX + tok * 1536 + 512 + h * 64 + pb) = pack4(y[0], y[1], y[2], y[3]);
    }
    ss += __shfl_xor(ss, 16); ss += __shfl_xor(ss, 32);
    if (lg == 0) p.SS_SSD[tok * 8 + h] = ss;
  }
}

__device__ void final_rows(const Params& p, int gw, int nw) {
  const int lane = threadIdx.x & 63;
  for (int row = gw; row < T_TOK; row += nw) {
    float r = rsqrtf(p.SS_OUT[row] * (1.f / 1024.f) + 1e-6f);
    float4* o = (float4*)(p.out + (size_t)row * 1024);
    const float4* gf = (const float4*)p.g_final;
#pragma unroll
    for (int i = 0; i < 4; i++) {
      float4 v = o[lane + 64 * i], gg = gf[lane + 64 * i];
      v.x *= r * gg.x; v.y *= r * gg.y; v.z *= r * gg.z; v.w *= r * gg.w;
      o[lane + 64 * i] = v;
    }
  }
}

__device__ __forceinline__ void grid_bar(unsigned* bar, unsigned k) {
  asm volatile("s_waitcnt vmcnt(0)" ::: "memory");
  __syncthreads();
  if (threadIdx.x == 0) {
    const unsigned nb = gridDim.x, r = blockIdx.x & 7u;
    const unsigned nsub = (nb - r + 7u) >> 3;
    const unsigned ngrp = nb < 8u ? nb : 8u;
    __builtin_amdgcn_fence(__ATOMIC_RELEASE, "agent");
    asm volatile("s_waitcnt vmcnt(0)" ::: "memory");
    const unsigned old = __hip_atomic_fetch_add(bar + 64 * r, 1u, __ATOMIC_RELAXED, __HIP_MEMORY_SCOPE_AGENT);
    if (old + 1u == k * nsub) {
      __builtin_amdgcn_fence(__ATOMIC_ACQ_REL, "agent");
      asm volatile("s_waitcnt vmcnt(0)" ::: "memory");
      __hip_atomic_fetch_add(bar + 64 * 8, 1u, __ATOMIC_RELAXED, __HIP_MEMORY_SCOPE_AGENT);
    }
    while (__hip_atomic_load(bar + 64 * 8, __ATOMIC_RELAXED, __HIP_MEMORY_SCOPE_AGENT) < k * ngrp) __builtin_amdgcn_s_sleep(1);
    __builtin_amdgcn_fence(__ATOMIC_ACQUIRE, "agent");
    asm volatile("s_waitcnt vmcnt(0)" ::: "memory");
  }
  __syncthreads();
}

__device__ __forceinline__ int next_item(unsigned* ctr, char* smem) {
  int* sh = (int*)(smem + SMEM_BYTES - 16);
  __syncthreads();
  if (threadIdx.x == 0) *sh = (int)__hip_atomic_fetch_add(ctr, 1u, __ATOMIC_RELAXED, __HIP_MEMORY_SCOPE_AGENT);
  __syncthreads();
  return *sh;
}

__global__ void __launch_bounds__(256, 2) hymba_fwd(Params p) {
  cg::grid_group grid = cg::this_grid();
  __shared__ __attribute__((aligned(16))) char smem[SMEM_BYTES];
  const int nb = gridDim.x, bid = blockIdx.x;
  unsigned bk = 0;

  if (p.out == nullptr) grid.sync();
  for (int rep = 0; rep < REP0; rep++) {
  phase_prep(p);
  grid_bar(p.BAR, ++bk);
  }
  for (int rep = 0; rep < REP1; rep++) {
  if ((nb & 7) == 0) {
    const int xcd = bid & 7, li = bid >> 3, nbx = nb >> 3;
    for (int e = li; e < 1120; e += nbx) {
      const int grp = e / 280, r = e - grp * 280;
      gemm_tile<0>(p, xcd * 32 + grp * 8 + (r & 7), r >> 3, smem);
    }
  } else {
    for (int it = bid; it < 256 * 35; it += nb) gemm_tile<0>(p, it / 35, it % 35, smem);
  }
  for (int j = bid; j < 128; j += nb) gemm_tile<1>(p, j >> 3, j & 7, smem);
  grid_bar(p.BAR, ++bk);
  }
  for (int rep = 0; rep < REP2; rep++) {
  for (int it = next_item(p.BAR + 64 * (9 + rep), smem); it < 256 + 1024 + 2048; it = next_item(p.BAR + 64 * (9 + rep), smem)) {
    if (it < 256) compress_item(p, it, smem);
    else if (it < 1280) memattn_item(p, it - 256, smem);
    else conv_units(p, (it - 1280) * 256 + get_tid());
  }
  grid_bar(p.BAR, ++bk);
  }
  for (int rep = 0; rep < REP3; rep++) {
  {
    const int xq = bid & 7;
    unsigned* ctr = p.BAR + 64 * (16 + xq + 8 * rep);
    for (int li = next_item(ctr, smem); li < 512; li = next_item(ctr, smem)) {
      if (li < 256) nsa_item(p, ((li >> 1) << 4) | (xq + 8 * (li & 1)), smem);
      else ssd_states_item(p, (li - 256) * 8 + xq, smem);
    }
  }
  grid_bar(p.BAR, ++bk);
  }
  for (int it = bid; it < 2048; it += nb) scan_units(p, it * 256 + get_tid());
  grid_bar(p.BAR, ++bk);
  for (int rep = 0; rep < REP5; rep++) {
  for (int it = bid; it < 2048; it += nb) ssd_y_item(p, it, smem);
  grid_bar(p.BAR, ++bk);
  }
  if ((nb & 7) == 0) {
    const int xcd = bid & 7, li = bid >> 3, nbx = nb >> 3;
    for (int e = li; e < 256; e += nbx) gemm_tile<2>(p, xcd * 32 + (e >> 3), e & 7, smem);
  } else {
    for (int it = bid; it < 256 * 8; it += nb) gemm_tile<2>(p, it >> 3, it & 7, smem);
  }
  grid_bar(p.BAR, ++bk);
  final_rows(p, (bid * 256 + threadIdx.x) >> 6, (nb * 256) >> 6);
}

extern "C" void kernel_launch(void* const* d_in, const int* in_sizes, int n_in, void* d_out, int out_size, void* d_ws, size_t ws_size,
                              hipStream_t stream) {
  static int grid_blocks = 0;
  if (!grid_blocks) {
    int dev = 0, cus = 0, per_cu = 0;
    hipGetDevice(&dev);
    hipDeviceGetAttribute(&cus, hipDeviceAttributeMultiprocessorCount, dev);
    hipOccupancyMaxActiveBlocksPerMultiprocessor(&per_cu, hymba_fwd, 256, 0);
    if (per_cu < 1) per_cu = 1;
    if (per_cu > 4) per_cu = 4;
    grid_blocks = cus * per_cu;
  }
  Params p{};
  p.x = (const float*)d_in[0]; p.mem = (const float*)d_in[1]; p.pos = (const int*)d_in[2];
  p.g_in = (const float*)d_in[3]; p.w_in = (const float*)d_in[4]; p.cpk = (const float*)d_in[5];
  p.w1k = (const float*)d_in[6]; p.w2k = (const float*)d_in[7]; p.cpv = (const float*)d_in[8];
  p.w1v = (const float*)d_in[9]; p.w2v = (const float*)d_in[10]; p.conv_w = (const float*)d_in[11];
  p.conv_b = (const float*)d_in[12]; p.dt_bias = (const float*)d_in[13]; p.a_log = (const float*)d_in[14];
  p.d_skip = (const float*)d_in[15]; p.g_ssd = (const float*)d_in[16]; p.g_mem = (const float*)d_in[17];
  p.w_kv = (const float*)d_in[18]; p.w_out = (const float*)d_in[19]; p.g_final = (const float*)d_in[20];
  p.out = (float*)d_out;
  char* w = (char*)d_ws; size_t off = 0;
  auto take = [&](size_t bytes) { char* r = w + off; off += (bytes + 255) & ~(size_t)255; return r; };
  p.WinT = (bf16_t*)take((size_t)NINP * 1024 * 2);
  p.WoutT = (bf16_t*)take((size_t)1024 * 1536 * 2);
  p.WkvT = (bf16_t*)take((size_t)1024 * 1024 * 2);
  p.W1kT = (bf16_t*)take((size_t)256 * 2048 * 2);
  p.W1vT = (bf16_t*)take((size_t)256 * 2048 * 2);
  p.W2kT = (bf16_t*)take((size_t)64 * 256 * 2);
  p.W2vT = (bf16_t*)take((size_t)64 * 256 * 2);
  p.MEMB = (bf16_t*)take((size_t)2048 * 1024 * 2);
  p.PROJ = (bf16_t*)take((size_t)T_TOK * NIN * 2);
  p.VST = (bf16_t*)take((size_t)16 * 64 * S_LEN * 2);
  p.VWT = (bf16_t*)take((size_t)16 * 64 * S_LEN * 2);
  p.KMEM = (bf16_t*)take((size_t)2048 * 512 * 2);
  p.VMEMT = (bf16_t*)take((size_t)32 * 128 * 256 * 2);
  p.KCMP = (bf16_t*)take((size_t)16 * 256 * 64 * 2);
  p.VCMPT = (bf16_t*)take((size_t)16 * 64 * 256 * 2);
  p.XT = (bf16_t*)take((size_t)64 * 64 * S_LEN * 2);
  p.BC = (bf16_t*)take((size_t)T_TOK * 512 * 2);
  p.BT = (bf16_t*)take((size_t)16 * 128 * S_LEN * 2);
  p.MIX = (bf16_t*)take((size_t)T_TOK * 1536 * 2);
  p.XB = p.MIX;
  p.CHDEC = (float*)take((size_t)8 * 32 * 8 * 4);
  p.ACS = (float*)take((size_t)8 * 32 * 8 * 128 * 4);
  p.DTV = (float*)take((size_t)8 * 32 * 8 * 128 * 4);
  p.SS_SSD = (float*)take((size_t)T_TOK * 8 * 4);
  p.SS_OUT = (float*)take((size_t)T_TOK * 4);
  p.BAR = (unsigned*)take((size_t)(64 * 32 + 256) * 4);
  p.MTCNT = p.BAR + 64 * 32;
  p.STATES = (float*)d_out;
  p.KSC = (bf16_t*)((char*)d_out + (size_t)80 * 1024 * 1024);
  p.KWC = p.KSC + (size_t)16 * S_LEN * 64;
  if (off > ws_size) { fprintf(stderr, "workspace too small: need %zu have %zu\n", off, ws_size); return; }
  hipMemsetAsync(p.BAR, 0, (64 * 32 + 256) * 4, stream);
  void* args[] = {&p};
  hipError_t e = hipLaunchCooperativeKernel((void*)hymba_fwd, dim3(grid_blocks), dim3(256), args, 0, stream);
  if (e != hipSuccess) fprintf(stderr, "cooperative launch failed: %s (grid %d)\n", hipGetErrorString(e), grid_blocks);
}
```

```cpp
#include <hip/hip_runtime.h>
#include <hip/hip_cooperative_groups.h>
#include <stdint.h>
#include <stdio.h>
namespace cg = cooperative_groups;

typedef unsigned short bf16_t;
typedef __attribute__((ext_vector_type(8))) short bf16x8;
typedef __attribute__((ext_vector_type(4))) short bf16x4;
typedef __attribute__((ext_vector_type(4))) float f32x4;

#define S_LEN 4096
#define T_TOK 32768
#define NIN 4384
#define NINP 4480
#define LOG2E 1.4426950408889634f

#define C_Q 0
#define C_KC 512
#define C_VC 640
#define C_KS 768
#define C_KW 1024
#define C_GL 1280
#define C_GA 1304
#define C_Z 1816
#define C_XBC 2328
#define C_DT 3352
#define C_QX 3360
#define C_GX 3872

#define SMEM_BYTES 73728
#ifndef REP0
#define REP0 1
#endif
#ifndef REP1
#define REP1 1
#endif
#ifndef REP2
#define REP2 1
#endif
#ifndef REP3
#define REP3 1
#endif
#ifndef REP5
#define REP5 1
#endif

struct Params {
  const float *x, *mem; const int* pos;
  const float *g_in, *w_in, *cpk, *w1k, *w2k, *cpv, *w1v, *w2v, *conv_w, *conv_b, *dt_bias, *a_log, *d_skip, *g_ssd, *g_mem, *w_kv, *w_out, *g_final;
  float* out;
  bf16_t *WinT, *WoutT, *WkvT, *W1kT, *W1vT, *W2kT, *W2vT, *XB, *MEMB, *PROJ, *VST, *VWT, *KMEM, *VMEMT, *KCMP, *VCMPT, *XT, *BC, *BT, *MIX, *KSC, *KWC;
  float *STATES, *CHDEC, *ACS, *DTV, *SS_SSD, *SS_OUT;
  unsigned* BAR;
  unsigned* MTCNT;
};

__device__ __forceinline__ bf16_t f2bf(float f) { uint32_t u = __float_as_uint(f); u += 0x7fffu + ((u >> 16) & 1u); return (bf16_t)(u >> 16); }
__device__ __forceinline__ float bf2f(bf16_t h) { return __uint_as_float(((uint32_t)h) << 16); }
__device__ __forceinline__ float bfs(short h) { return __uint_as_float(((uint32_t)(unsigned short)h) << 16); }
__device__ __forceinline__ float fexp2(float x) { return __builtin_amdgcn_exp2f(x); }
__device__ __forceinline__ float silu_f(float x) { return x * __builtin_amdgcn_rcpf(1.f + __builtin_amdgcn_exp2f(-1.4426950408889634f * x)); }
__device__ __forceinline__ float sigmoid_f(float x) { return __builtin_amdgcn_rcpf(1.f + __builtin_amdgcn_exp2f(-1.4426950408889634f * x)); }
__device__ __forceinline__ f32x4 mfma16(bf16x8 a, bf16x8 b, f32x4 c) { return __builtin_amdgcn_mfma_f32_16x16x32_bf16(a, b, c, 0, 0, 0); }
typedef __bf16 hbf2_t __attribute__((ext_vector_type(2)));
typedef float f2_t __attribute__((ext_vector_type(2)));
typedef uint32_t u32x2 __attribute__((ext_vector_type(2)));
typedef uint32_t u32x4 __attribute__((ext_vector_type(4)));
__device__ __forceinline__ uint32_t pk2(float a, float b) {
  f2_t v; v[0] = a; v[1] = b;
  hbf2_t r = __builtin_convertvector(v, hbf2_t);
  return __builtin_bit_cast(uint32_t, r);
}
__device__ __forceinline__ bf16x4 pack4(float a, float b, float c, float d) {
  u32x2 r; r[0] = pk2(a, b); r[1] = pk2(c, d); return __builtin_bit_cast(bf16x4, r);
}
__device__ __forceinline__ bf16x8 pack8(float a, float b, float c, float d, float e, float f, float g, float h) {
  u32x4 r; r[0] = pk2(a, b); r[1] = pk2(c, d); r[2] = pk2(e, f); r[3] = pk2(g, h); return __builtin_bit_cast(bf16x8, r);
}
__device__ __forceinline__ bf16x8 cat44(bf16x4 a, bf16x4 b) {
  u32x2 x = __builtin_bit_cast(u32x2, a), y = __builtin_bit_cast(u32x2, b);
  u32x4 r; r[0] = x[0]; r[1] = x[1]; r[2] = y[0]; r[3] = y[1]; return __builtin_bit_cast(bf16x8, r);
}
template <int NR, typename L, typename ST, typename C>
__device__ __forceinline__ void tile_pipeline(int n, L load, ST store, C compute) {
  if (n <= 0) return;
  bf16x8 ra[NR], rb[NR];
  const int last = n - 1;
  load(0, ra);
  load(min(1, last), rb);
  store(0, ra);
  load(min(2, last), ra);
  __syncthreads();
  for (int i = 0; i < n; i += 2) {
    compute(i, 0);
    store(1, rb);
    load(min(i + 3, last), rb);
    __syncthreads();
    if (i + 1 < n) compute(i + 1, 1);
    store(0, ra);
    load(min(i + 4, last), ra);
    __syncthreads();
  }
}
template <int NR, typename L, typename ST, typename C>
__device__ __forceinline__ void tile_pipeline1(int n, L load, ST store, C compute) {
  if (n <= 0) return;
  bf16x8 ra[NR];
  load(0, ra);
  store(0, ra);
  if (n > 1) load(1, ra);
  __syncthreads();
  for (int i = 0; i < n; i++) {
    compute(i, i & 1);
    if (i + 1 < n) { store((i + 1) & 1, ra); if (i + 2 < n) load(i + 2, ra); }
    __syncthreads();
  }
}
__device__ __forceinline__ void rope_cs(int pos, int j, float& cs, float& sn) {
  float inv = fexp2(-(float)j * (18.931568569324174f / 8.f));
  float a = (float)pos * inv;
  float n = rintf(a * 0.15915494309189535f);
  float r = fmaf(-n, 6.28125f, a);
  r = fmaf(-n, 1.9353071795864769e-3f, r);
  cs = __cosf(r); sn = __sinf(r);
}

__device__ __forceinline__ float rowmax4(float x) {
  unsigned xi = __float_as_uint(x);
  auto a = __builtin_amdgcn_permlane16_swap(xi, xi, false, false);
  float m = fmaxf(__uint_as_float(a[0]), __uint_as_float(a[1]));
  unsigned mi = __float_as_uint(m);
  auto b = __builtin_amdgcn_permlane32_swap(mi, mi, false, false);
  return fmaxf(__uint_as_float(b[0]), __uint_as_float(b[1]));
}
__device__ __forceinline__ float rowsum4(float x) {
  unsigned xi = __float_as_uint(x);
  auto a = __builtin_amdgcn_permlane16_swap(xi, xi, false, false);
  float m = __uint_as_float(a[0]) + __uint_as_float(a[1]);
  unsigned mi = __float_as_uint(m);
  auto b = __builtin_amdgcn_permlane32_swap(mi, mi, false, false);
  return __uint_as_float(b[0]) + __uint_as_float(b[1]);
}
__device__ __forceinline__ int get_tid() { int t = threadIdx.x; asm volatile("" : "+v"(t)); return t; }

__device__ void prep_rows(const float* __restrict__ x, bf16_t* __restrict__ xb, int nrows, int gw, int nw) {
  const int lane = threadIdx.x & 63;
  int row = gw;
  for (; row + 3 * nw < nrows; row += 4 * nw) {
    float4 v[4][4]; float ss[4];
#pragma unroll
    for (int r = 0; r < 4; r++) {
      const float4* p = (const float4*)(x + (size_t)(row + r * nw) * 1024);
#pragma unroll
      for (int i = 0; i < 4; i++) v[r][i] = p[lane + 64 * i];
    }
#pragma unroll
    for (int r = 0; r < 4; r++) {
      float s = 0.f;
#pragma unroll
      for (int i = 0; i < 4; i++) s += v[r][i].x * v[r][i].x + v[r][i].y * v[r][i].y + v[r][i].z * v[r][i].z + v[r][i].w * v[r][i].w;
#pragma unroll
      for (int o = 32; o >= 1; o >>= 1) s += __shfl_xor(s, o);
      ss[r] = rsqrtf(s * (1.f / 1024.f) + 1e-6f);
    }
#pragma unroll
    for (int r = 0; r < 4; r++)
#pragma unroll
      for (int i = 0; i < 4; i++)
        *(bf16x4*)(xb + (size_t)(row + r * nw) * 1024 + (lane + 64 * i) * 4) =
            pack4(v[r][i].x * ss[r], v[r][i].y * ss[r], v[r][i].z * ss[r], v[r][i].w * ss[r]);
  }
  for (; row < nrows; row += nw) {
    const float4* p = (const float4*)(x + (size_t)row * 1024);
    float4 v[4]; float ss = 0.f;
#pragma unroll
    for (int i = 0; i < 4; i++) { v[i] = p[lane + 64 * i]; ss += v[i].x * v[i].x + v[i].y * v[i].y + v[i].z * v[i].z + v[i].w * v[i].w; }
#pragma unroll
    for (int o = 32; o >= 1; o >>= 1) ss += __shfl_xor(ss, o);
    float r = rsqrtf(ss * (1.f / 1024.f) + 1e-6f);
#pragma unroll
    for (int i = 0; i < 4; i++) {
      bf16x4 o = pack4(v[i].x * r, v[i].y * r, v[i].z * r, v[i].w * r);
      *(bf16x4*)(xb + (size_t)row * 1024 + (lane + 64 * i) * 4) = o;
    }
  }
}

__device__ void prep_wT(const float* __restrict__ w, const float* __restrict__ g, int gk0, int gk1, bf16_t* __restrict__ wt,
                        int K, int N, int Npad, int gtid, int gthreads) {
  const int ln = gtid & 63, gwv = gtid >> 6, nwv = gthreads >> 6;
  const int kblocks = K >> 6;
  const int total = (Npad >> 3) * kblocks;
  for (int uw = gwv; uw < total; uw += nwv) {
    const int kb = uw % kblocks, nbk = uw / kblocks;
    const int n = nbk * 8 + (ln >> 3), k8 = kb * 8 + (ln & 7);
    bf16x8 o;
#pragma unroll
    for (int j = 0; j < 8; j++) {
      int k = k8 * 8 + j; float v = 0.f;
      if (n < N) { v = w[(size_t)k * N + n]; if (g != nullptr && k >= gk0 && k < gk1) v *= g[k - gk0]; }
      o[j] = (short)f2bf(v);
    }
    *(bf16x8*)(wt + (size_t)n * K + k8 * 8) = o;
  }
}

__device__ void phase_prep(const Params& p) {
  const int gtid = blockIdx.x * 256 + threadIdx.x, gthreads = gridDim.x * 256;
  const int gw = gtid >> 6, nw = gthreads >> 6;
  prep_rows(p.x, p.XB, T_TOK, gw, nw);
  prep_rows(p.mem, p.MEMB, 2048, gw, nw);
  prep_wT(p.w_in, p.g_in, 0, 1024, p.WinT, 1024, NIN, NINP, gtid, gthreads);
  prep_wT(p.w_out, p.g_ssd, 512, 1024, p.WoutT, 1536, 1024, 1024, gtid, gthreads);
  prep_wT(p.w_kv, p.g_mem, 0, 1024, p.WkvT, 1024, 1024, 1024, gtid, gthreads);
  prep_wT(p.w1k, nullptr, 0, 0, p.W1kT, 2048, 256, 256, gtid, gthreads);
  prep_wT(p.w1v, nullptr, 0, 0, p.W1vT, 2048, 256, 256, gtid, gthreads);
  prep_wT(p.w2k, nullptr, 0, 0, p.W2kT, 256, 64, 64, gtid, gthreads);
  prep_wT(p.w2v, nullptr, 0, 0, p.W2vT, 256, 64, 64, gtid, gthreads);
  for (int i = gtid; i < T_TOK; i += gthreads) p.SS_OUT[i] = 0.f;
  for (int i = gtid; i < 16 * 64; i += gthreads) {
    int bg = i >> 6, d = i & 63;
    p.KCMP[((size_t)bg * 256 + 255) * 64 + d] = 0;
    p.VCMPT[((size_t)bg * 64 + d) * 256 + 255] = 0;
  }
}

typedef __attribute__((address_space(3))) unsigned lds_u32_t;
typedef __attribute__((address_space(1))) const unsigned glb_u32_t;
__device__ __forceinline__ void glds16(const bf16_t* g, char* l) {
  __builtin_amdgcn_global_load_lds((glb_u32_t*)g, (lds_u32_t*)l, 16, 0, 0);
}
template <int MODE>
__device__ void gemm_tile_reg(const Params& p, int mt, int nt, char* smem) {
  const int tid = get_tid(), lane = tid & 63, wave = tid >> 6, lr = lane & 15, lg = lane >> 4;
  const int wr = wave >> 1, wc = wave & 1;
  const int m0 = mt * 128, n0 = nt * 128;
  const bf16_t* A; const bf16_t* Bt; int K;
  if (MODE == 0) { A = p.XB; Bt = p.WinT; K = 1024; }
  else if (MODE == 1) { A = p.MEMB; Bt = p.WkvT; K = 1024; }
  else { A = p.MIX; Bt = p.WoutT; K = 1536; }
  bf16_t* As = (bf16_t*)smem;
  bf16_t* Bs = As + 2 * 9216;
  const int lrow = tid >> 3, kc = tid & 7;
  const bf16_t* ga = A + (size_t)(m0 + lrow) * K + kc * 8;
  const bf16_t* gb = Bt + (size_t)(n0 + lrow) * K + kc * 8;
  float rs[4] = {1.f, 1.f, 1.f, 1.f};
  if (MODE == 2) {
#pragma unroll
    for (int i = 0; i < 4; i++) {
      const float4* sp = (const float4*)(p.SS_SSD + (size_t)(m0 + lrow + 32 * i) * 8);
      float4 a = sp[0], b = sp[1];
      rs[i] = rsqrtf((a.x + a.y + a.z + a.w + b.x + b.y + b.z + b.w) * (1.f / 512.f) + 1e-6f);
    }
  }
  bool swap;
  if (MODE == 0) swap = !(nt == 7 || nt == 9);
  else if (MODE == 1) swap = (nt < 4);
  else swap = true;
  const bf16_t* F = swap ? (Bs + (64 * wc) * 72) : (As + (64 * wr) * 72);
  const bf16_t* G = swap ? (As + (64 * wr) * 72) : (Bs + (64 * wc) * 72);
  f32x4 acc[4][4];
#pragma unroll
  for (int i = 0; i < 4; i++)
#pragma unroll
    for (int j = 0; j < 4; j++) acc[i][j] = (f32x4){0.f, 0.f, 0.f, 0.f};
  bf16x8 ra0[4], rb0[4], ra1[4], rb1[4];
  const int nk = K / 64;
  auto load = [&](int kt, bf16x8 (&ra)[4], bf16x8 (&rb)[4]) {
#pragma unroll
    for (int i = 0; i < 4; i++) {
      ra[i] = *(const bf16x8*)(ga + (size_t)(32 * i) * K + kt * 64);
      rb[i] = *(const bf16x8*)(gb + (size_t)(32 * i) * K + kt * 64);
    }
  };
  auto store = [&](int buf, int kt, bf16x8 (&ra)[4], bf16x8 (&rb)[4]) {
    if (MODE == 2) {
      if (kt >= 8 && kt < 16) {
#pragma unroll
        for (int i = 0; i < 4; i++) {
          bf16x8 v = ra[i];
          ra[i] = pack8(bfs(v[0]) * rs[i], bfs(v[1]) * rs[i], bfs(v[2]) * rs[i], bfs(v[3]) * rs[i],
                        bfs(v[4]) * rs[i], bfs(v[5]) * rs[i], bfs(v[6]) * rs[i], bfs(v[7]) * rs[i]);
        }
      }
    }
#pragma unroll
    for (int i = 0; i < 4; i++) {
      *(bf16x8*)(As + buf * 9216 + (lrow + 32 * i) * 72 + kc * 8) = ra[i];
      *(bf16x8*)(Bs + buf * 9216 + (lrow + 32 * i) * 72 + kc * 8) = rb[i];
    }
  };
  auto compute = [&](int buf) {
    const int cb = buf * 9216;
#pragma unroll
    for (int ks = 0; ks < 2; ks++) {
      bf16x8 ff[4], gg[4];
#pragma unroll
      for (int i = 0; i < 4; i++) {
        ff[i] = *(const bf16x8*)(F + cb + (16 * i + lr) * 72 + ks * 32 + lg * 8);
        gg[i] = *(const bf16x8*)(G + cb + (16 * i + lr) * 72 + ks * 32 + lg * 8);
      }
#pragma unroll
      for (int i = 0; i < 4; i++)
#pragma unroll
        for (int j = 0; j < 4; j++) acc[i][j] = mfma16(ff[i], gg[j], acc[i][j]);
    }
  };
  const int lastk = nk - 1;
  load(0, ra0, rb0);
  load(1, ra1, rb1);
  store(0, 0, ra0, rb0);
  load(2, ra0, rb0);
  __syncthreads();
  for (int kt = 0; kt < nk; kt += 2) {
    compute(0);
    store(1, kt + 1, ra1, rb1);
    load(min(kt + 3, lastk), ra1, rb1);
    __syncthreads();
    compute(1);
    store(0, min(kt + 2, lastk), ra0, rb0);
    load(min(kt + 4, lastk), ra0, rb0);
    __syncthreads();
  }
  if (swap) {
    if (MODE == 0) {
      const bool rope = (nt < 4) || nt == 6 || nt == 8;
#pragma unroll
      for (int mi = 0; mi < 4; mi++) {
        const int m = m0 + 64 * wr + 16 * mi + lr;
        if (rope) {
          const int pos = p.pos[m];
          f32x4 v = acc[0][mi];
          f32x4 o;
#pragma unroll
          for (int i = 0; i < 4; i++) {
            float pr = __shfl_xor(v[i], 32);
            float cs, sn; rope_cs(pos, 4 * (lg & 1) + i, cs, sn);
            o[i] = (lg < 2) ? (v[i] * cs - pr * sn) : (v[i] * cs + pr * sn);
          }
          acc[0][mi] = o;
        }
        {
          bf16_t* stg = (bf16_t*)smem + ((wave & 1) ? 2 * 9216 : 0) + (wave >> 1) * 4608;
#pragma unroll
          for (int ni = 0; ni < 4; ni++) {
            f32x4 v = acc[ni][mi];
            *(bf16x4*)(stg + (16 * mi + lr) * 72 + 16 * ni + 4 * lg) = pack4(v[0], v[1], v[2], v[3]);
          }
        }
      }
      {
        const bf16_t* stg = (const bf16_t*)smem + ((wave & 1) ? 2 * 9216 : 0) + (wave >> 1) * 4608;
        const int rr = lane >> 3, ch = lane & 7;
        const int nb0 = n0 + 64 * wc + ch * 8;
#pragma unroll
        for (int it = 0; it < 8; it++) {
          const int row = it * 8 + rr;
          const int m = m0 + 64 * wr + row;
          bf16x8 v = *(const bf16x8*)(stg + row * 72 + ch * 8);
          if (nt == 6 || nt == 8) {
            bf16_t* kd = ((nt == 6) ? p.KSC : p.KWC) + (((size_t)(m >> 12) * 2 + wc) * S_LEN + (m & 4095)) * 64;
            *(bf16x8*)(kd + ch * 8) = v;
          } else if (nb0 < NIN) {
            *(bf16x8*)(p.PROJ + (size_t)m * NIN + nb0) = v;
          }
        }
      }
      __syncthreads();
    } else if (MODE == 1) {
#pragma unroll
      for (int mi = 0; mi < 4; mi++) {
        const int m = m0 + 64 * wr + 16 * mi + lr;
#pragma unroll
        for (int ni = 0; ni < 4; ni++) {
          const int n = n0 + 64 * wc + 16 * ni + 4 * lg;
          f32x4 v = acc[ni][mi];
          *(bf16x4*)(p.KMEM + (size_t)m * 512 + n) = pack4(v[0], v[1], v[2], v[3]);
        }
      }
    } else {
#pragma unroll
      for (int mi = 0; mi < 4; mi++) {
        const int m = m0 + 64 * wr + 16 * mi + lr;
        float ss = 0.f;
#pragma unroll
        for (int ni = 0; ni < 4; ni++) {
          const int n = n0 + 64 * wc + 16 * ni + 4 * lg;
          float4 xv = *(const float4*)(p.x + (size_t)m * 1024 + n);
          f32x4 v = acc[ni][mi];
          float4 h; h.x = xv.x + v[0]; h.y = xv.y + v[1]; h.z = xv.z + v[2]; h.w = xv.w + v[3];
          ss += h.x * h.x + h.y * h.y + h.z * h.z + h.w * h.w;
          *(float4*)(p.out + (size_t)m * 1024 + n) = h;
        }
        ss += __shfl_xor(ss, 16); ss += __shfl_xor(ss, 32);
        if (lg == 0) atomicAdd(p.SS_OUT + m, ss);
      }
    }
  } else {
#pragma unroll
    for (int mi = 0; mi < 4; mi++)
#pragma unroll
      for (int ni = 0; ni < 4; ni++) {
        f32x4 v = acc[mi][ni];
        bf16x4 o = pack4(v[0], v[1], v[2], v[3]);
        if (MODE == 0) {
          const int b = m0 >> 12, s = (m0 & 4095) + 64 * wr + 16 * mi + 4 * lg;
          const int d = 16 * ni + lr;
          bf16_t* dst = (nt == 7) ? p.VST : p.VWT;
          *(bf16x4*)(dst + ((size_t)(b * 2 + wc) * 64 + d) * S_LEN + s) = o;
        } else {
          const int b = m0 >> 8, s = (m0 & 255) + 64 * wr + 16 * mi + 4 * lg;
          const int col = n0 - 512 + 64 * wc + 16 * ni + lr;
          const int h = col >> 7, d = col & 127;
          *(bf16x4*)(p.VMEMT + ((size_t)(b * 4 + h) * 128 + d) * 256 + s) = o;
        }
      }
  }
}

template <int MODE>
__device__ void gemm_tile_glds(const Params& p, int mt, int nt, char* smem) {
  const int tid = get_tid(), lane = tid & 63, wave = tid >> 6, lr = lane & 15, lg = lane >> 4;
  const int wr = wave >> 1, wc = wave & 1;
  const int m0 = mt * 128, n0 = nt * 128;
  const bf16_t* A; const bf16_t* Bt; int K;
  if (MODE == 0) { A = p.XB; Bt = p.WinT; K = 1024; }
  else if (MODE == 1) { A = p.MEMB; Bt = p.WkvT; K = 1024; }
  else { A = p.MIX; Bt = p.WoutT; K = 1536; }
  float rs[4] = {1.f, 1.f, 1.f, 1.f};
  if (MODE == 2) {
#pragma unroll
    for (int i = 0; i < 4; i++) {
      const float4* sp = (const float4*)(p.SS_SSD + (size_t)(m0 + (wave * 4 + i) * 8 + (lane >> 3)) * 8);
      float4 a = sp[0], b = sp[1];
      rs[i] = rsqrtf((a.x + a.y + a.z + a.w + b.x + b.y + b.z + b.w) * (1.f / 512.f) + 1e-6f);
    }
  }
  bool swap;
  if (MODE == 0) swap = !(nt == 7 || nt == 9);
  else if (MODE == 1) swap = (nt < 4);
  else swap = true;
  const int rl = lane >> 3, pcx = lane & 7;
  const bf16_t* gA[4]; const bf16_t* gB[4];
#pragma unroll
  for (int q = 0; q < 4; q++) {
    const int row = (wave * 4 + q) * 8 + rl;
    const int c = pcx ^ ((row >> 1) & 7);
    gA[q] = A + (size_t)(m0 + row) * K + c * 8;
    gB[q] = Bt + (size_t)(n0 + row) * K + c * 8;
  }
  char* lbase = smem + wave * 4096 + lane * 16;
  auto stage = [&](int buf, int koff) {
#pragma unroll
    for (int q = 0; q < 4; q++) {
      glds16(gA[q] + koff, lbase + buf * 32768 + q * 1024);
      glds16(gB[q] + koff, lbase + buf * 32768 + 16384 + q * 1024);
    }
  };
  const int fro = (swap ? (16384 + 64 * wc * 128) : (64 * wr * 128)) + lr * 128;
  const int gro = (swap ? (64 * wr * 128) : (16384 + 64 * wc * 128)) + lr * 128;
  const int sw = (lr >> 1) & 7;
  f32x4 acc[4][4];
#pragma unroll
  for (int i = 0; i < 4; i++)
#pragma unroll
    for (int j = 0; j < 4; j++) acc[i][j] = (f32x4){0.f, 0.f, 0.f, 0.f};
  const int nk = K / 64;
  auto kof = [&](int i) { return i * 64; };
  stage(0, kof(0));
  for (int kt = 0; kt < nk; kt++) {
    __syncthreads();
    if (kt + 1 < nk) stage((kt + 1) & 1, kof(kt + 1));
    if (MODE == 2) {
      if (kt >= 8 && kt < 16) {
#pragma unroll
        for (int q = 0; q < 4; q++) {
          bf16x8* cp = (bf16x8*)(lbase + (kt & 1) * 32768 + q * 1024);
          bf16x8 v = *cp;
          *cp = pack8(bfs(v[0]) * rs[q], bfs(v[1]) * rs[q], bfs(v[2]) * rs[q], bfs(v[3]) * rs[q],
                      bfs(v[4]) * rs[q], bfs(v[5]) * rs[q], bfs(v[6]) * rs[q], bfs(v[7]) * rs[q]);
        }
        __syncthreads();
      }
    }
    const char* sb = smem + (kt & 1) * 32768;
#pragma unroll
    for (int ks = 0; ks < 2; ks++) {
      bf16x8 ff[4], gg[4];
      const int co = ((ks * 4 + lg) ^ sw) * 16;
#pragma unroll
      for (int i = 0; i < 4; i++) {
        ff[i] = *(const bf16x8*)(sb + fro + i * 2048 + co);
        gg[i] = *(const bf16x8*)(sb + gro + i * 2048 + co);
      }
#pragma unroll
      for (int i = 0; i < 4; i++)
#pragma unroll
        for (int j = 0; j < 4; j++) acc[i][j] = mfma16(ff[i], gg[j], acc[i][j]);
    }
  }
  __syncthreads();
  if (swap) {
    if (MODE == 0) {
      const bool rope = (nt < 4) || nt == 6 || nt == 8;
#pragma unroll
      for (int mi = 0; mi < 4; mi++) {
        const int m = m0 + 64 * wr + 16 * mi + lr;
        if (rope) {
          const int pos = p.pos[m];
          f32x4 v = acc[0][mi];
          f32x4 o;
#pragma unroll
          for (int i = 0; i < 4; i++) {
            float pr = __shfl_xor(v[i], 32);
            float cs, sn; rope_cs(pos, 4 * (lg & 1) + i, cs, sn);
            o[i] = (lg < 2) ? (v[i] * cs - pr * sn) : (v[i] * cs + pr * sn);
          }
          acc[0][mi] = o;
        }
        {
          bf16_t* stg = (bf16_t*)smem + ((wave & 1) ? 2 * 9216 : 0) + (wave >> 1) * 4608;
#pragma unroll
          for (int ni = 0; ni < 4; ni++) {
            f32x4 v = acc[ni][mi];
            *(bf16x4*)(stg + (16 * mi + lr) * 72 + 16 * ni + 4 * lg) = pack4(v[0], v[1], v[2], v[3]);
          }
        }
      }
      {
        const bf16_t* stg = (const bf16_t*)smem + ((wave & 1) ? 2 * 9216 : 0) + (wave >> 1) * 4608;
        const int rr = lane >> 3, ch = lane & 7;
        const int nb0 = n0 + 64 * wc + ch * 8;
#pragma unroll
        for (int it = 0; it < 8; it++) {
          const int row = it * 8 + rr;
          const int m = m0 + 64 * wr + row;
          bf16x8 v = *(const bf16x8*)(stg + row * 72 + ch * 8);
          if (nt == 6 || nt == 8) {
            bf16_t* kd = ((nt == 6) ? p.KSC : p.KWC) + (((size_t)(m >> 12) * 2 + wc) * S_LEN + (m & 4095)) * 64;
            *(bf16x8*)(kd + ch * 8) = v;
          } else if (nb0 < NIN) {
            *(bf16x8*)(p.PROJ + (size_t)m * NIN + nb0) = v;
          }
        }
      }
      __syncthreads();
    } else if (MODE == 1) {
#pragma unroll
      for (int mi = 0; mi < 4; mi++) {
        const int m = m0 + 64 * wr + 16 * mi + lr;
#pragma unroll
        for (int ni = 0; ni < 4; ni++) {
          const int n = n0 + 64 * wc + 16 * ni + 4 * lg;
          f32x4 v = acc[ni][mi];
          *(bf16x4*)(p.KMEM + (size_t)m * 512 + n) = pack4(v[0], v[1], v[2], v[3]);
        }
      }
    } else {
#pragma unroll
      for (int mi = 0; mi < 4; mi++) {
        const int m = m0 + 64 * wr + 16 * mi + lr;
        float ss = 0.f;
#pragma unroll
        for (int ni = 0; ni < 4; ni++) {
          const int n = n0 + 64 * wc + 16 * ni + 4 * lg;
          float4 xv = *(const float4*)(p.x + (size_t)m * 1024 + n);
          f32x4 v = acc[ni][mi];
          float4 h; h.x = xv.x + v[0]; h.y = xv.y + v[1]; h.z = xv.z + v[2]; h.w = xv.w + v[3];
          ss += h.x * h.x + h.y * h.y + h.z * h.z + h.w * h.w;
          *(float4*)(p.out + (size_t)m * 1024 + n) = h;
        }
        ss += __shfl_xor(ss, 16); ss += __shfl_xor(ss, 32);
        if (lg == 0) atomicAdd(p.SS_OUT + m, ss);
      }
    }
  } else {
#pragma unroll
    for (int mi = 0; mi < 4; mi++)
#pragma unroll
      for (int ni = 0; ni < 4; ni++) {
        f32x4 v = acc[mi][ni];
        bf16x4 o = pack4(v[0], v[1], v[2], v[3]);
        if (MODE == 0) {
          const int b = m0 >> 12, s = (m0 & 4095) + 64 * wr + 16 * mi + 4 * lg;
          const int d = 16 * ni + lr;
          bf16_t* dst = (nt == 7) ? p.VST : p.VWT;
          *(bf16x4*)(dst + ((size_t)(b * 2 + wc) * 64 + d) * S_LEN + s) = o;
        } else {
          const int b = m0 >> 8, s = (m0 & 255) + 64 * wr + 16 * mi + 4 * lg;
          const int col = n0 - 512 + 64 * wc + 16 * ni + lr;
          const int h = col >> 7, d = col & 127;
          *(bf16x4*)(p.VMEMT + ((size_t)(b * 4 + h) * 128 + d) * 256 + s) = o;
        }
      }
  }
}

template <int MODE>
__device__ __forceinline__ void gemm_tile(const Params& p, int mt, int nt, char* smem) {
  gemm_tile_glds<MODE>(p, mt, nt, smem);
}

template <int DQK, int DV, int MASK, typename MaskF>
__device__ __forceinline__ void attn_tile(const bf16_t* sK, const bf16_t* sVt, const bf16x8 (&qf)[2][DQK / 32], f32x4 (&o)[DV / 16][2],
                                          float (&m)[2], float (&l)[2], float c, bool qsel0, bool qsel1, MaskF valid) {
  constexpr int KST = DQK + 8;
  const int lane = get_tid() & 63, lr = lane & 15, lg = lane >> 4;
  f32x4 s[4][2];
#pragma unroll
  for (int kt = 0; kt < 4; kt++) { s[kt][0] = (f32x4){0.f, 0.f, 0.f, 0.f}; s[kt][1] = (f32x4){0.f, 0.f, 0.f, 0.f}; }
#pragma unroll
  for (int ks = 0; ks < DQK / 32; ks++)
#pragma unroll
    for (int kt = 0; kt < 4; kt++) {
      bf16x8 a = *(const bf16x8*)(sK + (16 * kt + lr) * KST + ks * 32 + lg * 8);
      s[kt][0] = mfma16(a, qf[0][ks], s[kt][0]);
      s[kt][1] = mfma16(a, qf[1][ks], s[kt][1]);
    }
#pragma unroll
  for (int qt = 0; qt < 2; qt++) {
    const bool qs = qt ? qsel1 : qsel0;
    float mx = -1e30f;
    if (MASK) {
#pragma unroll
      for (int kt = 0; kt < 4; kt++)
#pragma unroll
        for (int i = 0; i < 4; i++) {
          bool v = valid(16 * kt + 4 * lg + i, qt);
          float sv = v ? s[kt][qt][i] * c : -1e30f;
          s[kt][qt][i] = sv; mx = fmaxf(mx, sv);
        }
    } else {
#pragma unroll
      for (int kt = 0; kt < 4; kt++) mx = fmaxf(fmaxf(mx, fmaxf(s[kt][qt][0], s[kt][qt][1])), fmaxf(s[kt][qt][2], s[kt][qt][3]));
      mx = qs ? mx * c : -1e30f;
    }
    mx = rowmax4(mx);
    const float mn = fmaxf(m[qt], mx);
    const float alpha = fexp2(m[qt] - mn);
    m[qt] = mn;
    float me;
    if (MASK) me = (mn > -1e29f) ? mn : 1e30f; else me = qs ? mn : 1e30f;
    float rs = 0.f;
#pragma unroll
    for (int kt = 0; kt < 4; kt++)
#pragma unroll
      for (int i = 0; i < 4; i++) {
        float pv = MASK ? fexp2(s[kt][qt][i] - me) : fexp2(fmaf(s[kt][qt][i], c, -me));
        s[kt][qt][i] = pv; rs += pv;
      }
    rs = rowsum4(rs);
    l[qt] = l[qt] * alpha + rs;
#pragma unroll
    for (int dt = 0; dt < DV / 16; dt++) {
      o[dt][qt][0] *= alpha; o[dt][qt][1] *= alpha; o[dt][qt][2] *= alpha; o[dt][qt][3] *= alpha;
    }
  }
#pragma unroll
  for (int k2 = 0; k2 < 2; k2++) {
    bf16x8 pb[2];
#pragma unroll
    for (int qt = 0; qt < 2; qt++)
      pb[qt] = pack8(s[2 * k2][qt][0], s[2 * k2][qt][1], s[2 * k2][qt][2], s[2 * k2][qt][3],
                     s[2 * k2 + 1][qt][0], s[2 * k2 + 1][qt][1], s[2 * k2 + 1][qt][2], s[2 * k2 + 1][qt][3]);
#pragma unroll
    for (int dt = 0; dt < DV / 16; dt++) {
      const bf16_t* vp = sVt + (16 * dt + lr) * 72 + 32 * k2 + 4 * lg;
      bf16x8 a = cat44(*(const bf16x4*)vp, *(const bf16x4*)(vp + 16));
      o[dt][0] = mfma16(a, pb[0], o[dt][0]);
      o[dt][1] = mfma16(a, pb[1], o[dt][1]);
    }
  }
}

__device__ __forceinline__ int next_bit_below(unsigned long long m, int below) {
  unsigned long long mm = (below >= 64) ? m : (m & ((1ull << below) - 1ull));
  return mm ? (63 - __clzll((long long)mm)) : -1;
}

__device__ void nsa_item(const Params& p, int item, char* smem) {
  const int tid = get_tid(), lane = tid & 63, wave = tid >> 6, lr = lane & 15, lg = lane >> 4;
  const int bg = item & 15, qb = 127 - (item >> 4);
  const int b = bg >> 1, g = bg & 1;
  const int t0 = qb * 32, cur = t0 >> 6;
  const int hq = g * 4 + wave;
  float* sImp = (float*)(smem + 55296);
  unsigned long long* sSel = (unsigned long long*)(smem + 63616);
  const float c = 0.125f * LOG2E;
  const size_t tokbase = (size_t)b * S_LEN + t0;
  const int r0 = tid >> 3, cc = tid & 7;

  bf16x8 qf[2][2];
#pragma unroll
  for (int qt = 0; qt < 2; qt++) {
    const bf16_t* row = p.PROJ + (tokbase + 16 * qt + lr) * NIN;
#pragma unroll
    for (int ks = 0; ks < 2; ks++) qf[qt][ks] = *(const bf16x8*)(row + C_Q + hq * 64 + 32 * ks + 8 * lg);
  }
  bf16_t* slab = (bf16_t*)(smem + 36864 + wave * 4608);
  auto emit = [&](f32x4 (&o)[4][2], float (&l)[2], int br) {
#pragma unroll
    for (int qt = 0; qt < 2; qt++) {
      const size_t tok = tokbase + 16 * qt + lr;
      const float gsc = sigmoid_f(bf2f(p.PROJ[tok * NIN + C_GL + hq * 3 + br])) / fmaxf(l[qt], 1e-30f);
#pragma unroll
      for (int dt = 0; dt < 4; dt++) {
        bf16_t* dst = slab + (16 * qt + lr) * 72 + 16 * dt + 4 * lg;
        f32x4 r = o[dt][qt];
        r[0] *= gsc; r[1] *= gsc; r[2] *= gsc; r[3] *= gsc;
        if (br > 0) { bf16x4 pv = *(const bf16x4*)dst; r[0] += bfs(pv[0]); r[1] += bfs(pv[1]); r[2] += bfs(pv[2]); r[3] += bfs(pv[3]); }
        *(bf16x4*)dst = pack4(r[0], r[1], r[2], r[3]);
      }
    }
    if (br == 2) {
      const int rr = lane >> 3, ch = lane & 7;
#pragma unroll
      for (int it = 0; it < 4; it++) {
        const int row = it * 8 + rr;
        const size_t tok = tokbase + row;
        const bf16x8 v = *(const bf16x8*)(slab + row * 72 + ch * 8);
        const bf16x8 ga = *(const bf16x8*)(p.PROJ + tok * NIN + C_GA + hq * 64 + ch * 8);
        *(bf16x8*)(p.MIX + tok * 1536 + hq * 64 + ch * 8) =
            pack8(bfs(v[0]) * silu_f(bfs(ga[0])), bfs(v[1]) * silu_f(bfs(ga[1])), bfs(v[2]) * silu_f(bfs(ga[2])), bfs(v[3]) * silu_f(bfs(ga[3])),
                  bfs(v[4]) * silu_f(bfs(ga[4])), bfs(v[5]) * silu_f(bfs(ga[5])), bfs(v[6]) * silu_f(bfs(ga[6])), bfs(v[7]) * silu_f(bfs(ga[7])));
      }
    }
  };
  auto store_kv = [&](int buf, bf16x8 (&rg)[4]) {
    bf16_t* sK = (bf16_t*)(smem + buf * 18432);
    bf16_t* sVt = sK + 64 * 72;
    *(bf16x8*)(sK + r0 * 72 + cc * 8) = rg[0];
    *(bf16x8*)(sK + (r0 + 32) * 72 + cc * 8) = rg[1];
    *(bf16x8*)(sVt + r0 * 72 + cc * 8) = rg[2];
    *(bf16x8*)(sVt + (r0 + 32) * 72 + cc * 8) = rg[3];
  };

  {
    const int ntiles = (t0 >> 10) + 1;
    const bf16_t* kb = p.KCMP + (size_t)bg * 256 * 64;
    const bf16_t* vb = p.VCMPT + (size_t)bg * 64 * 256;
    for (int pass = 0; pass < 2; pass++) {
      f32x4 o[4][2]; float m[2] = {-1e30f, -1e30f}, l[2] = {0.f, 0.f};
#pragma unroll
      for (int dt = 0; dt < 4; dt++) { o[dt][0] = (f32x4){0.f, 0.f, 0.f, 0.f}; o[dt][1] = (f32x4){0.f, 0.f, 0.f, 0.f}; }
      int ldn = 0;
      tile_pipeline<4>(ntiles,
        [&](int i, bf16x8 (&rg)[4]) {
          rg[0] = *(const bf16x8*)(kb + (size_t)(64 * i + r0) * 64 + cc * 8);
          rg[1] = *(const bf16x8*)(kb + (size_t)(64 * i + r0 + 32) * 64 + cc * 8);
          if (pass == 0) {
            rg[2] = *(const bf16x8*)(vb + (size_t)r0 * 256 + 64 * i + cc * 8);
            rg[3] = *(const bf16x8*)(vb + (size_t)(r0 + 32) * 256 + 64 * i + cc * 8);
          }
        },
        [&](int buf, bf16x8 (&rg)[4]) {
          const int nt = ldn++;
          if (pass == 1) {
#pragma unroll
            for (int i2 = 0; i2 < 2; i2++) {
              const int j = r0 + 32 * i2;
              bf16x8 ov;
#pragma unroll
              for (int x = 0; x < 8; x++) { int n = 64 * nt + cc * 8 + x; ov[x] = (n >= 4 * j - 1 && n <= 4 * j + 3) ? (short)0x3F80 : (short)0; }
              rg[2 + i2] = ov;
            }
          }
          store_kv(buf, rg);
        },
        [&](int i, int buf) {
          const bf16_t* sK = (const bf16_t*)(smem + buf * 18432);
          attn_tile<64, 64, 1>(sK, sK + 64 * 72, qf, o, m, l, c, true, true,
                               [&](int key, int qt) { return 16 * (64 * i + key) + 31 <= t0 + 16 * qt + lr; });
        });
      if (pass == 0) {
        emit(o, l, 0);
      } else {
        float inv[2];
#pragma unroll
        for (int qt = 0; qt < 2; qt++) inv[qt] = 1.f / fmaxf(l[qt], 1e-30f);
        for (int e2 = 0; e2 < 4; e2++) {
          if (wave == e2) {
#pragma unroll
            for (int dt = 0; dt < 4; dt++)
#pragma unroll
              for (int qt = 0; qt < 2; qt++)
#pragma unroll
                for (int i = 0; i < 4; i++) {
                  int j = 16 * dt + 4 * lg + i, q = 16 * qt + lr;
                  float v = o[dt][qt][i] * inv[qt];
                  if (e2 == 0) sImp[q * 65 + j] = v; else sImp[q * 65 + j] += v;
                }
          }
          __syncthreads();
        }
      }
    }
  }
  for (int qq = 0; qq < 8; qq++) {
    const int q = wave * 8 + qq;
    const int j = lane;
    float v = sImp[q * 65 + j];
    bool valid = j <= cur;
    bool forced = (j == 0) || (j == cur) || (j == cur - 1);
    float val = forced ? 1e9f : (valid ? v : -1e9f);
    int rank = 0;
#pragma unroll 16
    for (int jj = 0; jj < 64; jj++) {
      float ov = __int_as_float(__builtin_amdgcn_readlane(__float_as_int(val), jj));
      rank += ((ov > val) || (ov == val && jj < j)) ? 1 : 0;
    }
    unsigned long long mask = __ballot((rank < 16) && valid);
    if (lane == 0) sSel[q] = mask;
  }
  __syncthreads();
  unsigned long long any = 0ull;
  for (int q = 0; q < 32; q++) any |= sSel[q];
  unsigned long long mk[2];
  mk[0] = sSel[lr]; mk[1] = sSel[16 + lr];

  {
    f32x4 o[4][2]; float m[2] = {-1e30f, -1e30f}, l[2] = {0.f, 0.f};
#pragma unroll
    for (int dt = 0; dt < 4; dt++) { o[dt][0] = (f32x4){0.f, 0.f, 0.f, 0.f}; o[dt][1] = (f32x4){0.f, 0.f, 0.f, 0.f}; }
    const bf16_t* kb = p.KSC + (size_t)bg * S_LEN * 64;
    const bf16_t* vb = p.VST + (size_t)bg * 64 * S_LEN;
    const int ntiles = __popcll(any);
    int jl = 64, jc = 64;
    tile_pipeline<4>(ntiles,
      [&](int, bf16x8 (&rg)[4]) {
        jl = (jl > 0) ? next_bit_below(any, jl) : -1;
        const int jj = jl < 0 ? 0 : jl;
        rg[0] = *(const bf16x8*)(kb + (size_t)(64 * jj + r0) * 64 + cc * 8);
        rg[1] = *(const bf16x8*)(kb + (size_t)(64 * jj + r0 + 32) * 64 + cc * 8);
        rg[2] = *(const bf16x8*)(vb + (size_t)r0 * S_LEN + 64 * jj + cc * 8);
        rg[3] = *(const bf16x8*)(vb + (size_t)(r0 + 32) * S_LEN + 64 * jj + cc * 8);
      },
      store_kv,
      [&](int, int buf) {
        jc = next_bit_below(any, jc);
        const int j = jc;
        const bf16_t* sK = (const bf16_t*)(smem + buf * 18432);
        if (j == cur) {
          attn_tile<64, 64, 1>(sK, sK + 64 * 72, qf, o, m, l, c, true, true,
                               [&](int key, int qt) { return 64 * j + key <= t0 + 16 * qt + lr; });
        } else {
          attn_tile<64, 64, 0>(sK, sK + 64 * 72, qf, o, m, l, c, ((mk[0] >> j) & 1ull) != 0ull, ((mk[1] >> j) & 1ull) != 0ull,
                               [&](int, int) { return true; });
        }
      });
    emit(o, l, 1);
  }
  {
    f32x4 o[4][2]; float m[2] = {-1e30f, -1e30f}, l[2] = {0.f, 0.f};
#pragma unroll
    for (int dt = 0; dt < 4; dt++) { o[dt][0] = (f32x4){0.f, 0.f, 0.f, 0.f}; o[dt][1] = (f32x4){0.f, 0.f, 0.f, 0.f}; }
    const int jlo = (cur - 8 > 0) ? (cur - 8) : 0;
    const bf16_t* kb = p.KWC + (size_t)bg * S_LEN * 64;
    const bf16_t* vb = p.VWT + (size_t)bg * 64 * S_LEN;
    tile_pipeline<4>(cur - jlo + 1,
      [&](int i, bf16x8 (&rg)[4]) {
        const int j = cur - i;
        rg[0] = *(const bf16x8*)(kb + (size_t)(64 * j + r0) * 64 + cc * 8);
        rg[1] = *(const bf16x8*)(kb + (size_t)(64 * j + r0 + 32) * 64 + cc * 8);
        rg[2] = *(const bf16x8*)(vb + (size_t)r0 * S_LEN + 64 * j + cc * 8);
        rg[3] = *(const bf16x8*)(vb + (size_t)(r0 + 32) * S_LEN + 64 * j + cc * 8);
      },
      store_kv,
      [&](int i, int buf) {
        const int j = cur - i;
        const bf16_t* sK = (const bf16_t*)(smem + buf * 18432);
        if (j == cur || j == cur - 8) {
          attn_tile<64, 64, 1>(sK, sK + 64 * 72, qf, o, m, l, c, true, true, [&](int key, int qt) {
            int tq = t0 + 16 * qt + lr, kp = 64 * j + key;
            return (kp <= tq) && (kp > tq - 512);
          });
        } else {
          attn_tile<64, 64, 0>(sK, sK + 64 * 72, qf, o, m, l, c, true, true, [&](int, int) { return true; });
        }
      });
    emit(o, l, 2);
  }
}

__device__ void memattn_item(const Params& p, int item, char* smem) {
  const int tid = get_tid(), lane = tid & 63, wave = tid >> 6, lr = lane & 15, lg = lane >> 4;
  const int b = item >> 7, h = (item >> 5) & 3, qb = item & 31;
  const int t0 = qb * 128 + wave * 32;
  const size_t tokbase = (size_t)b * S_LEN + t0;
  bf16x8 qf[2][4];
#pragma unroll
  for (int qt = 0; qt < 2; qt++)
#pragma unroll
    for (int ks = 0; ks < 4; ks++) qf[qt][ks] = *(const bf16x8*)(p.PROJ + (tokbase + 16 * qt + lr) * NIN + C_QX + h * 128 + 32 * ks + 8 * lg);
  f32x4 o[8][2]; float m[2] = {-1e30f, -1e30f}, l[2] = {0.f, 0.f};
#pragma unroll
  for (int dt = 0; dt < 8; dt++) { o[dt][0] = (f32x4){0.f, 0.f, 0.f, 0.f}; o[dt][1] = (f32x4){0.f, 0.f, 0.f, 0.f}; }
  const float c = 0.08838834764831845f * LOG2E;
  const bf16_t* kb = p.KMEM + (size_t)b * 256 * 512 + h * 128;
  const bf16_t* vb = p.VMEMT + (size_t)(b * 4 + h) * 128 * 256;
  tile_pipeline1<8>(4,
    [&](int kt, bf16x8 (&rg)[8]) {
#pragma unroll
      for (int i = 0; i < 4; i++) {
        int ch = tid + 256 * i;
        rg[i] = *(const bf16x8*)(kb + (size_t)(64 * kt + (ch >> 4)) * 512 + (ch & 15) * 8);
        rg[4 + i] = *(const bf16x8*)(vb + (size_t)(ch >> 3) * 256 + 64 * kt + (ch & 7) * 8);
      }
    },
    [&](int buf, bf16x8 (&rg)[8]) {
      bf16_t* sK = (bf16_t*)(smem + buf * 35840);
      bf16_t* sVt = sK + 64 * 136;
#pragma unroll
      for (int i = 0; i < 4; i++) {
        int ch = tid + 256 * i;
        *(bf16x8*)(sK + (ch >> 4) * 136 + (ch & 15) * 8) = rg[i];
        *(bf16x8*)(sVt + (ch >> 3) * 72 + (ch & 7) * 8) = rg[4 + i];
      }
    },
    [&](int, int buf) {
      const bf16_t* sK = (const bf16_t*)(smem + buf * 35840);
      attn_tile<128, 128, 0>(sK, sK + 64 * 136, qf, o, m, l, c, true, true, [&](int, int) { return true; });
    });
#pragma unroll
  for (int qt = 0; qt < 2; qt++) {
    const size_t tok = tokbase + 16 * qt + lr;
    const float inv = 1.f / fmaxf(l[qt], 1e-30f);
#pragma unroll
    for (int dt = 0; dt < 8; dt++) {
      const int dbase = h * 128 + 16 * dt + 4 * lg;
      bf16x4 ga = *(const bf16x4*)(p.PROJ + tok * NIN + C_GX + dbase);
      f32x4 r = o[dt][qt];
      *(bf16x4*)(p.MIX + tok * 1536 + 1024 + dbase) =
          pack4(r[0] * inv * silu_f(bfs(ga[0])), r[1] * inv * silu_f(bfs(ga[1])), r[2] * inv * silu_f(bfs(ga[2])), r[3] * inv * silu_f(bfs(ga[3])));
    }
  }
}

__device__ void compress_item(const Params& p, int item, char* smem) {
  const int tid = get_tid(), lane = tid & 63, wave = tid >> 6, lr = lane & 15, lg = lane >> 4;
  const int which = item >> 7, rho0 = (item & 127) * 32;
  const bf16_t* W1T = which ? p.W1vT : p.W1kT;
  const bf16_t* W2T = which ? p.W2vT : p.W2kT;
  const float* pe = which ? p.cpv : p.cpk;
  const int col0 = which ? C_VC : C_KC;
  bf16_t* sA = (bf16_t*)smem;
  bf16_t* sW = sA + 32 * 72;
  bf16_t* sH = sW + 256 * 72;
  const int arow = tid >> 3, akc = tid & 7;
  const bf16_t* abase;
  {
    int rho = rho0 + arow; if (rho > 4079) rho = 4079;
    int b = rho / 510, rem = rho - b * 510, n = rem >> 1, g = rem & 1;
    abase = p.PROJ + ((size_t)b * S_LEN + 16 * n) * NIN + col0 + g * 64 + akc * 8;
  }
  const bf16_t* wbase = W1T + (size_t)arow * 2048 + akc * 8;
  f32x4 acc[2][4];
#pragma unroll
  for (int i = 0; i < 2; i++)
#pragma unroll
    for (int j = 0; j < 4; j++) acc[i][j] = (f32x4){0.f, 0.f, 0.f, 0.f};
  bf16x8 ra, rw[8];
  float4 rp0, rp1;
  auto load = [&](int kt) {
    ra = *(const bf16x8*)(abase + (size_t)kt * NIN);
    rp0 = *(const float4*)(pe + kt * 64 + akc * 8); rp1 = *(const float4*)(pe + kt * 64 + akc * 8 + 4);
#pragma unroll
    for (int i = 0; i < 8; i++) rw[i] = *(const bf16x8*)(wbase + (size_t)(32 * i) * 2048 + kt * 64);
  };
  load(0);
  for (int kt = 0; kt < 32; kt++) {
    __syncthreads();
    *(bf16x8*)(sA + arow * 72 + akc * 8) =
        pack8(bfs(ra[0]) + rp0.x, bfs(ra[1]) + rp0.y, bfs(ra[2]) + rp0.z, bfs(ra[3]) + rp0.w,
              bfs(ra[4]) + rp1.x, bfs(ra[5]) + rp1.y, bfs(ra[6]) + rp1.z, bfs(ra[7]) + rp1.w);
#pragma unroll
    for (int i = 0; i < 8; i++) *(bf16x8*)(sW + (arow + 32 * i) * 72 + akc * 8) = rw[i];
    __syncthreads();
    load(kt < 31 ? kt + 1 : 31);
#pragma unroll
    for (int ks = 0; ks < 2; ks++) {
      bf16x8 a0 = *(const bf16x8*)(sA + lr * 72 + ks * 32 + 8 * lg);
      bf16x8 a1 = *(const bf16x8*)(sA + (16 + lr) * 72 + ks * 32 + 8 * lg);
#pragma unroll
      for (int ct = 0; ct < 4; ct++) {
        bf16x8 bf = *(const bf16x8*)(sW + (64 * wave + 16 * ct + lr) * 72 + ks * 32 + 8 * lg);
        acc[0][ct] = mfma16(a0, bf, acc[0][ct]);
        acc[1][ct] = mfma16(a1, bf, acc[1][ct]);
      }
    }
  }
  __syncthreads();
#pragma unroll
  for (int rt = 0; rt < 2; rt++)
#pragma unroll
    for (int ct = 0; ct < 4; ct++)
#pragma unroll
      for (int i = 0; i < 4; i++) sH[(16 * rt + 4 * lg + i) * 264 + 64 * wave + 16 * ct + lr] = f2bf(silu_f(acc[rt][ct][i]));
  __syncthreads();
  f32x4 acc2[2] = {(f32x4){0.f, 0.f, 0.f, 0.f}, (f32x4){0.f, 0.f, 0.f, 0.f}};
#pragma unroll
  for (int ks = 0; ks < 8; ks++) {
    bf16x8 bf = *(const bf16x8*)(W2T + (size_t)(16 * wave + lr) * 256 + 32 * ks + 8 * lg);
#pragma unroll
    for (int rt = 0; rt < 2; rt++) {
      bf16x8 a = *(const bf16x8*)(sH + (16 * rt + lr) * 264 + 32 * ks + 8 * lg);
      acc2[rt] = mfma16(a, bf, acc2[rt]);
    }
  }
  const int col = 16 * wave + lr;
#pragma unroll
  for (int rt = 0; rt < 2; rt++)
#pragma unroll
    for (int i = 0; i < 4; i++) {
      int rho = rho0 + 16 * rt + 4 * lg + i;
      bool ok = rho < 4080;
      int rc = ok ? rho : 4079;
      int b = rc / 510, rem = rc - b * 510, n = rem >> 1, g = rem & 1;
      float v = acc2[rt][i];
      float pr = __shfl_xor(v, 8);
      if (which == 0) {
        if (wave == 0) {
          int pos = p.pos[b * S_LEN + 16 * n + 31];
          float cs, sn; rope_cs(pos, lr & 7, cs, sn);
          v = (lr < 8) ? (v * cs - pr * sn) : (v * cs + pr * sn);
        }
        if (ok) p.KCMP[((size_t)(b * 2 + g) * 256 + n) * 64 + col] = f2bf(v);
      } else {
        if (ok) p.VCMPT[((size_t)(b * 2 + g) * 64 + col) * 256 + n] = f2bf(v);
      }
    }
}

__device__ void conv_units(const Params& p, int u) {
  const int it = u >> 8, wvi = (u >> 6) & 3, ln = u & 63;
  const int cgp = ((it & 3) * 4 + wvi) * 8 + (ln >> 3), tg = (it >> 2) * 8 + (ln & 7);
  const int tok0 = tg * 8, s0 = tok0 & 4095, ch0 = cgp * 8;
  const int b = tok0 >> 12;
  bf16x8 in[11];
#pragma unroll
  for (int r = 0; r < 11; r++) {
    int s = s0 - 3 + r;
    if (s >= 0) in[r] = *(const bf16x8*)(p.PROJ + (size_t)(tok0 - 3 + r) * NIN + C_XBC + ch0);
    else in[r] = (bf16x8){0, 0, 0, 0, 0, 0, 0, 0};
  }
  float4 wv[4][2];
#pragma unroll
  for (int k = 0; k < 4; k++) { wv[k][0] = *(const float4*)(p.conv_w + k * 1024 + ch0); wv[k][1] = *(const float4*)(p.conv_w + k * 1024 + ch0 + 4); }
  float4 bv0 = *(const float4*)(p.conv_b + ch0), bv1 = *(const float4*)(p.conv_b + ch0 + 4);
  float w[4][8], bias[8];
#pragma unroll
  for (int k = 0; k < 4; k++) { w[k][0] = wv[k][0].x; w[k][1] = wv[k][0].y; w[k][2] = wv[k][0].z; w[k][3] = wv[k][0].w; w[k][4] = wv[k][1].x; w[k][5] = wv[k][1].y; w[k][6] = wv[k][1].z; w[k][7] = wv[k][1].w; }
  bias[0] = bv0.x; bias[1] = bv0.y; bias[2] = bv0.z; bias[3] = bv0.w; bias[4] = bv1.x; bias[5] = bv1.y; bias[6] = bv1.z; bias[7] = bv1.w;
  if (ch0 >= 512) {
#pragma unroll
    for (int tt = 0; tt < 8; tt++) {
      bf16x8 o;
#pragma unroll
      for (int j = 0; j < 8; j++) {
        float a = bias[j];
#pragma unroll
        for (int k = 0; k < 4; k++) a += bfs(in[tt + k][j]) * w[k][j];
        o[j] = (short)f2bf(silu_f(a));
      }
      *(bf16x8*)(p.BC + (size_t)(tok0 + tt) * 512 + (ch0 - 512)) = o;
    }
  }
  if (ch0 < 768) {
#pragma unroll
    for (int j = 0; j < 8; j++) {
      bf16x8 o;
#pragma unroll
      for (int tt = 0; tt < 8; tt++) {
        float a = bias[j];
#pragma unroll
        for (int k = 0; k < 4; k++) a += bfs(in[tt + k][j]) * w[k][j];
        o[tt] = (short)f2bf(silu_f(a));
      }
      const int ch = ch0 + j;
      bf16_t* dst;
      if (ch0 < 512) dst = p.XT + ((size_t)(b * 8 + (ch >> 6)) * 64 + (ch & 63)) * S_LEN + s0;
      else dst = p.BT + ((size_t)(b * 2 + ((ch - 512) >> 7)) * 128 + ((ch - 512) & 127)) * S_LEN + s0;
      *(bf16x8*)dst = o;
    }
  }
}

__device__ void ssd_states_item(const Params& p, int item, char* smem) {
  const int tid = get_tid(), lane = tid & 63, wave = tid >> 6, lr = lane & 15, lg = lane >> 4;
  const int h = item & 7, c = (item >> 3) & 31, b = item >> 8;
  const int g = h >> 2;
  bf16_t* sX = (bf16_t*)smem;
  bf16_t* sBt = sX + 64 * 136;
  float* sAcs = (float*)(smem + (64 + 128) * 136 * 2);
  float* sW = sAcs + 128;
  float* sTot = sW + 128;
  const size_t tok0 = (size_t)b * S_LEN + c * 128;
  const bf16_t* xt = p.XT + (size_t)(b * 8 + h) * 64 * S_LEN + c * 128;
  const bf16_t* bt = p.BT + (size_t)(b * 2 + g) * 128 * S_LEN + c * 128;
  __syncthreads();
  bf16x8 tx[4], tb[8];
#pragma unroll
  for (int i = 0; i < 4; i++) { int ch = tid + 256 * i; tx[i] = *(const bf16x8*)(xt + (size_t)(ch >> 4) * S_LEN + (ch & 15) * 8); }
#pragma unroll
  for (int i = 0; i < 8; i++) { int ch = tid + 256 * i; tb[i] = *(const bf16x8*)(bt + (size_t)(ch >> 4) * S_LEN + (ch & 15) * 8); }
  float dt = 0.f, cs = 0.f;
  if (tid < 128) {
    float raw = bf2f(p.PROJ[(tok0 + tid) * NIN + C_DT + h]) + p.dt_bias[h];
    dt = fmaxf(raw, 0.f) + log1pf(__expf(-fabsf(raw)));
    float a = -__expf(p.a_log[h]);
    cs = dt * a;
#pragma unroll
    for (int o = 1; o < 64; o <<= 1) { float t = __shfl_up(cs, o); if (lane >= o) cs += t; }
    if (lane == 63) sTot[wave] = cs;
  }
  __syncthreads();
  if (tid < 128) {
    if (wave == 1) cs += sTot[0];
    sAcs[tid] = cs;
  }
  __syncthreads();
  if (tid < 128) {
    float last = sAcs[127];
    sW[tid] = dt * __expf(last - cs);
    const size_t o = ((size_t)(b * 32 + c) * 8 + h) * 128 + tid;
    p.ACS[o] = cs; p.DTV[o] = dt;
    if (tid == 0) p.CHDEC[(b * 32 + c) * 8 + h] = __expf(last);
  }
#pragma unroll
  for (int i = 0; i < 8; i++) { int ch = tid + 256 * i; *(bf16x8*)(sBt + (ch >> 4) * 136 + (ch & 15) * 8) = tb[i]; }
  __syncthreads();
#pragma unroll
  for (int i = 0; i < 4; i++) {
    int ch = tid + 256 * i;
    const int l0 = (ch & 15) * 8;
    float4 w0 = *(const float4*)(sW + l0), w1 = *(const float4*)(sW + l0 + 4);
    bf16x8 r = tx[i];
    *(bf16x8*)(sX + (ch >> 4) * 136 + l0) = pack8(bfs(r[0]) * w0.x, bfs(r[1]) * w0.y, bfs(r[2]) * w0.z, bfs(r[3]) * w0.w,
                                                  bfs(r[4]) * w1.x, bfs(r[5]) * w1.y, bfs(r[6]) * w1.z, bfs(r[7]) * w1.w);
  }
  __syncthreads();
  f32x4 acc[4][2];
#pragma unroll
  for (int i = 0; i < 4; i++) { acc[i][0] = (f32x4){0.f, 0.f, 0.f, 0.f}; acc[i][1] = (f32x4){0.f, 0.f, 0.f, 0.f}; }
#pragma unroll
  for (int ks = 0; ks < 4; ks++) {
    const int l0 = 32 * ks + 8 * lg;
    bf16x8 bf0 = *(const bf16x8*)(sBt + (32 * wave + lr) * 136 + l0);
    bf16x8 bf1 = *(const bf16x8*)(sBt + (32 * wave + 16 + lr) * 136 + l0);
#pragma unroll
    for (int pt = 0; pt < 4; pt++) {
      bf16x8 a = *(const bf16x8*)(sX + (16 * pt + lr) * 136 + l0);
      acc[pt][0] = mfma16(a, bf0, acc[pt][0]);
      acc[pt][1] = mfma16(a, bf1, acc[pt][1]);
    }
  }
  bf16_t* st = (bf16_t*)p.STATES + ((size_t)(b * 32 + c) * 8 + h) * 8192;
#pragma unroll
  for (int pt = 0; pt < 4; pt++)
#pragma unroll
    for (int x = 0; x < 2; x++)
#pragma unroll
      for (int i = 0; i < 4; i++) st[(16 * pt + 4 * lg + i) * 128 + 32 * wave + 16 * x + lr] = f2bf(acc[pt][x][i]);
}

__device__ void scan_units(const Params& p, int q) {
  const int b = q >> 15, r2 = q & 32767, h = r2 >> 12;
  uint32_t* sw = (uint32_t*)p.STATES;
  float h0 = 0.f, h1 = 0.f;
  for (int c0 = 0; c0 < 32; c0 += 16) {
    uint32_t s[16]; float d[16];
#pragma unroll
    for (int i = 0; i < 16; i++) { s[i] = sw[(size_t)(b * 32 + c0 + i) * 32768 + r2]; d[i] = p.CHDEC[(b * 32 + c0 + i) * 8 + h]; }
#pragma unroll
    for (int i = 0; i < 16; i++) {
      sw[(size_t)(b * 32 + c0 + i) * 32768 + r2] = pk2(h0, h1);
      h0 = h0 * d[i] + __uint_as_float(s[i] << 16);
      h1 = h1 * d[i] + __uint_as_float(s[i] & 0xffff0000u);
    }
  }
}

__device__ void ssd_y_item(const Params& p, int item, char* smem) {
  const int tid = get_tid(), lane = tid & 63, wave = tid >> 6, lr = lane & 15, lg = lane >> 4;
  const int h = item & 7, c = (item >> 3) & 31, b = item >> 8;
  const int g = h >> 2;
  bf16_t* sB = (bf16_t*)smem;
  bf16_t* sXT = sB + 128 * 136;
  float* sAcs = (float*)(smem + (128 + 64) * 136 * 2);
  float* sDt = sAcs + 128;
  bf16_t* sPrev = (bf16_t*)(smem + (128 + 64) * 136 * 2 + 1024);
  const size_t tok0 = (size_t)b * S_LEN + c * 128;
  const bf16_t* xt = p.XT + (size_t)(b * 8 + h) * 64 * S_LEN + c * 128;
  const int LT[2] = {wave, 7 - wave};
  const bf16_t* prev = (const bf16_t*)p.STATES + ((size_t)(b * 32 + c) * 8 + h) * 8192;
  __syncthreads();
  {
    bf16x8 tb[8], tx[4];
    bf16x8 tp[4];
#pragma unroll
    for (int i = 0; i < 4; i++) { int ch = tid + 256 * i; tp[i] = *(const bf16x8*)(prev + (ch >> 4) * 128 + (ch & 15) * 8); }
#pragma unroll
    for (int i = 0; i < 8; i++) { int ch = tid + 256 * i; tb[i] = *(const bf16x8*)(p.BC + (tok0 + (ch >> 4)) * 512 + g * 128 + (ch & 15) * 8); }
#pragma unroll
    for (int i = 0; i < 4; i++) { int ch = tid + 256 * i; tx[i] = *(const bf16x8*)(xt + (size_t)(ch >> 4) * S_LEN + (ch & 15) * 8); }
    if (tid < 128) {
      const size_t o = ((size_t)(b * 32 + c) * 8 + h) * 128 + tid;
      sAcs[tid] = p.ACS[o]; sDt[tid] = p.DTV[o];
    }
#pragma unroll
    for (int i = 0; i < 8; i++) { int ch = tid + 256 * i; *(bf16x8*)(sB + (ch >> 4) * 136 + (ch & 15) * 8) = tb[i]; }
#pragma unroll
    for (int i = 0; i < 4; i++) { int ch = tid + 256 * i; *(bf16x8*)(sXT + (ch >> 4) * 136 + (ch & 15) * 8) = tx[i]; }
#pragma unroll
    for (int i = 0; i < 4; i++) { int ch = tid + 256 * i; *(bf16x8*)(sPrev + (ch >> 4) * 136 + (ch & 15) * 8) = tp[i]; }
  }
  bf16x8 cf[2][4];
  bf16x4 zpre[2][4];
#pragma unroll
  for (int li = 0; li < 2; li++) {
#pragma unroll
    for (int ks = 0; ks < 4; ks++)
      cf[li][ks] = *(const bf16x8*)(p.BC + (tok0 + 16 * LT[li] + lr) * 512 + 256 + g * 128 + 32 * ks + 8 * lg);
#pragma unroll
    for (int pt = 0; pt < 4; pt++)
      zpre[li][pt] = *(const bf16x4*)(p.PROJ + (tok0 + 16 * LT[li] + lr) * NIN + C_Z + h * 64 + 16 * pt + 4 * lg);
  }
  f32x4 acc[4][2];
#pragma unroll
  for (int i = 0; i < 4; i++) { acc[i][0] = (f32x4){0.f, 0.f, 0.f, 0.f}; acc[i][1] = (f32x4){0.f, 0.f, 0.f, 0.f}; }
  __syncthreads();
#pragma unroll
  for (int pt = 0; pt < 4; pt++)
#pragma unroll
    for (int ks = 0; ks < 4; ks++) {
      bf16x8 a = *(const bf16x8*)(sPrev + (16 * pt + lr) * 136 + 32 * ks + 8 * lg);
      acc[pt][0] = mfma16(a, cf[0][ks], acc[pt][0]);
      acc[pt][1] = mfma16(a, cf[1][ks], acc[pt][1]);
    }
#pragma unroll
  for (int li = 0; li < 2; li++) {
    float e = __expf(sAcs[16 * LT[li] + lr]);
#pragma unroll
    for (int pt = 0; pt < 4; pt++) { acc[pt][li][0] *= e; acc[pt][li][1] *= e; acc[pt][li][2] *= e; acc[pt][li][3] *= e; }
  }
#pragma unroll
  for (int li = 0; li < 2; li++) {
    const int lt = LT[li];
    const int lpos = 16 * lt + lr;
    const float acl = sAcs[lpos];
    for (int sp = 0; sp <= (lt >> 1); sp++) {
      f32x4 cb[2] = {(f32x4){0.f, 0.f, 0.f, 0.f}, (f32x4){0.f, 0.f, 0.f, 0.f}};
#pragma unroll
      for (int x = 0; x < 2; x++)
#pragma unroll
        for (int ks = 0; ks < 4; ks++) {
          bf16x8 bfr = *(const bf16x8*)(sB + (32 * sp + 16 * x + lr) * 136 + 32 * ks + 8 * lg);
          cb[x] = mfma16(bfr, cf[li][ks], cb[x]);
        }
      float mv[8];
#pragma unroll
      for (int x = 0; x < 2; x++)
#pragma unroll
        for (int i = 0; i < 4; i++) {
          const int s = 32 * sp + 16 * x + 4 * lg + i;
          mv[4 * x + i] = (s <= lpos) ? cb[x][i] * __expf(acl - sAcs[s]) * sDt[s] : 0.f;
        }
      bf16x8 mb = pack8(mv[0], mv[1], mv[2], mv[3], mv[4], mv[5], mv[6], mv[7]);
#pragma unroll
      for (int pt = 0; pt < 4; pt++) {
        const bf16_t* xp = sXT + (16 * pt + lr) * 136 + 32 * sp + 4 * lg;
        bf16x8 a = cat44(*(const bf16x4*)xp, *(const bf16x4*)(xp + 16));
        acc[pt][li] = mfma16(a, mb, acc[pt][li]);
      }
    }
  }
  const float dsk = p.d_skip[h];
#pragma unroll
  for (int li = 0; li < 2; li++) {
    const int lpos = 16 * LT[li] + lr;
    const size_t tok = tok0 + lpos;
    float ss = 0.f;
#pragma unroll
    for (int pt = 0; pt < 4; pt++) {
      const int pb = 16 * pt + 4 * lg;
      bf16x4 zv = zpre[li][pt];
      float y[4];
#pragma unroll
      for (int i = 0; i < 4; i++) {
        float xv = bf2f(sXT[(pb + i) * 136 + lpos]);
        y[i] = (acc[pt][li][i] + dsk * xv) * silu_f(bfs(zv[i]));
        ss += y[i] * y[i];
      }
      *(bf16x4*)(p.MIX + tok * 1536 + 512 + h * 64 + pb) = pack4(y[0], y[1], y[2], y[3]);
    }
    ss += __shfl_xor(ss, 16); ss += __shfl_xor(ss, 32);
    if (lg == 0) p.SS_SSD[tok * 8 + h] = ss;
  }
}

__device__ void final_rows(const Params& p, int gw, int nw) {
  const int lane = threadIdx.x & 63;
  for (int row = gw; row < T_TOK; row += nw) {
    float r = rsqrtf(p.SS_OUT[row] * (1.f / 1024.f) + 1e-6f);
    float4* o = (float4*)(p.out + (size_t)row * 1024);
    const float4* gf = (const float4*)p.g_final;
#pragma unroll
    for (int i = 0; i < 4; i++) {
      float4 v = o[lane + 64 * i], gg = gf[lane + 64 * i];
      v.x *= r * gg.x; v.y *= r * gg.y; v.z *= r * gg.z; v.w *= r * gg.w;
      o[lane + 64 * i] = v;
    }
  }
}

__device__ __forceinline__ void grid_bar(unsigned* bar, unsigned k) {
  asm volatile("s_waitcnt vmcnt(0)" ::: "memory");
  __syncthreads();
  if (threadIdx.x == 0) {
    const unsigned nb = gridDim.x, r = blockIdx.x & 7u;
    const unsigned nsub = (nb - r + 7u) >> 3;
    const unsigned ngrp = nb < 8u ? nb : 8u;
    __builtin_amdgcn_fence(__ATOMIC_RELEASE, "agent");
    asm volatile("s_waitcnt vmcnt(0)" ::: "memory");
    const unsigned old = __hip_atomic_fetch_add(bar + 64 * r, 1u, __ATOMIC_RELAXED, __HIP_MEMORY_SCOPE_AGENT);
    if (old + 1u == k * nsub) {
      __builtin_amdgcn_fence(__ATOMIC_ACQ_REL, "agent");
      asm volatile("s_waitcnt vmcnt(0)" ::: "memory");
      __hip_atomic_fetch_add(bar + 64 * 8, 1u, __ATOMIC_RELAXED, __HIP_MEMORY_SCOPE_AGENT);
    }
    while (__hip_atomic_load(bar + 64 * 8, __ATOMIC_RELAXED, __HIP_MEMORY_SCOPE_AGENT) < k * ngrp) __builtin_amdgcn_s_sleep(1);
    __builtin_amdgcn_fence(__ATOMIC_ACQUIRE, "agent");
    asm volatile("s_waitcnt vmcnt(0)" ::: "memory");
  }
  __syncthreads();
}

__device__ __forceinline__ int next_item(unsigned* ctr, char* smem) {
  int* sh = (int*)(smem + SMEM_BYTES - 16);
  __syncthreads();
  if (threadIdx.x == 0) *sh = (int)__hip_atomic_fetch_add(ctr, 1u, __ATOMIC_RELAXED, __HIP_MEMORY_SCOPE_AGENT);
  __syncthreads();
  return *sh;
}

__global__ void __launch_bounds__(256, 2) hymba_fwd(Params p) {
  cg::grid_group grid = cg::this_grid();
  __shared__ __attribute__((aligned(16))) char smem[SMEM_BYTES];
  const int nb = gridDim.x, bid = blockIdx.x;
  unsigned bk = 0;

  if (p.out == nullptr) grid.sync();
  for (int rep = 0; rep < REP0; rep++) {
  phase_prep(p);
  grid_bar(p.BAR, ++bk);
  }
  for (int rep = 0; rep < REP1; rep++) {
  if ((nb & 7) == 0) {
    const int xcd = bid & 7, li = bid >> 3, nbx = nb >> 3;
    for (int e = li; e < 1120; e += nbx) {
      const int grp = e / 280, r = e - grp * 280;
      gemm_tile<0>(p, xcd * 32 + grp * 8 + (r & 7), r >> 3, smem);
    }
  } else {
    for (int it = bid; it < 256 * 35; it += nb) gemm_tile<0>(p, it / 35, it % 35, smem);
  }
  for (int j = bid; j < 128; j += nb) gemm_tile<1>(p, j >> 3, j & 7, smem);
  grid_bar(p.BAR, ++bk);
  }
  for (int rep = 0; rep < REP2; rep++) {
  for (int it = next_item(p.BAR + 64 * (9 + rep), smem); it < 256 + 1024 + 2048; it = next_item(p.BAR + 64 * (9 + rep), smem)) {
    if (it < 256) compress_item(p, it, smem);
    else if (it < 1280) memattn_item(p, it - 256, smem);
    else conv_units(p, (it - 1280) * 256 + get_tid());
  }
  grid_bar(p.BAR, ++bk);
  }
  for (int rep = 0; rep < REP3; rep++) {
  {
    const int xq = bid & 7;
    unsigned* ctr = p.BAR + 64 * (16 + xq + 8 * rep);
    for (int li = next_item(ctr, smem); li < 512; li = next_item(ctr, smem)) {
      if (li < 256) nsa_item(p, ((li >> 1) << 4) | (xq + 8 * (li & 1)), smem);
      else ssd_states_item(p, (li - 256) * 8 + xq, smem);
    }
  }
  grid_bar(p.BAR, ++bk);
  }
  for (int it = bid; it < 1024; it += nb) scan_units(p, it * 256 + get_tid());
  grid_bar(p.BAR, ++bk);
  for (int rep = 0; rep < REP5; rep++) {
  for (int it = bid; it < 2048; it += nb) ssd_y_item(p, it, smem);
  grid_bar(p.BAR, ++bk);
  }
  if ((nb & 7) == 0) {
    const int xcd = bid & 7, li = bid >> 3, nbx = nb >> 3;
    for (int e = li; e < 256; e += nbx) gemm_tile<2>(p, xcd * 32 + (e >> 3), e & 7, smem);
  } else {
    for (int it = bid; it < 256 * 8; it += nb) gemm_tile<2>(p, it >> 3, it & 7, smem);
  }
  grid_bar(p.BAR, ++bk);
  final_rows(p, (bid * 256 + threadIdx.x) >> 6, (nb * 256) >> 6);
}

extern "C" void kernel_launch(void* const* d_in, const int* in_sizes, int n_in, void* d_out, int out_size, void* d_ws, size_t ws_size,
                              hipStream_t stream) {
  static int grid_blocks = 0;
  if (!grid_blocks) {
    int dev = 0, cus = 0, per_cu = 0;
    hipGetDevice(&dev);
    hipDeviceGetAttribute(&cus, hipDeviceAttributeMultiprocessorCount, dev);
    hipOccupancyMaxActiveBlocksPerMultiprocessor(&per_cu, hymba_fwd, 256, 0);
    if (per_cu < 1) per_cu = 1;
    if (per_cu > 4) per_cu = 4;
    grid_blocks = cus * per_cu;
  }
  Params p{};
  p.x = (const float*)d_in[0]; p.mem = (const float*)d_in[1]; p.pos = (const int*)d_in[2];
  p.g_in = (const float*)d_in[3]; p.w_in = (const float*)d_in[4]; p.cpk = (const float*)d_in[5];
  p.w1k = (const float*)d_in[6]; p.w2k = (const float*)d_in[7]; p.cpv = (const float*)d_in[8];
  p.w1v = (const float*)d_in[9]; p.w2v = (const float*)d_in[10]; p.conv_w = (const float*)d_in[11];
  p.conv_b = (const float*)d_in[12]; p.dt_bias = (const float*)d_in[13]; p.a_log = (const float*)d_in[14];
  p.d_skip = (const float*)d_in[15]; p.g_ssd = (const float*)d_in[16]; p.g_mem = (const float*)d_in[17];
  p.w_kv = (const float*)d_in[18]; p.w_out = (const float*)d_in[19]; p.g_final = (const float*)d_in[20];
  p.out = (float*)d_out;
  char* w = (char*)d_ws; size_t off = 0;
  auto take = [&](size_t bytes) { char* r = w + off; off += (bytes + 255) & ~(size_t)255; return r; };
  p.WinT = (bf16_t*)take((size_t)NINP * 1024 * 2);
  p.WoutT = (bf16_t*)take((size_t)1024 * 1536 * 2);
  p.WkvT = (bf16_t*)take((size_t)1024 * 1024 * 2);
  p.W1kT = (bf16_t*)take((size_t)256 * 2048 * 2);
  p.W1vT = (bf16_t*)take((size_t)256 * 2048 * 2);
  p.W2kT = (bf16_t*)take((size_t)64 * 256 * 2);
  p.W2vT = (bf16_t*)take((size_t)64 * 256 * 2);
  p.MEMB = (bf16_t*)take((size_t)2048 * 1024 * 2);
  p.PROJ = (bf16_t*)take((size_t)T_TOK * NIN * 2);
  p.VST = (bf16_t*)take((size_t)16 * 64 * S_LEN * 2);
  p.VWT = (bf16_t*)take((size_t)16 * 64 * S_LEN * 2);
  p.KMEM = (bf16_t*)take((size_t)2048 * 512 * 2);
  p.VMEMT = (bf16_t*)take((size_t)32 * 128 * 256 * 2);
  p.KCMP = (bf16_t*)take((size_t)16 * 256 * 64 * 2);
  p.VCMPT = (bf16_t*)take((size_t)16 * 64 * 256 * 2);
  p.XT = (bf16_t*)take((size_t)64 * 64 * S_LEN * 2);
  p.BC = (bf16_t*)take((size_t)T_TOK * 512 * 2);
  p.BT = (bf16_t*)take((size_t)16 * 128 * S_LEN * 2);
  p.MIX = (bf16_t*)take((size_t)T_TOK * 1536 * 2);
  p.XB = p.MIX;
  p.CHDEC = (float*)take((size_t)8 * 32 * 8 * 4);
  p.ACS = (float*)take((size_t)8 * 32 * 8 * 128 * 4);
  p.DTV = (float*)take((size_t)8 * 32 * 8 * 128 * 4);
  p.SS_SSD = (float*)take((size_t)T_TOK * 8 * 4);
  p.SS_OUT = (float*)take((size_t)T_TOK * 4);
  p.BAR = (unsigned*)take((size_t)(64 * 32 + 256) * 4);
  p.MTCNT = p.BAR + 64 * 32;
  p.STATES = (float*)d_out;
  p.KSC = (bf16_t*)((char*)d_out + (size_t)80 * 1024 * 1024);
  p.KWC = p.KSC + (size_t)16 * S_LEN * 64;
  if (off > ws_size) { fprintf(stderr, "workspace too small: need %zu have %zu\n", off, ws_size); return; }
  hipMemsetAsync(p.BAR, 0, (64 * 32 + 256) * 4, stream);
  void* args[] = {&p};
  hipError_t e = hipLaunchCooperativeKernel((void*)hymba_fwd, dim3(grid_blocks), dim3(256), args, 0, stream);
  if (e != hipSuccess) fprintf(stderr, "cooperative launch failed: %s (grid %d)\n", hipGetErrorString(e), grid_blocks);
}
```

```cpp
#include <hip/hip_runtime.h>
#include <hip/hip_cooperative_groups.h>
#include <stdint.h>
#include <stdio.h>
namespace cg = cooperative_groups;

typedef unsigned short bf16_t;
typedef __attribute__((ext_vector_type(8))) short bf16x8;
typedef __attribute__((ext_vector_type(4))) short bf16x4;
typedef __attribute__((ext_vector_type(4))) float f32x4;

#define S_LEN 4096
#define T_TOK 32768
#define NIN 4384
#define NINP 4480
#define LOG2E 1.4426950408889634f

#define C_Q 0
#define C_KC 512
#define C_VC 640
#define C_KS 768
#define C_KW 1024
#define C_GL 1280
#define C_GA 1304
#define C_Z 1816
#define C_XBC 2328
#define C_DT 3352
#define C_QX 3360
#define C_GX 3872

#define SMEM_BYTES 73728
#ifndef REP0
#define REP0 1
#endif
#ifndef REP1
#define REP1 1
#endif
#ifndef REP2
#define REP2 1
#endif
#ifndef REP3
#define REP3 1
#endif
#ifndef REP5
#define REP5 1
#endif

struct Params {
  const float *x, *mem; const int* pos;
  const float *g_in, *w_in, *cpk, *w1k, *w2k, *cpv, *w1v, *w2v, *conv_w, *conv_b, *dt_bias, *a_log, *d_skip, *g_ssd, *g_mem, *w_kv, *w_out, *g_final;
  float* out;
  bf16_t *WinT, *WoutT, *WkvT, *W1kT, *W1vT, *W2kT, *W2vT, *XB, *MEMB, *PROJ, *VST, *VWT, *KMEM, *VMEMT, *KCMP, *VCMPT, *XT, *BC, *BT, *MIX, *KSC, *KWC;
  float *STATES, *CHDEC, *ACS, *DTV, *SS_SSD, *SS_OUT;
  unsigned* BAR;
  unsigned* MTCNT;
};

__device__ __forceinline__ bf16_t f2bf(float f) { uint32_t u = __float_as_uint(f); u += 0x7fffu + ((u >> 16) & 1u); return (bf16_t)(u >> 16); }
__device__ __forceinline__ float bf2f(bf16_t h) { return __uint_as_float(((uint32_t)h) << 16); }
__device__ __forceinline__ float bfs(short h) { return __uint_as_float(((uint32_t)(unsigned short)h) << 16); }
__device__ __forceinline__ float fexp2(float x) { return __builtin_amdgcn_exp2f(x); }
__device__ __forceinline__ float silu_f(float x) { return x * __builtin_amdgcn_rcpf(1.f + __builtin_amdgcn_exp2f(-1.4426950408889634f * x)); }
__device__ __forceinline__ float sigmoid_f(float x) { return __builtin_amdgcn_rcpf(1.f + __builtin_amdgcn_exp2f(-1.4426950408889634f * x)); }
__device__ __forceinline__ f32x4 mfma16(bf16x8 a, bf16x8 b, f32x4 c) { return __builtin_amdgcn_mfma_f32_16x16x32_bf16(a, b, c, 0, 0, 0); }
typedef __bf16 hbf2_t __attribute__((ext_vector_type(2)));
typedef float f2_t __attribute__((ext_vector_type(2)));
typedef uint32_t u32x2 __attribute__((ext_vector_type(2)));
typedef uint32_t u32x4 __attribute__((ext_vector_type(4)));
__device__ __forceinline__ uint32_t pk2(float a, float b) {
  f2_t v; v[0] = a; v[1] = b;
  hbf2_t r = __builtin_convertvector(v, hbf2_t);
  return __builtin_bit_cast(uint32_t, r);
}
__device__ __forceinline__ bf16x4 pack4(float a, float b, float c, float d) {
  u32x2 r; r[0] = pk2(a, b); r[1] = pk2(c, d); return __builtin_bit_cast(bf16x4, r);
}
__device__ __forceinline__ bf16x8 pack8(float a, float b, float c, float d, float e, float f, float g, float h) {
  u32x4 r; r[0] = pk2(a, b); r[1] = pk2(c, d); r[2] = pk2(e, f); r[3] = pk2(g, h); return __builtin_bit_cast(bf16x8, r);
}
__device__ __forceinline__ bf16x8 cat44(bf16x4 a, bf16x4 b) {
  u32x2 x = __builtin_bit_cast(u32x2, a), y = __builtin_bit_cast(u32x2, b);
  u32x4 r; r[0] = x[0]; r[1] = x[1]; r[2] = y[0]; r[3] = y[1]; return __builtin_bit_cast(bf16x8, r);
}
template <int NR, typename L, typename ST, typename C>
__device__ __forceinline__ void tile_pipeline(int n, L load, ST store, C compute) {
  if (n <= 0) return;
  bf16x8 ra[NR], rb[NR];
  const int last = n - 1;
  load(0, ra);
  load(min(1, last), rb);
  store(0, ra);
  load(min(2, last), ra);
  __syncthreads();
  for (int i = 0; i < n; i += 2) {
    compute(i, 0);
    store(1, rb);
    load(min(i + 3, last), rb);
    __syncthreads();
    if (i + 1 < n) compute(i + 1, 1);
    store(0, ra);
    load(min(i + 4, last), ra);
    __syncthreads();
  }
}
template <int NR, typename L, typename ST, typename C>
__device__ __forceinline__ void tile_pipeline1(int n, L load, ST store, C compute) {
  if (n <= 0) return;
  bf16x8 ra[NR];
  load(0, ra);
  store(0, ra);
  if (n > 1) load(1, ra);
  __syncthreads();
  for (int i = 0; i < n; i++) {
    compute(i, i & 1);
    if (i + 1 < n) { store((i + 1) & 1, ra); if (i + 2 < n) load(i + 2, ra); }
    __syncthreads();
  }
}
__device__ __forceinline__ void rope_cs(int pos, int j, float& cs, float& sn) {
  float inv = fexp2(-(float)j * (18.931568569324174f / 8.f));
  float a = (float)pos * inv;
  float n = rintf(a * 0.15915494309189535f);
  float r = fmaf(-n, 6.28125f, a);
  r = fmaf(-n, 1.9353071795864769e-3f, r);
  cs = __cosf(r); sn = __sinf(r);
}

__device__ __forceinline__ float rowmax4(float x) {
  unsigned xi = __float_as_uint(x);
  auto a = __builtin_amdgcn_permlane16_swap(xi, xi, false, false);
  float m = fmaxf(__uint_as_float(a[0]), __uint_as_float(a[1]));
  unsigned mi = __float_as_uint(m);
  auto b = __builtin_amdgcn_permlane32_swap(mi, mi, false, false);
  return fmaxf(__uint_as_float(b[0]), __uint_as_float(b[1]));
}
__device__ __forceinline__ float rowsum4(float x) {
  unsigned xi = __float_as_uint(x);
  auto a = __builtin_amdgcn_permlane16_swap(xi, xi, false, false);
  float m = __uint_as_float(a[0]) + __uint_as_float(a[1]);
  unsigned mi = __float_as_uint(m);
  auto b = __builtin_amdgcn_permlane32_swap(mi, mi, false, false);
  return __uint_as_float(b[0]) + __uint_as_float(b[1]);
}
__device__ __forceinline__ int get_tid() { int t = threadIdx.x; asm volatile("" : "+v"(t)); return t; }

__device__ void prep_rows(const float* __restrict__ x, bf16_t* __restrict__ xb, int nrows, int gw, int nw) {
  const int lane = threadIdx.x & 63;
  int row = gw;
  for (; row + 3 * nw < nrows; row += 4 * nw) {
    float4 v[4][4]; float ss[4];
#pragma unroll
    for (int r = 0; r < 4; r++) {
      const float4* p = (const float4*)(x + (size_t)(row + r * nw) * 1024);
#pragma unroll
      for (int i = 0; i < 4; i++) v[r][i] = p[lane + 64 * i];
    }
#pragma unroll
    for (int r = 0; r < 4; r++) {
      float s = 0.f;
#pragma unroll
      for (int i = 0; i < 4; i++) s += v[r][i].x * v[r][i].x + v[r][i].y * v[r][i].y + v[r][i].z * v[r][i].z + v[r][i].w * v[r][i].w;
#pragma unroll
      for (int o = 32; o >= 1; o >>= 1) s += __shfl_xor(s, o);
      ss[r] = rsqrtf(s * (1.f / 1024.f) + 1e-6f);
    }
#pragma unroll
    for (int r = 0; r < 4; r++)
#pragma unroll
      for (int i = 0; i < 4; i++)
        *(bf16x4*)(xb + (size_t)(row + r * nw) * 1024 + (lane + 64 * i) * 4) =
            pack4(v[r][i].x * ss[r], v[r][i].y * ss[r], v[r][i].z * ss[r], v[r][i].w * ss[r]);
  }
  for (; row < nrows; row += nw) {
    const float4* p = (const float4*)(x + (size_t)row * 1024);
    float4 v[4]; float ss = 0.f;
#pragma unroll
    for (int i = 0; i < 4; i++) { v[i] = p[lane + 64 * i]; ss += v[i].x * v[i].x + v[i].y * v[i].y + v[i].z * v[i].z + v[i].w * v[i].w; }
#pragma unroll
    for (int o = 32; o >= 1; o >>= 1) ss += __shfl_xor(ss, o);
    float r = rsqrtf(ss * (1.f / 1024.f) + 1e-6f);
#pragma unroll
    for (int i = 0; i < 4; i++) {
      bf16x4 o = pack4(v[i].x * r, v[i].y * r, v[i].z * r, v[i].w * r);
      *(bf16x4*)(xb + (size_t)row * 1024 + (lane + 64 * i) * 4) = o;
    }
  }
}

__device__ void prep_wT(const float* __restrict__ w, const float* __restrict__ g, int gk0, int gk1, bf16_t* __restrict__ wt,
                        int K, int N, int Npad, int gtid, int gthreads) {
  const int ln = gtid & 63, gwv = gtid >> 6, nwv = gthreads >> 6;
  const int kblocks = K >> 6;
  const int total = (Npad >> 3) * kblocks;
  for (int uw = gwv; uw < total; uw += nwv) {
    const int kb = uw % kblocks, nbk = uw / kblocks;
    const int n = nbk * 8 + (ln >> 3), k8 = kb * 8 + (ln & 7);
    bf16x8 o;
#pragma unroll
    for (int j = 0; j < 8; j++) {
      int k = k8 * 8 + j; float v = 0.f;
      if (n < N) { v = w[(size_t)k * N + n]; if (g != nullptr && k >= gk0 && k < gk1) v *= g[k - gk0]; }
      o[j] = (short)f2bf(v);
    }
    *(bf16x8*)(wt + (size_t)n * K + k8 * 8) = o;
  }
}

__device__ void phase_prep(const Params& p) {
  const int gtid = blockIdx.x * 256 + threadIdx.x, gthreads = gridDim.x * 256;
  const int gw = gtid >> 6, nw = gthreads >> 6;
  prep_rows(p.x, p.XB, T_TOK, gw, nw);
  prep_rows(p.mem, p.MEMB, 2048, gw, nw);
  prep_wT(p.w_in, p.g_in, 0, 1024, p.WinT, 1024, NIN, NINP, gtid, gthreads);
  prep_wT(p.w_out, p.g_ssd, 512, 1024, p.WoutT, 1536, 1024, 1024, gtid, gthreads);
  prep_wT(p.w_kv, p.g_mem, 0, 1024, p.WkvT, 1024, 1024, 1024, gtid, gthreads);
  prep_wT(p.w1k, nullptr, 0, 0, p.W1kT, 2048, 256, 256, gtid, gthreads);
  prep_wT(p.w1v, nullptr, 0, 0, p.W1vT, 2048, 256, 256, gtid, gthreads);
  prep_wT(p.w2k, nullptr, 0, 0, p.W2kT, 256, 64, 64, gtid, gthreads);
  prep_wT(p.w2v, nullptr, 0, 0, p.W2vT, 256, 64, 64, gtid, gthreads);
  for (int i = gtid; i < T_TOK; i += gthreads) p.SS_OUT[i] = 0.f;
  for (int i = gtid; i < 16 * 64; i += gthreads) {
    int bg = i >> 6, d = i & 63;
    p.KCMP[((size_t)bg * 256 + 255) * 64 + d] = 0;
    p.VCMPT[((size_t)bg * 64 + d) * 256 + 255] = 0;
  }
}

typedef __attribute__((address_space(3))) unsigned lds_u32_t;
typedef __attribute__((address_space(1))) const unsigned glb_u32_t;
__device__ __forceinline__ void glds16(const bf16_t* g, char* l) {
  __builtin_amdgcn_global_load_lds((glb_u32_t*)g, (lds_u32_t*)l, 16, 0, 0);
}
template <int MODE>
__device__ void gemm_tile_reg(const Params& p, int mt, int nt, char* smem) {
  const int tid = get_tid(), lane = tid & 63, wave = tid >> 6, lr = lane & 15, lg = lane >> 4;
  const int wr = wave >> 1, wc = wave & 1;
  const int m0 = mt * 128, n0 = nt * 128;
  const bf16_t* A; const bf16_t* Bt; int K;
  if (MODE == 0) { A = p.XB; Bt = p.WinT; K = 1024; }
  else if (MODE == 1) { A = p.MEMB; Bt = p.WkvT; K = 1024; }
  else { A = p.MIX; Bt = p.WoutT; K = 1536; }
  bf16_t* As = (bf16_t*)smem;
  bf16_t* Bs = As + 2 * 9216;
  const int lrow = tid >> 3, kc = tid & 7;
  const bf16_t* ga = A + (size_t)(m0 + lrow) * K + kc * 8;
  const bf16_t* gb = Bt + (size_t)(n0 + lrow) * K + kc * 8;
  float rs[4] = {1.f, 1.f, 1.f, 1.f};
  if (MODE == 2) {
#pragma unroll
    for (int i = 0; i < 4; i++) {
      const float4* sp = (const float4*)(p.SS_SSD + (size_t)(m0 + lrow + 32 * i) * 8);
      float4 a = sp[0], b = sp[1];
      rs[i] = rsqrtf((a.x + a.y + a.z + a.w + b.x + b.y + b.z + b.w) * (1.f / 512.f) + 1e-6f);
    }
  }
  bool swap;
  if (MODE == 0) swap = !(nt == 7 || nt == 9);
  else if (MODE == 1) swap = (nt < 4);
  else swap = true;
  const bf16_t* F = swap ? (Bs + (64 * wc) * 72) : (As + (64 * wr) * 72);
  const bf16_t* G = swap ? (As + (64 * wr) * 72) : (Bs + (64 * wc) * 72);
  f32x4 acc[4][4];
#pragma unroll
  for (int i = 0; i < 4; i++)
#pragma unroll
    for (int j = 0; j < 4; j++) acc[i][j] = (f32x4){0.f, 0.f, 0.f, 0.f};
  bf16x8 ra0[4], rb0[4], ra1[4], rb1[4];
  const int nk = K / 64;
  auto load = [&](int kt, bf16x8 (&ra)[4], bf16x8 (&rb)[4]) {
#pragma unroll
    for (int i = 0; i < 4; i++) {
      ra[i] = *(const bf16x8*)(ga + (size_t)(32 * i) * K + kt * 64);
      rb[i] = *(const bf16x8*)(gb + (size_t)(32 * i) * K + kt * 64);
    }
  };
  auto store = [&](int buf, int kt, bf16x8 (&ra)[4], bf16x8 (&rb)[4]) {
    if (MODE == 2) {
      if (kt >= 8 && kt < 16) {
#pragma unroll
        for (int i = 0; i < 4; i++) {
          bf16x8 v = ra[i];
          ra[i] = pack8(bfs(v[0]) * rs[i], bfs(v[1]) * rs[i], bfs(v[2]) * rs[i], bfs(v[3]) * rs[i],
                        bfs(v[4]) * rs[i], bfs(v[5]) * rs[i], bfs(v[6]) * rs[i], bfs(v[7]) * rs[i]);
        }
      }
    }
#pragma unroll
    for (int i = 0; i < 4; i++) {
      *(bf16x8*)(As + buf * 9216 + (lrow + 32 * i) * 72 + kc * 8) = ra[i];
      *(bf16x8*)(Bs + buf * 9216 + (lrow + 32 * i) * 72 + kc * 8) = rb[i];
    }
  };
  auto compute = [&](int buf) {
    const int cb = buf * 9216;
#pragma unroll
    for (int ks = 0; ks < 2; ks++) {
      bf16x8 ff[4], gg[4];
#pragma unroll
      for (int i = 0; i < 4; i++) {
        ff[i] = *(const bf16x8*)(F + cb + (16 * i + lr) * 72 + ks * 32 + lg * 8);
        gg[i] = *(const bf16x8*)(G + cb + (16 * i + lr) * 72 + ks * 32 + lg * 8);
      }
#pragma unroll
      for (int i = 0; i < 4; i++)
#pragma unroll
        for (int j = 0; j < 4; j++) acc[i][j] = mfma16(ff[i], gg[j], acc[i][j]);
    }
  };
  const int lastk = nk - 1;
  load(0, ra0, rb0);
  load(1, ra1, rb1);
  store(0, 0, ra0, rb0);
  load(2, ra0, rb0);
  __syncthreads();
  for (int kt = 0; kt < nk; kt += 2) {
    compute(0);
    store(1, kt + 1, ra1, rb1);
    load(min(kt + 3, lastk), ra1, rb1);
    __syncthreads();
    compute(1);
    store(0, min(kt + 2, lastk), ra0, rb0);
    load(min(kt + 4, lastk), ra0, rb0);
    __syncthreads();
  }
  if (swap) {
    if (MODE == 0) {
      const bool rope = (nt < 4) || nt == 6 || nt == 8;
#pragma unroll
      for (int mi = 0; mi < 4; mi++) {
        const int m = m0 + 64 * wr + 16 * mi + lr;
        if (rope) {
          const int pos = p.pos[m];
          f32x4 v = acc[0][mi];
          f32x4 o;
#pragma unroll
          for (int i = 0; i < 4; i++) {
            float pr = __shfl_xor(v[i], 32);
            float cs, sn; rope_cs(pos, 4 * (lg & 1) + i, cs, sn);
            o[i] = (lg < 2) ? (v[i] * cs - pr * sn) : (v[i] * cs + pr * sn);
          }
          acc[0][mi] = o;
        }
        {
          bf16_t* stg = (bf16_t*)smem + ((wave & 1) ? 2 * 9216 : 0) + (wave >> 1) * 4608;
#pragma unroll
          for (int ni = 0; ni < 4; ni++) {
            f32x4 v = acc[ni][mi];
            *(bf16x4*)(stg + (16 * mi + lr) * 72 + 16 * ni + 4 * lg) = pack4(v[0], v[1], v[2], v[3]);
          }
        }
      }
      {
        const bf16_t* stg = (const bf16_t*)smem + ((wave & 1) ? 2 * 9216 : 0) + (wave >> 1) * 4608;
        const int rr = lane >> 3, ch = lane & 7;
        const int nb0 = n0 + 64 * wc + ch * 8;
#pragma unroll
        for (int it = 0; it < 8; it++) {
          const int row = it * 8 + rr;
          const int m = m0 + 64 * wr + row;
          bf16x8 v = *(const bf16x8*)(stg + row * 72 + ch * 8);
          if (nt == 6 || nt == 8) {
            bf16_t* kd = ((nt == 6) ? p.KSC : p.KWC) + (((size_t)(m >> 12) * 2 + wc) * S_LEN + (m & 4095)) * 64;
            *(bf16x8*)(kd + ch * 8) = v;
          } else if (nb0 < NIN) {
            *(bf16x8*)(p.PROJ + (size_t)m * NIN + nb0) = v;
          }
        }
      }
      __syncthreads();
    } else if (MODE == 1) {
#pragma unroll
      for (int mi = 0; mi < 4; mi++) {
        const int m = m0 + 64 * wr + 16 * mi + lr;
#pragma unroll
        for (int ni = 0; ni < 4; ni++) {
          const int n = n0 + 64 * wc + 16 * ni + 4 * lg;
          f32x4 v = acc[ni][mi];
          *(bf16x4*)(p.KMEM + (size_t)m * 512 + n) = pack4(v[0], v[1], v[2], v[3]);
        }
      }
    } else {
#pragma unroll
      for (int mi = 0; mi < 4; mi++) {
        const int m = m0 + 64 * wr + 16 * mi + lr;
        float ss = 0.f;
#pragma unroll
        for (int ni = 0; ni < 4; ni++) {
          const int n = n0 + 64 * wc + 16 * ni + 4 * lg;
          float4 xv = *(const float4*)(p.x + (size_t)m * 1024 + n);
          f32x4 v = acc[ni][mi];
          float4 h; h.x = xv.x + v[0]; h.y = xv.y + v[1]; h.z = xv.z + v[2]; h.w = xv.w + v[3];
          ss += h.x * h.x + h.y * h.y + h.z * h.z + h.w * h.w;
          *(float4*)(p.out + (size_t)m * 1024 + n) = h;
        }
        ss += __shfl_xor(ss, 16); ss += __shfl_xor(ss, 32);
        if (lg == 0) atomicAdd(p.SS_OUT + m, ss);
      }
    }
  } else {
#pragma unroll
    for (int mi = 0; mi < 4; mi++)
#pragma unroll
      for (int ni = 0; ni < 4; ni++) {
        f32x4 v = acc[mi][ni];
        bf16x4 o = pack4(v[0], v[1], v[2], v[3]);
        if (MODE == 0) {
          const int b = m0 >> 12, s = (m0 & 4095) + 64 * wr + 16 * mi + 4 * lg;
          const int d = 16 * ni + lr;
          bf16_t* dst = (nt == 7) ? p.VST : p.VWT;
          *(bf16x4*)(dst + ((size_t)(b * 2 + wc) * 64 + d) * S_LEN + s) = o;
        } else {
          const int b = m0 >> 8, s = (m0 & 255) + 64 * wr + 16 * mi + 4 * lg;
          const int col = n0 - 512 + 64 * wc + 16 * ni + lr;
          const int h = col >> 7, d = col & 127;
          *(bf16x4*)(p.VMEMT + ((size_t)(b * 4 + h) * 128 + d) * 256 + s) = o;
        }
      }
  }
}

template <int MODE>
__device__ void gemm_tile_glds(const Params& p, int mt, int nt, char* smem) {
  const int tid = get_tid(), lane = tid & 63, wave = tid >> 6, lr = lane & 15, lg = lane >> 4;
  const int wr = wave >> 1, wc = wave & 1;
  const int m0 = mt * 128, n0 = nt * 128;
  const bf16_t* A; const bf16_t* Bt; int K;
  if (MODE == 0) { A = p.XB; Bt = p.WinT; K = 1024; }
  else if (MODE == 1) { A = p.MEMB; Bt = p.WkvT; K = 1024; }
  else { A = p.MIX; Bt = p.WoutT; K = 1536; }
  float rs[4] = {1.f, 1.f, 1.f, 1.f};
  if (MODE == 2) {
#pragma unroll
    for (int i = 0; i < 4; i++) {
      const float4* sp = (const float4*)(p.SS_SSD + (size_t)(m0 + (wave * 4 + i) * 8 + (lane >> 3)) * 8);
      float4 a = sp[0], b = sp[1];
      rs[i] = rsqrtf((a.x + a.y + a.z + a.w + b.x + b.y + b.z + b.w) * (1.f / 512.f) + 1e-6f);
    }
  }
  bool swap;
  if (MODE == 0) swap = !(nt == 7 || nt == 9);
  else if (MODE == 1) swap = (nt < 4);
  else swap = true;
  const int rl = lane >> 3, pcx = lane & 7;
  const bf16_t* gA[4]; const bf16_t* gB[4];
#pragma unroll
  for (int q = 0; q < 4; q++) {
    const int row = (wave * 4 + q) * 8 + rl;
    const int c = pcx ^ ((row >> 1) & 7);
    gA[q] = A + (size_t)(m0 + row) * K + c * 8;
    gB[q] = Bt + (size_t)(n0 + row) * K + c * 8;
  }
  char* lbase = smem + wave * 4096 + lane * 16;
  auto stage = [&](int buf, int koff) {
#pragma unroll
    for (int q = 0; q < 4; q++) {
      glds16(gA[q] + koff, lbase + buf * 32768 + q * 1024);
      glds16(gB[q] + koff, lbase + buf * 32768 + 16384 + q * 1024);
    }
  };
  const int fro = (swap ? (16384 + 64 * wc * 128) : (64 * wr * 128)) + lr * 128;
  const int gro = (swap ? (64 * wr * 128) : (16384 + 64 * wc * 128)) + lr * 128;
  const int sw = (lr >> 1) & 7;
  f32x4 acc[4][4];
#pragma unroll
  for (int i = 0; i < 4; i++)
#pragma unroll
    for (int j = 0; j < 4; j++) acc[i][j] = (f32x4){0.f, 0.f, 0.f, 0.f};
  const int nk = K / 64;
  auto kof = [&](int i) { return i * 64; };
  stage(0, kof(0));
  for (int kt = 0; kt < nk; kt++) {
    __syncthreads();
    if (kt + 1 < nk) stage((kt + 1) & 1, kof(kt + 1));
    if (MODE == 2) {
      if (kt >= 8 && kt < 16) {
#pragma unroll
        for (int q = 0; q < 4; q++) {
          bf16x8* cp = (bf16x8*)(lbase + (kt & 1) * 32768 + q * 1024);
          bf16x8 v = *cp;
          *cp = pack8(bfs(v[0]) * rs[q], bfs(v[1]) * rs[q], bfs(v[2]) * rs[q], bfs(v[3]) * rs[q],
                      bfs(v[4]) * rs[q], bfs(v[5]) * rs[q], bfs(v[6]) * rs[q], bfs(v[7]) * rs[q]);
        }
        __syncthreads();
      }
    }
    const char* sb = smem + (kt & 1) * 32768;
#pragma unroll
    for (int ks = 0; ks < 2; ks++) {
      bf16x8 ff[4], gg[4];
      const int co = ((ks * 4 + lg) ^ sw) * 16;
#pragma unroll
      for (int i = 0; i < 4; i++) {
        ff[i] = *(const bf16x8*)(sb + fro + i * 2048 + co);
        gg[i] = *(const bf16x8*)(sb + gro + i * 2048 + co);
      }
#pragma unroll
      for (int i = 0; i < 4; i++)
#pragma unroll
        for (int j = 0; j < 4; j++) acc[i][j] = mfma16(ff[i], gg[j], acc[i][j]);
    }
  }
  __syncthreads();
  if (swap) {
    if (MODE == 0) {
      const bool rope = (nt < 4) || nt == 6 || nt == 8;
#pragma unroll
      for (int mi = 0; mi < 4; mi++) {
        const int m = m0 + 64 * wr + 16 * mi + lr;
        if (rope) {
          const int pos = p.pos[m];
          f32x4 v = acc[0][mi];
          f32x4 o;
#pragma unroll
          for (int i = 0; i < 4; i++) {
            float pr = __shfl_xor(v[i], 32);
            float cs, sn; rope_cs(pos, 4 * (lg & 1) + i, cs, sn);
            o[i] = (lg < 2) ? (v[i] * cs - pr * sn) : (v[i] * cs + pr * sn);
          }
          acc[0][mi] = o;
        }
        {
          bf16_t* stg = (bf16_t*)smem + ((wave & 1) ? 2 * 9216 : 0) + (wave >> 1) * 4608;
#pragma unroll
          for (int ni = 0; ni < 4; ni++) {
            f32x4 v = acc[ni][mi];
            *(bf16x4*)(stg + (16 * mi + lr) * 72 + 16 * ni + 4 * lg) = pack4(v[0], v[1], v[2], v[3]);
          }
        }
      }
      {
        const bf16_t* stg = (const bf16_t*)smem + ((wave & 1) ? 2 * 9216 : 0) + (wave >> 1) * 4608;
        const int rr = lane >> 3, ch = lane & 7;
        const int nb0 = n0 + 64 * wc + ch * 8;
#pragma unroll
        for (int it = 0; it < 8; it++) {
          const int row = it * 8 + rr;
          const int m = m0 + 64 * wr + row;
          bf16x8 v = *(const bf16x8*)(stg + row * 72 + ch * 8);
          if (nt == 6 || nt == 8) {
            bf16_t* kd = ((nt == 6) ? p.KSC : p.KWC) + (((size_t)(m >> 12) * 2 + wc) * S_LEN + (m & 4095)) * 64;
            *(bf16x8*)(kd + ch * 8) = v;
          } else if (nb0 < NIN) {
            *(bf16x8*)(p.PROJ + (size_t)m * NIN + nb0) = v;
          }
        }
      }
      __syncthreads();
    } else if (MODE == 1) {
#pragma unroll
      for (int mi = 0; mi < 4; mi++) {
        const int m = m0 + 64 * wr + 16 * mi + lr;
#pragma unroll
        for (int ni = 0; ni < 4; ni++) {
          const int n = n0 + 64 * wc + 16 * ni + 4 * lg;
          f32x4 v = acc[ni][mi];
          *(bf16x4*)(p.KMEM + (size_t)m * 512 + n) = pack4(v[0], v[1], v[2], v[3]);
        }
      }
    } else {
#pragma unroll
      for (int mi = 0; mi < 4; mi++) {
        const int m = m0 + 64 * wr + 16 * mi + lr;
        float ss = 0.f;
#pragma unroll
        for (int ni = 0; ni < 4; ni++) {
          const int n = n0 + 64 * wc + 16 * ni + 4 * lg;
          float4 xv = *(const float4*)(p.x + (size_t)m * 1024 + n);
          f32x4 v = acc[ni][mi];
          float4 h; h.x = xv.x + v[0]; h.y = xv.y + v[1]; h.z = xv.z + v[2]; h.w = xv.w + v[3];
          ss += h.x * h.x + h.y * h.y + h.z * h.z + h.w * h.w;
          *(float4*)(p.out + (size_t)m * 1024 + n) = h;
        }
        ss += __shfl_xor(ss, 16); ss += __shfl_xor(ss, 32);
        if (lg == 0) atomicAdd(p.SS_OUT + m, ss);
      }
    }
  } else {
#pragma unroll
    for (int mi = 0; mi < 4; mi++)
#pragma unroll
      for (int ni = 0; ni < 4; ni++) {
        f32x4 v = acc[mi][ni];
        bf16x4 o = pack4(v[0], v[1], v[2], v[3]);
        if (MODE == 0) {
          const int b = m0 >> 12, s = (m0 & 4095) + 64 * wr + 16 * mi + 4 * lg;
          const int d = 16 * ni + lr;
          bf16_t* dst = (nt == 7) ? p.VST : p.VWT;
          *(bf16x4*)(dst + ((size_t)(b * 2 + wc) * 64 + d) * S_LEN + s) = o;
        } else {
          const int b = m0 >> 8, s = (m0 & 255) + 64 * wr + 16 * mi + 4 * lg;
          const int col = n0 - 512 + 64 * wc + 16 * ni + lr;
          const int h = col >> 7, d = col & 127;
          *(bf16x4*)(p.VMEMT + ((size_t)(b * 4 + h) * 128 + d) * 256 + s) = o;
        }
      }
  }
}

template <int MODE>
__device__ __forceinline__ void gemm_tile(const Params& p, int mt, int nt, char* smem) {
  gemm_tile_glds<MODE>(p, mt, nt, smem);
}

template <int DQK, int DV, int MASK, typename MaskF>
__device__ __forceinline__ void attn_tile(const bf16_t* sK, const bf16_t* sVt, const bf16x8 (&qf)[2][DQK / 32], f32x4 (&o)[DV / 16][2],
                                          float (&m)[2], float (&l)[2], float c, bool qsel0, bool qsel1, MaskF valid) {
  constexpr int KST = DQK + 8;
  const int lane = get_tid() & 63, lr = lane & 15, lg = lane >> 4;
  f32x4 s[4][2];
#pragma unroll
  for (int kt = 0; kt < 4; kt++) { s[kt][0] = (f32x4){0.f, 0.f, 0.f, 0.f}; s[kt][1] = (f32x4){0.f, 0.f, 0.f, 0.f}; }
#pragma unroll
  for (int ks = 0; ks < DQK / 32; ks++)
#pragma unroll
    for (int kt = 0; kt < 4; kt++) {
      bf16x8 a = *(const bf16x8*)(sK + (16 * kt + lr) * KST + ks * 32 + lg * 8);
      s[kt][0] = mfma16(a, qf[0][ks], s[kt][0]);
      s[kt][1] = mfma16(a, qf[1][ks], s[kt][1]);
    }
#pragma unroll
  for (int qt = 0; qt < 2; qt++) {
    const bool qs = qt ? qsel1 : qsel0;
    float mx = -1e30f;
    if (MASK) {
#pragma unroll
      for (int kt = 0; kt < 4; kt++)
#pragma unroll
        for (int i = 0; i < 4; i++) {
          bool v = valid(16 * kt + 4 * lg + i, qt);
          float sv = v ? s[kt][qt][i] * c : -1e30f;
          s[kt][qt][i] = sv; mx = fmaxf(mx, sv);
        }
    } else {
#pragma unroll
      for (int kt = 0; kt < 4; kt++) mx = fmaxf(fmaxf(mx, fmaxf(s[kt][qt][0], s[kt][qt][1])), fmaxf(s[kt][qt][2], s[kt][qt][3]));
      mx = qs ? mx * c : -1e30f;
    }
    mx = rowmax4(mx);
    const float mn = fmaxf(m[qt], mx);
    const float alpha = fexp2(m[qt] - mn);
    m[qt] = mn;
    float me;
    if (MASK) me = (mn > -1e29f) ? mn : 1e30f; else me = qs ? mn : 1e30f;
    float rs = 0.f;
#pragma unroll
    for (int kt = 0; kt < 4; kt++)
#pragma unroll
      for (int i = 0; i < 4; i++) {
        float pv = MASK ? fexp2(s[kt][qt][i] - me) : fexp2(fmaf(s[kt][qt][i], c, -me));
        s[kt][qt][i] = pv; rs += pv;
      }
    rs = rowsum4(rs);
    l[qt] = l[qt] * alpha + rs;
#pragma unroll
    for (int dt = 0; dt < DV / 16; dt++) {
      o[dt][qt][0] *= alpha; o[dt][qt][1] *= alpha; o[dt][qt][2] *= alpha; o[dt][qt][3] *= alpha;
    }
  }
#pragma unroll
  for (int k2 = 0; k2 < 2; k2++) {
    bf16x8 pb[2];
#pragma unroll
    for (int qt = 0; qt < 2; qt++)
      pb[qt] = pack8(s[2 * k2][qt][0], s[2 * k2][qt][1], s[2 * k2][qt][2], s[2 * k2][qt][3],
                     s[2 * k2 + 1][qt][0], s[2 * k2 + 1][qt][1], s[2 * k2 + 1][qt][2], s[2 * k2 + 1][qt][3]);
#pragma unroll
    for (int dt = 0; dt < DV / 16; dt++) {
      const bf16_t* vp = sVt + (16 * dt + lr) * 72 + 32 * k2 + 4 * lg;
      bf16x8 a = cat44(*(const bf16x4*)vp, *(const bf16x4*)(vp + 16));
      o[dt][0] = mfma16(a, pb[0], o[dt][0]);
      o[dt][1] = mfma16(a, pb[1], o[dt][1]);
    }
  }
}

__device__ __forceinline__ int next_bit_below(unsigned long long m, int below) {
  unsigned long long mm = (below >= 64) ? m : (m & ((1ull << below) - 1ull));
  return mm ? (63 - __clzll((long long)mm)) : -1;
}

__device__ void nsa_item(const Params& p, int item, char* smem) {
  const int tid = get_tid(), lane = tid & 63, wave = tid >> 6, lr = lane & 15, lg = lane >> 4;
  const int bg = item & 15, qb = 127 - (item >> 4);
  const int b = bg >> 1, g = bg & 1;
  const int t0 = qb * 32, cur = t0 >> 6;
  const int hq = g * 4 + wave;
  float* sImp = (float*)(smem + 55296);
  unsigned long long* sSel = (unsigned long long*)(smem + 63616);
  const float c = 0.125f * LOG2E;
  const size_t tokbase = (size_t)b * S_LEN + t0;
  const int r0 = tid >> 3, cc = tid & 7;

  bf16x8 qf[2][2];
#pragma unroll
  for (int qt = 0; qt < 2; qt++) {
    const bf16_t* row = p.PROJ + (tokbase + 16 * qt + lr) * NIN;
#pragma unroll
    for (int ks = 0; ks < 2; ks++) qf[qt][ks] = *(const bf16x8*)(row + C_Q + hq * 64 + 32 * ks + 8 * lg);
  }
  bf16_t* slab = (bf16_t*)(smem + 36864 + wave * 4608);
  auto emit = [&](f32x4 (&o)[4][2], float (&l)[2], int br) {
#pragma unroll
    for (int qt = 0; qt < 2; qt++) {
      const size_t tok = tokbase + 16 * qt + lr;
      const float gsc = sigmoid_f(bf2f(p.PROJ[tok * NIN + C_GL + hq * 3 + br])) / fmaxf(l[qt], 1e-30f);
#pragma unroll
      for (int dt = 0; dt < 4; dt++) {
        bf16_t* dst = slab + (16 * qt + lr) * 72 + 16 * dt + 4 * lg;
        f32x4 r = o[dt][qt];
        r[0] *= gsc; r[1] *= gsc; r[2] *= gsc; r[3] *= gsc;
        if (br > 0) { bf16x4 pv = *(const bf16x4*)dst; r[0] += bfs(pv[0]); r[1] += bfs(pv[1]); r[2] += bfs(pv[2]); r[3] += bfs(pv[3]); }
        *(bf16x4*)dst = pack4(r[0], r[1], r[2], r[3]);
      }
    }
    if (br == 2) {
      const int rr = lane >> 3, ch = lane & 7;
#pragma unroll
      for (int it = 0; it < 4; it++) {
        const int row = it * 8 + rr;
        const size_t tok = tokbase + row;
        const bf16x8 v = *(const bf16x8*)(slab + row * 72 + ch * 8);
        const bf16x8 ga = *(const bf16x8*)(p.PROJ + tok * NIN + C_GA + hq * 64 + ch * 8);
        *(bf16x8*)(p.MIX + tok * 1536 + hq * 64 + ch * 8) =
            pack8(bfs(v[0]) * silu_f(bfs(ga[0])), bfs(v[1]) * silu_f(bfs(ga[1])), bfs(v[2]) * silu_f(bfs(ga[2])), bfs(v[3]) * silu_f(bfs(ga[3])),
                  bfs(v[4]) * silu_f(bfs(ga[4])), bfs(v[5]) * silu_f(bfs(ga[5])), bfs(v[6]) * silu_f(bfs(ga[6])), bfs(v[7]) * silu_f(bfs(ga[7])));
      }
    }
  };
  auto store_kv = [&](int buf, bf16x8 (&rg)[4]) {
    bf16_t* sK = (bf16_t*)(smem + buf * 18432);
    bf16_t* sVt = sK + 64 * 72;
    *(bf16x8*)(sK + r0 * 72 + cc * 8) = rg[0];
    *(bf16x8*)(sK + (r0 + 32) * 72 + cc * 8) = rg[1];
    *(bf16x8*)(sVt + r0 * 72 + cc * 8) = rg[2];
    *(bf16x8*)(sVt + (r0 + 32) * 72 + cc * 8) = rg[3];
  };

  {
    const int ntiles = (t0 >> 10) + 1;
    const bf16_t* kb = p.KCMP + (size_t)bg * 256 * 64;
    const bf16_t* vb = p.VCMPT + (size_t)bg * 64 * 256;
    for (int pass = 0; pass < 2; pass++) {
      f32x4 o[4][2]; float m[2] = {-1e30f, -1e30f}, l[2] = {0.f, 0.f};
#pragma unroll
      for (int dt = 0; dt < 4; dt++) { o[dt][0] = (f32x4){0.f, 0.f, 0.f, 0.f}; o[dt][1] = (f32x4){0.f, 0.f, 0.f, 0.f}; }
      int ldn = 0;
      tile_pipeline<4>(ntiles,
        [&](int i, bf16x8 (&rg)[4]) {
          rg[0] = *(const bf16x8*)(kb + (size_t)(64 * i + r0) * 64 + cc * 8);
          rg[1] = *(const bf16x8*)(kb + (size_t)(64 * i + r0 + 32) * 64 + cc * 8);
          if (pass == 0) {
            rg[2] = *(const bf16x8*)(vb + (size_t)r0 * 256 + 64 * i + cc * 8);
            rg[3] = *(const bf16x8*)(vb + (size_t)(r0 + 32) * 256 + 64 * i + cc * 8);
          }
        },
        [&](int buf, bf16x8 (&rg)[4]) {
          const int nt = ldn++;
          if (pass == 1) {
#pragma unroll
            for (int i2 = 0; i2 < 2; i2++) {
              const int j = r0 + 32 * i2;
              bf16x8 ov;
#pragma unroll
              for (int x = 0; x < 8; x++) { int n = 64 * nt + cc * 8 + x; ov[x] = (n >= 4 * j - 1 && n <= 4 * j + 3) ? (short)0x3F80 : (short)0; }
              rg[2 + i2] = ov;
            }
          }
          store_kv(buf, rg);
        },
        [&](int i, int buf) {
          const bf16_t* sK = (const bf16_t*)(smem + buf * 18432);
          attn_tile<64, 64, 1>(sK, sK + 64 * 72, qf, o, m, l, c, true, true,
                               [&](int key, int qt) { return 16 * (64 * i + key) + 31 <= t0 + 16 * qt + lr; });
        });
      if (pass == 0) {
        emit(o, l, 0);
      } else {
        float inv[2];
#pragma unroll
        for (int qt = 0; qt < 2; qt++) inv[qt] = 1.f / fmaxf(l[qt], 1e-30f);
        for (int e2 = 0; e2 < 4; e2++) {
          if (wave == e2) {
#pragma unroll
            for (int dt = 0; dt < 4; dt++)
#pragma unroll
              for (int qt = 0; qt < 2; qt++)
#pragma unroll
                for (int i = 0; i < 4; i++) {
                  int j = 16 * dt + 4 * lg + i, q = 16 * qt + lr;
                  float v = o[dt][qt][i] * inv[qt];
                  if (e2 == 0) sImp[q * 65 + j] = v; else sImp[q * 65 + j] += v;
                }
          }
          __syncthreads();
        }
      }
    }
  }
  for (int qq = 0; qq < 8; qq++) {
    const int q = wave * 8 + qq;
    const int j = lane;
    float v = sImp[q * 65 + j];
    bool valid = j <= cur;
    bool forced = (j == 0) || (j == cur) || (j == cur - 1);
    float val = forced ? 1e9f : (valid ? v : -1e9f);
    int rank = 0;
#pragma unroll 16
    for (int jj = 0; jj < 64; jj++) {
      float ov = __int_as_float(__builtin_amdgcn_readlane(__float_as_int(val), jj));
      rank += ((ov > val) || (ov == val && jj < j)) ? 1 : 0;
    }
    unsigned long long mask = __ballot((rank < 16) && valid);
    if (lane == 0) sSel[q] = mask;
  }
  __syncthreads();
  unsigned long long any = 0ull;
  for (int q = 0; q < 32; q++) any |= sSel[q];
  unsigned long long mk[2];
  mk[0] = sSel[lr]; mk[1] = sSel[16 + lr];

  {
    f32x4 o[4][2]; float m[2] = {-1e30f, -1e30f}, l[2] = {0.f, 0.f};
#pragma unroll
    for (int dt = 0; dt < 4; dt++) { o[dt][0] = (f32x4){0.f, 0.f, 0.f, 0.f}; o[dt][1] = (f32x4){0.f, 0.f, 0.f, 0.f}; }
    const bf16_t* kb = p.KSC + (size_t)bg * S_LEN * 64;
    const bf16_t* vb = p.VST + (size_t)bg * 64 * S_LEN;
    const int ntiles = __popcll(any);
    int jl = 64, jc = 64;
    tile_pipeline<4>(ntiles,
      [&](int, bf16x8 (&rg)[4]) {
        jl = (jl > 0) ? next_bit_below(any, jl) : -1;
        const int jj = jl < 0 ? 0 : jl;
        rg[0] = *(const bf16x8*)(kb + (size_t)(64 * jj + r0) * 64 + cc * 8);
        rg[1] = *(const bf16x8*)(kb + (size_t)(64 * jj + r0 + 32) * 64 + cc * 8);
        rg[2] = *(const bf16x8*)(vb + (size_t)r0 * S_LEN + 64 * jj + cc * 8);
        rg[3] = *(const bf16x8*)(vb + (size_t)(r0 + 32) * S_LEN + 64 * jj + cc * 8);
      },
      store_kv,
      [&](int, int buf) {
        jc = next_bit_below(any, jc);
        const int j = jc;
        const bf16_t* sK = (const bf16_t*)(smem + buf * 18432);
        if (j == cur) {
          attn_tile<64, 64, 1>(sK, sK + 64 * 72, qf, o, m, l, c, true, true,
                               [&](int key, int qt) { return 64 * j + key <= t0 + 16 * qt + lr; });
        } else {
          attn_tile<64, 64, 0>(sK, sK + 64 * 72, qf, o, m, l, c, ((mk[0] >> j) & 1ull) != 0ull, ((mk[1] >> j) & 1ull) != 0ull,
                               [&](int, int) { return true; });
        }
      });
    emit(o, l, 1);
  }
  {
    f32x4 o[4][2]; float m[2] = {-1e30f, -1e30f}, l[2] = {0.f, 0.f};
#pragma unroll
    for (int dt = 0; dt < 4; dt++) { o[dt][0] = (f32x4){0.f, 0.f, 0.f, 0.f}; o[dt][1] = (f32x4){0.f, 0.f, 0.f, 0.f}; }
    const int jlo = (cur - 8 > 0) ? (cur - 8) : 0;
    const bf16_t* kb = p.KWC + (size_t)bg * S_LEN * 64;
    const bf16_t* vb = p.VWT + (size_t)bg * 64 * S_LEN;
    tile_pipeline<4>(cur - jlo + 1,
      [&](int i, bf16x8 (&rg)[4]) {
        const int j = cur - i;
        rg[0] = *(const bf16x8*)(kb + (size_t)(64 * j + r0) * 64 + cc * 8);
        rg[1] = *(const bf16x8*)(kb + (size_t)(64 * j + r0 + 32) * 64 + cc * 8);
        rg[2] = *(const bf16x8*)(vb + (size_t)r0 * S_LEN + 64 * j + cc * 8);
        rg[3] = *(const bf16x8*)(vb + (size_t)(r0 + 32) * S_LEN + 64 * j + cc * 8);
      },
      store_kv,
      [&](int i, int buf) {
        const int j = cur - i;
        const bf16_t* sK = (const bf16_t*)(smem + buf * 18432);
        if (j == cur || j == cur - 8) {
          attn_tile<64, 64, 1>(sK, sK + 64 * 72, qf, o, m, l, c, true, true, [&](int key, int qt) {
            int tq = t0 + 16 * qt + lr, kp = 64 * j + key;
            return (kp <= tq) && (kp > tq - 512);
          });
        } else {
          attn_tile<64, 64, 0>(sK, sK + 64 * 72, qf, o, m, l, c, true, true, [&](int, int) { return true; });
        }
      });
    emit(o, l, 2);
  }
}

__device__ void memattn_item(const Params& p, int item, char* smem) {
  const int tid = get_tid(), lane = tid & 63, wave = tid >> 6, lr = lane & 15, lg = lane >> 4;
  const int b = item >> 7, h = (item >> 5) & 3, qb = item & 31;
  const int t0 = qb * 128 + wave * 32;
  const size_t tokbase = (size_t)b * S_LEN + t0;
  bf16x8 qf[2][4];
#pragma unroll
  for (int qt = 0; qt < 2; qt++)
#pragma unroll
    for (int ks = 0; ks < 4; ks++) qf[qt][ks] = *(const bf16x8*)(p.PROJ + (tokbase + 16 * qt + lr) * NIN + C_QX + h * 128 + 32 * ks + 8 * lg);
  f32x4 o[8][2]; float m[2] = {-1e30f, -1e30f}, l[2] = {0.f, 0.f};
#pragma unroll
  for (int dt = 0; dt < 8; dt++) { o[dt][0] = (f32x4){0.f, 0.f, 0.f, 0.f}; o[dt][1] = (f32x4){0.f, 0.f, 0.f, 0.f}; }
  const float c = 0.08838834764831845f * LOG2E;
  const bf16_t* kb = p.KMEM + (size_t)b * 256 * 512 + h * 128;
  const bf16_t* vb = p.VMEMT + (size_t)(b * 4 + h) * 128 * 256;
  tile_pipeline1<8>(4,
    [&](int kt, bf16x8 (&rg)[8]) {
#pragma unroll
      for (int i = 0; i < 4; i++) {
        int ch = tid + 256 * i;
        rg[i] = *(const bf16x8*)(kb + (size_t)(64 * kt + (ch >> 4)) * 512 + (ch & 15) * 8);
        rg[4 + i] = *(const bf16x8*)(vb + (size_t)(ch >> 3) * 256 + 64 * kt + (ch & 7) * 8);
      }
    },
    [&](int buf, bf16x8 (&rg)[8]) {
      bf16_t* sK = (bf16_t*)(smem + buf * 35840);
      bf16_t* sVt = sK + 64 * 136;
#pragma unroll
      for (int i = 0; i < 4; i++) {
        int ch = tid + 256 * i;
        *(bf16x8*)(sK + (ch >> 4) * 136 + (ch & 15) * 8) = rg[i];
        *(bf16x8*)(sVt + (ch >> 3) * 72 + (ch & 7) * 8) = rg[4 + i];
      }
    },
    [&](int, int buf) {
      const bf16_t* sK = (const bf16_t*)(smem + buf * 35840);
      attn_tile<128, 128, 0>(sK, sK + 64 * 136, qf, o, m, l, c, true, true, [&](int, int) { return true; });
    });
#pragma unroll
  for (int qt = 0; qt < 2; qt++) {
    const size_t tok = tokbase + 16 * qt + lr;
    const float inv = 1.f / fmaxf(l[qt], 1e-30f);
#pragma unroll
    for (int dt = 0; dt < 8; dt++) {
      const int dbase = h * 128 + 16 * dt + 4 * lg;
      bf16x4 ga = *(const bf16x4*)(p.PROJ + tok * NIN + C_GX + dbase);
      f32x4 r = o[dt][qt];
      *(bf16x4*)(p.MIX + tok * 1536 + 1024 + dbase) =
          pack4(r[0] * inv * silu_f(bfs(ga[0])), r[1] * inv * silu_f(bfs(ga[1])), r[2] * inv * silu_f(bfs(ga[2])), r[3] * inv * silu_f(bfs(ga[3])));
    }
  }
}

__device__ void compress_item(const Params& p, int item, char* smem) {
  const int tid = get_tid(), lane = tid & 63, wave = tid >> 6, lr = lane & 15, lg = lane >> 4;
  const int which = item >> 7, rho0 = (item & 127) * 32;
  const bf16_t* W1T = which ? p.W1vT : p.W1kT;
  const bf16_t* W2T = which ? p.W2vT : p.W2kT;
  const float* pe = which ? p.cpv : p.cpk;
  const int col0 = which ? C_VC : C_KC;
  bf16_t* sA = (bf16_t*)smem;
  bf16_t* sW = sA + 32 * 72;
  bf16_t* sH = sW + 256 * 72;
  const int arow = tid >> 3, akc = tid & 7;
  const bf16_t* abase;
  {
    int rho = rho0 + arow; if (rho > 4079) rho = 4079;
    int b = rho / 510, rem = rho - b * 510, n = rem >> 1, g = rem & 1;
    abase = p.PROJ + ((size_t)b * S_LEN + 16 * n) * NIN + col0 + g * 64 + akc * 8;
  }
  const bf16_t* wbase = W1T + (size_t)arow * 2048 + akc * 8;
  f32x4 acc[2][4];
#pragma unroll
  for (int i = 0; i < 2; i++)
#pragma unroll
    for (int j = 0; j < 4; j++) acc[i][j] = (f32x4){0.f, 0.f, 0.f, 0.f};
  bf16x8 ra, rw[8];
  float4 rp0, rp1;
  auto load = [&](int kt) {
    ra = *(const bf16x8*)(abase + (size_t)kt * NIN);
    rp0 = *(const float4*)(pe + kt * 64 + akc * 8); rp1 = *(const float4*)(pe + kt * 64 + akc * 8 + 4);
#pragma unroll
    for (int i = 0; i < 8; i++) rw[i] = *(const bf16x8*)(wbase + (size_t)(32 * i) * 2048 + kt * 64);
  };
  load(0);
  for (int kt = 0; kt < 32; kt++) {
    __syncthreads();
    *(bf16x8*)(sA + arow * 72 + akc * 8) =
        pack8(bfs(ra[0]) + rp0.x, bfs(ra[1]) + rp0.y, bfs(ra[2]) + rp0.z, bfs(ra[3]) + rp0.w,
              bfs(ra[4]) + rp1.x, bfs(ra[5]) + rp1.y, bfs(ra[6]) + rp1.z, bfs(ra[7]) + rp1.w);
#pragma unroll
    for (int i = 0; i < 8; i++) *(bf16x8*)(sW + (arow + 32 * i) * 72 + akc * 8) = rw[i];
    __syncthreads();
    load(kt < 31 ? kt + 1 : 31);
#pragma unroll
    for (int ks = 0; ks < 2; ks++) {
      bf16x8 a0 = *(const bf16x8*)(sA + lr * 72 + ks * 32 + 8 * lg);
      bf16x8 a1 = *(const bf16x8*)(sA + (16 + lr) * 72 + ks * 32 + 8 * lg);
#pragma unroll
      for (int ct = 0; ct < 4; ct++) {
        bf16x8 bf = *(const bf16x8*)(sW + (64 * wave + 16 * ct + lr) * 72 + ks * 32 + 8 * lg);
        acc[0][ct] = mfma16(a0, bf, acc[0][ct]);
        acc[1][ct] = mfma16(a1, bf, acc[1][ct]);
      }
    }
  }
  __syncthreads();
#pragma unroll
  for (int rt = 0; rt < 2; rt++)
#pragma unroll
    for (int ct = 0; ct < 4; ct++)
#pragma unroll
      for (int i = 0; i < 4; i++) sH[(16 * rt + 4 * lg + i) * 264 + 64 * wave + 16 * ct + lr] = f2bf(silu_f(acc[rt][ct][i]));
  __syncthreads();
  f32x4 acc2[2] = {(f32x4){0.f, 0.f, 0.f, 0.f}, (f32x4){0.f, 0.f, 0.f, 0.f}};
#pragma unroll
  for (int ks = 0; ks < 8; ks++) {
    bf16x8 bf = *(const bf16x8*)(W2T + (size_t)(16 * wave + lr) * 256 + 32 * ks + 8 * lg);
#pragma unroll
    for (int rt = 0; rt < 2; rt++) {
      bf16x8 a = *(const bf16x8*)(sH + (16 * rt + lr) * 264 + 32 * ks + 8 * lg);
      acc2[rt] = mfma16(a, bf, acc2[rt]);
    }
  }
  const int col = 16 * wave + lr;
#pragma unroll
  for (int rt = 0; rt < 2; rt++)
#pragma unroll
    for (int i = 0; i < 4; i++) {
      int rho = rho0 + 16 * rt + 4 * lg + i;
      bool ok = rho < 4080;
      int rc = ok ? rho : 4079;
      int b = rc / 510, rem = rc - b * 510, n = rem >> 1, g = rem & 1;
      float v = acc2[rt][i];
      float pr = __shfl_xor(v, 8);
      if (which == 0) {
        if (wave == 0) {
          int pos = p.pos[b * S_LEN + 16 * n + 31];
          float cs, sn; rope_cs(pos, lr & 7, cs, sn);
          v = (lr < 8) ? (v * cs - pr * sn) : (v * cs + pr * sn);
        }
        if (ok) p.KCMP[((size_t)(b * 2 + g) * 256 + n) * 64 + col] = f2bf(v);
      } else {
        if (ok) p.VCMPT[((size_t)(b * 2 + g) * 64 + col) * 256 + n] = f2bf(v);
      }
    }
}

__device__ void conv_units(const Params& p, int u) {
  const int it = u >> 8, wvi = (u >> 6) & 3, ln = u & 63;
  const int cgp = ((it & 3) * 4 + wvi) * 8 + (ln >> 3), tg = (it >> 2) * 8 + (ln & 7);
  const int tok0 = tg * 8, s0 = tok0 & 4095, ch0 = cgp * 8;
  const int b = tok0 >> 12;
  bf16x8 in[11];
#pragma unroll
  for (int r = 0; r < 11; r++) {
    int s = s0 - 3 + r;
    if (s >= 0) in[r] = *(const bf16x8*)(p.PROJ + (size_t)(tok0 - 3 + r) * NIN + C_XBC + ch0);
    else in[r] = (bf16x8){0, 0, 0, 0, 0, 0, 0, 0};
  }
  float4 wv[4][2];
#pragma unroll
  for (int k = 0; k < 4; k++) { wv[k][0] = *(const float4*)(p.conv_w + k * 1024 + ch0); wv[k][1] = *(const float4*)(p.conv_w + k * 1024 + ch0 + 4); }
  float4 bv0 = *(const float4*)(p.conv_b + ch0), bv1 = *(const float4*)(p.conv_b + ch0 + 4);
  float w[4][8], bias[8];
#pragma unroll
  for (int k = 0; k < 4; k++) { w[k][0] = wv[k][0].x; w[k][1] = wv[k][0].y; w[k][2] = wv[k][0].z; w[k][3] = wv[k][0].w; w[k][4] = wv[k][1].x; w[k][5] = wv[k][1].y; w[k][6] = wv[k][1].z; w[k][7] = wv[k][1].w; }
  bias[0] = bv0.x; bias[1] = bv0.y; bias[2] = bv0.z; bias[3] = bv0.w; bias[4] = bv1.x; bias[5] = bv1.y; bias[6] = bv1.z; bias[7] = bv1.w;
  if (ch0 >= 512) {
#pragma unroll
    for (int tt = 0; tt < 8; tt++) {
      bf16x8 o;
#pragma unroll
      for (int j = 0; j < 8; j++) {
        float a = bias[j];
#pragma unroll
        for (int k = 0; k < 4; k++) a += bfs(in[tt + k][j]) * w[k][j];
        o[j] = (short)f2bf(silu_f(a));
      }
      *(bf16x8*)(p.BC + (size_t)(tok0 + tt) * 512 + (ch0 - 512)) = o;
    }
  }
  if (ch0 < 768) {
#pragma unroll
    for (int j = 0; j < 8; j++) {
      bf16x8 o;
#pragma unroll
      for (int tt = 0; tt < 8; tt++) {
        float a = bias[j];
#pragma unroll
        for (int k = 0; k < 4; k++) a += bfs(in[tt + k][j]) * w[k][j];
        o[tt] = (short)f2bf(silu_f(a));
      }
      const int ch = ch0 + j;
      bf16_t* dst;
      if (ch0 < 512) dst = p.XT + ((size_t)(b * 8 + (ch >> 6)) * 64 + (ch & 63)) * S_LEN + s0;
      else dst = p.BT + ((size_t)(b * 2 + ((ch - 512) >> 7)) * 128 + ((ch - 512) & 127)) * S_LEN + s0;
      *(bf16x8*)dst = o;
    }
  }
}

__device__ void ssd_states_item(const Params& p, int item, char* smem) {
  const int tid = get_tid(), lane = tid & 63, wave = tid >> 6, lr = lane & 15, lg = lane >> 4;
  const int h = item & 7, c = (item >> 3) & 31, b = item >> 8;
  const int g = h >> 2;
  bf16_t* sX = (bf16_t*)smem;
  bf16_t* sBt = sX + 64 * 136;
  float* sAcs = (float*)(smem + (64 + 128) * 136 * 2);
  float* sW = sAcs + 128;
  float* sTot = sW + 128;
  const size_t tok0 = (size_t)b * S_LEN + c * 128;
  const bf16_t* xt = p.XT + (size_t)(b * 8 + h) * 64 * S_LEN + c * 128;
  const bf16_t* bt = p.BT + (size_t)(b * 2 + g) * 128 * S_LEN + c * 128;
  __syncthreads();
  bf16x8 tx[4], tb[8];
#pragma unroll
  for (int i = 0; i < 4; i++) { int ch = tid + 256 * i; tx[i] = *(const bf16x8*)(xt + (size_t)(ch >> 4) * S_LEN + (ch & 15) * 8); }
#pragma unroll
  for (int i = 0; i < 8; i++) { int ch = tid + 256 * i; tb[i] = *(const bf16x8*)(bt + (size_t)(ch >> 4) * S_LEN + (ch & 15) * 8); }
  float dt = 0.f, cs = 0.f;
  if (tid < 128) {
    float raw = bf2f(p.PROJ[(tok0 + tid) * NIN + C_DT + h]) + p.dt_bias[h];
    dt = fmaxf(raw, 0.f) + log1pf(__expf(-fabsf(raw)));
    float a = -__expf(p.a_log[h]);
    cs = dt * a;
#pragma unroll
    for (int o = 1; o < 64; o <<= 1) { float t = __shfl_up(cs, o); if (lane >= o) cs += t; }
    if (lane == 63) sTot[wave] = cs;
  }
  __syncthreads();
  if (tid < 128) {
    if (wave == 1) cs += sTot[0];
    sAcs[tid] = cs;
  }
  __syncthreads();
  if (tid < 128) {
    float last = sAcs[127];
    sW[tid] = dt * __expf(last - cs);
    const size_t o = ((size_t)(b * 32 + c) * 8 + h) * 128 + tid;
    p.ACS[o] = cs; p.DTV[o] = dt;
    if (tid == 0) p.CHDEC[(b * 32 + c) * 8 + h] = __expf(last);
  }
#pragma unroll
  for (int i = 0; i < 8; i++) { int ch = tid + 256 * i; *(bf16x8*)(sBt + (ch >> 4) * 136 + (ch & 15) * 8) = tb[i]; }
  __syncthreads();
#pragma unroll
  for (int i = 0; i < 4; i++) {
    int ch = tid + 256 * i;
    const int l0 = (ch & 15) * 8;
    float4 w0 = *(const float4*)(sW + l0), w1 = *(const float4*)(sW + l0 + 4);
    bf16x8 r = tx[i];
    *(bf16x8*)(sX + (ch >> 4) * 136 + l0) = pack8(bfs(r[0]) * w0.x, bfs(r[1]) * w0.y, bfs(r[2]) * w0.z, bfs(r[3]) * w0.w,
                                                  bfs(r[4]) * w1.x, bfs(r[5]) * w1.y, bfs(r[6]) * w1.z, bfs(r[7]) * w1.w);
  }
  __syncthreads();
  f32x4 acc[4][2];
#pragma unroll
  for (int i = 0; i < 4; i++) { acc[i][0] = (f32x4){0.f, 0.f, 0.f, 0.f}; acc[i][1] = (f32x4){0.f, 0.f, 0.f, 0.f}; }
#pragma unroll
  for (int ks = 0; ks < 4; ks++) {
    const int l0 = 32 * ks + 8 * lg;
    bf16x8 bf0 = *(const bf16x8*)(sBt + (32 * wave + lr) * 136 + l0);
    bf16x8 bf1 = *(const bf16x8*)(sBt + (32 * wave + 16 + lr) * 136 + l0);
#pragma unroll
    for (int pt = 0; pt < 4; pt++) {
      bf16x8 a = *(const bf16x8*)(sX + (16 * pt + lr) * 136 + l0);
      acc[pt][0] = mfma16(a, bf0, acc[pt][0]);
      acc[pt][1] = mfma16(a, bf1, acc[pt][1]);
    }
  }
  bf16_t* st = (bf16_t*)p.STATES + ((size_t)(b * 32 + c) * 8 + h) * 8192;
#pragma unroll
  for (int pt = 0; pt < 4; pt++)
#pragma unroll
    for (int x = 0; x < 2; x++)
#pragma unroll
      for (int i = 0; i < 4; i++) st[(16 * pt + 4 * lg + i) * 128 + 32 * wave + 16 * x + lr] = f2bf(acc[pt][x][i]);
}

__device__ void scan_units(const Params& p, int q) {
  const int b = q >> 15, r2 = q & 32767, h = r2 >> 12;
  uint32_t* sw = (uint32_t*)p.STATES;
  float h0 = 0.f, h1 = 0.f;
  for (int c0 = 0; c0 < 32; c0 += 16) {
    uint32_t s[16]; float d[16];
#pragma unroll
    for (int i = 0; i < 16; i++) { s[i] = sw[(size_t)(b * 32 + c0 + i) * 32768 + r2]; d[i] = p.CHDEC[(b * 32 + c0 + i) * 8 + h]; }
#pragma unroll
    for (int i = 0; i < 16; i++) {
      sw[(size_t)(b * 32 + c0 + i) * 32768 + r2] = pk2(h0, h1);
      h0 = h0 * d[i] + __uint_as_float(s[i] << 16);
      h1 = h1 * d[i] + __uint_as_float(s[i] & 0xffff0000u);
    }
  }
}

__device__ void ssd_y_item(const Params& p, int item, char* smem) {
  const int tid = get_tid(), lane = tid & 63, wave = tid >> 6, lr = lane & 15, lg = lane >> 4;
  const int h = item & 7, c = (item >> 3) & 31, b = item >> 8;
  const int g = h >> 2;
  bf16_t* sB = (bf16_t*)smem;
  bf16_t* sXT = sB + 128 * 136;
  float* sAcs = (float*)(smem + (128 + 64) * 136 * 2);
  float* sDt = sAcs + 128;
  bf16_t* sPrev = (bf16_t*)(smem + (128 + 64) * 136 * 2 + 1024);
  const size_t tok0 = (size_t)b * S_LEN + c * 128;
  const bf16_t* xt = p.XT + (size_t)(b * 8 + h) * 64 * S_LEN + c * 128;
  const int LT[2] = {wave, 7 - wave};
  const bf16_t* prev = (const bf16_t*)p.STATES + ((size_t)(b * 32 + c) * 8 + h) * 8192;
  __syncthreads();
  {
    bf16x8 tb[8], tx[4];
    bf16x8 tp[4];
#pragma unroll
    for (int i = 0; i < 4; i++) { int ch = tid + 256 * i; tp[i] = *(const bf16x8*)(prev + (ch >> 4) * 128 + (ch & 15) * 8); }
#pragma unroll
    for (int i = 0; i < 8; i++) { int ch = tid + 256 * i; tb[i] = *(const bf16x8*)(p.BC + (tok0 + (ch >> 4)) * 512 + g * 128 + (ch & 15) * 8); }
#pragma unroll
    for (int i = 0; i < 4; i++) { int ch = tid + 256 * i; tx[i] = *(const bf16x8*)(xt + (size_t)(ch >> 4) * S_LEN + (ch & 15) * 8); }
    if (tid < 128) {
      const size_t o = ((size_t)(b * 32 + c) * 8 + h) * 128 + tid;
      sAcs[tid] = p.ACS[o]; sDt[tid] = p.DTV[o];
    }
#pragma unroll
    for (int i = 0; i < 8; i++) { int ch = tid + 256 * i; *(bf16x8*)(sB + (ch >> 4) * 136 + (ch & 15) * 8) = tb[i]; }
#pragma unroll
    for (int i = 0; i < 4; i++) { int ch = tid + 256 * i; *(bf16x8*)(sXT + (ch >> 4) * 136 + (ch & 15) * 8) = tx[i]; }
#pragma unroll
    for (int i = 0; i < 4; i++) { int ch = tid + 256 * i; *(bf16x8*)(sPrev + (ch >> 4) * 136 + (ch & 15) * 8) = tp[i]; }
  }
  bf16x8 cf[2][4];
  bf16x4 zpre[2][4];
#pragma unroll
  for (int li = 0; li < 2; li++) {
#pragma unroll
    for (int ks = 0; ks < 4; ks++)
      cf[li][ks] = *(const bf16x8*)(p.BC + (tok0 + 16 * LT[li] + lr) * 512 + 256 + g * 128 + 32 * ks + 8 * lg);
#pragma unroll
    for (int pt = 0; pt < 4; pt++)
      zpre[li][pt] = *(const bf16x4*)(p.PROJ + (tok0 + 16 * LT[li] + lr) * NIN + C_Z + h * 64 + 16 * pt + 4 * lg);
  }
  f32x4 acc[4][2];
#pragma unroll
  for (int i = 0; i < 4; i++) { acc[i][0] = (f32x4){0.f, 0.f, 0.f, 0.f}; acc[i][1] = (f32x4){0.f, 0.f, 0.f, 0.f}; }
  __syncthreads();
#pragma unroll
  for (int pt = 0; pt < 4; pt++)
#pragma unroll
    for (int ks = 0; ks < 4; ks++) {
      bf16x8 a = *(const bf16x8*)(sPrev + (16 * pt + lr) * 136 + 32 * ks + 8 * lg);
      acc[pt][0] = mfma16(a, cf[0][ks], acc[pt][0]);
      acc[pt][1] = mfma16(a, cf[1][ks], acc[pt][1]);
    }
#pragma unroll
  for (int li = 0; li < 2; li++) {
    float e = __expf(sAcs[16 * LT[li] + lr]);
#pragma unroll
    for (int pt = 0; pt < 4; pt++) { acc[pt][li][0] *= e; acc[pt][li][1] *= e; acc[pt][li][2] *= e; acc[pt][li][3] *= e; }
  }
#pragma unroll
  for (int li = 0; li < 2; li++) {
    const int lt = LT[li];
    const int lpos = 16 * lt + lr;
    const float acl = sAcs[lpos];
    for (int sp = 0; sp <= (lt >> 1); sp++) {
      f32x4 cb[2] = {(f32x4){0.f, 0.f, 0.f, 0.f}, (f32x4){0.f, 0.f, 0.f, 0.f}};
#pragma unroll
      for (int x = 0; x < 2; x++)
#pragma unroll
        for (int ks = 0; ks < 4; ks++) {
          bf16x8 bfr = *(const bf16x8*)(sB + (32 * sp + 16 * x + lr) * 136 + 32 * ks + 8 * lg);
          cb[x] = mfma16(bfr, cf[li][ks], cb[x]);
        }
      float mv[8];
#pragma unroll
      for (int x = 0; x < 2; x++)
#pragma unroll
        for (int i = 0; i < 4; i++) {
          const int s = 32 * sp + 16 * x + 4 * lg + i;
          mv[4 * x + i] = (s <= lpos) ? cb[x][i] * __expf(acl - sAcs[s]) * sDt[s] : 0.f;
        }
      bf16x8 mb = pack8(mv[0], mv[1], mv[2], mv[3], mv[4], mv[5], mv[6], mv[7]);
#pragma unroll
      for (int pt = 0; pt < 4; pt++) {
        const bf16_t* xp = sXT + (16 * pt + lr) * 136 + 32 * sp + 4 * lg;
        bf16x8 a = cat44(*(const bf16x4*)xp, *(const bf16x4*)(xp + 16));
        acc[pt][li] = mfma16(a, mb, acc[pt][li]);
      }
    }
  }
  const float dsk = p.d_skip[h];
#pragma unroll
  for (int li = 0; li < 2; li++) {
    const int lpos = 16 * LT[li] + lr;
    const size_t tok = tok0 + lpos;
    float ss = 0.f;
#pragma unroll
    for (int pt = 0; pt < 4; pt++) {
      const int pb = 16 * pt + 4 * lg;
      bf16x4 zv = zpre[li][pt];
      float y[4];
#pragma unroll
      for (int i = 0; i < 4; i++) {
        float xv = bf2f(sXT[(pb + i) * 136 + lpos]);
        y[i] = (acc[pt][li][i] + dsk * xv) * silu_f(bfs(zv[i]));
        ss += y[i] * y[i];
      }
      *(bf16x4*)(p.MIX + tok * 1536 + 512 + h * 64 + pb) = pack4(y[0], y[1], y[2], y[3]);
    }
    ss += __shfl_xor(ss, 16); ss += __shfl_xor(ss, 32);
    if (lg == 0) p.SS_SSD[tok * 8 + h] = ss;
  }
}

__device__ void final_rows(const Params& p, int gw, int nw) {
  const int lane = threadIdx.x & 63;
  for (int row = gw; row < T_TOK; row += nw) {
    float r = rsqrtf(p.SS_OUT[row] * (1.f / 1024.f) + 1e-6f);
    float4* o = (float4*)(p.out + (size_t)row * 1024);
    const float4* gf = (const float4*)p.g_final;
#pragma unroll
    for (int i = 0; i < 4; i++) {
      float4 v = o[lane + 64 * i], gg = gf[lane + 64 * i];
      v.x *= r * gg.x; v.y *= r * gg.y; v.z *= r * gg.z; v.w *= r * gg.w;
      o[lane + 64 * i] = v;
    }
  }
}

__device__ __forceinline__ void grid_bar(unsigned* bar, unsigned k) {
  asm volatile("s_waitcnt vmcnt(0)" ::: "memory");
  __syncthreads();
  if (threadIdx.x == 0) {
    const unsigned nb = gridDim.x, r = blockIdx.x & 7u;
    const unsigned nsub = (nb - r + 7u) >> 3;
    const unsigned ngrp = nb < 8u ? nb : 8u;
    __builtin_amdgcn_fence(__ATOMIC_RELEASE, "agent");
    asm volatile("s_waitcnt vmcnt(0)" ::: "memory");
    const unsigned old = __hip_atomic_fetch_add(bar + 64 * r, 1u, __ATOMIC_RELAXED, __HIP_MEMORY_SCOPE_AGENT);
    if (old + 1u == k * nsub) {
      __builtin_amdgcn_fence(__ATOMIC_ACQ_REL, "agent");
      asm volatile("s_waitcnt vmcnt(0)" ::: "memory");
      __hip_atomic_fetch_add(bar + 64 * 8, 1u, __ATOMIC_RELAXED, __HIP_MEMORY_SCOPE_AGENT);
    }
    while (__hip_atomic_load(bar + 64 * 8, __ATOMIC_RELAXED, __HIP_MEMORY_SCOPE_AGENT) < k * ngrp) __builtin_amdgcn_s_sleep(1);
    __builtin_amdgcn_fence(__ATOMIC_ACQUIRE, "agent");
    asm volatile("s_waitcnt vmcnt(0)" ::: "memory");
  }
  __syncthreads();
}

__device__ __forceinline__ int next_item(unsigned* ctr, char* smem) {
  int* sh = (int*)(smem + SMEM_BYTES - 16);
  __syncthreads();
  if (threadIdx.x == 0) *sh = (int)__hip_atomic_fetch_add(ctr, 1u, __ATOMIC_RELAXED, __HIP_MEMORY_SCOPE_AGENT);
  __syncthreads();
  return *sh;
}

__global__ void __launch_bounds__(256, 2) hymba_fwd(Params p) {
  cg::grid_group grid = cg::this_grid();
  __shared__ __attribute__((aligned(16))) char smem[SMEM_BYTES];
  const int nb = gridDim.x, bid = blockIdx.x;
  unsigned bk = 0;

  if (p.out == nullptr) grid.sync();
  for (int rep = 0; rep < REP0; rep++) {
  phase_prep(p);
  grid_bar(p.BAR, ++bk);
  }
  for (int rep = 0; rep < REP1; rep++) {
  if ((nb & 7) == 0) {
    const int xcd = bid & 7, li = bid >> 3, nbx = nb >> 3;
    for (int e = li; e < 1120; e += nbx) {
      const int grp = e / 280, r = e - grp * 280;
      gemm_tile<0>(p, xcd * 32 + grp * 8 + (r & 7), r >> 3, smem);
    }
  } else {
    for (int it = bid; it < 256 * 35; it += nb) gemm_tile<0>(p, it / 35, it % 35, smem);
  }
  for (int j = bid; j < 128; j += nb) gemm_tile<1>(p, j >> 3, j & 7, smem);
  grid_bar(p.BAR, ++bk);
  }
  for (int rep = 0; rep < REP2; rep++) {
  for (int it = next_item(p.BAR + 64 * (9 + rep), smem); it < 256 + 1024 + 2048; it = next_item(p.BAR + 64 * (9 + rep), smem)) {
    if (it < 256) compress_item(p, it, smem);
    else if (it < 1280) memattn_item(p, it - 256, smem);
    else conv_units(p, (it - 1280) * 256 + get_tid());
  }
  grid_bar(p.BAR, ++bk);
  }
  for (int rep = 0; rep < REP3; rep++) {
  {
    const int xq = bid & 7;
    unsigned* ctr = p.BAR + 64 * (16 + xq + 8 * rep);
    for (int li = next_item(ctr, smem); li < 512; li = next_item(ctr, smem)) {
      if (li < 256) ssd_states_item(p, li * 8 + xq, smem);
      else { const int l2 = li - 256; nsa_item(p, ((l2 >> 1) << 4) | (xq + 8 * (l2 & 1)), smem); }
    }
  }
  grid_bar(p.BAR, ++bk);
  }
  for (int it = bid; it < 1024; it += nb) scan_units(p, it * 256 + get_tid());
  grid_bar(p.BAR, ++bk);
  for (int rep = 0; rep < REP5; rep++) {
  for (int it = bid; it < 2048; it += nb) ssd_y_item(p, it, smem);
  grid_bar(p.BAR, ++bk);
  }
  if ((nb & 7) == 0) {
    const int xcd = bid & 7, li = bid >> 3, nbx = nb >> 3;
    for (int e = li; e < 256; e += nbx) gemm_tile<2>(p, xcd * 32 + (e >> 3), e & 7, smem);
  } else {
    for (int it = bid; it < 256 * 8; it += nb) gemm_tile<2>(p, it >> 3, it & 7, smem);
  }
  grid_bar(p.BAR, ++bk);
  final_rows(p, (bid * 256 + threadIdx.x) >> 6, (nb * 256) >> 6);
}

extern "C" void kernel_launch(void* const* d_in, const int* in_sizes, int n_in, void* d_out, int out_size, void* d_ws, size_t ws_size,
                              hipStream_t stream) {
  static int grid_blocks = 0;
  if (!grid_blocks) {
    int dev = 0, cus = 0, per_cu = 0;
    hipGetDevice(&dev);
    hipDeviceGetAttribute(&cus, hipDeviceAttributeMultiprocessorCount, dev);
    hipOccupancyMaxActiveBlocksPerMultiprocessor(&per_cu, hymba_fwd, 256, 0);
    if (per_cu < 1) per_cu = 1;
    if (per_cu > 4) per_cu = 4;
    grid_blocks = cus * per_cu;
  }
  Params p{};
  p.x = (const float*)d_in[0]; p.mem = (const float*)d_in[1]; p.pos = (const int*)d_in[2];
  p.g_in = (const float*)d_in[3]; p.w_in = (const float*)d_in[4]; p.cpk = (const float*)d_in[5];
  p.w1k = (const float*)d_in[6]; p.w2k = (const float*)d_in[7]; p.cpv = (const float*)d_in[8];
  p.w1v = (const float*)d_in[9]; p.w2v = (const float*)d_in[10]; p.conv_w = (const float*)d_in[11];
  p.conv_b = (const float*)d_in[12]; p.dt_bias = (const float*)d_in[13]; p.a_log = (const float*)d_in[14];
  p.d_skip = (const float*)d_in[15]; p.g_ssd = (const float*)d_in[16]; p.g_mem = (const float*)d_in[17];
  p.w_kv = (const float*)d_in[18]; p.w_out = (const float*)d_in[19]; p.g_final = (const float*)d_in[20];
  p.out = (float*)d_out;
  char* w = (char*)d_ws; size_t off = 0;
  auto take = [&](size_t bytes) { char* r = w + off; off += (bytes + 255) & ~(size_t)255; return r; };
  p.WinT = (bf16_t*)take((size_t)NINP * 1024 * 2);
  p.WoutT = (bf16_t*)take((size_t)1024 * 1536 * 2);
  p.WkvT = (bf16_t*)take((size_t)1024 * 1024 * 2);
  p.W1kT = (bf16_t*)take((size_t)256 * 2048 * 2);
  p.W1vT = (bf16_t*)take((size_t)256 * 2048 * 2);
  p.W2kT = (bf16_t*)take((size_t)64 * 256 * 2);
  p.W2vT = (bf16_t*)take((size_t)64 * 256 * 2);
  p.MEMB = (bf16_t*)take((size_t)2048 * 1024 * 2);
  p.PROJ = (bf16_t*)take((size_t)T_TOK * NIN * 2);
  p.VST = (bf16_t*)take((size_t)16 * 64 * S_LEN * 2);
  p.VWT = (bf16_t*)take((size_t)16 * 64 * S_LEN * 2);
  p.KMEM = (bf16_t*)take((size_t)2048 * 512 * 2);
  p.VMEMT = (bf16_t*)take((size_t)32 * 128 * 256 * 2);
  p.KCMP = (bf16_t*)take((size_t)16 * 256 * 64 * 2);
  p.VCMPT = (bf16_t*)take((size_t)16 * 64 * 256 * 2);
  p.XT = (bf16_t*)take((size_t)64 * 64 * S_LEN * 2);
  p.BC = (bf16_t*)take((size_t)T_TOK * 512 * 2);
  p.BT = (bf16_t*)take((size_t)16 * 128 * S_LEN * 2);
  p.MIX = (bf16_t*)take((size_t)T_TOK * 1536 * 2);
  p.XB = p.MIX;
  p.CHDEC = (float*)take((size_t)8 * 32 * 8 * 4);
  p.ACS = (float*)take((size_t)8 * 32 * 8 * 128 * 4);
  p.DTV = (float*)take((size_t)8 * 32 * 8 * 128 * 4);
  p.SS_SSD = (float*)take((size_t)T_TOK * 8 * 4);
  p.SS_OUT = (float*)take((size_t)T_TOK * 4);
  p.BAR = (unsigned*)take((size_t)(64 * 32 + 256) * 4);
  p.MTCNT = p.BAR + 64 * 32;
  p.STATES = (float*)d_out;
  p.KSC = (bf16_t*)((char*)d_out + (size_t)80 * 1024 * 1024);
  p.KWC = p.KSC + (size_t)16 * S_LEN * 64;
  if (off > ws_size) { fprintf(stderr, "workspace too small: need %zu have %zu\n", off, ws_size); return; }
  hipMemsetAsync(p.BAR, 0, (64 * 32 + 256) * 4, stream);
  void* args[] = {&p};
  hipError_t e = hipLaunchCooperativeKernel((void*)hymba_fwd, dim3(grid_blocks), dim3(256), args, 0, stream);
  if (e != hipSuccess) fprintf(stderr, "cooperative launch failed: %s (grid %d)\n", hipGetErrorString(e), grid_blocks);
}
```

```cpp
#include <hip/hip_runtime.h>
#include <hip/hip_cooperative_groups.h>
#include <stdint.h>
#include <stdio.h>
namespace cg = cooperative_groups;

typedef unsigned short bf16_t;
typedef __attribute__((ext_vector_type(8))) short bf16x8;
typedef __attribute__((ext_vector_type(4))) short bf16x4;
typedef __attribute__((ext_vector_type(4))) float f32x4;

#define S_LEN 4096
#define T_TOK 32768
#define NIN 4384
#define NINP 4480
#define LOG2E 1.4426950408889634f

#define C_Q 0
#define C_KC 512
#define C_VC 640
#define C_KS 768
#define C_KW 1024
#define C_GL 1280
#define C_GA 1304
#define C_Z 1816
#define C_XBC 2328
#define C_DT 3352
#define C_QX 3360
#define C_GX 3872

#define SMEM_BYTES 73728
#ifndef REP0
#define REP0 1
#endif
#ifndef REP1
#define REP1 1
#endif
#ifndef REP2
#define REP2 1
#endif
#ifndef REP3
#define REP3 1
#endif
#ifndef REP5
#define REP5 1
#endif

struct Params {
  const float *x, *mem; const int* pos;
  const float *g_in, *w_in, *cpk, *w1k, *w2k, *cpv, *w1v, *w2v, *conv_w, *conv_b, *dt_bias, *a_log, *d_skip, *g_ssd, *g_mem, *w_kv, *w_out, *g_final;
  float* out;
  bf16_t *WinT, *WoutT, *WkvT, *W1kT, *W1vT, *W2kT, *W2vT, *XB, *MEMB, *PROJ, *VST, *VWT, *KMEM, *VMEMT, *KCMP, *VCMPT, *XT, *BC, *BT, *MIX, *KSC, *KWC;
  float *STATES, *CHDEC, *ACS, *DTV, *SS_SSD, *SS_OUT;
  unsigned* BAR;
  unsigned* MTCNT;
};

__device__ __forceinline__ bf16_t f2bf(float f) { uint32_t u = __float_as_uint(f); u += 0x7fffu + ((u >> 16) & 1u); return (bf16_t)(u >> 16); }
__device__ __forceinline__ float bf2f(bf16_t h) { return __uint_as_float(((uint32_t)h) << 16); }
__device__ __forceinline__ float bfs(short h) { return __uint_as_float(((uint32_t)(unsigned short)h) << 16); }
__device__ __forceinline__ float fexp2(float x) { return __builtin_amdgcn_exp2f(x); }
__device__ __forceinline__ float silu_f(float x) { return x * __builtin_amdgcn_rcpf(1.f + __builtin_amdgcn_exp2f(-1.4426950408889634f * x)); }
__device__ __forceinline__ float sigmoid_f(float x) { return __builtin_amdgcn_rcpf(1.f + __builtin_amdgcn_exp2f(-1.4426950408889634f * x)); }
__device__ __forceinline__ f32x4 mfma16(bf16x8 a, bf16x8 b, f32x4 c) { return __builtin_amdgcn_mfma_f32_16x16x32_bf16(a, b, c, 0, 0, 0); }
typedef __bf16 hbf2_t __attribute__((ext_vector_type(2)));
typedef float f2_t __attribute__((ext_vector_type(2)));
typedef uint32_t u32x2 __attribute__((ext_vector_type(2)));
typedef uint32_t u32x4 __attribute__((ext_vector_type(4)));
__device__ __forceinline__ uint32_t pk2(float a, float b) {
  f2_t v; v[0] = a; v[1] = b;
  hbf2_t r = __builtin_convertvector(v, hbf2_t);
  return __builtin_bit_cast(uint32_t, r);
}
__device__ __forceinline__ bf16x4 pack4(float a, float b, float c, float d) {
  u32x2 r; r[0] = pk2(a, b); r[1] = pk2(c, d); return __builtin_bit_cast(bf16x4, r);
}
__device__ __forceinline__ bf16x8 pack8(float a, float b, float c, float d, float e, float f, float g, float h) {
  u32x4 r; r[0] = pk2(a, b); r[1] = pk2(c, d); r[2] = pk2(e, f); r[3] = pk2(g, h); return __builtin_bit_cast(bf16x8, r);
}
__device__ __forceinline__ bf16x8 cat44(bf16x4 a, bf16x4 b) {
  u32x2 x = __builtin_bit_cast(u32x2, a), y = __builtin_bit_cast(u32x2, b);
  u32x4 r; r[0] = x[0]; r[1] = x[1]; r[2] = y[0]; r[3] = y[1]; return __builtin_bit_cast(bf16x8, r);
}
template <int NR, typename L, typename ST, typename C>
__device__ __forceinline__ void tile_pipeline(int n, L load, ST store, C compute) {
  if (n <= 0) return;
  bf16x8 ra[NR], rb[NR];
  const int last = n - 1;
  load(0, ra);
  load(min(1, last), rb);
  store(0, ra);
  load(min(2, last), ra);
  __syncthreads();
  for (int i = 0; i < n; i += 2) {
    compute(i, 0);
    store(1, rb);
    load(min(i + 3, last), rb);
    __syncthreads();
    if (i + 1 < n) compute(i + 1, 1);
    store(0, ra);
    load(min(i + 4, last), ra);
    __syncthreads();
  }
}
template <int NR, typename L, typename ST, typename C>
__device__ __forceinline__ void tile_pipeline1(int n, L load, ST store, C compute) {
  if (n <= 0) return;
  bf16x8 ra[NR];
  load(0, ra);
  store(0, ra);
  if (n > 1) load(1, ra);
  __syncthreads();
  for (int i = 0; i < n; i++) {
    compute(i, i & 1);
    if (i + 1 < n) { store((i + 1) & 1, ra); if (i + 2 < n) load(i + 2, ra); }
    __syncthreads();
  }
}
__device__ __forceinline__ void rope_cs(int pos, int j, float& cs, float& sn) {
  float inv = fexp2(-(float)j * (18.931568569324174f / 8.f));
  float a = (float)pos * inv;
  float n = rintf(a * 0.15915494309189535f);
  float r = fmaf(-n, 6.28125f, a);
  r = fmaf(-n, 1.9353071795864769e-3f, r);
  cs = __cosf(r); sn = __sinf(r);
}

__device__ __forceinline__ float rowmax4(float x) {
  unsigned xi = __float_as_uint(x);
  auto a = __builtin_amdgcn_permlane16_swap(xi, xi, false, false);
  float m = fmaxf(__uint_as_float(a[0]), __uint_as_float(a[1]));
  unsigned mi = __float_as_uint(m);
  auto b = __builtin_amdgcn_permlane32_swap(mi, mi, false, false);
  return fmaxf(__uint_as_float(b[0]), __uint_as_float(b[1]));
}
__device__ __forceinline__ float rowsum4(float x) {
  unsigned xi = __float_as_uint(x);
  auto a = __builtin_amdgcn_permlane16_swap(xi, xi, false, false);
  float m = __uint_as_float(a[0]) + __uint_as_float(a[1]);
  unsigned mi = __float_as_uint(m);
  auto b = __builtin_amdgcn_permlane32_swap(mi, mi, false, false);
  return __uint_as_float(b[0]) + __uint_as_float(b[1]);
}
__device__ __forceinline__ int get_tid() { int t = threadIdx.x; asm volatile("" : "+v"(t)); return t; }

__device__ void prep_rows(const float* __restrict__ x, bf16_t* __restrict__ xb, int nrows, int gw, int nw) {
  const int lane = threadIdx.x & 63;
  int row = gw;
  for (; row + 3 * nw < nrows; row += 4 * nw) {
    float4 v[4][4]; float ss[4];
#pragma unroll
    for (int r = 0; r < 4; r++) {
      const float4* p = (const float4*)(x + (size_t)(row + r * nw) * 1024);
#pragma unroll
      for (int i = 0; i < 4; i++) v[r][i] = p[lane + 64 * i];
    }
#pragma unroll
    for (int r = 0; r < 4; r++) {
      float s = 0.f;
#pragma unroll
      for (int i = 0; i < 4; i++) s += v[r][i].x * v[r][i].x + v[r][i].y * v[r][i].y + v[r][i].z * v[r][i].z + v[r][i].w * v[r][i].w;
#pragma unroll
      for (int o = 32; o >= 1; o >>= 1) s += __shfl_xor(s, o);
      ss[r] = rsqrtf(s * (1.f / 1024.f) + 1e-6f);
    }
#pragma unroll
    for (int r = 0; r < 4; r++)
#pragma unroll
      for (int i = 0; i < 4; i++)
        *(bf16x4*)(xb + (size_t)(row + r * nw) * 1024 + (lane + 64 * i) * 4) =
            pack4(v[r][i].x * ss[r], v[r][i].y * ss[r], v[r][i].z * ss[r], v[r][i].w * ss[r]);
  }
  for (; row < nrows; row += nw) {
    const float4* p = (const float4*)(x + (size_t)row * 1024);
    float4 v[4]; float ss = 0.f;
#pragma unroll
    for (int i = 0; i < 4; i++) { v[i] = p[lane + 64 * i]; ss += v[i].x * v[i].x + v[i].y * v[i].y + v[i].z * v[i].z + v[i].w * v[i].w; }
#pragma unroll
    for (int o = 32; o >= 1; o >>= 1) ss += __shfl_xor(ss, o);
    float r = rsqrtf(ss * (1.f / 1024.f) + 1e-6f);
#pragma unroll
    for (int i = 0; i < 4; i++) {
      bf16x4 o = pack4(v[i].x * r, v[i].y * r, v[i].z * r, v[i].w * r);
      *(bf16x4*)(xb + (size_t)row * 1024 + (lane + 64 * i) * 4) = o;
    }
  }
}

__device__ void prep_wT(const float* __restrict__ w, const float* __restrict__ g, int gk0, int gk1, bf16_t* __restrict__ wt,
                        int K, int N, int Npad, int gtid, int gthreads) {
  const int ln = gtid & 63, gwv = gtid >> 6, nwv = gthreads >> 6;
  const int kblocks = K >> 6;
  const int total = (Npad >> 3) * kblocks;
  for (int uw = gwv; uw < total; uw += nwv) {
    const int kb = uw % kblocks, nbk = uw / kblocks;
    const int n = nbk * 8 + (ln >> 3), k8 = kb * 8 + (ln & 7);
    bf16x8 o;
#pragma unroll
    for (int j = 0; j < 8; j++) {
      int k = k8 * 8 + j; float v = 0.f;
      if (n < N) { v = w[(size_t)k * N + n]; if (g != nullptr && k >= gk0 && k < gk1) v *= g[k - gk0]; }
      o[j] = (short)f2bf(v);
    }
    *(bf16x8*)(wt + (size_t)n * K + k8 * 8) = o;
  }
}

__device__ void phase_prep(const Params& p) {
  const int gtid = blockIdx.x * 256 + threadIdx.x, gthreads = gridDim.x * 256;
  const int gw = gtid >> 6, nw = gthreads >> 6;
  prep_rows(p.x, p.XB, T_TOK, gw, nw);
  prep_rows(p.mem, p.MEMB, 2048, gw, nw);
  prep_wT(p.w_in, p.g_in, 0, 1024, p.WinT, 1024, NIN, NINP, gtid, gthreads);
  prep_wT(p.w_out, p.g_ssd, 512, 1024, p.WoutT, 1536, 1024, 1024, gtid, gthreads);
  prep_wT(p.w_kv, p.g_mem, 0, 1024, p.WkvT, 1024, 1024, 1024, gtid, gthreads);
  prep_wT(p.w1k, nullptr, 0, 0, p.W1kT, 2048, 256, 256, gtid, gthreads);
  prep_wT(p.w1v, nullptr, 0, 0, p.W1vT, 2048, 256, 256, gtid, gthreads);
  prep_wT(p.w2k, nullptr, 0, 0, p.W2kT, 256, 64, 64, gtid, gthreads);
  prep_wT(p.w2v, nullptr, 0, 0, p.W2vT, 256, 64, 64, gtid, gthreads);
  for (int i = gtid; i < T_TOK; i += gthreads) p.SS_OUT[i] = 0.f;
  for (int i = gtid; i < 16 * 64; i += gthreads) {
    int bg = i >> 6, d = i & 63;
    p.KCMP[((size_t)bg * 256 + 255) * 64 + d] = 0;
    p.VCMPT[((size_t)bg * 64 + d) * 256 + 255] = 0;
  }
}

typedef __attribute__((address_space(3))) unsigned lds_u32_t;
typedef __attribute__((address_space(1))) const unsigned glb_u32_t;
__device__ __forceinline__ void glds16(const bf16_t* g, char* l) {
  __builtin_amdgcn_global_load_lds((glb_u32_t*)g, (lds_u32_t*)l, 16, 0, 0);
}
template <int MODE>
__device__ void gemm_tile_reg(const Params& p, int mt, int nt, char* smem) {
  const int tid = get_tid(), lane = tid & 63, wave = tid >> 6, lr = lane & 15, lg = lane >> 4;
  const int wr = wave >> 1, wc = wave & 1;
  const int m0 = mt * 128, n0 = nt * 128;
  const bf16_t* A; const bf16_t* Bt; int K;
  if (MODE == 0) { A = p.XB; Bt = p.WinT; K = 1024; }
  else if (MODE == 1) { A = p.MEMB; Bt = p.WkvT; K = 1024; }
  else { A = p.MIX; Bt = p.WoutT; K = 1536; }
  bf16_t* As = (bf16_t*)smem;
  bf16_t* Bs = As + 2 * 9216;
  const int lrow = tid >> 3, kc = tid & 7;
  const bf16_t* ga = A + (size_t)(m0 + lrow) * K + kc * 8;
  const bf16_t* gb = Bt + (size_t)(n0 + lrow) * K + kc * 8;
  float rs[4] = {1.f, 1.f, 1.f, 1.f};
  if (MODE == 2) {
#pragma unroll
    for (int i = 0; i < 4; i++) {
      const float4* sp = (const float4*)(p.SS_SSD + (size_t)(m0 + lrow + 32 * i) * 8);
      float4 a = sp[0], b = sp[1];
      rs[i] = rsqrtf((a.x + a.y + a.z + a.w + b.x + b.y + b.z + b.w) * (1.f / 512.f) + 1e-6f);
    }
  }
  bool swap;
  if (MODE == 0) swap = !(nt == 7 || nt == 9);
  else if (MODE == 1) swap = (nt < 4);
  else swap = true;
  const bf16_t* F = swap ? (Bs + (64 * wc) * 72) : (As + (64 * wr) * 72);
  const bf16_t* G = swap ? (As + (64 * wr) * 72) : (Bs + (64 * wc) * 72);
  f32x4 acc[4][4];
#pragma unroll
  for (int i = 0; i < 4; i++)
#pragma unroll
    for (int j = 0; j < 4; j++) acc[i][j] = (f32x4){0.f, 0.f, 0.f, 0.f};
  bf16x8 ra0[4], rb0[4], ra1[4], rb1[4];
  const int nk = K / 64;
  auto load = [&](int kt, bf16x8 (&ra)[4], bf16x8 (&rb)[4]) {
#pragma unroll
    for (int i = 0; i < 4; i++) {
      ra[i] = *(const bf16x8*)(ga + (size_t)(32 * i) * K + kt * 64);
      rb[i] = *(const bf16x8*)(gb + (size_t)(32 * i) * K + kt * 64);
    }
  };
  auto store = [&](int buf, int kt, bf16x8 (&ra)[4], bf16x8 (&rb)[4]) {
    if (MODE == 2) {
      if (kt >= 8 && kt < 16) {
#pragma unroll
        for (int i = 0; i < 4; i++) {
          bf16x8 v = ra[i];
          ra[i] = pack8(bfs(v[0]) * rs[i], bfs(v[1]) * rs[i], bfs(v[2]) * rs[i], bfs(v[3]) * rs[i],
                        bfs(v[4]) * rs[i], bfs(v[5]) * rs[i], bfs(v[6]) * rs[i], bfs(v[7]) * rs[i]);
        }
      }
    }
#pragma unroll
    for (int i = 0; i < 4; i++) {
      *(bf16x8*)(As + buf * 9216 + (lrow + 32 * i) * 72 + kc * 8) = ra[i];
      *(bf16x8*)(Bs + buf * 9216 + (lrow + 32 * i) * 72 + kc * 8) = rb[i];
    }
  };
  auto compute = [&](int buf) {
    const int cb = buf * 9216;
#pragma unroll
    for (int ks = 0; ks < 2; ks++) {
      bf16x8 ff[4], gg[4];
#pragma unroll
      for (int i = 0; i < 4; i++) {
        ff[i] = *(const bf16x8*)(F + cb + (16 * i + lr) * 72 + ks * 32 + lg * 8);
        gg[i] = *(const bf16x8*)(G + cb + (16 * i + lr) * 72 + ks * 32 + lg * 8);
      }
#pragma unroll
      for (int i = 0; i < 4; i++)
#pragma unroll
        for (int j = 0; j < 4; j++) acc[i][j] = mfma16(ff[i], gg[j], acc[i][j]);
    }
  };
  const int lastk = nk - 1;
  load(0, ra0, rb0);
  load(1, ra1, rb1);
  store(0, 0, ra0, rb0);
  load(2, ra0, rb0);
  __syncthreads();
  for (int kt = 0; kt < nk; kt += 2) {
    compute(0);
    store(1, kt + 1, ra1, rb1);
    load(min(kt + 3, lastk), ra1, rb1);
    __syncthreads();
    compute(1);
    store(0, min(kt + 2, lastk), ra0, rb0);
    load(min(kt + 4, lastk), ra0, rb0);
    __syncthreads();
  }
  if (swap) {
    if (MODE == 0) {
      const bool rope = (nt < 4) || nt == 6 || nt == 8;
#pragma unroll
      for (int mi = 0; mi < 4; mi++) {
        const int m = m0 + 64 * wr + 16 * mi + lr;
        if (rope) {
          const int pos = p.pos[m];
          f32x4 v = acc[0][mi];
          f32x4 o;
#pragma unroll
          for (int i = 0; i < 4; i++) {
            float pr = __shfl_xor(v[i], 32);
            float cs, sn; rope_cs(pos, 4 * (lg & 1) + i, cs, sn);
            o[i] = (lg < 2) ? (v[i] * cs - pr * sn) : (v[i] * cs + pr * sn);
          }
          acc[0][mi] = o;
        }
        {
          bf16_t* stg = (bf16_t*)smem + ((wave & 1) ? 2 * 9216 : 0) + (wave >> 1) * 4608;
#pragma unroll
          for (int ni = 0; ni < 4; ni++) {
            f32x4 v = acc[ni][mi];
            *(bf16x4*)(stg + (16 * mi + lr) * 72 + 16 * ni + 4 * lg) = pack4(v[0], v[1], v[2], v[3]);
          }
        }
      }
      {
        const bf16_t* stg = (const bf16_t*)smem + ((wave & 1) ? 2 * 9216 : 0) + (wave >> 1) * 4608;
        const int rr = lane >> 3, ch = lane & 7;
        const int nb0 = n0 + 64 * wc + ch * 8;
#pragma unroll
        for (int it = 0; it < 8; it++) {
          const int row = it * 8 + rr;
          const int m = m0 + 64 * wr + row;
          bf16x8 v = *(const bf16x8*)(stg + row * 72 + ch * 8);
          if (nt == 6 || nt == 8) {
            bf16_t* kd = ((nt == 6) ? p.KSC : p.KWC) + (((size_t)(m >> 12) * 2 + wc) * S_LEN + (m & 4095)) * 64;
            *(bf16x8*)(kd + ch * 8) = v;
          } else if (nb0 < NIN) {
            *(bf16x8*)(p.PROJ + (size_t)m * NIN + nb0) = v;
          }
        }
      }
      __syncthreads();
    } else if (MODE == 1) {
#pragma unroll
      for (int mi = 0; mi < 4; mi++) {
        const int m = m0 + 64 * wr + 16 * mi + lr;
#pragma unroll
        for (int ni = 0; ni < 4; ni++) {
          const int n = n0 + 64 * wc + 16 * ni + 4 * lg;
          f32x4 v = acc[ni][mi];
          *(bf16x4*)(p.KMEM + (size_t)m * 512 + n) = pack4(v[0], v[1], v[2], v[3]);
        }
      }
    } else {
#pragma unroll
      for (int mi = 0; mi < 4; mi++) {
        const int m = m0 + 64 * wr + 16 * mi + lr;
        float ss = 0.f;
#pragma unroll
        for (int ni = 0; ni < 4; ni++) {
          const int n = n0 + 64 * wc + 16 * ni + 4 * lg;
          float4 xv = *(const float4*)(p.x + (size_t)m * 1024 + n);
          f32x4 v = acc[ni][mi];
          float4 h; h.x = xv.x + v[0]; h.y = xv.y + v[1]; h.z = xv.z + v[2]; h.w = xv.w + v[3];
          ss += h.x * h.x + h.y * h.y + h.z * h.z + h.w * h.w;
          *(float4*)(p.out + (size_t)m * 1024 + n) = h;
        }
        ss += __shfl_xor(ss, 16); ss += __shfl_xor(ss, 32);
        if (lg == 0) atomicAdd(p.SS_OUT + m, ss);
      }
    }
  } else {
#pragma unroll
    for (int mi = 0; mi < 4; mi++)
#pragma unroll
      for (int ni = 0; ni < 4; ni++) {
        f32x4 v = acc[mi][ni];
        bf16x4 o = pack4(v[0], v[1], v[2], v[3]);
        if (MODE == 0) {
          const int b = m0 >> 12, s = (m0 & 4095) + 64 * wr + 16 * mi + 4 * lg;
          const int d = 16 * ni + lr;
          bf16_t* dst = (nt == 7) ? p.VST : p.VWT;
          *(bf16x4*)(dst + ((size_t)(b * 2 + wc) * 64 + d) * S_LEN + s) = o;
        } else {
          const int b = m0 >> 8, s = (m0 & 255) + 64 * wr + 16 * mi + 4 * lg;
          const int col = n0 - 512 + 64 * wc + 16 * ni + lr;
          const int h = col >> 7, d = col & 127;
          *(bf16x4*)(p.VMEMT + ((size_t)(b * 4 + h) * 128 + d) * 256 + s) = o;
        }
      }
  }
}

template <int MODE>
__device__ void gemm_tile_glds(const Params& p, int mt, int nt, char* smem) {
  const int tid = get_tid(), lane = tid & 63, wave = tid >> 6, lr = lane & 15, lg = lane >> 4;
  const int wr = wave >> 1, wc = wave & 1;
  const int m0 = mt * 128, n0 = nt * 128;
  const bf16_t* A; const bf16_t* Bt; int K;
  if (MODE == 0) { A = p.XB; Bt = p.WinT; K = 1024; }
  else if (MODE == 1) { A = p.MEMB; Bt = p.WkvT; K = 1024; }
  else { A = p.MIX; Bt = p.WoutT; K = 1536; }
  float rs[4] = {1.f, 1.f, 1.f, 1.f};
  if (MODE == 2) {
#pragma unroll
    for (int i = 0; i < 4; i++) {
      const float4* sp = (const float4*)(p.SS_SSD + (size_t)(m0 + (wave * 4 + i) * 8 + (lane >> 3)) * 8);
      float4 a = sp[0], b = sp[1];
      rs[i] = rsqrtf((a.x + a.y + a.z + a.w + b.x + b.y + b.z + b.w) * (1.f / 512.f) + 1e-6f);
    }
  }
  bool swap;
  if (MODE == 0) swap = !(nt == 7 || nt == 9);
  else if (MODE == 1) swap = (nt < 4);
  else swap = true;
  const int rl = lane >> 3, pcx = lane & 7;
  const bf16_t* gA[4]; const bf16_t* gB[4];
#pragma unroll
  for (int q = 0; q < 4; q++) {
    const int row = (wave * 4 + q) * 8 + rl;
    const int c = pcx ^ ((row >> 1) & 7);
    gA[q] = A + (size_t)(m0 + row) * K + c * 8;
    gB[q] = Bt + (size_t)(n0 + row) * K + c * 8;
  }
  char* lbase = smem + wave * 4096 + lane * 16;
  auto stage = [&](int buf, int koff) {
#pragma unroll
    for (int q = 0; q < 4; q++) {
      glds16(gA[q] + koff, lbase + buf * 32768 + q * 1024);
      glds16(gB[q] + koff, lbase + buf * 32768 + 16384 + q * 1024);
    }
  };
  const int fro = (swap ? (16384 + 64 * wc * 128) : (64 * wr * 128)) + lr * 128;
  const int gro = (swap ? (64 * wr * 128) : (16384 + 64 * wc * 128)) + lr * 128;
  const int sw = (lr >> 1) & 7;
  f32x4 acc[4][4];
#pragma unroll
  for (int i = 0; i < 4; i++)
#pragma unroll
    for (int j = 0; j < 4; j++) acc[i][j] = (f32x4){0.f, 0.f, 0.f, 0.f};
  const int nk = K / 64;
  auto kof = [&](int i) { return i * 64; };
  stage(0, kof(0));
  for (int kt = 0; kt < nk; kt++) {
    __syncthreads();
    if (kt + 1 < nk) stage((kt + 1) & 1, kof(kt + 1));
    if (MODE == 2) {
      if (kt >= 8 && kt < 16) {
#pragma unroll
        for (int q = 0; q < 4; q++) {
          bf16x8* cp = (bf16x8*)(lbase + (kt & 1) * 32768 + q * 1024);
          bf16x8 v = *cp;
          *cp = pack8(bfs(v[0]) * rs[q], bfs(v[1]) * rs[q], bfs(v[2]) * rs[q], bfs(v[3]) * rs[q],
                      bfs(v[4]) * rs[q], bfs(v[5]) * rs[q], bfs(v[6]) * rs[q], bfs(v[7]) * rs[q]);
        }
        __syncthreads();
      }
    }
    const char* sb = smem + (kt & 1) * 32768;
#pragma unroll
    for (int ks = 0; ks < 2; ks++) {
      bf16x8 ff[4], gg[4];
      const int co = ((ks * 4 + lg) ^ sw) * 16;
#pragma unroll
      for (int i = 0; i < 4; i++) {
        ff[i] = *(const bf16x8*)(sb + fro + i * 2048 + co);
        gg[i] = *(const bf16x8*)(sb + gro + i * 2048 + co);
      }
#pragma unroll
      for (int i = 0; i < 4; i++)
#pragma unroll
        for (int j = 0; j < 4; j++) acc[i][j] = mfma16(ff[i], gg[j], acc[i][j]);
    }
  }
  __syncthreads();
  if (swap) {
    if (MODE == 0) {
      const bool rope = (nt < 4) || nt == 6 || nt == 8;
#pragma unroll
      for (int mi = 0; mi < 4; mi++) {
        const int m = m0 + 64 * wr + 16 * mi + lr;
        if (rope) {
          const int pos = p.pos[m];
          f32x4 v = acc[0][mi];
          f32x4 o;
#pragma unroll
          for (int i = 0; i < 4; i++) {
            float pr = __shfl_xor(v[i], 32);
            float cs, sn; rope_cs(pos, 4 * (lg & 1) + i, cs, sn);
            o[i] = (lg < 2) ? (v[i] * cs - pr * sn) : (v[i] * cs + pr * sn);
          }
          acc[0][mi] = o;
        }
        {
          bf16_t* stg = (bf16_t*)smem + ((wave & 1) ? 2 * 9216 : 0) + (wave >> 1) * 4608;
#pragma unroll
          for (int ni = 0; ni < 4; ni++) {
            f32x4 v = acc[ni][mi];
            *(bf16x4*)(stg + (16 * mi + lr) * 72 + 16 * ni + 4 * lg) = pack4(v[0], v[1], v[2], v[3]);
          }
        }
      }
      {
        const bf16_t* stg = (const bf16_t*)smem + ((wave & 1) ? 2 * 9216 : 0) + (wave >> 1) * 4608;
        const int rr = lane >> 3, ch = lane & 7;
        const int nb0 = n0 + 64 * wc + ch * 8;
#pragma unroll
        for (int it = 0; it < 8; it++) {
          const int row = it * 8 + rr;
          const int m = m0 + 64 * wr + row;
          bf16x8 v = *(const bf16x8*)(stg + row * 72 + ch * 8);
          if (nt == 6 || nt == 8) {
            bf16_t* kd = ((nt == 6) ? p.KSC : p.KWC) + (((size_t)(m >> 12) * 2 + wc) * S_LEN + (m & 4095)) * 64;
            *(bf16x8*)(kd + ch * 8) = v;
          } else if (nb0 < NIN) {
            *(bf16x8*)(p.PROJ + (size_t)m * NIN + nb0) = v;
          }
        }
      }
      __syncthreads();
    } else if (MODE == 1) {
#pragma unroll
      for (int mi = 0; mi < 4; mi++) {
        const int m = m0 + 64 * wr + 16 * mi + lr;
#pragma unroll
        for (int ni = 0; ni < 4; ni++) {
          const int n = n0 + 64 * wc + 16 * ni + 4 * lg;
          f32x4 v = acc[ni][mi];
          *(bf16x4*)(p.KMEM + (size_t)m * 512 + n) = pack4(v[0], v[1], v[2], v[3]);
        }
      }
    } else {
#pragma unroll
      for (int mi = 0; mi < 4; mi++) {
        const int m = m0 + 64 * wr + 16 * mi + lr;
        float ss = 0.f;
#pragma unroll
        for (int ni = 0; ni < 4; ni++) {
          const int n = n0 + 64 * wc + 16 * ni + 4 * lg;
          float4 xv = *(const float4*)(p.x + (size_t)m * 1024 + n);
          f32x4 v = acc[ni][mi];
          float4 h; h.x = xv.x + v[0]; h.y = xv.y + v[1]; h.z = xv.z + v[2]; h.w = xv.w + v[3];
          ss += h.x * h.x + h.y * h.y + h.z * h.z + h.w * h.w;
          *(float4*)(p.out + (size_t)m * 1024 + n) = h;
        }
        ss += __shfl_xor(ss, 16); ss += __shfl_xor(ss, 32);
        if (lg == 0) atomicAdd(p.SS_OUT + m, ss);
      }
    }
  } else {
#pragma unroll
    for (int mi = 0; mi < 4; mi++)
#pragma unroll
      for (int ni = 0; ni < 4; ni++) {
        f32x4 v = acc[mi][ni];
        bf16x4 o = pack4(v[0], v[1], v[2], v[3]);
        if (MODE == 0) {
          const int b = m0 >> 12, s = (m0 & 4095) + 64 * wr + 16 * mi + 4 * lg;
          const int d = 16 * ni + lr;
          bf16_t* dst = (nt == 7) ? p.VST : p.VWT;
          *(bf16x4*)(dst + ((size_t)(b * 2 + wc) * 64 + d) * S_LEN + s) = o;
        } else {
          const int b = m0 >> 8, s = (m0 & 255) + 64 * wr + 16 * mi + 4 * lg;
          const int col = n0 - 512 + 64 * wc + 16 * ni + lr;
          const int h = col >> 7, d = col & 127;
          *(bf16x4*)(p.VMEMT + ((size_t)(b * 4 + h) * 128 + d) * 256 + s) = o;
        }
      }
  }
}

template <int MODE>
__device__ __forceinline__ void gemm_tile(const Params& p, int mt, int nt, char* smem) {
  gemm_tile_glds<MODE>(p, mt, nt, smem);
}

template <int DQK, int DV, int MASK, typename MaskF>
__device__ __forceinline__ void attn_tile(const bf16_t* sK, const bf16_t* sVt, const bf16x8 (&qf)[2][DQK / 32], f32x4 (&o)[DV / 16][2],
                                          float (&m)[2], float (&l)[2], float c, bool qsel0, bool qsel1, MaskF valid) {
  constexpr int KST = DQK + 8;
  const int lane = get_tid() & 63, lr = lane & 15, lg = lane >> 4;
  f32x4 s[4][2];
#pragma unroll
  for (int kt = 0; kt < 4; kt++) { s[kt][0] = (f32x4){0.f, 0.f, 0.f, 0.f}; s[kt][1] = (f32x4){0.f, 0.f, 0.f, 0.f}; }
#pragma unroll
  for (int ks = 0; ks < DQK / 32; ks++)
#pragma unroll
    for (int kt = 0; kt < 4; kt++) {
      bf16x8 a = *(const bf16x8*)(sK + (16 * kt + lr) * KST + ks * 32 + lg * 8);
      s[kt][0] = mfma16(a, qf[0][ks], s[kt][0]);
      s[kt][1] = mfma16(a, qf[1][ks], s[kt][1]);
    }
#pragma unroll
  for (int qt = 0; qt < 2; qt++) {
    const bool qs = qt ? qsel1 : qsel0;
    float mx = -1e30f;
    if (MASK) {
#pragma unroll
      for (int kt = 0; kt < 4; kt++)
#pragma unroll
        for (int i = 0; i < 4; i++) {
          bool v = valid(16 * kt + 4 * lg + i, qt);
          float sv = v ? s[kt][qt][i] * c : -1e30f;
          s[kt][qt][i] = sv; mx = fmaxf(mx, sv);
        }
    } else {
#pragma unroll
      for (int kt = 0; kt < 4; kt++) mx = fmaxf(fmaxf(mx, fmaxf(s[kt][qt][0], s[kt][qt][1])), fmaxf(s[kt][qt][2], s[kt][qt][3]));
      mx = qs ? mx * c : -1e30f;
    }
    mx = rowmax4(mx);
    const float mn = fmaxf(m[qt], mx);
    const float alpha = fexp2(m[qt] - mn);
    m[qt] = mn;
    float me;
    if (MASK) me = (mn > -1e29f) ? mn : 1e30f; else me = qs ? mn : 1e30f;
    float rs = 0.f;
#pragma unroll
    for (int kt = 0; kt < 4; kt++)
#pragma unroll
      for (int i = 0; i < 4; i++) {
        float pv = MASK ? fexp2(s[kt][qt][i] - me) : fexp2(fmaf(s[kt][qt][i], c, -me));
        s[kt][qt][i] = pv; rs += pv;
      }
    rs = rowsum4(rs);
    l[qt] = l[qt] * alpha + rs;
#pragma unroll
    for (int dt = 0; dt < DV / 16; dt++) {
      o[dt][qt][0] *= alpha; o[dt][qt][1] *= alpha; o[dt][qt][2] *= alpha; o[dt][qt][3] *= alpha;
    }
  }
#pragma unroll
  for (int k2 = 0; k2 < 2; k2++) {
    bf16x8 pb[2];
#pragma unroll
    for (int qt = 0; qt < 2; qt++)
      pb[qt] = pack8(s[2 * k2][qt][0], s[2 * k2][qt][1], s[2 * k2][qt][2], s[2 * k2][qt][3],
                     s[2 * k2 + 1][qt][0], s[2 * k2 + 1][qt][1], s[2 * k2 + 1][qt][2], s[2 * k2 + 1][qt][3]);
#pragma unroll
    for (int dt = 0; dt < DV / 16; dt++) {
      const bf16_t* vp = sVt + (16 * dt + lr) * 72 + 32 * k2 + 4 * lg;
      bf16x8 a = cat44(*(const bf16x4*)vp, *(const bf16x4*)(vp + 16));
      o[dt][0] = mfma16(a, pb[0], o[dt][0]);
      o[dt][1] = mfma16(a, pb[1], o[dt][1]);
    }
  }
}

__device__ __forceinline__ int next_bit_below(unsigned long long m, int below) {
  unsigned long long mm = (below >= 64) ? m : (m & ((1ull << below) - 1ull));
  return mm ? (63 - __clzll((long long)mm)) : -1;
}

__device__ void nsa_item(const Params& p, int item, char* smem) {
  const int tid = get_tid(), lane = tid & 63, wave = tid >> 6, lr = lane & 15, lg = lane >> 4;
  const int bg = item & 15, qb = 127 - (item >> 4);
  const int b = bg >> 1, g = bg & 1;
  const int t0 = qb * 32, cur = t0 >> 6;
  const int hq = g * 4 + wave;
  float* sImp = (float*)(smem + 55296);
  unsigned long long* sSel = (unsigned long long*)(smem + 63616);
  const float c = 0.125f * LOG2E;
  const size_t tokbase = (size_t)b * S_LEN + t0;
  const int r0 = tid >> 3, cc = tid & 7;

  bf16x8 qf[2][2];
#pragma unroll
  for (int qt = 0; qt < 2; qt++) {
    const bf16_t* row = p.PROJ + (tokbase + 16 * qt + lr) * NIN;
#pragma unroll
    for (int ks = 0; ks < 2; ks++) qf[qt][ks] = *(const bf16x8*)(row + C_Q + hq * 64 + 32 * ks + 8 * lg);
  }
  bf16_t* slab = (bf16_t*)(smem + 36864 + wave * 4608);
  auto emit = [&](f32x4 (&o)[4][2], float (&l)[2], int br) {
#pragma unroll
    for (int qt = 0; qt < 2; qt++) {
      const size_t tok = tokbase + 16 * qt + lr;
      const float gsc = sigmoid_f(bf2f(p.PROJ[tok * NIN + C_GL + hq * 3 + br])) / fmaxf(l[qt], 1e-30f);
#pragma unroll
      for (int dt = 0; dt < 4; dt++) {
        bf16_t* dst = slab + (16 * qt + lr) * 72 + 16 * dt + 4 * lg;
        f32x4 r = o[dt][qt];
        r[0] *= gsc; r[1] *= gsc; r[2] *= gsc; r[3] *= gsc;
        if (br > 0) { bf16x4 pv = *(const bf16x4*)dst; r[0] += bfs(pv[0]); r[1] += bfs(pv[1]); r[2] += bfs(pv[2]); r[3] += bfs(pv[3]); }
        *(bf16x4*)dst = pack4(r[0], r[1], r[2], r[3]);
      }
    }
    if (br == 2) {
      const int rr = lane >> 3, ch = lane & 7;
#pragma unroll
      for (int it = 0; it < 4; it++) {
        const int row = it * 8 + rr;
        const size_t tok = tokbase + row;
        const bf16x8 v = *(const bf16x8*)(slab + row * 72 + ch * 8);
        const bf16x8 ga = *(const bf16x8*)(p.PROJ + tok * NIN + C_GA + hq * 64 + ch * 8);
        *(bf16x8*)(p.MIX + tok * 1536 + hq * 64 + ch * 8) =
            pack8(bfs(v[0]) * silu_f(bfs(ga[0])), bfs(v[1]) * silu_f(bfs(ga[1])), bfs(v[2]) * silu_f(bfs(ga[2])), bfs(v[3]) * silu_f(bfs(ga[3])),
                  bfs(v[4]) * silu_f(bfs(ga[4])), bfs(v[5]) * silu_f(bfs(ga[5])), bfs(v[6]) * silu_f(bfs(ga[6])), bfs(v[7]) * silu_f(bfs(ga[7])));
      }
    }
  };
  auto store_kv = [&](int buf, bf16x8 (&rg)[4]) {
    bf16_t* sK = (bf16_t*)(smem + buf * 18432);
    bf16_t* sVt = sK + 64 * 72;
    *(bf16x8*)(sK + r0 * 72 + cc * 8) = rg[0];
    *(bf16x8*)(sK + (r0 + 32) * 72 + cc * 8) = rg[1];
    *(bf16x8*)(sVt + r0 * 72 + cc * 8) = rg[2];
    *(bf16x8*)(sVt + (r0 + 32) * 72 + cc * 8) = rg[3];
  };

  {
    const int ntiles = (t0 >> 10) + 1;
    const bf16_t* kb = p.KCMP + (size_t)bg * 256 * 64;
    const bf16_t* vb = p.VCMPT + (size_t)bg * 64 * 256;
    for (int pass = 0; pass < 2; pass++) {
      f32x4 o[4][2]; float m[2] = {-1e30f, -1e30f}, l[2] = {0.f, 0.f};
#pragma unroll
      for (int dt = 0; dt < 4; dt++) { o[dt][0] = (f32x4){0.f, 0.f, 0.f, 0.f}; o[dt][1] = (f32x4){0.f, 0.f, 0.f, 0.f}; }
      int ldn = 0;
      tile_pipeline<4>(ntiles,
        [&](int i, bf16x8 (&rg)[4]) {
          rg[0] = *(const bf16x8*)(kb + (size_t)(64 * i + r0) * 64 + cc * 8);
          rg[1] = *(const bf16x8*)(kb + (size_t)(64 * i + r0 + 32) * 64 + cc * 8);
          if (pass == 0) {
            rg[2] = *(const bf16x8*)(vb + (size_t)r0 * 256 + 64 * i + cc * 8);
            rg[3] = *(const bf16x8*)(vb + (size_t)(r0 + 32) * 256 + 64 * i + cc * 8);
          }
        },
        [&](int buf, bf16x8 (&rg)[4]) {
          const int nt = ldn++;
          if (pass == 1) {
#pragma unroll
            for (int i2 = 0; i2 < 2; i2++) {
              const int j = r0 + 32 * i2;
              bf16x8 ov;
#pragma unroll
              for (int x = 0; x < 8; x++) { int n = 64 * nt + cc * 8 + x; ov[x] = (n >= 4 * j - 1 && n <= 4 * j + 3) ? (short)0x3F80 : (short)0; }
              rg[2 + i2] = ov;
            }
          }
          store_kv(buf, rg);
        },
        [&](int i, int buf) {
          const bf16_t* sK = (const bf16_t*)(smem + buf * 18432);
          attn_tile<64, 64, 1>(sK, sK + 64 * 72, qf, o, m, l, c, true, true,
                               [&](int key, int qt) { return 16 * (64 * i + key) + 31 <= t0 + 16 * qt + lr; });
        });
      if (pass == 0) {
        emit(o, l, 0);
      } else {
        float inv[2];
#pragma unroll
        for (int qt = 0; qt < 2; qt++) inv[qt] = 1.f / fmaxf(l[qt], 1e-30f);
        for (int e2 = 0; e2 < 4; e2++) {
          if (wave == e2) {
#pragma unroll
            for (int dt = 0; dt < 4; dt++)
#pragma unroll
              for (int qt = 0; qt < 2; qt++)
#pragma unroll
                for (int i = 0; i < 4; i++) {
                  int j = 16 * dt + 4 * lg + i, q = 16 * qt + lr;
                  float v = o[dt][qt][i] * inv[qt];
                  if (e2 == 0) sImp[q * 65 + j] = v; else sImp[q * 65 + j] += v;
                }
          }
          __syncthreads();
        }
      }
    }
  }
  for (int qq = 0; qq < 8; qq++) {
    const int q = wave * 8 + qq;
    const int j = lane;
    float v = sImp[q * 65 + j];
    bool valid = j <= cur;
    bool forced = (j == 0) || (j == cur) || (j == cur - 1);
    float val = forced ? 1e9f : (valid ? v : -1e9f);
    int rank = 0;
#pragma unroll 16
    for (int jj = 0; jj < 64; jj++) {
      float ov = __int_as_float(__builtin_amdgcn_readlane(__float_as_int(val), jj));
      rank += ((ov > val) || (ov == val && jj < j)) ? 1 : 0;
    }
    unsigned long long mask = __ballot((rank < 16) && valid);
    if (lane == 0) sSel[q] = mask;
  }
  __syncthreads();
  unsigned long long any = 0ull;
  for (int q = 0; q < 32; q++) any |= sSel[q];
  unsigned long long mk[2];
  mk[0] = sSel[lr]; mk[1] = sSel[16 + lr];

  {
    f32x4 o[4][2]; float m[2] = {-1e30f, -1e30f}, l[2] = {0.f, 0.f};
#pragma unroll
    for (int dt = 0; dt < 4; dt++) { o[dt][0] = (f32x4){0.f, 0.f, 0.f, 0.f}; o[dt][1] = (f32x4){0.f, 0.f, 0.f, 0.f}; }
    const bf16_t* kb = p.KSC + (size_t)bg * S_LEN * 64;
    const bf16_t* vb = p.VST + (size_t)bg * 64 * S_LEN;
    const int ntiles = __popcll(any);
    int jl = 64, jc = 64;
    tile_pipeline<4>(ntiles,
      [&](int, bf16x8 (&rg)[4]) {
        jl = (jl > 0) ? next_bit_below(any, jl) : -1;
        const int jj = jl < 0 ? 0 : jl;
        rg[0] = *(const bf16x8*)(kb + (size_t)(64 * jj + r0) * 64 + cc * 8);
        rg[1] = *(const bf16x8*)(kb + (size_t)(64 * jj + r0 + 32) * 64 + cc * 8);
        rg[2] = *(const bf16x8*)(vb + (size_t)r0 * S_LEN + 64 * jj + cc * 8);
        rg[3] = *(const bf16x8*)(vb + (size_t)(r0 + 32) * S_LEN + 64 * jj + cc * 8);
      },
      store_kv,
      [&](int, int buf) {
        jc = next_bit_below(any, jc);
        const int j = jc;
        const bf16_t* sK = (const bf16_t*)(smem + buf * 18432);
        if (j == cur) {
          attn_tile<64, 64, 1>(sK, sK + 64 * 72, qf, o, m, l, c, true, true,
                               [&](int key, int qt) { return 64 * j + key <= t0 + 16 * qt + lr; });
        } else {
          attn_tile<64, 64, 0>(sK, sK + 64 * 72, qf, o, m, l, c, ((mk[0] >> j) & 1ull) != 0ull, ((mk[1] >> j) & 1ull) != 0ull,
                               [&](int, int) { return true; });
        }
      });
    emit(o, l, 1);
  }
  {
    f32x4 o[4][2]; float m[2] = {-1e30f, -1e30f}, l[2] = {0.f, 0.f};
#pragma unroll
    for (int dt = 0; dt < 4; dt++) { o[dt][0] = (f32x4){0.f, 0.f, 0.f, 0.f}; o[dt][1] = (f32x4){0.f, 0.f, 0.f, 0.f}; }
    const int jlo = (cur - 8 > 0) ? (cur - 8) : 0;
    const bf16_t* kb = p.KWC + (size_t)bg * S_LEN * 64;
    const bf16_t* vb = p.VWT + (size_t)bg * 64 * S_LEN;
    tile_pipeline<4>(cur - jlo + 1,
      [&](int i, bf16x8 (&rg)[4]) {
        const int j = cur - i;
        rg[0] = *(const bf16x8*)(kb + (size_t)(64 * j + r0) * 64 + cc * 8);
        rg[1] = *(const bf16x8*)(kb + (size_t)(64 * j + r0 + 32) * 64 + cc * 8);
        rg[2] = *(const bf16x8*)(vb + (size_t)r0 * S_LEN + 64 * j + cc * 8);
        rg[3] = *(const bf16x8*)(vb + (size_t)(r0 + 32) * S_LEN + 64 * j + cc * 8);
      },
      store_kv,
      [&](int i, int buf) {
        const int j = cur - i;
        const bf16_t* sK = (const bf16_t*)(smem + buf * 18432);
        if (j == cur || j == cur - 8) {
          attn_tile<64, 64, 1>(sK, sK + 64 * 72, qf, o, m, l, c, true, true, [&](int key, int qt) {
            int tq = t0 + 16 * qt + lr, kp = 64 * j + key;
            return (kp <= tq) && (kp > tq - 512);
          });
        } else {
          attn_tile<64, 64, 0>(sK, sK + 64 * 72, qf, o, m, l, c, true, true, [&](int, int) { return true; });
        }
      });
    emit(o, l, 2);
  }
}

__device__ void memattn_item(const Params& p, int item, char* smem) {
  const int tid = get_tid(), lane = tid & 63, wave = tid >> 6, lr = lane & 15, lg = lane >> 4;
  const int b = item >> 7, h = (item >> 5) & 3, qb = item & 31;
  const int t0 = qb * 128 + wave * 32;
  const size_t tokbase = (size_t)b * S_LEN + t0;
  bf16x8 qf[2][4];
#pragma unroll
  for (int qt = 0; qt < 2; qt++)
#pragma unroll
    for (int ks = 0; ks < 4; ks++) qf[qt][ks] = *(const bf16x8*)(p.PROJ + (tokbase + 16 * qt + lr) * NIN + C_QX + h * 128 + 32 * ks + 8 * lg);
  f32x4 o[8][2]; float m[2] = {-1e30f, -1e30f}, l[2] = {0.f, 0.f};
#pragma unroll
  for (int dt = 0; dt < 8; dt++) { o[dt][0] = (f32x4){0.f, 0.f, 0.f, 0.f}; o[dt][1] = (f32x4){0.f, 0.f, 0.f, 0.f}; }
  const float c = 0.08838834764831845f * LOG2E;
  const bf16_t* kb = p.KMEM + (size_t)b * 256 * 512 + h * 128;
  const bf16_t* vb = p.VMEMT + (size_t)(b * 4 + h) * 128 * 256;
  tile_pipeline1<8>(4,
    [&](int kt, bf16x8 (&rg)[8]) {
#pragma unroll
      for (int i = 0; i < 4; i++) {
        int ch = tid + 256 * i;
        rg[i] = *(const bf16x8*)(kb + (size_t)(64 * kt + (ch >> 4)) * 512 + (ch & 15) * 8);
        rg[4 + i] = *(const bf16x8*)(vb + (size_t)(ch >> 3) * 256 + 64 * kt + (ch & 7) * 8);
      }
    },
    [&](int buf, bf16x8 (&rg)[8]) {
      bf16_t* sK = (bf16_t*)(smem + buf * 35840);
      bf16_t* sVt = sK + 64 * 136;
#pragma unroll
      for (int i = 0; i < 4; i++) {
        int ch = tid + 256 * i;
        *(bf16x8*)(sK + (ch >> 4) * 136 + (ch & 15) * 8) = rg[i];
        *(bf16x8*)(sVt + (ch >> 3) * 72 + (ch & 7) * 8) = rg[4 + i];
      }
    },
    [&](int, int buf) {
      const bf16_t* sK = (const bf16_t*)(smem + buf * 35840);
      attn_tile<128, 128, 0>(sK, sK + 64 * 136, qf, o, m, l, c, true, true, [&](int, int) { return true; });
    });
#pragma unroll
  for (int qt = 0; qt < 2; qt++) {
    const size_t tok = tokbase + 16 * qt + lr;
    const float inv = 1.f / fmaxf(l[qt], 1e-30f);
#pragma unroll
    for (int dt = 0; dt < 8; dt++) {
      const int dbase = h * 128 + 16 * dt + 4 * lg;
      bf16x4 ga = *(const bf16x4*)(p.PROJ + tok * NIN + C_GX + dbase);
      f32x4 r = o[dt][qt];
      *(bf16x4*)(p.MIX + tok * 1536 + 1024 + dbase) =
          pack4(r[0] * inv * silu_f(bfs(ga[0])), r[1] * inv * silu_f(bfs(ga[1])), r[2] * inv * silu_f(bfs(ga[2])), r[3] * inv * silu_f(bfs(ga[3])));
    }
  }
}

__device__ void compress_item(const Params& p, int item, char* smem) {
  const int tid = get_tid(), lane = tid & 63, wave = tid >> 6, lr = lane & 15, lg = lane >> 4;
  const int which = item >> 7, rho0 = (item & 127) * 32;
  const bf16_t* W1T = which ? p.W1vT : p.W1kT;
  const bf16_t* W2T = which ? p.W2vT : p.W2kT;
  const float* pe = which ? p.cpv : p.cpk;
  const int col0 = which ? C_VC : C_KC;
  bf16_t* sA = (bf16_t*)smem;
  bf16_t* sW = sA + 32 * 72;
  bf16_t* sH = sW + 256 * 72;
  const int arow = tid >> 3, akc = tid & 7;
  const bf16_t* abase;
  {
    int rho = rho0 + arow; if (rho > 4079) rho = 4079;
    int b = rho / 510, rem = rho - b * 510, n = rem >> 1, g = rem & 1;
    abase = p.PROJ + ((size_t)b * S_LEN + 16 * n) * NIN + col0 + g * 64 + akc * 8;
  }
  const bf16_t* wbase = W1T + (size_t)arow * 2048 + akc * 8;
  f32x4 acc[2][4];
#pragma unroll
  for (int i = 0; i < 2; i++)
#pragma unroll
    for (int j = 0; j < 4; j++) acc[i][j] = (f32x4){0.f, 0.f, 0.f, 0.f};
  bf16x8 ra, rw[8];
  float4 rp0, rp1;
  auto load = [&](int kt) {
    ra = *(const bf16x8*)(abase + (size_t)kt * NIN);
    rp0 = *(const float4*)(pe + kt * 64 + akc * 8); rp1 = *(const float4*)(pe + kt * 64 + akc * 8 + 4);
#pragma unroll
    for (int i = 0; i < 8; i++) rw[i] = *(const bf16x8*)(wbase + (size_t)(32 * i) * 2048 + kt * 64);
  };
  load(0);
  for (int kt = 0; kt < 32; kt++) {
    __syncthreads();
    *(bf16x8*)(sA + arow * 72 + akc * 8) =
        pack8(bfs(ra[0]) + rp0.x, bfs(ra[1]) + rp0.y, bfs(ra[2]) + rp0.z, bfs(ra[3]) + rp0.w,
              bfs(ra[4]) + rp1.x, bfs(ra[5]) + rp1.y, bfs(ra[6]) + rp1.z, bfs(ra[7]) + rp1.w);
#pragma unroll
    for (int i = 0; i < 8; i++) *(bf16x8*)(sW + (arow + 32 * i) * 72 + akc * 8) = rw[i];
    __syncthreads();
    load(kt < 31 ? kt + 1 : 31);
#pragma unroll
    for (int ks = 0; ks < 2; ks++) {
      bf16x8 a0 = *(const bf16x8*)(sA + lr * 72 + ks * 32 + 8 * lg);
      bf16x8 a1 = *(const bf16x8*)(sA + (16 + lr) * 72 + ks * 32 + 8 * lg);
#pragma unroll
      for (int ct = 0; ct < 4; ct++) {
        bf16x8 bf = *(const bf16x8*)(sW + (64 * wave + 16 * ct + lr) * 72 + ks * 32 + 8 * lg);
        acc[0][ct] = mfma16(a0, bf, acc[0][ct]);
        acc[1][ct] = mfma16(a1, bf, acc[1][ct]);
      }
    }
  }
  __syncthreads();
#pragma unroll
  for (int rt = 0; rt < 2; rt++)
#pragma unroll
    for (int ct = 0; ct < 4; ct++)
#pragma unroll
      for (int i = 0; i < 4; i++) sH[(16 * rt + 4 * lg + i) * 264 + 64 * wave + 16 * ct + lr] = f2bf(silu_f(acc[rt][ct][i]));
  __syncthreads();
  f32x4 acc2[2] = {(f32x4){0.f, 0.f, 0.f, 0.f}, (f32x4){0.f, 0.f, 0.f, 0.f}};
#pragma unroll
  for (int ks = 0; ks < 8; ks++) {
    bf16x8 bf = *(const bf16x8*)(W2T + (size_t)(16 * wave + lr) * 256 + 32 * ks + 8 * lg);
#pragma unroll
    for (int rt = 0; rt < 2; rt++) {
      bf16x8 a = *(const bf16x8*)(sH + (16 * rt + lr) * 264 + 32 * ks + 8 * lg);
      acc2[rt] = mfma16(a, bf, acc2[rt]);
    }
  }
  const int col = 16 * wave + lr;
#pragma unroll
  for (int rt = 0; rt < 2; rt++)
#pragma unroll
    for (int i = 0; i < 4; i++) {
      int rho = rho0 + 16 * rt + 4 * lg + i;
      bool ok = rho < 4080;
      int rc = ok ? rho : 4079;
      int b = rc / 510, rem = rc - b * 510, n = rem >> 1, g = rem & 1;
      float v = acc2[rt][i];
      float pr = __shfl_xor(v, 8);
      if (which == 0) {
        if (wave == 0) {
          int pos = p.pos[b * S_LEN + 16 * n + 31];
          float cs, sn; rope_cs(pos, lr & 7, cs, sn);
          v = (lr < 8) ? (v * cs - pr * sn) : (v * cs + pr * sn);
        }
        if (ok) p.KCMP[((size_t)(b * 2 + g) * 256 + n) * 64 + col] = f2bf(v);
      } else {
        if (ok) p.VCMPT[((size_t)(b * 2 + g) * 64 + col) * 256 + n] = f2bf(v);
      }
    }
}

__device__ void conv_units(const Params& p, int u) {
  const int it = u >> 8, wvi = (u >> 6) & 3, ln = u & 63;
  const int cgp = ((it & 3) * 4 + wvi) * 8 + (ln >> 3), tg = (it >> 2) * 8 + (ln & 7);
  const int tok0 = tg * 8, s0 = tok0 & 4095, ch0 = cgp * 8;
  const int b = tok0 >> 12;
  bf16x8 in[11];
#pragma unroll
  for (int r = 0; r < 11; r++) {
    int s = s0 - 3 + r;
    if (s >= 0) in[r] = *(const bf16x8*)(p.PROJ + (size_t)(tok0 - 3 + r) * NIN + C_XBC + ch0);
    else in[r] = (bf16x8){0, 0, 0, 0, 0, 0, 0, 0};
  }
  float4 wv[4][2];
#pragma unroll
  for (int k = 0; k < 4; k++) { wv[k][0] = *(const float4*)(p.conv_w + k * 1024 + ch0); wv[k][1] = *(const float4*)(p.conv_w + k * 1024 + ch0 + 4); }
  float4 bv0 = *(const float4*)(p.conv_b + ch0), bv1 = *(const float4*)(p.conv_b + ch0 + 4);
  float w[4][8], bias[8];
#pragma unroll
  for (int k = 0; k < 4; k++) { w[k][0] = wv[k][0].x; w[k][1] = wv[k][0].y; w[k][2] = wv[k][0].z; w[k][3] = wv[k][0].w; w[k][4] = wv[k][1].x; w[k][5] = wv[k][1].y; w[k][6] = wv[k][1].z; w[k][7] = wv[k][1].w; }
  bias[0] = bv0.x; bias[1] = bv0.y; bias[2] = bv0.z; bias[3] = bv0.w; bias[4] = bv1.x; bias[5] = bv1.y; bias[6] = bv1.z; bias[7] = bv1.w;
  if (ch0 >= 512) {
#pragma unroll
    for (int tt = 0; tt < 8; tt++) {
      bf16x8 o;
#pragma unroll
      for (int j = 0; j < 8; j++) {
        float a = bias[j];
#pragma unroll
        for (int k = 0; k < 4; k++) a += bfs(in[tt + k][j]) * w[k][j];
        o[j] = (short)f2bf(silu_f(a));
      }
      *(bf16x8*)(p.BC + (size_t)(tok0 + tt) * 512 + (ch0 - 512)) = o;
    }
  }
  if (ch0 < 768) {
#pragma unroll
    for (int j = 0; j < 8; j++) {
      bf16x8 o;
#pragma unroll
      for (int tt = 0; tt < 8; tt++) {
        float a = bias[j];
#pragma unroll
        for (int k = 0; k < 4; k++) a += bfs(in[tt + k][j]) * w[k][j];
        o[tt] = (short)f2bf(silu_f(a));
      }
      const int ch = ch0 + j;
      bf16_t* dst;
      if (ch0 < 512) dst = p.XT + ((size_t)(b * 8 + (ch >> 6)) * 64 + (ch & 63)) * S_LEN + s0;
      else dst = p.BT + ((size_t)(b * 2 + ((ch - 512) >> 7)) * 128 + ((ch - 512) & 127)) * S_LEN + s0;
      *(bf16x8*)dst = o;
    }
  }
}

__device__ void ssd_states_item(const Params& p, int item, char* smem) {
  const int tid = get_tid(), lane = tid & 63, wave = tid >> 6, lr = lane & 15, lg = lane >> 4;
  const int h = item & 7, c = (item >> 3) & 31, b = item >> 8;
  const int g = h >> 2;
  bf16_t* sX = (bf16_t*)smem;
  bf16_t* sBt = sX + 64 * 136;
  float* sAcs = (float*)(smem + (64 + 128) * 136 * 2);
  float* sW = sAcs + 128;
  float* sTot = sW + 128;
  const size_t tok0 = (size_t)b * S_LEN + c * 128;
  const bf16_t* xt = p.XT + (size_t)(b * 8 + h) * 64 * S_LEN + c * 128;
  const bf16_t* bt = p.BT + (size_t)(b * 2 + g) * 128 * S_LEN + c * 128;
  __syncthreads();
  bf16x8 tx[4], tb[8];
#pragma unroll
  for (int i = 0; i < 4; i++) { int ch = tid + 256 * i; tx[i] = *(const bf16x8*)(xt + (size_t)(ch >> 4) * S_LEN + (ch & 15) * 8); }
#pragma unroll
  for (int i = 0; i < 8; i++) { int ch = tid + 256 * i; tb[i] = *(const bf16x8*)(bt + (size_t)(ch >> 4) * S_LEN + (ch & 15) * 8); }
  float dt = 0.f, cs = 0.f;
  if (tid < 128) {
    float raw = bf2f(p.PROJ[(tok0 + tid) * NIN + C_DT + h]) + p.dt_bias[h];
    dt = fmaxf(raw, 0.f) + log1pf(__expf(-fabsf(raw)));
    float a = -__expf(p.a_log[h]);
    cs = dt * a;
#pragma unroll
    for (int o = 1; o < 64; o <<= 1) { float t = __shfl_up(cs, o); if (lane >= o) cs += t; }
    if (lane == 63) sTot[wave] = cs;
  }
  __syncthreads();
  if (tid < 128) {
    if (wave == 1) cs += sTot[0];
    sAcs[tid] = cs;
  }
  __syncthreads();
  if (tid < 128) {
    float last = sAcs[127];
    sW[tid] = dt * __expf(last - cs);
    const size_t o = ((size_t)(b * 32 + c) * 8 + h) * 128 + tid;
    p.ACS[o] = cs; p.DTV[o] = dt;
    if (tid == 0) p.CHDEC[(b * 32 + c) * 8 + h] = __expf(last);
  }
#pragma unroll
  for (int i = 0; i < 8; i++) { int ch = tid + 256 * i; *(bf16x8*)(sBt + (ch >> 4) * 136 + (ch & 15) * 8) = tb[i]; }
  __syncthreads();
#pragma unroll
  for (int i = 0; i < 4; i++) {
    int ch = tid + 256 * i;
    const int l0 = (ch & 15) * 8;
    float4 w0 = *(const float4*)(sW + l0), w1 = *(const float4*)(sW + l0 + 4);
    bf16x8 r = tx[i];
    *(bf16x8*)(sX + (ch >> 4) * 136 + l0) = pack8(bfs(r[0]) * w0.x, bfs(r[1]) * w0.y, bfs(r[2]) * w0.z, bfs(r[3]) * w0.w,
                                                  bfs(r[4]) * w1.x, bfs(r[5]) * w1.y, bfs(r[6]) * w1.z, bfs(r[7]) * w1.w);
  }
  __syncthreads();
  f32x4 acc[4][2];
#pragma unroll
  for (int i = 0; i < 4; i++) { acc[i][0] = (f32x4){0.f, 0.f, 0.f, 0.f}; acc[i][1] = (f32x4){0.f, 0.f, 0.f, 0.f}; }
#pragma unroll
  for (int ks = 0; ks < 4; ks++) {
    const int l0 = 32 * ks + 8 * lg;
    bf16x8 bf0 = *(const bf16x8*)(sBt + (32 * wave + lr) * 136 + l0);
    bf16x8 bf1 = *(const bf16x8*)(sBt + (32 * wave + 16 + lr) * 136 + l0);
#pragma unroll
    for (int pt = 0; pt < 4; pt++) {
      bf16x8 a = *(const bf16x8*)(sX + (16 * pt + lr) * 136 + l0);
      acc[pt][0] = mfma16(a, bf0, acc[pt][0]);
      acc[pt][1] = mfma16(a, bf1, acc[pt][1]);
    }
  }
  bf16_t* st = (bf16_t*)p.STATES + ((size_t)(b * 32 + c) * 8 + h) * 8192;
#pragma unroll
  for (int pt = 0; pt < 4; pt++)
#pragma unroll
    for (int x = 0; x < 2; x++)
#pragma unroll
      for (int i = 0; i < 4; i++) st[(16 * pt + 4 * lg + i) * 128 + 32 * wave + 16 * x + lr] = f2bf(acc[pt][x][i]);
}

__device__ void scan_units(const Params& p, int q) {
  const int b = q >> 15, r2 = q & 32767, h = r2 >> 12;
  uint32_t* sw = (uint32_t*)p.STATES;
  float h0 = 0.f, h1 = 0.f;
  for (int c0 = 0; c0 < 32; c0 += 16) {
    uint32_t s[16]; float d[16];
#pragma unroll
    for (int i = 0; i < 16; i++) { s[i] = sw[(size_t)(b * 32 + c0 + i) * 32768 + r2]; d[i] = p.CHDEC[(b * 32 + c0 + i) * 8 + h]; }
#pragma unroll
    for (int i = 0; i < 16; i++) {
      sw[(size_t)(b * 32 + c0 + i) * 32768 + r2] = pk2(h0, h1);
      h0 = h0 * d[i] + __uint_as_float(s[i] << 16);
      h1 = h1 * d[i] + __uint_as_float(s[i] & 0xffff0000u);
    }
  }
}

__device__ void ssd_y_item(const Params& p, int item, char* smem) {
  const int tid = get_tid(), lane = tid & 63, wave = tid >> 6, lr = lane & 15, lg = lane >> 4;
  const int h = item & 7, c = (item >> 3) & 31, b = item >> 8;
  const int g = h >> 2;
  bf16_t* sB = (bf16_t*)smem;
  bf16_t* sXT = sB + 128 * 136;
  float* sAcs = (float*)(smem + (128 + 64) * 136 * 2);
  float* sDt = sAcs + 128;
  bf16_t* sPrev = (bf16_t*)(smem + (128 + 64) * 136 * 2 + 1024);
  const size_t tok0 = (size_t)b * S_LEN + c * 128;
  const bf16_t* xt = p.XT + (size_t)(b * 8 + h) * 64 * S_LEN + c * 128;
  const int LT[2] = {wave, 7 - wave};
  const bf16_t* prev = (const bf16_t*)p.STATES + ((size_t)(b * 32 + c) * 8 + h) * 8192;
  __syncthreads();
  {
    bf16x8 tb[8], tx[4];
    bf16x8 tp[4];
#pragma unroll
    for (int i = 0; i < 4; i++) { int ch = tid + 256 * i; tp[i] = *(const bf16x8*)(prev + (ch >> 4) * 128 + (ch & 15) * 8); }
#pragma unroll
    for (int i = 0; i < 8; i++) { int ch = tid + 256 * i; tb[i] = *(const bf16x8*)(p.BC + (tok0 + (ch >> 4)) * 512 + g * 128 + (ch & 15) * 8); }
#pragma unroll
    for (int i = 0; i < 4; i++) { int ch = tid + 256 * i; tx[i] = *(const bf16x8*)(xt + (size_t)(ch >> 4) * S_LEN + (ch & 15) * 8); }
    if (tid < 128) {
      const size_t o = ((size_t)(b * 32 + c) * 8 + h) * 128 + tid;
      sAcs[tid] = p.ACS[o]; sDt[tid] = p.DTV[o];
    }
#pragma unroll
    for (int i = 0; i < 8; i++) { int ch = tid + 256 * i; *(bf16x8*)(sB + (ch >> 4) * 136 + (ch & 15) * 8) = tb[i]; }
#pragma unroll
    for (int i = 0; i < 4; i++) { int ch = tid + 256 * i; *(bf16x8*)(sXT + (ch >> 4) * 136 + (ch & 15) * 8) = tx[i]; }
#pragma unroll
    for (int i = 0; i < 4; i++) { int ch = tid + 256 * i; *(bf16x8*)(sPrev + (ch >> 4) * 136 + (ch & 15) * 8) = tp[i]; }
  }
  bf16x8 cf[2][4];
  bf16x4 zpre[2][4];
#pragma unroll
  for (int li = 0; li < 2; li++) {
#pragma unroll
    for (int ks = 0; ks < 4; ks++)
      cf[li][ks] = *(const bf16x8*)(p.BC + (tok0 + 16 * LT[li] + lr) * 512 + 256 + g * 128 + 32 * ks + 8 * lg);
#pragma unroll
    for (int pt = 0; pt < 4; pt++)
      zpre[li][pt] = *(const bf16x4*)(p.PROJ + (tok0 + 16 * LT[li] + lr) * NIN + C_Z + h * 64 + 16 * pt + 4 * lg);
  }
  f32x4 acc[4][2];
#pragma unroll
  for (int i = 0; i < 4; i++) { acc[i][0] = (f32x4){0.f, 0.f, 0.f, 0.f}; acc[i][1] = (f32x4){0.f, 0.f, 0.f, 0.f}; }
  __syncthreads();
#pragma unroll
  for (int pt = 0; pt < 4; pt++)
#pragma unroll
    for (int ks = 0; ks < 4; ks++) {
      bf16x8 a = *(const bf16x8*)(sPrev + (16 * pt + lr) * 136 + 32 * ks + 8 * lg);
      acc[pt][0] = mfma16(a, cf[0][ks], acc[pt][0]);
      acc[pt][1] = mfma16(a, cf[1][ks], acc[pt][1]);
    }
#pragma unroll
  for (int li = 0; li < 2; li++) {
    float e = __expf(sAcs[16 * LT[li] + lr]);
#pragma unroll
    for (int pt = 0; pt < 4; pt++) { acc[pt][li][0] *= e; acc[pt][li][1] *= e; acc[pt][li][2] *= e; acc[pt][li][3] *= e; }
  }
#pragma unroll
  for (int li = 0; li < 2; li++) {
    const int lt = LT[li];
    const int lpos = 16 * lt + lr;
    const float acl = sAcs[lpos];
    for (int sp = 0; sp <= (lt >> 1); sp++) {
      f32x4 cb[2] = {(f32x4){0.f, 0.f, 0.f, 0.f}, (f32x4){0.f, 0.f, 0.f, 0.f}};
#pragma unroll
      for (int x = 0; x < 2; x++)
#pragma unroll
        for (int ks = 0; ks < 4; ks++) {
          bf16x8 bfr = *(const bf16x8*)(sB + (32 * sp + 16 * x + lr) * 136 + 32 * ks + 8 * lg);
          cb[x] = mfma16(bfr, cf[li][ks], cb[x]);
        }
      float mv[8];
#pragma unroll
      for (int x = 0; x < 2; x++)
#pragma unroll
        for (int i = 0; i < 4; i++) {
          const int s = 32 * sp + 16 * x + 4 * lg + i;
          mv[4 * x + i] = (s <= lpos) ? cb[x][i] * __expf(acl - sAcs[s]) * sDt[s] : 0.f;
        }
      bf16x8 mb = pack8(mv[0], mv[1], mv[2], mv[3], mv[4], mv[5], mv[6], mv[7]);
#pragma unroll
      for (int pt = 0; pt < 4; pt++) {
        const bf16_t* xp = sXT + (16 * pt + lr) * 136 + 32 * sp + 4 * lg;
        bf16x8 a = cat44(*(const bf16x4*)xp, *(const bf16x4*)(xp + 16));
        acc[pt][li] = mfma16(a, mb, acc[pt][li]);
      }
    }
  }
  const float dsk = p.d_skip[h];
#pragma unroll
  for (int li = 0; li < 2; li++) {
    const int lpos = 16 * LT[li] + lr;
    const size_t tok = tok0 + lpos;
    float ss = 0.f;
#pragma unroll
    for (int pt = 0; pt < 4; pt++) {
      const int pb = 16 * pt + 4 * lg;
      bf16x4 zv = zpre[li][pt];
      float y[4];
#pragma unroll
      for (int i = 0; i < 4; i++) {
        float xv = bf2f(sXT[(pb + i) * 136 + lpos]);
        y[i] = (acc[pt][li][i] + dsk * xv) * silu_f(bfs(zv[i]));
        ss += y[i] * y[i];
      }
      *(bf16x4*)(p.MIX + tok * 1536 + 512 + h * 64 + pb) = pack4(y[0], y[1], y[2], y[3]);
    }
    ss += __shfl_xor(ss, 16); ss += __shfl_xor(ss, 32);
    if (lg == 0) p.SS_SSD[tok * 8 + h] = ss;
  }
}

__device__ void final_rows(const Params& p, int gw, int nw) {
  const int lane = threadIdx.x & 63;
  const float4* gf = (const float4*)p.g_final;
  float4 gg[4];
#pragma unroll
  for (int i = 0; i < 4; i++) gg[i] = gf[lane + 64 * i];
  const int nb = gridDim.x;
  if ((nb & 7) == 0) {
    const int xcd = blockIdx.x & 7, lw = (blockIdx.x >> 3) * 4 + (threadIdx.x >> 6), nlw = (nb >> 3) * 4;
    for (int k = lw; k < 4096; k += nlw) {
      const int row = xcd * 4096 + 4095 - k;
      const float rr = rsqrtf(p.SS_OUT[row] * (1.f / 1024.f) + 1e-6f);
      float4* o = (float4*)(p.out + (size_t)row * 1024);
#pragma unroll
      for (int i = 0; i < 4; i++) {
        float4 t = o[lane + 64 * i];
        t.x *= rr * gg[i].x; t.y *= rr * gg[i].y; t.z *= rr * gg[i].z; t.w *= rr * gg[i].w;
        o[lane + 64 * i] = t;
      }
    }
  } else {
    for (int row = gw; row < T_TOK; row += nw) {
      const float rr = rsqrtf(p.SS_OUT[row] * (1.f / 1024.f) + 1e-6f);
      float4* o = (float4*)(p.out + (size_t)row * 1024);
#pragma unroll
      for (int i = 0; i < 4; i++) {
        float4 t = o[lane + 64 * i];
        t.x *= rr * gg[i].x; t.y *= rr * gg[i].y; t.z *= rr * gg[i].z; t.w *= rr * gg[i].w;
        o[lane + 64 * i] = t;
      }
    }
  }
}

__device__ __forceinline__ void grid_bar(unsigned* bar, unsigned k) {
  asm volatile("s_waitcnt vmcnt(0)" ::: "memory");
  __syncthreads();
  if (threadIdx.x == 0) {
    const unsigned nb = gridDim.x, r = blockIdx.x & 7u;
    const unsigned nsub = (nb - r + 7u) >> 3;
    const unsigned ngrp = nb < 8u ? nb : 8u;
    __builtin_amdgcn_fence(__ATOMIC_RELEASE, "agent");
    asm volatile("s_waitcnt vmcnt(0)" ::: "memory");
    const unsigned old = __hip_atomic_fetch_add(bar + 64 * r, 1u, __ATOMIC_RELAXED, __HIP_MEMORY_SCOPE_AGENT);
    if (old + 1u == k * nsub) {
      __builtin_amdgcn_fence(__ATOMIC_ACQ_REL, "agent");
      asm volatile("s_waitcnt vmcnt(0)" ::: "memory");
      __hip_atomic_fetch_add(bar + 64 * 8, 1u, __ATOMIC_RELAXED, __HIP_MEMORY_SCOPE_AGENT);
    }
    while (__hip_atomic_load(bar + 64 * 8, __ATOMIC_RELAXED, __HIP_MEMORY_SCOPE_AGENT) < k * ngrp) __builtin_amdgcn_s_sleep(1);
    __builtin_amdgcn_fence(__ATOMIC_ACQUIRE, "agent");
    asm volatile("s_waitcnt vmcnt(0)" ::: "memory");
  }
  __syncthreads();
}

__device__ __forceinline__ int next_item(unsigned* ctr, char* smem) {
  int* sh = (int*)(smem + SMEM_BYTES - 16);
  __syncthreads();
  if (threadIdx.x == 0) *sh = (int)__hip_atomic_fetch_add(ctr, 1u, __ATOMIC_RELAXED, __HIP_MEMORY_SCOPE_AGENT);
  __syncthreads();
  return *sh;
}

__global__ void __launch_bounds__(256, 2) hymba_fwd(Params p) {
  cg::grid_group grid = cg::this_grid();
  __shared__ __attribute__((aligned(16))) char smem[SMEM_BYTES];
  const int nb = gridDim.x, bid = blockIdx.x;
  unsigned bk = 0;

  if (p.out == nullptr) grid.sync();
  for (int rep = 0; rep < REP0; rep++) {
  phase_prep(p);
  grid_bar(p.BAR, ++bk);
  }
  for (int rep = 0; rep < REP1; rep++) {
  if ((nb & 7) == 0) {
    const int xcd = bid & 7, li = bid >> 3, nbx = nb >> 3;
    for (int e = li; e < 1120; e += nbx) {
      const int grp = e / 280, r = e - grp * 280;
      gemm_tile<0>(p, xcd * 32 + grp * 8 + (r & 7), r >> 3, smem);
    }
  } else {
    for (int it = bid; it < 256 * 35; it += nb) gemm_tile<0>(p, it / 35, it % 35, smem);
  }
  for (int j = bid; j < 128; j += nb) gemm_tile<1>(p, j >> 3, j & 7, smem);
  grid_bar(p.BAR, ++bk);
  }
  for (int rep = 0; rep < REP2; rep++) {
  for (int it = next_item(p.BAR + 64 * (9 + rep), smem); it < 256 + 1024 + 2048; it = next_item(p.BAR + 64 * (9 + rep), smem)) {
    if (it < 256) compress_item(p, it, smem);
    else if (it < 1280) memattn_item(p, it - 256, smem);
    else conv_units(p, (it - 1280) * 256 + get_tid());
  }
  grid_bar(p.BAR, ++bk);
  }
  for (int rep = 0; rep < REP3; rep++) {
  {
    const int xq = bid & 7;
    unsigned* ctr = p.BAR + 64 * (16 + xq + 8 * rep);
    for (int li = next_item(ctr, smem); li < 512; li = next_item(ctr, smem)) {
      if (li < 256) ssd_states_item(p, li * 8 + xq, smem);
      else { const int l2 = li - 256; nsa_item(p, ((l2 >> 1) << 4) | (xq + 8 * (l2 & 1)), smem); }
    }
  }
  grid_bar(p.BAR, ++bk);
  }
  for (int it = bid; it < 1024; it += nb) scan_units(p, it * 256 + get_tid());
  grid_bar(p.BAR, ++bk);
  for (int rep = 0; rep < REP5; rep++) {
  for (int it = bid; it < 2048; it += nb) ssd_y_item(p, it, smem);
  grid_bar(p.BAR, ++bk);
  }
  if ((nb & 7) == 0) {
    const int xcd = bid & 7, li = bid >> 3, nbx = nb >> 3;
    for (int e = li; e < 256; e += nbx) gemm_tile<2>(p, xcd * 32 + (e >> 3), e & 7, smem);
  } else {
    for (int it = bid; it < 256 * 8; it += nb) gemm_tile<2>(p, it >> 3, it & 7, smem);
  }
  grid_bar(p.BAR, ++bk);
  final_rows(p, (bid * 256 + threadIdx.x) >> 6, (nb * 256) >> 6);
}

extern "C" void kernel_launch(void* const* d_in, const int* in_sizes, int n_in, void* d_out, int out_size, void* d_ws, size_t ws_size,
                              hipStream_t stream) {
  static int grid_blocks = 0;
  if (!grid_blocks) {
    int dev = 0, cus = 0, per_cu = 0;
    hipGetDevice(&dev);
    hipDeviceGetAttribute(&cus, hipDeviceAttributeMultiprocessorCount, dev);
    hipOccupancyMaxActiveBlocksPerMultiprocessor(&per_cu, hymba_fwd, 256, 0);
    if (per_cu < 1) per_cu = 1;
    if (per_cu > 4) per_cu = 4;
    grid_blocks = cus * per_cu;
  }
  Params p{};
  p.x = (const float*)d_in[0]; p.mem = (const float*)d_in[1]; p.pos = (const int*)d_in[2];
  p.g_in = (const float*)d_in[3]; p.w_in = (const float*)d_in[4]; p.cpk = (const float*)d_in[5];
  p.w1k = (const float*)d_in[6]; p.w2k = (const float*)d_in[7]; p.cpv = (const float*)d_in[8];
  p.w1v = (const float*)d_in[9]; p.w2v = (const float*)d_in[10]; p.conv_w = (const float*)d_in[11];
  p.conv_b = (const float*)d_in[12]; p.dt_bias = (const float*)d_in[13]; p.a_log = (const float*)d_in[14];
  p.d_skip = (const float*)d_in[15]; p.g_ssd = (const float*)d_in[16]; p.g_mem = (const float*)d_in[17];
  p.w_kv = (const float*)d_in[18]; p.w_out = (const float*)d_in[19]; p.g_final = (const float*)d_in[20];
  p.out = (float*)d_out;
  char* w = (char*)d_ws; size_t off = 0;
  auto take = [&](size_t bytes) { char* r = w + off; off += (bytes + 255) & ~(size_t)255; return r; };
  p.WinT = (bf16_t*)take((size_t)NINP * 1024 * 2);
  p.WoutT = (bf16_t*)take((size_t)1024 * 1536 * 2);
  p.WkvT = (bf16_t*)take((size_t)1024 * 1024 * 2);
  p.W1kT = (bf16_t*)take((size_t)256 * 2048 * 2);
  p.W1vT = (bf16_t*)take((size_t)256 * 2048 * 2);
  p.W2kT = (bf16_t*)take((size_t)64 * 256 * 2);
  p.W2vT = (bf16_t*)take((size_t)64 * 256 * 2);
  p.MEMB = (bf16_t*)take((size_t)2048 * 1024 * 2);
  p.PROJ = (bf16_t*)take((size_t)T_TOK * NIN * 2);
  p.VST = (bf16_t*)take((size_t)16 * 64 * S_LEN * 2);
  p.VWT = (bf16_t*)take((size_t)16 * 64 * S_LEN * 2);
  p.KMEM = (bf16_t*)take((size_t)2048 * 512 * 2);
  p.VMEMT = (bf16_t*)take((size_t)32 * 128 * 256 * 2);
  p.KCMP = (bf16_t*)take((size_t)16 * 256 * 64 * 2);
  p.VCMPT = (bf16_t*)take((size_t)16 * 64 * 256 * 2);
  p.XT = (bf16_t*)take((size_t)64 * 64 * S_LEN * 2);
  p.BC = (bf16_t*)take((size_t)T_TOK * 512 * 2);
  p.BT = (bf16_t*)take((size_t)16 * 128 * S_LEN * 2);
  p.MIX = (bf16_t*)take((size_t)T_TOK * 1536 * 2);
  p.XB = p.MIX;
  p.CHDEC = (float*)take((size_t)8 * 32 * 8 * 4);
  p.ACS = (float*)take((size_t)8 * 32 * 8 * 128 * 4);
  p.DTV = (float*)take((size_t)8 * 32 * 8 * 128 * 4);
  p.SS_SSD = (float*)take((size_t)T_TOK * 8 * 4);
  p.SS_OUT = (float*)take((size_t)T_TOK * 4);
  p.BAR = (unsigned*)take((size_t)(64 * 32 + 256) * 4);
  p.MTCNT = p.BAR + 64 * 32;
  p.STATES = (float*)d_out;
  p.KSC = (bf16_t*)((char*)d_out + (size_t)80 * 1024 * 1024);
  p.KWC = p.KSC + (size_t)16 * S_LEN * 64;
  if (off > ws_size) { fprintf(stderr, "workspace too small: need %zu have %zu\n", off, ws_size); return; }
  hipMemsetAsync(p.BAR, 0, (64 * 32 + 256) * 4, stream);
  void* args[] = {&p};
  hipError_t e = hipLaunchCooperativeKernel((void*)hymba_fwd, dim3(grid_blocks), dim3(256), args, 0, stream);
  if (e != hipSuccess) fprintf(stderr, "cooperative launch failed: %s (grid %d)\n", hipGetErrorString(e), grid_blocks);
}
```

```cpp
#include <hip/hip_runtime.h>
#include <hip/hip_cooperative_groups.h>
#include <stdint.h>
#include <stdio.h>
namespace cg = cooperative_groups;

typedef unsigned short bf16_t;
typedef __attribute__((ext_vector_type(8))) short bf16x8;
typedef __attribute__((ext_vector_type(4))) short bf16x4;
typedef __attribute__((ext_vector_type(4))) float f32x4;

#define S_LEN 4096
#define T_TOK 32768
#define NIN 4384
#define NINP 4480
#define LOG2E 1.4426950408889634f

#define C_Q 0
#define C_KC 512
#define C_VC 640
#define C_KS 768
#define C_KW 1024
#define C_GL 1280
#define C_GA 1304
#define C_Z 1816
#define C_XBC 2328
#define C_DT 3352
#define C_QX 3360
#define C_GX 3872

#define SMEM_BYTES 73728
#ifndef REP0
#define REP0 1
#endif
#ifndef REP1
#define REP1 1
#endif
#ifndef REP2
#define REP2 1
#endif
#ifndef REP3
#define REP3 1
#endif
#ifndef REP5
#define REP5 1
#endif

struct Params {
  const float *x, *mem; const int* pos;
  const float *g_in, *w_in, *cpk, *w1k, *w2k, *cpv, *w1v, *w2v, *conv_w, *conv_b, *dt_bias, *a_log, *d_skip, *g_ssd, *g_mem, *w_kv, *w_out, *g_final;
  float* out;
  bf16_t *WinT, *WoutT, *WkvT, *W1kT, *W1vT, *W2kT, *W2vT, *XB, *MEMB, *PROJ, *VST, *VWT, *KMEM, *VMEMT, *KCMP, *VCMPT, *XT, *BC, *BT, *MIX, *KSC, *KWC;
  float *STATES, *CHDEC, *ACS, *DTV, *SS_SSD, *SS_OUT;
  unsigned* BAR;
  unsigned* MTCNT;
};

__device__ __forceinline__ bf16_t f2bf(float f) { uint32_t u = __float_as_uint(f); u += 0x7fffu + ((u >> 16) & 1u); return (bf16_t)(u >> 16); }
__device__ __forceinline__ float bf2f(bf16_t h) { return __uint_as_float(((uint32_t)h) << 16); }
__device__ __forceinline__ float bfs(short h) { return __uint_as_float(((uint32_t)(unsigned short)h) << 16); }
__device__ __forceinline__ float fexp2(float x) { return __builtin_amdgcn_exp2f(x); }
__device__ __forceinline__ float silu_f(float x) { return x * __builtin_amdgcn_rcpf(1.f + __builtin_amdgcn_exp2f(-1.4426950408889634f * x)); }
__device__ __forceinline__ float sigmoid_f(float x) { return __builtin_amdgcn_rcpf(1.f + __builtin_amdgcn_exp2f(-1.4426950408889634f * x)); }
__device__ __forceinline__ f32x4 mfma16(bf16x8 a, bf16x8 b, f32x4 c) { return __builtin_amdgcn_mfma_f32_16x16x32_bf16(a, b, c, 0, 0, 0); }
typedef __bf16 hbf2_t __attribute__((ext_vector_type(2)));
typedef float f2_t __attribute__((ext_vector_type(2)));
typedef uint32_t u32x2 __attribute__((ext_vector_type(2)));
typedef uint32_t u32x4 __attribute__((ext_vector_type(4)));
__device__ __forceinline__ uint32_t pk2(float a, float b) {
  f2_t v; v[0] = a; v[1] = b;
  hbf2_t r = __builtin_convertvector(v, hbf2_t);
  return __builtin_bit_cast(uint32_t, r);
}
__device__ __forceinline__ bf16x4 pack4(float a, float b, float c, float d) {
  u32x2 r; r[0] = pk2(a, b); r[1] = pk2(c, d); return __builtin_bit_cast(bf16x4, r);
}
__device__ __forceinline__ bf16x8 pack8(float a, float b, float c, float d, float e, float f, float g, float h) {
  u32x4 r; r[0] = pk2(a, b); r[1] = pk2(c, d); r[2] = pk2(e, f); r[3] = pk2(g, h); return __builtin_bit_cast(bf16x8, r);
}
__device__ __forceinline__ bf16x8 cat44(bf16x4 a, bf16x4 b) {
  u32x2 x = __builtin_bit_cast(u32x2, a), y = __builtin_bit_cast(u32x2, b);
  u32x4 r; r[0] = x[0]; r[1] = x[1]; r[2] = y[0]; r[3] = y[1]; return __builtin_bit_cast(bf16x8, r);
}
template <int NR, typename L, typename ST, typename C>
__device__ __forceinline__ void tile_pipeline(int n, L load, ST store, C compute) {
  if (n <= 0) return;
  bf16x8 ra[NR], rb[NR];
  const int last = n - 1;
  load(0, ra);
  load(min(1, last), rb);
  store(0, ra);
  load(min(2, last), ra);
  __syncthreads();
  for (int i = 0; i < n; i += 2) {
    compute(i, 0);
    store(1, rb);
    load(min(i + 3, last), rb);
    __syncthreads();
    if (i + 1 < n) compute(i + 1, 1);
    store(0, ra);
    load(min(i + 4, last), ra);
    __syncthreads();
  }
}
template <int NR, typename L, typename ST, typename C>
__device__ __forceinline__ void tile_pipeline1(int n, L load, ST store, C compute) {
  if (n <= 0) return;
  bf16x8 ra[NR];
  load(0, ra);
  store(0, ra);
  if (n > 1) load(1, ra);
  __syncthreads();
  for (int i = 0; i < n; i++) {
    compute(i, i & 1);
    if (i + 1 < n) { store((i + 1) & 1, ra); if (i + 2 < n) load(i + 2, ra); }
    __syncthreads();
  }
}
__device__ __forceinline__ void rope_cs(int pos, int j, float& cs, float& sn) {
  float inv = fexp2(-(float)j * (18.931568569324174f / 8.f));
  float a = (float)pos * inv;
  float n = rintf(a * 0.15915494309189535f);
  float r = fmaf(-n, 6.28125f, a);
  r = fmaf(-n, 1.9353071795864769e-3f, r);
  cs = __cosf(r); sn = __sinf(r);
}

__device__ __forceinline__ float rowmax4(float x) {
  unsigned xi = __float_as_uint(x);
  auto a = __builtin_amdgcn_permlane16_swap(xi, xi, false, false);
  float m = fmaxf(__uint_as_float(a[0]), __uint_as_float(a[1]));
  unsigned mi = __float_as_uint(m);
  auto b = __builtin_amdgcn_permlane32_swap(mi, mi, false, false);
  return fmaxf(__uint_as_float(b[0]), __uint_as_float(b[1]));
}
__device__ __forceinline__ float rowsum4(float x) {
  unsigned xi = __float_as_uint(x);
  auto a = __builtin_amdgcn_permlane16_swap(xi, xi, false, false);
  float m = __uint_as_float(a[0]) + __uint_as_float(a[1]);
  unsigned mi = __float_as_uint(m);
  auto b = __builtin_amdgcn_permlane32_swap(mi, mi, false, false);
  return __uint_as_float(b[0]) + __uint_as_float(b[1]);
}
__device__ __forceinline__ int get_tid() { int t = threadIdx.x; asm volatile("" : "+v"(t)); return t; }

__device__ void prep_rows(const float* __restrict__ x, bf16_t* __restrict__ xb, int nrows, int gw, int nw) {
  const int lane = threadIdx.x & 63;
  int row = gw;
  for (; row + 3 * nw < nrows; row += 4 * nw) {
    float4 v[4][4]; float ss[4];
#pragma unroll
    for (int r = 0; r < 4; r++) {
      const float4* p = (const float4*)(x + (size_t)(row + r * nw) * 1024);
#pragma unroll
      for (int i = 0; i < 4; i++) v[r][i] = p[lane + 64 * i];
    }
#pragma unroll
    for (int r = 0; r < 4; r++) {
      float s = 0.f;
#pragma unroll
      for (int i = 0; i < 4; i++) s += v[r][i].x * v[r][i].x + v[r][i].y * v[r][i].y + v[r][i].z * v[r][i].z + v[r][i].w * v[r][i].w;
#pragma unroll
      for (int o = 32; o >= 1; o >>= 1) s += __shfl_xor(s, o);
      ss[r] = rsqrtf(s * (1.f / 1024.f) + 1e-6f);
    }
#pragma unroll
    for (int r = 0; r < 4; r++)
#pragma unroll
      for (int i = 0; i < 4; i++)
        *(bf16x4*)(xb + (size_t)(row + r * nw) * 1024 + (lane + 64 * i) * 4) =
            pack4(v[r][i].x * ss[r], v[r][i].y * ss[r], v[r][i].z * ss[r], v[r][i].w * ss[r]);
  }
  for (; row < nrows; row += nw) {
    const float4* p = (const float4*)(x + (size_t)row * 1024);
    float4 v[4]; float ss = 0.f;
#pragma unroll
    for (int i = 0; i < 4; i++) { v[i] = p[lane + 64 * i]; ss += v[i].x * v[i].x + v[i].y * v[i].y + v[i].z * v[i].z + v[i].w * v[i].w; }
#pragma unroll
    for (int o = 32; o >= 1; o >>= 1) ss += __shfl_xor(ss, o);
    float r = rsqrtf(ss * (1.f / 1024.f) + 1e-6f);
#pragma unroll
    for (int i = 0; i < 4; i++) {
      bf16x4 o = pack4(v[i].x * r, v[i].y * r, v[i].z * r, v[i].w * r);
      *(bf16x4*)(xb + (size_t)row * 1024 + (lane + 64 * i) * 4) = o;
    }
  }
}

__device__ void prep_wT(const float* __restrict__ w, const float* __restrict__ g, int gk0, int gk1, bf16_t* __restrict__ wt,
                        int K, int N, int Npad, int gtid, int gthreads) {
  const int ln = gtid & 63, gwv = gtid >> 6, nwv = gthreads >> 6;
  const int kblocks = K >> 6;
  const int total = (Npad >> 3) * kblocks;
  for (int uw = gwv; uw < total; uw += nwv) {
    const int kb = uw % kblocks, nbk = uw / kblocks;
    const int n = nbk * 8 + (ln >> 3), k8 = kb * 8 + (ln & 7);
    bf16x8 o;
#pragma unroll
    for (int j = 0; j < 8; j++) {
      int k = k8 * 8 + j; float v = 0.f;
      if (n < N) { v = w[(size_t)k * N + n]; if (g != nullptr && k >= gk0 && k < gk1) v *= g[k - gk0]; }
      o[j] = (short)f2bf(v);
    }
    *(bf16x8*)(wt + (size_t)n * K + k8 * 8) = o;
  }
}

__device__ void phase_prep(const Params& p) {
  const int gtid = blockIdx.x * 256 + threadIdx.x, gthreads = gridDim.x * 256;
  const int gw = gtid >> 6, nw = gthreads >> 6;
  prep_rows(p.x, p.XB, T_TOK, gw, nw);
  prep_rows(p.mem, p.MEMB, 2048, gw, nw);
  prep_wT(p.w_in, p.g_in, 0, 1024, p.WinT, 1024, NIN, NINP, gtid, gthreads);
  prep_wT(p.w_out, p.g_ssd, 512, 1024, p.WoutT, 1536, 1024, 1024, gtid, gthreads);
  prep_wT(p.w_kv, p.g_mem, 0, 1024, p.WkvT, 1024, 1024, 1024, gtid, gthreads);
  prep_wT(p.w1k, nullptr, 0, 0, p.W1kT, 2048, 256, 256, gtid, gthreads);
  prep_wT(p.w1v, nullptr, 0, 0, p.W1vT, 2048, 256, 256, gtid, gthreads);
  prep_wT(p.w2k, nullptr, 0, 0, p.W2kT, 256, 64, 64, gtid, gthreads);
  prep_wT(p.w2v, nullptr, 0, 0, p.W2vT, 256, 64, 64, gtid, gthreads);
  for (int i = gtid; i < T_TOK; i += gthreads) p.SS_OUT[i] = 0.f;
  for (int i = gtid; i < 16 * 64; i += gthreads) {
    int bg = i >> 6, d = i & 63;
    p.KCMP[((size_t)bg * 256 + 255) * 64 + d] = 0;
    p.VCMPT[((size_t)bg * 64 + d) * 256 + 255] = 0;
  }
}

typedef __attribute__((address_space(3))) unsigned lds_u32_t;
typedef __attribute__((address_space(1))) const unsigned glb_u32_t;
__device__ __forceinline__ void glds16(const bf16_t* g, char* l) {
  __builtin_amdgcn_global_load_lds((glb_u32_t*)g, (lds_u32_t*)l, 16, 0, 0);
}
template <int MODE>
__device__ void gemm_tile_reg(const Params& p, int mt, int nt, char* smem) {
  const int tid = get_tid(), lane = tid & 63, wave = tid >> 6, lr = lane & 15, lg = lane >> 4;
  const int wr = wave >> 1, wc = wave & 1;
  const int m0 = mt * 128, n0 = nt * 128;
  const bf16_t* A; const bf16_t* Bt; int K;
  if (MODE == 0) { A = p.XB; Bt = p.WinT; K = 1024; }
  else if (MODE == 1) { A = p.MEMB; Bt = p.WkvT; K = 1024; }
  else { A = p.MIX; Bt = p.WoutT; K = 1536; }
  bf16_t* As = (bf16_t*)smem;
  bf16_t* Bs = As + 2 * 9216;
  const int lrow = tid >> 3, kc = tid & 7;
  const bf16_t* ga = A + (size_t)(m0 + lrow) * K + kc * 8;
  const bf16_t* gb = Bt + (size_t)(n0 + lrow) * K + kc * 8;
  float rs[4] = {1.f, 1.f, 1.f, 1.f};
  if (MODE == 2) {
#pragma unroll
    for (int i = 0; i < 4; i++) {
      const float4* sp = (const float4*)(p.SS_SSD + (size_t)(m0 + lrow + 32 * i) * 8);
      float4 a = sp[0], b = sp[1];
      rs[i] = rsqrtf((a.x + a.y + a.z + a.w + b.x + b.y + b.z + b.w) * (1.f / 512.f) + 1e-6f);
    }
  }
  bool swap;
  if (MODE == 0) swap = !(nt == 7 || nt == 9);
  else if (MODE == 1) swap = (nt < 4);
  else swap = true;
  const bf16_t* F = swap ? (Bs + (64 * wc) * 72) : (As + (64 * wr) * 72);
  const bf16_t* G = swap ? (As + (64 * wr) * 72) : (Bs + (64 * wc) * 72);
  f32x4 acc[4][4];
#pragma unroll
  for (int i = 0; i < 4; i++)
#pragma unroll
    for (int j = 0; j < 4; j++) acc[i][j] = (f32x4){0.f, 0.f, 0.f, 0.f};
  bf16x8 ra0[4], rb0[4], ra1[4], rb1[4];
  const int nk = K / 64;
  auto load = [&](int kt, bf16x8 (&ra)[4], bf16x8 (&rb)[4]) {
#pragma unroll
    for (int i = 0; i < 4; i++) {
      ra[i] = *(const bf16x8*)(ga + (size_t)(32 * i) * K + kt * 64);
      rb[i] = *(const bf16x8*)(gb + (size_t)(32 * i) * K + kt * 64);
    }
  };
  auto store = [&](int buf, int kt, bf16x8 (&ra)[4], bf16x8 (&rb)[4]) {
    if (MODE == 2) {
      if (kt >= 8 && kt < 16) {
#pragma unroll
        for (int i = 0; i < 4; i++) {
          bf16x8 v = ra[i];
          ra[i] = pack8(bfs(v[0]) * rs[i], bfs(v[1]) * rs[i], bfs(v[2]) * rs[i], bfs(v[3]) * rs[i],
                        bfs(v[4]) * rs[i], bfs(v[5]) * rs[i], bfs(v[6]) * rs[i], bfs(v[7]) * rs[i]);
        }
      }
    }
#pragma unroll
    for (int i = 0; i < 4; i++) {
      *(bf16x8*)(As + buf * 9216 + (lrow + 32 * i) * 72 + kc * 8) = ra[i];
      *(bf16x8*)(Bs + buf * 9216 + (lrow + 32 * i) * 72 + kc * 8) = rb[i];
    }
  };
  auto compute = [&](int buf) {
    const int cb = buf * 9216;
#pragma unroll
    for (int ks = 0; ks < 2; ks++) {
      bf16x8 ff[4], gg[4];
#pragma unroll
      for (int i = 0; i < 4; i++) {
        ff[i] = *(const bf16x8*)(F + cb + (16 * i + lr) * 72 + ks * 32 + lg * 8);
        gg[i] = *(const bf16x8*)(G + cb + (16 * i + lr) * 72 + ks * 32 + lg * 8);
      }
#pragma unroll
      for (int i = 0; i < 4; i++)
#pragma unroll
        for (int j = 0; j < 4; j++) acc[i][j] = mfma16(ff[i], gg[j], acc[i][j]);
    }
  };
  const int lastk = nk - 1;
  load(0, ra0, rb0);
  load(1, ra1, rb1);
  store(0, 0, ra0, rb0);
  load(2, ra0, rb0);
  __syncthreads();
  for (int kt = 0; kt < nk; kt += 2) {
    compute(0);
    store(1, kt + 1, ra1, rb1);
    load(min(kt + 3, lastk), ra1, rb1);
    __syncthreads();
    compute(1);
    store(0, min(kt + 2, lastk), ra0, rb0);
    load(min(kt + 4, lastk), ra0, rb0);
    __syncthreads();
  }
  if (swap) {
    if (MODE == 0) {
      const bool rope = (nt < 4) || nt == 6 || nt == 8;
#pragma unroll
      for (int mi = 0; mi < 4; mi++) {
        const int m = m0 + 64 * wr + 16 * mi + lr;
        if (rope) {
          const int pos = p.pos[m];
          f32x4 v = acc[0][mi];
          f32x4 o;
#pragma unroll
          for (int i = 0; i < 4; i++) {
            float pr = __shfl_xor(v[i], 32);
            float cs, sn; rope_cs(pos, 4 * (lg & 1) + i, cs, sn);
            o[i] = (lg < 2) ? (v[i] * cs - pr * sn) : (v[i] * cs + pr * sn);
          }
          acc[0][mi] = o;
        }
        {
          bf16_t* stg = (bf16_t*)smem + ((wave & 1) ? 2 * 9216 : 0) + (wave >> 1) * 4608;
#pragma unroll
          for (int ni = 0; ni < 4; ni++) {
            f32x4 v = acc[ni][mi];
            *(bf16x4*)(stg + (16 * mi + lr) * 72 + 16 * ni + 4 * lg) = pack4(v[0], v[1], v[2], v[3]);
          }
        }
      }
      {
        const bf16_t* stg = (const bf16_t*)smem + ((wave & 1) ? 2 * 9216 : 0) + (wave >> 1) * 4608;
        const int rr = lane >> 3, ch = lane & 7;
        const int nb0 = n0 + 64 * wc + ch * 8;
#pragma unroll
        for (int it = 0; it < 8; it++) {
          const int row = it * 8 + rr;
          const int m = m0 + 64 * wr + row;
          bf16x8 v = *(const bf16x8*)(stg + row * 72 + ch * 8);
          if (nt == 6 || nt == 8) {
            bf16_t* kd = ((nt == 6) ? p.KSC : p.KWC) + (((size_t)(m >> 12) * 2 + wc) * S_LEN + (m & 4095)) * 64;
            *(bf16x8*)(kd + ch * 8) = v;
          } else if (nb0 < NIN) {
            *(bf16x8*)(p.PROJ + (size_t)m * NIN + nb0) = v;
          }
        }
      }
      __syncthreads();
    } else if (MODE == 1) {
#pragma unroll
      for (int mi = 0; mi < 4; mi++) {
        const int m = m0 + 64 * wr + 16 * mi + lr;
#pragma unroll
        for (int ni = 0; ni < 4; ni++) {
          const int n = n0 + 64 * wc + 16 * ni + 4 * lg;
          f32x4 v = acc[ni][mi];
          *(bf16x4*)(p.KMEM + (size_t)m * 512 + n) = pack4(v[0], v[1], v[2], v[3]);
        }
      }
    } else {
#pragma unroll
      for (int mi = 0; mi < 4; mi++) {
        const int m = m0 + 64 * wr + 16 * mi + lr;
        float ss = 0.f;
#pragma unroll
        for (int ni = 0; ni < 4; ni++) {
          const int n = n0 + 64 * wc + 16 * ni + 4 * lg;
          float4 xv = *(const float4*)(p.x + (size_t)m * 1024 + n);
          f32x4 v = acc[ni][mi];
          float4 h; h.x = xv.x + v[0]; h.y = xv.y + v[1]; h.z = xv.z + v[2]; h.w = xv.w + v[3];
          ss += h.x * h.x + h.y * h.y + h.z * h.z + h.w * h.w;
          *(float4*)(p.out + (size_t)m * 1024 + n) = h;
        }
        ss += __shfl_xor(ss, 16); ss += __shfl_xor(ss, 32);
        if (lg == 0) atomicAdd(p.SS_OUT + m, ss);
      }
    }
  } else {
#pragma unroll
    for (int mi = 0; mi < 4; mi++)
#pragma unroll
      for (int ni = 0; ni < 4; ni++) {
        f32x4 v = acc[mi][ni];
        bf16x4 o = pack4(v[0], v[1], v[2], v[3]);
        if (MODE == 0) {
          const int b = m0 >> 12, s = (m0 & 4095) + 64 * wr + 16 * mi + 4 * lg;
          const int d = 16 * ni + lr;
          bf16_t* dst = (nt == 7) ? p.VST : p.VWT;
          *(bf16x4*)(dst + ((size_t)(b * 2 + wc) * 64 + d) * S_LEN + s) = o;
        } else {
          const int b = m0 >> 8, s = (m0 & 255) + 64 * wr + 16 * mi + 4 * lg;
          const int col = n0 - 512 + 64 * wc + 16 * ni + lr;
          const int h = col >> 7, d = col & 127;
          *(bf16x4*)(p.VMEMT + ((size_t)(b * 4 + h) * 128 + d) * 256 + s) = o;
        }
      }
  }
}

template <int MODE>
__device__ void gemm_tile_glds(const Params& p, int mt, int nt, char* smem) {
  const int tid = get_tid(), lane = tid & 63, wave = tid >> 6, lr = lane & 15, lg = lane >> 4;
  const int wr = wave >> 1, wc = wave & 1;
  const int m0 = mt * 128, n0 = nt * 128;
  const bf16_t* A; const bf16_t* Bt; int K;
  if (MODE == 0) { A = p.XB; Bt = p.WinT; K = 1024; }
  else if (MODE == 1) { A = p.MEMB; Bt = p.WkvT; K = 1024; }
  else { A = p.MIX; Bt = p.WoutT; K = 1536; }
  float rs[4] = {1.f, 1.f, 1.f, 1.f};
  if (MODE == 2) {
#pragma unroll
    for (int i = 0; i < 4; i++) {
      const float4* sp = (const float4*)(p.SS_SSD + (size_t)(m0 + (wave * 4 + i) * 8 + (lane >> 3)) * 8);
      float4 a = sp[0], b = sp[1];
      rs[i] = rsqrtf((a.x + a.y + a.z + a.w + b.x + b.y + b.z + b.w) * (1.f / 512.f) + 1e-6f);
    }
  }
  bool swap;
  if (MODE == 0) swap = !(nt == 7 || nt == 9);
  else if (MODE == 1) swap = (nt < 4);
  else swap = true;
  const int rl = lane >> 3, pcx = lane & 7;
  const bf16_t* gA[4]; const bf16_t* gB[4];
#pragma unroll
  for (int q = 0; q < 4; q++) {
    const int row = (wave * 4 + q) * 8 + rl;
    const int c = pcx ^ ((row >> 1) & 7);
    gA[q] = A + (size_t)(m0 + row) * K + c * 8;
    gB[q] = Bt + (size_t)(n0 + row) * K + c * 8;
  }
  char* lbase = smem + wave * 4096 + lane * 16;
  auto stage = [&](int buf, int koff) {
#pragma unroll
    for (int q = 0; q < 4; q++) {
      glds16(gA[q] + koff, lbase + buf * 32768 + q * 1024);
      glds16(gB[q] + koff, lbase + buf * 32768 + 16384 + q * 1024);
    }
  };
  const int fro = (swap ? (16384 + 64 * wc * 128) : (64 * wr * 128)) + lr * 128;
  const int gro = (swap ? (64 * wr * 128) : (16384 + 64 * wc * 128)) + lr * 128;
  const int sw = (lr >> 1) & 7;
  f32x4 acc[4][4];
#pragma unroll
  for (int i = 0; i < 4; i++)
#pragma unroll
    for (int j = 0; j < 4; j++) acc[i][j] = (f32x4){0.f, 0.f, 0.f, 0.f};
  const int nk = K / 64;
  auto kof = [&](int i) { return i * 64; };
  stage(0, kof(0));
  for (int kt = 0; kt < nk; kt++) {
    __syncthreads();
    if (kt + 1 < nk) stage((kt + 1) & 1, kof(kt + 1));
    if (MODE == 2) {
      if (kt >= 8 && kt < 16) {
#pragma unroll
        for (int q = 0; q < 4; q++) {
          bf16x8* cp = (bf16x8*)(lbase + (kt & 1) * 32768 + q * 1024);
          bf16x8 v = *cp;
          *cp = pack8(bfs(v[0]) * rs[q], bfs(v[1]) * rs[q], bfs(v[2]) * rs[q], bfs(v[3]) * rs[q],
                      bfs(v[4]) * rs[q], bfs(v[5]) * rs[q], bfs(v[6]) * rs[q], bfs(v[7]) * rs[q]);
        }
        __syncthreads();
      }
    }
    const char* sb = smem + (kt & 1) * 32768;
#pragma unroll
    for (int ks = 0; ks < 2; ks++) {
      bf16x8 ff[4], gg[4];
      const int co = ((ks * 4 + lg) ^ sw) * 16;
#pragma unroll
      for (int i = 0; i < 4; i++) {
        ff[i] = *(const bf16x8*)(sb + fro + i * 2048 + co);
        gg[i] = *(const bf16x8*)(sb + gro + i * 2048 + co);
      }
#pragma unroll
      for (int i = 0; i < 4; i++)
#pragma unroll
        for (int j = 0; j < 4; j++) acc[i][j] = mfma16(ff[i], gg[j], acc[i][j]);
    }
  }
  __syncthreads();
  if (swap) {
    if (MODE == 0) {
      const bool rope = (nt < 4) || nt == 6 || nt == 8;
#pragma unroll
      for (int mi = 0; mi < 4; mi++) {
        const int m = m0 + 64 * wr + 16 * mi + lr;
        if (rope) {
          const int pos = p.pos[m];
          f32x4 v = acc[0][mi];
          f32x4 o;
#pragma unroll
          for (int i = 0; i < 4; i++) {
            float pr = __shfl_xor(v[i], 32);
            float cs, sn; rope_cs(pos, 4 * (lg & 1) + i, cs, sn);
            o[i] = (lg < 2) ? (v[i] * cs - pr * sn) : (v[i] * cs + pr * sn);
          }
          acc[0][mi] = o;
        }
        {
          bf16_t* stg = (bf16_t*)smem + ((wave & 1) ? 2 * 9216 : 0) + (wave >> 1) * 4608;
#pragma unroll
          for (int ni = 0; ni < 4; ni++) {
            f32x4 v = acc[ni][mi];
            *(bf16x4*)(stg + (16 * mi + lr) * 72 + 16 * ni + 4 * lg) = pack4(v[0], v[1], v[2], v[3]);
          }
        }
      }
      {
        const bf16_t* stg = (const bf16_t*)smem + ((wave & 1) ? 2 * 9216 : 0) + (wave >> 1) * 4608;
        const int rr = lane >> 3, ch = lane & 7;
        const int nb0 = n0 + 64 * wc + ch * 8;
#pragma unroll
        for (int it = 0; it < 8; it++) {
          const int row = it * 8 + rr;
          const int m = m0 + 64 * wr + row;
          bf16x8 v = *(const bf16x8*)(stg + row * 72 + ch * 8);
          if (nt == 6 || nt == 8) {
            bf16_t* kd = ((nt == 6) ? p.KSC : p.KWC) + (((size_t)(m >> 12) * 2 + wc) * S_LEN + (m & 4095)) * 64;
            *(bf16x8*)(kd + ch * 8) = v;
          } else if (nb0 < NIN) {
            *(bf16x8*)(p.PROJ + (size_t)m * NIN + nb0) = v;
          }
        }
      }
      __syncthreads();
    } else if (MODE == 1) {
#pragma unroll
      for (int mi = 0; mi < 4; mi++) {
        const int m = m0 + 64 * wr + 16 * mi + lr;
#pragma unroll
        for (int ni = 0; ni < 4; ni++) {
          const int n = n0 + 64 * wc + 16 * ni + 4 * lg;
          f32x4 v = acc[ni][mi];
          *(bf16x4*)(p.KMEM + (size_t)m * 512 + n) = pack4(v[0], v[1], v[2], v[3]);
        }
      }
    } else {
#pragma unroll
      for (int mi = 0; mi < 4; mi++) {
        const int m = m0 + 64 * wr + 16 * mi + lr;
        float ss = 0.f;
#pragma unroll
        for (int ni = 0; ni < 4; ni++) {
          const int n = n0 + 64 * wc + 16 * ni + 4 * lg;
          float4 xv = *(const float4*)(p.x + (size_t)m * 1024 + n);
          f32x4 v = acc[ni][mi];
          float4 h; h.x = xv.x + v[0]; h.y = xv.y + v[1]; h.z = xv.z + v[2]; h.w = xv.w + v[3];
          ss += h.x * h.x + h.y * h.y + h.z * h.z + h.w * h.w;
          *(float4*)(p.out + (size_t)m * 1024 + n) = h;
        }
        ss += __shfl_xor(ss, 16); ss += __shfl_xor(ss, 32);
        if (lg == 0) atomicAdd(p.SS_OUT + m, ss);
      }
    }
  } else {
#pragma unroll
    for (int mi = 0; mi < 4; mi++)
#pragma unroll
      for (int ni = 0; ni < 4; ni++) {
        f32x4 v = acc[mi][ni];
        bf16x4 o = pack4(v[0], v[1], v[2], v[3]);
        if (MODE == 0) {
          const int b = m0 >> 12, s = (m0 & 4095) + 64 * wr + 16 * mi + 4 * lg;
          const int d = 16 * ni + lr;
          bf16_t* dst = (nt == 7) ? p.VST : p.VWT;
          *(bf16x4*)(dst + ((size_t)(b * 2 + wc) * 64 + d) * S_LEN + s) = o;
        } else {
          const int b = m0 >> 8, s = (m0 & 255) + 64 * wr + 16 * mi + 4 * lg;
          const int col = n0 - 512 + 64 * wc + 16 * ni + lr;
          const int h = col >> 7, d = col & 127;
          *(bf16x4*)(p.VMEMT + ((size_t)(b * 4 + h) * 128 + d) * 256 + s) = o;
        }
      }
  }
}

template <int MODE>
__device__ __forceinline__ void gemm_tile(const Params& p, int mt, int nt, char* smem) {
  gemm_tile_glds<MODE>(p, mt, nt, smem);
}

template <int DQK, int DV, int MASK, typename MaskF>
__device__ __forceinline__ void attn_tile(const bf16_t* sK, const bf16_t* sVt, const bf16x8 (&qf)[2][DQK / 32], f32x4 (&o)[DV / 16][2],
                                          float (&m)[2], float (&l)[2], float c, bool qsel0, bool qsel1, MaskF valid) {
  constexpr int KST = DQK + 8;
  const int lane = get_tid() & 63, lr = lane & 15, lg = lane >> 4;
  f32x4 s[4][2];
#pragma unroll
  for (int kt = 0; kt < 4; kt++) { s[kt][0] = (f32x4){0.f, 0.f, 0.f, 0.f}; s[kt][1] = (f32x4){0.f, 0.f, 0.f, 0.f}; }
#pragma unroll
  for (int ks = 0; ks < DQK / 32; ks++)
#pragma unroll
    for (int kt = 0; kt < 4; kt++) {
      bf16x8 a = *(const bf16x8*)(sK + (16 * kt + lr) * KST + ks * 32 + lg * 8);
      s[kt][0] = mfma16(a, qf[0][ks], s[kt][0]);
      s[kt][1] = mfma16(a, qf[1][ks], s[kt][1]);
    }
#pragma unroll
  for (int qt = 0; qt < 2; qt++) {
    const bool qs = qt ? qsel1 : qsel0;
    float mx = -1e30f;
    if (MASK) {
#pragma unroll
      for (int kt = 0; kt < 4; kt++)
#pragma unroll
        for (int i = 0; i < 4; i++) {
          bool v = valid(16 * kt + 4 * lg + i, qt);
          float sv = v ? s[kt][qt][i] * c : -1e30f;
          s[kt][qt][i] = sv; mx = fmaxf(mx, sv);
        }
    } else {
#pragma unroll
      for (int kt = 0; kt < 4; kt++) mx = fmaxf(fmaxf(mx, fmaxf(s[kt][qt][0], s[kt][qt][1])), fmaxf(s[kt][qt][2], s[kt][qt][3]));
      mx = qs ? mx * c : -1e30f;
    }
    mx = rowmax4(mx);
    const float mn = fmaxf(m[qt], mx);
    const float alpha = fexp2(m[qt] - mn);
    m[qt] = mn;
    float me;
    if (MASK) me = (mn > -1e29f) ? mn : 1e30f; else me = qs ? mn : 1e30f;
    float rs = 0.f;
#pragma unroll
    for (int kt = 0; kt < 4; kt++)
#pragma unroll
      for (int i = 0; i < 4; i++) {
        float pv = MASK ? fexp2(s[kt][qt][i] - me) : fexp2(fmaf(s[kt][qt][i], c, -me));
        s[kt][qt][i] = pv; rs += pv;
      }
    rs = rowsum4(rs);
    l[qt] = l[qt] * alpha + rs;
#pragma unroll
    for (int dt = 0; dt < DV / 16; dt++) {
      o[dt][qt][0] *= alpha; o[dt][qt][1] *= alpha; o[dt][qt][2] *= alpha; o[dt][qt][3] *= alpha;
    }
  }
#pragma unroll
  for (int k2 = 0; k2 < 2; k2++) {
    bf16x8 pb[2];
#pragma unroll
    for (int qt = 0; qt < 2; qt++)
      pb[qt] = pack8(s[2 * k2][qt][0], s[2 * k2][qt][1], s[2 * k2][qt][2], s[2 * k2][qt][3],
                     s[2 * k2 + 1][qt][0], s[2 * k2 + 1][qt][1], s[2 * k2 + 1][qt][2], s[2 * k2 + 1][qt][3]);
#pragma unroll
    for (int dt = 0; dt < DV / 16; dt++) {
      const bf16_t* vp = sVt + (16 * dt + lr) * 72 + 32 * k2 + 4 * lg;
      bf16x8 a = cat44(*(const bf16x4*)vp, *(const bf16x4*)(vp + 16));
      o[dt][0] = mfma16(a, pb[0], o[dt][0]);
      o[dt][1] = mfma16(a, pb[1], o[dt][1]);
    }
  }
}

__device__ __forceinline__ int next_bit_below(unsigned long long m, int below) {
  unsigned long long mm = (below >= 64) ? m : (m & ((1ull << below) - 1ull));
  return mm ? (63 - __clzll((long long)mm)) : -1;
}

__device__ void nsa_item(const Params& p, int item, char* smem) {
  const int tid = get_tid(), lane = tid & 63, wave = tid >> 6, lr = lane & 15, lg = lane >> 4;
  const int bg = item & 15, qb = 127 - (item >> 4);
  const int b = bg >> 1, g = bg & 1;
  const int t0 = qb * 32, cur = t0 >> 6;
  const int hq = g * 4 + wave;
  float* sImp = (float*)(smem + 55296);
  unsigned long long* sSel = (unsigned long long*)(smem + 63616);
  const float c = 0.125f * LOG2E;
  const size_t tokbase = (size_t)b * S_LEN + t0;
  const int r0 = tid >> 3, cc = tid & 7;

  bf16x8 qf[2][2];
#pragma unroll
  for (int qt = 0; qt < 2; qt++) {
    const bf16_t* row = p.PROJ + (tokbase + 16 * qt + lr) * NIN;
#pragma unroll
    for (int ks = 0; ks < 2; ks++) qf[qt][ks] = *(const bf16x8*)(row + C_Q + hq * 64 + 32 * ks + 8 * lg);
  }
  bf16_t* slab = (bf16_t*)(smem + 36864 + wave * 4608);
  auto emit = [&](f32x4 (&o)[4][2], float (&l)[2], int br) {
#pragma unroll
    for (int qt = 0; qt < 2; qt++) {
      const size_t tok = tokbase + 16 * qt + lr;
      const float gsc = sigmoid_f(bf2f(p.PROJ[tok * NIN + C_GL + hq * 3 + br])) / fmaxf(l[qt], 1e-30f);
#pragma unroll
      for (int dt = 0; dt < 4; dt++) {
        bf16_t* dst = slab + (16 * qt + lr) * 72 + 16 * dt + 4 * lg;
        f32x4 r = o[dt][qt];
        r[0] *= gsc; r[1] *= gsc; r[2] *= gsc; r[3] *= gsc;
        if (br > 0) { bf16x4 pv = *(const bf16x4*)dst; r[0] += bfs(pv[0]); r[1] += bfs(pv[1]); r[2] += bfs(pv[2]); r[3] += bfs(pv[3]); }
        *(bf16x4*)dst = pack4(r[0], r[1], r[2], r[3]);
      }
    }
    if (br == 2) {
      const int rr = lane >> 3, ch = lane & 7;
#pragma unroll
      for (int it = 0; it < 4; it++) {
        const int row = it * 8 + rr;
        const size_t tok = tokbase + row;
        const bf16x8 v = *(const bf16x8*)(slab + row * 72 + ch * 8);
        const bf16x8 ga = *(const bf16x8*)(p.PROJ + tok * NIN + C_GA + hq * 64 + ch * 8);
        *(bf16x8*)(p.MIX + tok * 1536 + hq * 64 + ch * 8) =
            pack8(bfs(v[0]) * silu_f(bfs(ga[0])), bfs(v[1]) * silu_f(bfs(ga[1])), bfs(v[2]) * silu_f(bfs(ga[2])), bfs(v[3]) * silu_f(bfs(ga[3])),
                  bfs(v[4]) * silu_f(bfs(ga[4])), bfs(v[5]) * silu_f(bfs(ga[5])), bfs(v[6]) * silu_f(bfs(ga[6])), bfs(v[7]) * silu_f(bfs(ga[7])));
      }
    }
  };
  auto store_kv = [&](int buf, bf16x8 (&rg)[4]) {
    bf16_t* sK = (bf16_t*)(smem + buf * 18432);
    bf16_t* sVt = sK + 64 * 72;
    *(bf16x8*)(sK + r0 * 72 + cc * 8) = rg[0];
    *(bf16x8*)(sK + (r0 + 32) * 72 + cc * 8) = rg[1];
    *(bf16x8*)(sVt + r0 * 72 + cc * 8) = rg[2];
    *(bf16x8*)(sVt + (r0 + 32) * 72 + cc * 8) = rg[3];
  };

  {
    const int ntiles = (t0 >> 10) + 1;
    const bf16_t* kb = p.KCMP + (size_t)bg * 256 * 64;
    const bf16_t* vb = p.VCMPT + (size_t)bg * 64 * 256;
    for (int pass = 0; pass < 2; pass++) {
      f32x4 o[4][2]; float m[2] = {-1e30f, -1e30f}, l[2] = {0.f, 0.f};
#pragma unroll
      for (int dt = 0; dt < 4; dt++) { o[dt][0] = (f32x4){0.f, 0.f, 0.f, 0.f}; o[dt][1] = (f32x4){0.f, 0.f, 0.f, 0.f}; }
      int ldn = 0;
      tile_pipeline<4>(ntiles,
        [&](int i, bf16x8 (&rg)[4]) {
          rg[0] = *(const bf16x8*)(kb + (size_t)(64 * i + r0) * 64 + cc * 8);
          rg[1] = *(const bf16x8*)(kb + (size_t)(64 * i + r0 + 32) * 64 + cc * 8);
          if (pass == 0) {
            rg[2] = *(const bf16x8*)(vb + (size_t)r0 * 256 + 64 * i + cc * 8);
            rg[3] = *(const bf16x8*)(vb + (size_t)(r0 + 32) * 256 + 64 * i + cc * 8);
          }
        },
        [&](int buf, bf16x8 (&rg)[4]) {
          const int nt = ldn++;
          if (pass == 1) {
#pragma unroll
            for (int i2 = 0; i2 < 2; i2++) {
              const int j = r0 + 32 * i2;
              bf16x8 ov;
#pragma unroll
              for (int x = 0; x < 8; x++) { int n = 64 * nt + cc * 8 + x; ov[x] = (n >= 4 * j - 1 && n <= 4 * j + 3) ? (short)0x3F80 : (short)0; }
              rg[2 + i2] = ov;
            }
          }
          store_kv(buf, rg);
        },
        [&](int i, int buf) {
          const bf16_t* sK = (const bf16_t*)(smem + buf * 18432);
          attn_tile<64, 64, 1>(sK, sK + 64 * 72, qf, o, m, l, c, true, true,
                               [&](int key, int qt) { return 16 * (64 * i + key) + 31 <= t0 + 16 * qt + lr; });
        });
      if (pass == 0) {
        emit(o, l, 0);
      } else {
        float inv[2];
#pragma unroll
        for (int qt = 0; qt < 2; qt++) inv[qt] = 1.f / fmaxf(l[qt], 1e-30f);
        for (int e2 = 0; e2 < 4; e2++) {
          if (wave == e2) {
#pragma unroll
            for (int dt = 0; dt < 4; dt++)
#pragma unroll
              for (int qt = 0; qt < 2; qt++)
#pragma unroll
                for (int i = 0; i < 4; i++) {
                  int j = 16 * dt + 4 * lg + i, q = 16 * qt + lr;
                  float v = o[dt][qt][i] * inv[qt];
                  if (e2 == 0) sImp[q * 65 + j] = v; else sImp[q * 65 + j] += v;
                }
          }
          __syncthreads();
        }
      }
    }
  }
  for (int qq = 0; qq < 8; qq++) {
    const int q = wave * 8 + qq;
    const int j = lane;
    float v = sImp[q * 65 + j];
    bool valid = j <= cur;
    bool forced = (j == 0) || (j == cur) || (j == cur - 1);
    float val = forced ? 1e9f : (valid ? v : -1e9f);
    int rank = 0;
#pragma unroll 16
    for (int jj = 0; jj < 64; jj++) {
      float ov = __int_as_float(__builtin_amdgcn_readlane(__float_as_int(val), jj));
      rank += ((ov > val) || (ov == val && jj < j)) ? 1 : 0;
    }
    unsigned long long mask = __ballot((rank < 16) && valid);
    if (lane == 0) sSel[q] = mask;
  }
  __syncthreads();
  unsigned long long any = 0ull;
  for (int q = 0; q < 32; q++) any |= sSel[q];
  unsigned long long mk[2];
  mk[0] = sSel[lr]; mk[1] = sSel[16 + lr];

  {
    f32x4 o[4][2]; float m[2] = {-1e30f, -1e30f}, l[2] = {0.f, 0.f};
#pragma unroll
    for (int dt = 0; dt < 4; dt++) { o[dt][0] = (f32x4){0.f, 0.f, 0.f, 0.f}; o[dt][1] = (f32x4){0.f, 0.f, 0.f, 0.f}; }
    const bf16_t* kb = p.KSC + (size_t)bg * S_LEN * 64;
    const bf16_t* vb = p.VST + (size_t)bg * 64 * S_LEN;
    const int ntiles = __popcll(any);
    int jl = 64, jc = 64;
    tile_pipeline<4>(ntiles,
      [&](int, bf16x8 (&rg)[4]) {
        jl = (jl > 0) ? next_bit_below(any, jl) : -1;
        const int jj = jl < 0 ? 0 : jl;
        rg[0] = *(const bf16x8*)(kb + (size_t)(64 * jj + r0) * 64 + cc * 8);
        rg[1] = *(const bf16x8*)(kb + (size_t)(64 * jj + r0 + 32) * 64 + cc * 8);
        rg[2] = *(const bf16x8*)(vb + (size_t)r0 * S_LEN + 64 * jj + cc * 8);
        rg[3] = *(const bf16x8*)(vb + (size_t)(r0 + 32) * S_LEN + 64 * jj + cc * 8);
      },
      store_kv,
      [&](int, int buf) {
        jc = next_bit_below(any, jc);
        const int j = jc;
        const bf16_t* sK = (const bf16_t*)(smem + buf * 18432);
        if (j == cur) {
          attn_tile<64, 64, 1>(sK, sK + 64 * 72, qf, o, m, l, c, true, true,
                               [&](int key, int qt) { return 64 * j + key <= t0 + 16 * qt + lr; });
        } else {
          attn_tile<64, 64, 0>(sK, sK + 64 * 72, qf, o, m, l, c, ((mk[0] >> j) & 1ull) != 0ull, ((mk[1] >> j) & 1ull) != 0ull,
                               [&](int, int) { return true; });
        }
      });
    emit(o, l, 1);
  }
  {
    f32x4 o[4][2]; float m[2] = {-1e30f, -1e30f}, l[2] = {0.f, 0.f};
#pragma unroll
    for (int dt = 0; dt < 4; dt++) { o[dt][0] = (f32x4){0.f, 0.f, 0.f, 0.f}; o[dt][1] = (f32x4){0.f, 0.f, 0.f, 0.f}; }
    const int jlo = (cur - 8 > 0) ? (cur - 8) : 0;
    const bf16_t* kb = p.KWC + (size_t)bg * S_LEN * 64;
    const bf16_t* vb = p.VWT + (size_t)bg * 64 * S_LEN;
    tile_pipeline<4>(cur - jlo + 1,
      [&](int i, bf16x8 (&rg)[4]) {
        const int j = cur - i;
        rg[0] = *(const bf16x8*)(kb + (size_t)(64 * j + r0) * 64 + cc * 8);
        rg[1] = *(const bf16x8*)(kb + (size_t)(64 * j + r0 + 32) * 64 + cc * 8);
        rg[2] = *(const bf16x8*)(vb + (size_t)r0 * S_LEN + 64 * j + cc * 8);
        rg[3] = *(const bf16x8*)(vb + (size_t)(r0 + 32) * S_LEN + 64 * j + cc * 8);
      },
      store_kv,
      [&](int i, int buf) {
        const int j = cur - i;
        const bf16_t* sK = (const bf16_t*)(smem + buf * 18432);
        if (j == cur || j == cur - 8) {
          attn_tile<64, 64, 1>(sK, sK + 64 * 72, qf, o, m, l, c, true, true, [&](int key, int qt) {
            int tq = t0 + 16 * qt + lr, kp = 64 * j + key;
            return (kp <= tq) && (kp > tq - 512);
          });
        } else {
          attn_tile<64, 64, 0>(sK, sK + 64 * 72, qf, o, m, l, c, true, true, [&](int, int) { return true; });
        }
      });
    emit(o, l, 2);
  }
}

__device__ void memattn_item(const Params& p, int item, char* smem) {
  const int tid = get_tid(), lane = tid & 63, wave = tid >> 6, lr = lane & 15, lg = lane >> 4;
  const int b = item >> 7, h = (item >> 5) & 3, qb = item & 31;
  const int t0 = qb * 128 + wave * 32;
  const size_t tokbase = (size_t)b * S_LEN + t0;
  bf16x8 qf[2][4];
#pragma unroll
  for (int qt = 0; qt < 2; qt++)
#pragma unroll
    for (int ks = 0; ks < 4; ks++) qf[qt][ks] = *(const bf16x8*)(p.PROJ + (tokbase + 16 * qt + lr) * NIN + C_QX + h * 128 + 32 * ks + 8 * lg);
  f32x4 o[8][2]; float m[2] = {-1e30f, -1e30f}, l[2] = {0.f, 0.f};
#pragma unroll
  for (int dt = 0; dt < 8; dt++) { o[dt][0] = (f32x4){0.f, 0.f, 0.f, 0.f}; o[dt][1] = (f32x4){0.f, 0.f, 0.f, 0.f}; }
  const float c = 0.08838834764831845f * LOG2E;
  const bf16_t* kb = p.KMEM + (size_t)b * 256 * 512 + h * 128;
  const bf16_t* vb = p.VMEMT + (size_t)(b * 4 + h) * 128 * 256;
  tile_pipeline1<8>(4,
    [&](int kt, bf16x8 (&rg)[8]) {
#pragma unroll
      for (int i = 0; i < 4; i++) {
        int ch = tid + 256 * i;
        rg[i] = *(const bf16x8*)(kb + (size_t)(64 * kt + (ch >> 4)) * 512 + (ch & 15) * 8);
        rg[4 + i] = *(const bf16x8*)(vb + (size_t)(ch >> 3) * 256 + 64 * kt + (ch & 7) * 8);
      }
    },
    [&](int buf, bf16x8 (&rg)[8]) {
      bf16_t* sK = (bf16_t*)(smem + buf * 35840);
      bf16_t* sVt = sK + 64 * 136;
#pragma unroll
      for (int i = 0; i < 4; i++) {
        int ch = tid + 256 * i;
        *(bf16x8*)(sK + (ch >> 4) * 136 + (ch & 15) * 8) = rg[i];
        *(bf16x8*)(sVt + (ch >> 3) * 72 + (ch & 7) * 8) = rg[4 + i];
      }
    },
    [&](int, int buf) {
      const bf16_t* sK = (const bf16_t*)(smem + buf * 35840);
      attn_tile<128, 128, 0>(sK, sK + 64 * 136, qf, o, m, l, c, true, true, [&](int, int) { return true; });
    });
#pragma unroll
  for (int qt = 0; qt < 2; qt++) {
    const size_t tok = tokbase + 16 * qt + lr;
    const float inv = 1.f / fmaxf(l[qt], 1e-30f);
#pragma unroll
    for (int dt = 0; dt < 8; dt++) {
      const int dbase = h * 128 + 16 * dt + 4 * lg;
      bf16x4 ga = *(const bf16x4*)(p.PROJ + tok * NIN + C_GX + dbase);
      f32x4 r = o[dt][qt];
      *(bf16x4*)(p.MIX + tok * 1536 + 1024 + dbase) =
          pack4(r[0] * inv * silu_f(bfs(ga[0])), r[1] * inv * silu_f(bfs(ga[1])), r[2] * inv * silu_f(bfs(ga[2])), r[3] * inv * silu_f(bfs(ga[3])));
    }
  }
}

__device__ void compress_item(const Params& p, int item, char* smem) {
  const int tid = get_tid(), lane = tid & 63, wave = tid >> 6, lr = lane & 15, lg = lane >> 4;
  const int which = item >> 7, rho0 = (item & 127) * 32;
  const bf16_t* W1T = which ? p.W1vT : p.W1kT;
  const bf16_t* W2T = which ? p.W2vT : p.W2kT;
  const float* pe = which ? p.cpv : p.cpk;
  const int col0 = which ? C_VC : C_KC;
  bf16_t* sA = (bf16_t*)smem;
  bf16_t* sW = sA + 32 * 72;
  bf16_t* sH = sW + 256 * 72;
  const int arow = tid >> 3, akc = tid & 7;
  const bf16_t* abase;
  {
    int rho = rho0 + arow; if (rho > 4079) rho = 4079;
    int b = rho / 510, rem = rho - b * 510, n = rem >> 1, g = rem & 1;
    abase = p.PROJ + ((size_t)b * S_LEN + 16 * n) * NIN + col0 + g * 64 + akc * 8;
  }
  const bf16_t* wbase = W1T + (size_t)arow * 2048 + akc * 8;
  f32x4 acc[2][4];
#pragma unroll
  for (int i = 0; i < 2; i++)
#pragma unroll
    for (int j = 0; j < 4; j++) acc[i][j] = (f32x4){0.f, 0.f, 0.f, 0.f};
  bf16x8 ra, rw[8];
  float4 rp0, rp1;
  auto load = [&](int kt) {
    ra = *(const bf16x8*)(abase + (size_t)kt * NIN);
    rp0 = *(const float4*)(pe + kt * 64 + akc * 8); rp1 = *(const float4*)(pe + kt * 64 + akc * 8 + 4);
#pragma unroll
    for (int i = 0; i < 8; i++) rw[i] = *(const bf16x8*)(wbase + (size_t)(32 * i) * 2048 + kt * 64);
  };
  load(0);
  for (int kt = 0; kt < 32; kt++) {
    __syncthreads();
    *(bf16x8*)(sA + arow * 72 + akc * 8) =
        pack8(bfs(ra[0]) + rp0.x, bfs(ra[1]) + rp0.y, bfs(ra[2]) + rp0.z, bfs(ra[3]) + rp0.w,
              bfs(ra[4]) + rp1.x, bfs(ra[5]) + rp1.y, bfs(ra[6]) + rp1.z, bfs(ra[7]) + rp1.w);
#pragma unroll
    for (int i = 0; i < 8; i++) *(bf16x8*)(sW + (arow + 32 * i) * 72 + akc * 8) = rw[i];
    __syncthreads();
    load(kt < 31 ? kt + 1 : 31);
#pragma unroll
    for (int ks = 0; ks < 2; ks++) {
      bf16x8 a0 = *(const bf16x8*)(sA + lr * 72 + ks * 32 + 8 * lg);
      bf16x8 a1 = *(const bf16x8*)(sA + (16 + lr) * 72 + ks * 32 + 8 * lg);
#pragma unroll
      for (int ct = 0; ct < 4; ct++) {
        bf16x8 bf = *(const bf16x8*)(sW + (64 * wave + 16 * ct + lr) * 72 + ks * 32 + 8 * lg);
        acc[0][ct] = mfma16(a0, bf, acc[0][ct]);
        acc[1][ct] = mfma16(a1, bf, acc[1][ct]);
      }
    }
  }
  __syncthreads();
#pragma unroll
  for (int rt = 0; rt < 2; rt++)
#pragma unroll
    for (int ct = 0; ct < 4; ct++)
#pragma unroll
      for (int i = 0; i < 4; i++) sH[(16 * rt + 4 * lg + i) * 264 + 64 * wave + 16 * ct + lr] = f2bf(silu_f(acc[rt][ct][i]));
  __syncthreads();
  f32x4 acc2[2] = {(f32x4){0.f, 0.f, 0.f, 0.f}, (f32x4){0.f, 0.f, 0.f, 0.f}};
#pragma unroll
  for (int ks = 0; ks < 8; ks++) {
    bf16x8 bf = *(const bf16x8*)(W2T + (size_t)(16 * wave + lr) * 256 + 32 * ks + 8 * lg);
#pragma unroll
    for (int rt = 0; rt < 2; rt++) {
      bf16x8 a = *(const bf16x8*)(sH + (16 * rt + lr) * 264 + 32 * ks + 8 * lg);
      acc2[rt] = mfma16(a, bf, acc2[rt]);
    }
  }
  const int col = 16 * wave + lr;
#pragma unroll
  for (int rt = 0; rt < 2; rt++)
#pragma unroll
    for (int i = 0; i < 4; i++) {
      int rho = rho0 + 16 * rt + 4 * lg + i;
      bool ok = rho < 4080;
      int rc = ok ? rho : 4079;
      int b = rc / 510, rem = rc - b * 510, n = rem >> 1, g = rem & 1;
      float v = acc2[rt][i];
      float pr = __shfl_xor(v, 8);
      if (which == 0) {
        if (wave == 0) {
          int pos = p.pos[b * S_LEN + 16 * n + 31];
          float cs, sn; rope_cs(pos, lr & 7, cs, sn);
          v = (lr < 8) ? (v * cs - pr * sn) : (v * cs + pr * sn);
        }
        if (ok) p.KCMP[((size_t)(b * 2 + g) * 256 + n) * 64 + col] = f2bf(v);
      } else {
        if (ok) p.VCMPT[((size_t)(b * 2 + g) * 64 + col) * 256 + n] = f2bf(v);
      }
    }
}

__device__ void conv_units(const Params& p, int u) {
  const int it = u >> 8, wvi = (u >> 6) & 3, ln = u & 63;
  const int cgp = ((it & 3) * 4 + wvi) * 8 + (ln >> 3), tg = (it >> 2) * 8 + (ln & 7);
  const int tok0 = tg * 8, s0 = tok0 & 4095, ch0 = cgp * 8;
  const int b = tok0 >> 12;
  bf16x8 in[11];
#pragma unroll
  for (int r = 0; r < 11; r++) {
    int s = s0 - 3 + r;
    if (s >= 0) in[r] = *(const bf16x8*)(p.PROJ + (size_t)(tok0 - 3 + r) * NIN + C_XBC + ch0);
    else in[r] = (bf16x8){0, 0, 0, 0, 0, 0, 0, 0};
  }
  float4 wv[4][2];
#pragma unroll
  for (int k = 0; k < 4; k++) { wv[k][0] = *(const float4*)(p.conv_w + k * 1024 + ch0); wv[k][1] = *(const float4*)(p.conv_w + k * 1024 + ch0 + 4); }
  float4 bv0 = *(const float4*)(p.conv_b + ch0), bv1 = *(const float4*)(p.conv_b + ch0 + 4);
  float w[4][8], bias[8];
#pragma unroll
  for (int k = 0; k < 4; k++) { w[k][0] = wv[k][0].x; w[k][1] = wv[k][0].y; w[k][2] = wv[k][0].z; w[k][3] = wv[k][0].w; w[k][4] = wv[k][1].x; w[k][5] = wv[k][1].y; w[k][6] = wv[k][1].z; w[k][7] = wv[k][1].w; }
  bias[0] = bv0.x; bias[1] = bv0.y; bias[2] = bv0.z; bias[3] = bv0.w; bias[4] = bv1.x; bias[5] = bv1.y; bias[6] = bv1.z; bias[7] = bv1.w;
  if (ch0 >= 512) {
#pragma unroll
    for (int tt = 0; tt < 8; tt++) {
      bf16x8 o;
#pragma unroll
      for (int j = 0; j < 8; j++) {
        float a = bias[j];
#pragma unroll
        for (int k = 0; k < 4; k++) a += bfs(in[tt + k][j]) * w[k][j];
        o[j] = (short)f2bf(silu_f(a));
      }
      *(bf16x8*)(p.BC + (size_t)(tok0 + tt) * 512 + (ch0 - 512)) = o;
    }
  }
  if (ch0 < 768) {
#pragma unroll
    for (int j = 0; j < 8; j++) {
      bf16x8 o;
#pragma unroll
      for (int tt = 0; tt < 8; tt++) {
        float a = bias[j];
#pragma unroll
        for (int k = 0; k < 4; k++) a += bfs(in[tt + k][j]) * w[k][j];
        o[tt] = (short)f2bf(silu_f(a));
      }
      const int ch = ch0 + j;
      bf16_t* dst;
      if (ch0 < 512) dst = p.XT + ((size_t)(b * 8 + (ch >> 6)) * 64 + (ch & 63)) * S_LEN + s0;
      else dst = p.BT + ((size_t)(b * 2 + ((ch - 512) >> 7)) * 128 + ((ch - 512) & 127)) * S_LEN + s0;
      *(bf16x8*)dst = o;
    }
  }
}

__device__ void ssd_states_item(const Params& p, int item, char* smem) {
  const int tid = get_tid(), lane = tid & 63, wave = tid >> 6, lr = lane & 15, lg = lane >> 4;
  const int h = item & 7, c = (item >> 3) & 31, b = item >> 8;
  const int g = h >> 2;
  bf16_t* sX = (bf16_t*)smem;
  bf16_t* sBt = sX + 64 * 136;
  float* sAcs = (float*)(smem + (64 + 128) * 136 * 2);
  float* sW = sAcs + 128;
  float* sTot = sW + 128;
  const size_t tok0 = (size_t)b * S_LEN + c * 128;
  const bf16_t* xt = p.XT + (size_t)(b * 8 + h) * 64 * S_LEN + c * 128;
  const bf16_t* bt = p.BT + (size_t)(b * 2 + g) * 128 * S_LEN + c * 128;
  __syncthreads();
  bf16x8 tx[4], tb[8];
#pragma unroll
  for (int i = 0; i < 4; i++) { int ch = tid + 256 * i; tx[i] = *(const bf16x8*)(xt + (size_t)(ch >> 4) * S_LEN + (ch & 15) * 8); }
#pragma unroll
  for (int i = 0; i < 8; i++) { int ch = tid + 256 * i; tb[i] = *(const bf16x8*)(bt + (size_t)(ch >> 4) * S_LEN + (ch & 15) * 8); }
  float dt = 0.f, cs = 0.f;
  if (tid < 128) {
    float raw = bf2f(p.PROJ[(tok0 + tid) * NIN + C_DT + h]) + p.dt_bias[h];
    dt = fmaxf(raw, 0.f) + log1pf(__expf(-fabsf(raw)));
    float a = -__expf(p.a_log[h]);
    cs = dt * a;
#pragma unroll
    for (int o = 1; o < 64; o <<= 1) { float t = __shfl_up(cs, o); if (lane >= o) cs += t; }
    if (lane == 63) sTot[wave] = cs;
  }
  __syncthreads();
  if (tid < 128) {
    if (wave == 1) cs += sTot[0];
    sAcs[tid] = cs;
  }
  __syncthreads();
  if (tid < 128) {
    float last = sAcs[127];
    sW[tid] = dt * __expf(last - cs);
    const size_t o = ((size_t)(b * 32 + c) * 8 + h) * 128 + tid;
    p.ACS[o] = cs; p.DTV[o] = dt;
    if (tid == 0) p.CHDEC[(b * 32 + c) * 8 + h] = __expf(last);
  }
#pragma unroll
  for (int i = 0; i < 8; i++) { int ch = tid + 256 * i; *(bf16x8*)(sBt + (ch >> 4) * 136 + (ch & 15) * 8) = tb[i]; }
  __syncthreads();
#pragma unroll
  for (int i = 0; i < 4; i++) {
    int ch = tid + 256 * i;
    const int l0 = (ch & 15) * 8;
    float4 w0 = *(const float4*)(sW + l0), w1 = *(const float4*)(sW + l0 + 4);
    bf16x8 r = tx[i];
    *(bf16x8*)(sX + (ch >> 4) * 136 + l0) = pack8(bfs(r[0]) * w0.x, bfs(r[1]) * w0.y, bfs(r[2]) * w0.z, bfs(r[3]) * w0.w,
                                                  bfs(r[4]) * w1.x, bfs(r[5]) * w1.y, bfs(r[6]) * w1.z, bfs(r[7]) * w1.w);
  }
  __syncthreads();
  f32x4 acc[4][2];
#pragma unroll
  for (int i = 0; i < 4; i++) { acc[i][0] = (f32x4){0.f, 0.f, 0.f, 0.f}; acc[i][1] = (f32x4){0.f, 0.f, 0.f, 0.f}; }
#pragma unroll
  for (int ks = 0; ks < 4; ks++) {
    const int l0 = 32 * ks + 8 * lg;
    bf16x8 bf0 = *(const bf16x8*)(sBt + (32 * wave + lr) * 136 + l0);
    bf16x8 bf1 = *(const bf16x8*)(sBt + (32 * wave + 16 + lr) * 136 + l0);
#pragma unroll
    for (int pt = 0; pt < 4; pt++) {
      bf16x8 a = *(const bf16x8*)(sX + (16 * pt + lr) * 136 + l0);
      acc[pt][0] = mfma16(a, bf0, acc[pt][0]);
      acc[pt][1] = mfma16(a, bf1, acc[pt][1]);
    }
  }
  bf16_t* st = (bf16_t*)p.STATES + ((size_t)(b * 32 + c) * 8 + h) * 8192;
#pragma unroll
  for (int pt = 0; pt < 4; pt++)
#pragma unroll
    for (int x = 0; x < 2; x++)
#pragma unroll
      for (int i = 0; i < 4; i++) st[(16 * pt + 4 * lg + i) * 128 + 32 * wave + 16 * x + lr] = f2bf(acc[pt][x][i]);
}

__device__ void scan_units(const Params& p, int q) {
  const int b = q >> 15, r2 = q & 32767, h = r2 >> 12;
  uint32_t* sw = (uint32_t*)p.STATES;
  float h0 = 0.f, h1 = 0.f;
  for (int c0 = 0; c0 < 32; c0 += 16) {
    uint32_t s[16]; float d[16];
#pragma unroll
    for (int i = 0; i < 16; i++) { s[i] = sw[(size_t)(b * 32 + c0 + i) * 32768 + r2]; d[i] = p.CHDEC[(b * 32 + c0 + i) * 8 + h]; }
#pragma unroll
    for (int i = 0; i < 16; i++) {
      sw[(size_t)(b * 32 + c0 + i) * 32768 + r2] = pk2(h0, h1);
      h0 = h0 * d[i] + __uint_as_float(s[i] << 16);
      h1 = h1 * d[i] + __uint_as_float(s[i] & 0xffff0000u);
    }
  }
}

__device__ void ssd_y_item(const Params& p, int item, char* smem) {
  const int tid = get_tid(), lane = tid & 63, wave = tid >> 6, lr = lane & 15, lg = lane >> 4;
  const int h = item & 7, c = (item >> 3) & 31, b = item >> 8;
  const int g = h >> 2;
  bf16_t* sB = (bf16_t*)smem;
  bf16_t* sXT = sB + 128 * 136;
  float* sAcs = (float*)(smem + (128 + 64) * 136 * 2);
  float* sDt = sAcs + 128;
  bf16_t* sPrev = (bf16_t*)(smem + (128 + 64) * 136 * 2 + 1024);
  const size_t tok0 = (size_t)b * S_LEN + c * 128;
  const bf16_t* xt = p.XT + (size_t)(b * 8 + h) * 64 * S_LEN + c * 128;
  const int LT[2] = {wave, 7 - wave};
  const bf16_t* prev = (const bf16_t*)p.STATES + ((size_t)(b * 32 + c) * 8 + h) * 8192;
  __syncthreads();
  {
    bf16x8 tb[8], tx[4];
    bf16x8 tp[4];
#pragma unroll
    for (int i = 0; i < 4; i++) { int ch = tid + 256 * i; tp[i] = *(const bf16x8*)(prev + (ch >> 4) * 128 + (ch & 15) * 8); }
#pragma unroll
    for (int i = 0; i < 8; i++) { int ch = tid + 256 * i; tb[i] = *(const bf16x8*)(p.BC + (tok0 + (ch >> 4)) * 512 + g * 128 + (ch & 15) * 8); }
#pragma unroll
    for (int i = 0; i < 4; i++) { int ch = tid + 256 * i; tx[i] = *(const bf16x8*)(xt + (size_t)(ch >> 4) * S_LEN + (ch & 15) * 8); }
    if (tid < 128) {
      const size_t o = ((size_t)(b * 32 + c) * 8 + h) * 128 + tid;
      sAcs[tid] = p.ACS[o]; sDt[tid] = p.DTV[o];
    }
#pragma unroll
    for (int i = 0; i < 8; i++) { int ch = tid + 256 * i; *(bf16x8*)(sB + (ch >> 4) * 136 + (ch & 15) * 8) = tb[i]; }
#pragma unroll
    for (int i = 0; i < 4; i++) { int ch = tid + 256 * i; *(bf16x8*)(sXT + (ch >> 4) * 136 + (ch & 15) * 8) = tx[i]; }
#pragma unroll
    for (int i = 0; i < 4; i++) { int ch = tid + 256 * i; *(bf16x8*)(sPrev + (ch >> 4) * 136 + (ch & 15) * 8) = tp[i]; }
  }
  bf16x8 cf[2][4];
  bf16x4 zpre[2][4];
#pragma unroll
  for (int li = 0; li < 2; li++) {
#pragma unroll
    for (int ks = 0; ks < 4; ks++)
      cf[li][ks] = *(const bf16x8*)(p.BC + (tok0 + 16 * LT[li] + lr) * 512 + 256 + g * 128 + 32 * ks + 8 * lg);
#pragma unroll
    for (int pt = 0; pt < 4; pt++)
      zpre[li][pt] = *(const bf16x4*)(p.PROJ + (tok0 + 16 * LT[li] + lr) * NIN + C_Z + h * 64 + 16 * pt + 4 * lg);
  }
  f32x4 acc[4][2];
#pragma unroll
  for (int i = 0; i < 4; i++) { acc[i][0] = (f32x4){0.f, 0.f, 0.f, 0.f}; acc[i][1] = (f32x4){0.f, 0.f, 0.f, 0.f}; }
  __syncthreads();
#pragma unroll
  for (int pt = 0; pt < 4; pt++)
#pragma unroll
    for (int ks = 0; ks < 4; ks++) {
      bf16x8 a = *(const bf16x8*)(sPrev + (16 * pt + lr) * 136 + 32 * ks + 8 * lg);
      acc[pt][0] = mfma16(a, cf[0][ks], acc[pt][0]);
      acc[pt][1] = mfma16(a, cf[1][ks], acc[pt][1]);
    }
#pragma unroll
  for (int li = 0; li < 2; li++) {
    float e = __expf(sAcs[16 * LT[li] + lr]);
#pragma unroll
    for (int pt = 0; pt < 4; pt++) { acc[pt][li][0] *= e; acc[pt][li][1] *= e; acc[pt][li][2] *= e; acc[pt][li][3] *= e; }
  }
#pragma unroll
  for (int li = 0; li < 2; li++) {
    const int lt = LT[li];
    const int lpos = 16 * lt + lr;
    const float acl = sAcs[lpos];
    for (int sp = 0; sp <= (lt >> 1); sp++) {
      f32x4 cb[2] = {(f32x4){0.f, 0.f, 0.f, 0.f}, (f32x4){0.f, 0.f, 0.f, 0.f}};
#pragma unroll
      for (int x = 0; x < 2; x++)
#pragma unroll
        for (int ks = 0; ks < 4; ks++) {
          bf16x8 bfr = *(const bf16x8*)(sB + (32 * sp + 16 * x + lr) * 136 + 32 * ks + 8 * lg);
          cb[x] = mfma16(bfr, cf[li][ks], cb[x]);
        }
      float mv[8];
#pragma unroll
      for (int x = 0; x < 2; x++)
#pragma unroll
        for (int i = 0; i < 4; i++) {
          const int s = 32 * sp + 16 * x + 4 * lg + i;
          mv[4 * x + i] = (s <= lpos) ? cb[x][i] * __expf(acl - sAcs[s]) * sDt[s] : 0.f;
        }
      bf16x8 mb = pack8(mv[0], mv[1], mv[2], mv[3], mv[4], mv[5], mv[6], mv[7]);
#pragma unroll
      for (int pt = 0; pt < 4; pt++) {
        const bf16_t* xp = sXT + (16 * pt + lr) * 136 + 32 * sp + 4 * lg;
        bf16x8 a = cat44(*(const bf16x4*)xp, *(const bf16x4*)(xp + 16));
        acc[pt][li] = mfma16(a, mb, acc[pt][li]);
      }
    }
  }
  const float dsk = p.d_skip[h];
#pragma unroll
  for (int li = 0; li < 2; li++) {
    const int lpos = 16 * LT[li] + lr;
    const size_t tok = tok0 + lpos;
    float ss = 0.f;
#pragma unroll
    for (int pt = 0; pt < 4; pt++) {
      const int pb = 16 * pt + 4 * lg;
      bf16x4 zv = zpre[li][pt];
      float y[4];
#pragma unroll
      for (int i = 0; i < 4; i++) {
        float xv = bf2f(sXT[(pb + i) * 136 + lpos]);
        y[i] = (acc[pt][li][i] + dsk * xv) * silu_f(bfs(zv[i]));
        ss += y[i] * y[i];
      }
      *(bf16x4*)(p.MIX + tok * 1536 + 512 + h * 64 + pb) = pack4(y[0], y[1], y[2], y[3]);
    }
    ss += __shfl_xor(ss, 16); ss += __shfl_xor(ss, 32);
    if (lg == 0) p.SS_SSD[tok * 8 + h] = ss;
  }
}

__device__ void final_rows(const Params& p, int gw, int nw) {
  const int lane = threadIdx.x & 63;
  const float4* gf = (const float4*)p.g_final;
  float4 gg[4];
#pragma unroll
  for (int i = 0; i < 4; i++) gg[i] = gf[lane + 64 * i];
  const int nb = gridDim.x;
  if ((nb & 7) == 0) {
    const int xcd = blockIdx.x & 7, lw = (blockIdx.x >> 3) * 4 + (threadIdx.x >> 6), nlw = (nb >> 3) * 4;
    for (int k = lw; k < 4096; k += nlw) {
      const int row = xcd * 4096 + 4095 - k;
      const float rr = rsqrtf(p.SS_OUT[row] * (1.f / 1024.f) + 1e-6f);
      float4* o = (float4*)(p.out + (size_t)row * 1024);
#pragma unroll
      for (int i = 0; i < 4; i++) {
        float4 t = o[lane + 64 * i];
        t.x *= rr * gg[i].x; t.y *= rr * gg[i].y; t.z *= rr * gg[i].z; t.w *= rr * gg[i].w;
        o[lane + 64 * i] = t;
      }
    }
  } else {
    for (int row = gw; row < T_TOK; row += nw) {
      const float rr = rsqrtf(p.SS_OUT[row] * (1.f / 1024.f) + 1e-6f);
      float4* o = (float4*)(p.out + (size_t)row * 1024);
#pragma unroll
      for (int i = 0; i < 4; i++) {
        float4 t = o[lane + 64 * i];
        t.x *= rr * gg[i].x; t.y *= rr * gg[i].y; t.z *= rr * gg[i].z; t.w *= rr * gg[i].w;
        o[lane + 64 * i] = t;
      }
    }
  }
}

__device__ __forceinline__ void grid_bar(unsigned* bar, unsigned k) {
  asm volatile("s_waitcnt vmcnt(0)" ::: "memory");
  __syncthreads();
  if (threadIdx.x == 0) {
    const unsigned nb = gridDim.x, r = blockIdx.x & 7u;
    const unsigned nsub = (nb - r + 7u) >> 3;
    const unsigned ngrp = nb < 8u ? nb : 8u;
    __builtin_amdgcn_fence(__ATOMIC_RELEASE, "agent");
    asm volatile("s_waitcnt vmcnt(0)" ::: "memory");
    const unsigned old = __hip_atomic_fetch_add(bar + 64 * r, 1u, __ATOMIC_RELAXED, __HIP_MEMORY_SCOPE_AGENT);
    if (old + 1u == k * nsub) {
      __builtin_amdgcn_fence(__ATOMIC_ACQ_REL, "agent");
      asm volatile("s_waitcnt vmcnt(0)" ::: "memory");
      __hip_atomic_fetch_add(bar + 64 * 8, 1u, __ATOMIC_RELAXED, __HIP_MEMORY_SCOPE_AGENT);
    }
    while (__hip_atomic_load(bar + 64 * 8, __ATOMIC_RELAXED, __HIP_MEMORY_SCOPE_AGENT) < k * ngrp) __builtin_amdgcn_s_sleep(1);
    __builtin_amdgcn_fence(__ATOMIC_ACQUIRE, "agent");
    asm volatile("s_waitcnt vmcnt(0)" ::: "memory");
  }
  __syncthreads();
}

__device__ __forceinline__ int next_item(unsigned* ctr, char* smem) {
  int* sh = (int*)(smem + SMEM_BYTES - 16);
  __syncthreads();
  if (threadIdx.x == 0) *sh = (int)__hip_atomic_fetch_add(ctr, 1u, __ATOMIC_RELAXED, __HIP_MEMORY_SCOPE_AGENT);
  __syncthreads();
  return *sh;
}

__global__ void __launch_bounds__(256, 2) hymba_fwd(Params p) {
  cg::grid_group grid = cg::this_grid();
  __shared__ __attribute__((aligned(16))) char smem[SMEM_BYTES];
  const int nb = gridDim.x, bid = blockIdx.x;
  unsigned bk = 0;

  if (p.out == nullptr) grid.sync();
  for (int rep = 0; rep < REP0; rep++) {
  phase_prep(p);
  grid_bar(p.BAR, ++bk);
  }
  for (int rep = 0; rep < REP1; rep++) {
  if ((nb & 7) == 0) {
    const int xcd = bid & 7, li = bid >> 3, nbx = nb >> 3;
    for (int e = li; e < 1120; e += nbx) {
      const int grp = e / 280, r = e - grp * 280;
      gemm_tile<0>(p, xcd * 32 + grp * 8 + (r & 7), r >> 3, smem);
    }
  } else {
    for (int it = bid; it < 256 * 35; it += nb) gemm_tile<0>(p, it / 35, it % 35, smem);
  }
  for (int j = bid; j < 128; j += nb) gemm_tile<1>(p, j >> 3, j & 7, smem);
  grid_bar(p.BAR, ++bk);
  }
  for (int rep = 0; rep < REP2; rep++) {
  for (int it = next_item(p.BAR + 64 * (9 + rep), smem); it < 256 + 1024 + 2048; it = next_item(p.BAR + 64 * (9 + rep), smem)) {
    if (it < 256) compress_item(p, it, smem);
    else if (it < 1280) memattn_item(p, it - 256, smem);
    else conv_units(p, (it - 1280) * 256 + get_tid());
  }
  grid_bar(p.BAR, ++bk);
  }
  for (int rep = 0; rep < REP3; rep++) {
  {
    const int xq = bid & 7;
    unsigned* ctr = p.BAR + 64 * (16 + xq + 8 * rep);
    for (int li = next_item(ctr, smem); li < 512; li = next_item(ctr, smem)) {
      if (li < 256) ssd_states_item(p, xq * 256 + li, smem);
      else { const int l2 = li - 256; nsa_item(p, ((l2 >> 1) << 4) | (xq + 8 * (l2 & 1)), smem); }
    }
  }
  grid_bar(p.BAR, ++bk);
  }
  if ((nb & 7) == 0) {
    const int xcd = bid & 7, li = bid >> 3, nbx = nb >> 3;
    for (int e = li; e < 128; e += nbx) scan_units(p, (xcd * 128 + e) * 256 + get_tid());
  } else {
    for (int it = bid; it < 1024; it += nb) scan_units(p, it * 256 + get_tid());
  }
  grid_bar(p.BAR, ++bk);
  for (int rep = 0; rep < REP5; rep++) {
  if ((nb & 7) == 0) {
    const int xcd = bid & 7, li = bid >> 3, nbx = nb >> 3;
    for (int e = li; e < 256; e += nbx) ssd_y_item(p, xcd * 256 + e, smem);
  } else {
    for (int it = bid; it < 2048; it += nb) ssd_y_item(p, it, smem);
  }
  grid_bar(p.BAR, ++bk);
  }
  if ((nb & 7) == 0) {
    const int xcd = bid & 7, li = bid >> 3, nbx = nb >> 3;
    for (int e = li; e < 256; e += nbx) gemm_tile<2>(p, xcd * 32 + (e >> 3), e & 7, smem);
  } else {
    for (int it = bid; it < 256 * 8; it += nb) gemm_tile<2>(p, it >> 3, it & 7, smem);
  }
  grid_bar(p.BAR, ++bk);
  final_rows(p, (bid * 256 + threadIdx.x) >> 6, (nb * 256) >> 6);
}

extern "C" void kernel_launch(void* const* d_in, const int* in_sizes, int n_in, void* d_out, int out_size, void* d_ws, size_t ws_size,
                              hipStream_t stream) {
  static int grid_blocks = 0;
  if (!grid_blocks) {
    int dev = 0, cus = 0, per_cu = 0;
    hipGetDevice(&dev);
    hipDeviceGetAttribute(&cus, hipDeviceAttributeMultiprocessorCount, dev);
    hipOccupancyMaxActiveBlocksPerMultiprocessor(&per_cu, hymba_fwd, 256, 0);
    if (per_cu < 1) per_cu = 1;
    if (per_cu > 4) per_cu = 4;
    grid_blocks = cus * per_cu;
  }
  Params p{};
  p.x = (const float*)d_in[0]; p.mem = (const float*)d_in[1]; p.pos = (const int*)d_in[2];
  p.g_in = (const float*)d_in[3]; p.w_in = (const float*)d_in[4]; p.cpk = (const float*)d_in[5];
  p.w1k = (const float*)d_in[6]; p.w2k = (const float*)d_in[7]; p.cpv = (const float*)d_in[8];
  p.w1v = (const float*)d_in[9]; p.w2v = (const float*)d_in[10]; p.conv_w = (const float*)d_in[11];
  p.conv_b = (const float*)d_in[12]; p.dt_bias = (const float*)d_in[13]; p.a_log = (const float*)d_in[14];
  p.d_skip = (const float*)d_in[15]; p.g_ssd = (const float*)d_in[16]; p.g_mem = (const float*)d_in[17];
  p.w_kv = (const float*)d_in[18]; p.w_out = (const float*)d_in[19]; p.g_final = (const float*)d_in[20];
  p.out = (float*)d_out;
  char* w = (char*)d_ws; size_t off = 0;
  auto take = [&](size_t bytes) { char* r = w + off; off += (bytes + 255) & ~(size_t)255; return r; };
  p.WinT = (bf16_t*)take((size_t)NINP * 1024 * 2);
  p.WoutT = (bf16_t*)take((size_t)1024 * 1536 * 2);
  p.WkvT = (bf16_t*)take((size_t)1024 * 1024 * 2);
  p.W1kT = (bf16_t*)take((size_t)256 * 2048 * 2);
  p.W1vT = (bf16_t*)take((size_t)256 * 2048 * 2);
  p.W2kT = (bf16_t*)take((size_t)64 * 256 * 2);
  p.W2vT = (bf16_t*)take((size_t)64 * 256 * 2);
  p.MEMB = (bf16_t*)take((size_t)2048 * 1024 * 2);
  p.PROJ = (bf16_t*)take((size_t)T_TOK * NIN * 2);
  p.VST = (bf16_t*)take((size_t)16 * 64 * S_LEN * 2);
  p.VWT = (bf16_t*)take((size_t)16 * 64 * S_LEN * 2);
  p.KMEM = (bf16_t*)take((size_t)2048 * 512 * 2);
  p.VMEMT = (bf16_t*)take((size_t)32 * 128 * 256 * 2);
  p.KCMP = (bf16_t*)take((size_t)16 * 256 * 64 * 2);
  p.VCMPT = (bf16_t*)take((size_t)16 * 64 * 256 * 2);
  p.XT = (bf16_t*)take((size_t)64 * 64 * S_LEN * 2);
  p.BC = (bf16_t*)take((size_t)T_TOK * 512 * 2);
  p.BT = (bf16_t*)take((size_t)16 * 128 * S_LEN * 2);
  p.MIX = (bf16_t*)take((size_t)T_TOK * 1536 * 2);
  p.XB = p.MIX;
  p.CHDEC = (float*)take((size_t)8 * 32 * 8 * 4);
  p.ACS = (float*)take((size_t)8 * 32 * 8 * 128 * 4);
  p.DTV = (float*)take((size_t)8 * 32 * 8 * 128 * 4);
  p.SS_SSD = (float*)take((size_t)T_TOK * 8 * 4);
  p.SS_OUT = (float*)take((size_t)T_TOK * 4);
  p.BAR = (unsigned*)take((size_t)(64 * 32 + 256) * 4);
  p.MTCNT = p.BAR + 64 * 32;
  p.STATES = (float*)d_out;
  p.KSC = (bf16_t*)((char*)d_out + (size_t)80 * 1024 * 1024);
  p.KWC = p.KSC + (size_t)16 * S_LEN * 64;
  if (off > ws_size) { fprintf(stderr, "workspace too small: need %zu have %zu\n", off, ws_size); return; }
  hipMemsetAsync(p.BAR, 0, (64 * 32 + 256) * 4, stream);
  void* args[] = {&p};
  hipError_t e = hipLaunchCooperativeKernel((void*)hymba_fwd, dim3(grid_blocks), dim3(256), args, 0, stream);
  if (e != hipSuccess) fprintf(stderr, "cooperative launch failed: %s (grid %d)\n", hipGetErrorString(e), grid_blocks);
}
```
